# Optimizing an MI355X kernel written in HIP

```python
import math
import jax, jax.numpy as jnp
from jax import lax
import numpy as np

D_MODEL = 1024
BATCH = 32
SEQ = 2048
DEPTH = 1

HEAD_DIM = 64
HEADS_DIFF = 4
HEADS_MOBA = 8
N_HEADS_TOTAL = HEADS_DIFF + HEADS_MOBA
DIFF_WIDTH = HEADS_DIFF * 2 * HEAD_DIM
MOBA_WIDTH = HEADS_MOBA * HEAD_DIM
MIX_WIDTH = DIFF_WIDTH + MOBA_WIDTH
IN_PROJ_WIDTH = 3 * MIX_WIDTH
DIFF_Q_BLOCK = 128
MOBA_BLOCK = 256
MOBA_TOPK = 3
MOBA_Q_CHUNK = 16
NUM_BUCKETS = 32
MAX_DISTANCE = 2048
N_GROUPS = 4
EXPERTS_PER_GROUP = 8
N_EXPERTS = N_GROUPS * EXPERTS_PER_GROUP
EXPERTS_PER_TOKEN = 2
EXPERT_HIDDEN = 256
DISPATCH_CHUNK = 256
RMS_EPS = 1e-6
NEG_INF = -1e30

kernel_name = 'hybrid_diffattn_moba_hier_moe'


def rms_norm(x, g):
    xf = x.astype(jnp.float32)
    y = xf * lax.rsqrt(jnp.mean(xf * xf, axis=-1, keepdims=True) + RMS_EPS)
    return (y * g.astype(jnp.float32)).astype(x.dtype)


def t5_bucket(dist):
    n = jnp.maximum(dist, 0)
    max_exact = NUM_BUCKETS // 2
    nf = jnp.maximum(n, 1).astype(jnp.float32)
    large = max_exact + (jnp.log(nf / max_exact) / math.log(MAX_DISTANCE / max_exact)
                         * (NUM_BUCKETS - max_exact)).astype(jnp.int32)
    large = jnp.minimum(large, NUM_BUCKETS - 1)
    return jnp.where(n < max_exact, n, large)


def diff_attention(q, k, v, q_g, k_g, lq1, lk1, lq2, lk2, sub_g, bias_table, lambda_init):
    B, S, H = q.shape[:3]
    q = rms_norm(q, q_g).transpose(0, 2, 3, 1, 4)
    k = rms_norm(k, k_g).transpose(0, 2, 3, 1, 4)
    v = v.transpose(0, 2, 1, 3)
    f32 = jnp.float32
    lam = (jnp.exp(jnp.sum(lq1.astype(f32) * lk1.astype(f32)))
           - jnp.exp(jnp.sum(lq2.astype(f32) * lk2.astype(f32))) + lambda_init)
    scale = HEAD_DIM ** -0.5
    kpos = jnp.arange(S)

    def block(i):
        s0 = i * DIFF_Q_BLOCK
        qb = lax.dynamic_slice_in_dim(q, s0, DIFF_Q_BLOCK, axis=3)
        logits = jnp.einsum('bhmqd,bhmkd->bhmqk', qb, k, preferred_element_type=f32) * scale
        dist = (s0 + jnp.arange(DIFF_Q_BLOCK))[:, None] - kpos[None, :]
        bias = bias_table[t5_bucket(dist)].astype(f32).transpose(2, 0, 1)
        logits = jnp.where(dist >= 0, logits + bias[None, :, None], NEG_INF)
        p = jax.nn.softmax(logits, axis=-1)
        w = p[:, :, 0] - lam * p[:, :, 1]
        return jnp.einsum('bhqk,bhkc->bhqc', w.astype(v.dtype), v)

    out = lax.map(block, jnp.arange(S // DIFF_Q_BLOCK))
    out = out.transpose(1, 0, 3, 2, 4).reshape(B, S, H, 2 * HEAD_DIM)
    out = rms_norm(out, sub_g) * (1.0 - lambda_init)
    return out.reshape(B, S, H * 2 * HEAD_DIM)


def moba_attention(q, k, v, q_g, k_g, bias_table):
    B, S, H, d = q.shape
    f32 = jnp.float32
    q = rms_norm(q, q_g).transpose(0, 2, 1, 3)
    k = rms_norm(k, k_g).transpose(0, 2, 1, 3)
    v = v.transpose(0, 2, 1, 3)
    n_kb = -(-S // MOBA_BLOCK)
    pad = n_kb * MOBA_BLOCK - S
    k_blocks = jnp.pad(k, ((0, 0), (0, 0), (0, pad), (0, 0))).reshape(B, H, n_kb, MOBA_BLOCK, d)
    v_blocks = jnp.pad(v, ((0, 0), (0, 0), (0, pad), (0, 0))).reshape(B, H, n_kb, MOBA_BLOCK, d)
    k_mean = jnp.mean(k_blocks.astype(f32), axis=3)
    top = min(MOBA_TOPK, n_kb)
    scale = HEAD_DIM ** -0.5
    bi = jnp.arange(B)[:, None, None, None]
    hi = jnp.arange(H)[None, :, None, None]
    blk_off = jnp.arange(MOBA_BLOCK)

    def chunk(i):
        s0 = i * MOBA_Q_CHUNK
        qc = lax.dynamic_slice_in_dim(q, s0, MOBA_Q_CHUNK, axis=2)
        qpos = s0 + jnp.arange(MOBA_Q_CHUNK)
        own = s0 // MOBA_BLOCK
        gate = jnp.einsum('bhqd,bhnd->bhqn', qc.astype(f32), k_mean)
        gate = jnp.where(jnp.arange(n_kb) < own, gate, NEG_INF)
        _, sel = lax.top_k(gate, top)
        sel_valid = jnp.arange(top)[:, None] < own
        k_sel = k_blocks[bi, hi, sel]
        v_sel = v_blocks[bi, hi, sel]
        sel_logits = jnp.einsum('bhqd,bhqtkd->bhqtk', qc, k_sel, preferred_element_type=f32) * scale
        sel_pos = sel[..., None] * MOBA_BLOCK + blk_off
        sel_bias = bias_table[t5_bucket(qpos[:, None, None] - sel_pos), hi[..., None]].astype(f32)
        sel_logits = jnp.where(sel_valid, sel_logits + sel_bias, NEG_INF)
        k_own = lax.dynamic_index_in_dim(k_blocks, own, axis=2, keepdims=False)
        v_own = lax.dynamic_index_in_dim(v_blocks, own, axis=2, keepdims=False)
        dist_own = qpos[:, None] - (own * MOBA_BLOCK + blk_off)[None, :]
        own_bias = bias_table[t5_bucket(dist_own)].astype(f32).transpose(2, 0, 1)[None]
        own_logits = jnp.einsum('bhqd,bhkd->bhqk', qc, k_own, preferred_element_type=f32) * scale
        own_logits = jnp.where(dist_own >= 0, own_logits + own_bias, NEG_INF)
        logits = jnp.concatenate([sel_logits.reshape(B, H, MOBA_Q_CHUNK, top * MOBA_BLOCK), own_logits], axis=-1)
        p = jax.nn.softmax(logits, axis=-1).astype(v.dtype)
        p_sel = p[..., :top * MOBA_BLOCK].reshape(B, H, MOBA_Q_CHUNK, top, MOBA_BLOCK)
        p_own = p[..., top * MOBA_BLOCK:]
        return (jnp.einsum('bhqtk,bhqtkd->bhqd', p_sel, v_sel)
                + jnp.einsum('bhqk,bhkd->bhqd', p_own, v_own))

    out = lax.map(chunk, jnp.arange(S // MOBA_Q_CHUNK))
    return out.transpose(1, 0, 3, 2, 4).reshape(B, S, H * d)


def hier_moe(h, router_group, router_expert, w_gate, w_up, w_down):
    B, S, D = h.shape
    N = B * S
    t = h.reshape(N, D)
    f32 = jnp.float32
    g_logits = (t @ router_group).astype(f32)
    g_prob = jax.nn.softmax(g_logits, axis=-1)
    g = jnp.argmax(g_logits, axis=-1)
    p_group = jnp.take_along_axis(g_prob, g[:, None], axis=-1)
    e_logits_all = jnp.einsum('nd,gde->nge', t, router_expert).astype(f32)
    e_logits = jnp.take_along_axis(e_logits_all, g[:, None, None], axis=1)[:, 0]
    top_v, top_e = lax.top_k(e_logits, EXPERTS_PER_TOKEN)
    weight = p_group * jax.nn.softmax(top_v, axis=-1)
    expert_id = g[:, None] * EXPERTS_PER_GROUP + top_e
    A = N * EXPERTS_PER_TOKEN
    C = DISPATCH_CHUNK
    eid = expert_id.reshape(A)
    tok = jnp.repeat(jnp.arange(N, dtype=jnp.int32), EXPERTS_PER_TOKEN)
    w_flat = weight.reshape(A)
    order = jnp.argsort(eid)
    eid_s, tok_s, w_s = eid[order], tok[order], w_flat[order]
    counts = jax.ops.segment_sum(jnp.ones((A,), jnp.int32), eid, num_segments=N_EXPERTS)
    start = jnp.cumsum(counts) - counts
    pad_counts = ((counts + C - 1) // C) * C
    pad_end = jnp.cumsum(pad_counts)
    pad_start = pad_end - pad_counts
    dest = pad_start[eid_s] + (jnp.arange(A, dtype=jnp.int32) - start[eid_s])
    P = A + N_EXPERTS * C
    n_chunks = P // C
    slot_tok = jnp.zeros((P,), jnp.int32).at[dest].set(tok_s)
    slot_w = jnp.zeros((P,), f32).at[dest].set(w_s)
    chunk_e = jnp.minimum(jnp.searchsorted(pad_end, jnp.arange(n_chunks) * C, side='right'), N_EXPERTS - 1)

    def run(args):
        e, toks = args
        xc = t[toks]
        hid = jax.nn.silu(xc @ w_gate[e]) * (xc @ w_up[e])
        return hid @ w_down[e]

    out = lax.map(run, (chunk_e, slot_tok.reshape(n_chunks, C))).reshape(P, D)
    y = jnp.zeros((N, D), t.dtype).at[slot_tok].add((out * slot_w[:, None]).astype(t.dtype))
    return y.reshape(B, S, D)


def setup_inputs(seed: int = 0) -> dict:
    key = jax.random.key(seed)
    ks = jax.random.split(key, 20)
    f32 = jnp.float32

    def nrm(k, shape, scale):
        return jax.random.normal(k, shape, f32) * scale

    def gain(k, shape):
        return 1.0 + 0.05 * jax.random.normal(k, shape, f32)

    return {
        'x': nrm(ks[0], (BATCH, SEQ, D_MODEL), 1.0),
        'norm1_g': gain(ks[1], (DEPTH, D_MODEL)),
        'w_in': nrm(ks[2], (DEPTH, D_MODEL, IN_PROJ_WIDTH), D_MODEL ** -0.5),
        'diff_q_g': gain(ks[3], (DEPTH, HEAD_DIM)),
        'diff_k_g': gain(ks[4], (DEPTH, HEAD_DIM)),
        'lambda_q1': nrm(ks[5], (DEPTH, HEAD_DIM), 0.1),
        'lambda_k1': nrm(ks[6], (DEPTH, HEAD_DIM), 0.1),
        'lambda_q2': nrm(ks[7], (DEPTH, HEAD_DIM), 0.1),
        'lambda_k2': nrm(ks[8], (DEPTH, HEAD_DIM), 0.1),
        'diff_sub_g': gain(ks[9], (DEPTH, 2 * HEAD_DIM)),
        'moba_q_g': gain(ks[10], (DEPTH, HEAD_DIM)),
        'moba_k_g': gain(ks[11], (DEPTH, HEAD_DIM)),
        'rel_bias': nrm(ks[12], (NUM_BUCKETS, N_HEADS_TOTAL), 0.5),
        'w_out': nrm(ks[13], (DEPTH, MIX_WIDTH, D_MODEL), MIX_WIDTH ** -0.5),
        'norm2_g': gain(ks[14], (DEPTH, D_MODEL)),
        'router_group': nrm(ks[15], (DEPTH, D_MODEL, N_GROUPS), D_MODEL ** -0.5),
        'router_expert': nrm(ks[16], (DEPTH, N_GROUPS, D_MODEL, EXPERTS_PER_GROUP), D_MODEL ** -0.5),
        'w_gate': nrm(ks[17], (DEPTH, N_EXPERTS, D_MODEL, EXPERT_HIDDEN), D_MODEL ** -0.5),
        'w_up': nrm(ks[18], (DEPTH, N_EXPERTS, D_MODEL, EXPERT_HIDDEN), D_MODEL ** -0.5),
        'w_down': nrm(ks[19], (DEPTH, N_EXPERTS, EXPERT_HIDDEN, D_MODEL), EXPERT_HIDDEN ** -0.5),
    }


def reference(x, norm1_g, w_in, diff_q_g, diff_k_g, lambda_q1, lambda_k1, lambda_q2, lambda_k2,
              diff_sub_g, moba_q_g, moba_k_g, rel_bias, w_out, norm2_g, router_group,
              router_expert, w_gate, w_up, w_down):
    B, S, _ = x.shape
    bias_diff = rel_bias[:, :HEADS_DIFF]
    bias_moba = rel_bias[:, HEADS_DIFF:]
    splits = [DIFF_WIDTH, 2 * DIFF_WIDTH, 3 * DIFF_WIDTH,
              3 * DIFF_WIDTH + MOBA_WIDTH, 3 * DIFF_WIDTH + 2 * MOBA_WIDTH]
    for layer in range(DEPTH):
        lambda_init = 0.8 - 0.6 * math.exp(-0.3 * layer)
        h = rms_norm(x, norm1_g[layer])
        proj = h @ w_in[layer]
        q_d, k_d, v_d, q_m, k_m, v_m = jnp.split(proj, splits, axis=-1)
        y_d = diff_attention(q_d.reshape(B, S, HEADS_DIFF, 2, HEAD_DIM),
                             k_d.reshape(B, S, HEADS_DIFF, 2, HEAD_DIM),
                             v_d.reshape(B, S, HEADS_DIFF, 2 * HEAD_DIM),
                             diff_q_g[layer], diff_k_g[layer], lambda_q1[layer], lambda_k1[layer],
                             lambda_q2[layer], lambda_k2[layer], diff_sub_g[layer], bias_diff, lambda_init)
        y_m = moba_attention(q_m.reshape(B, S, HEADS_MOBA, HEAD_DIM),
                             k_m.reshape(B, S, HEADS_MOBA, HEAD_DIM),
                             v_m.reshape(B, S, HEADS_MOBA, HEAD_DIM),
                             moba_q_g[layer], moba_k_g[layer], bias_moba)
        x = x + jnp.concatenate([y_d, y_m], axis=-1) @ w_out[layer]
        x = x + hier_moe(rms_norm(x, norm2_g[layer]), router_group[layer], router_expert[layer],
                         w_gate[layer], w_up[layer], w_down[layer])
    return x
```

```cpp
#include <hip/hip_runtime.h>
#include <cstdint>
#include <cstdio>

typedef unsigned short bf16_t;
typedef unsigned v4u __attribute__((ext_vector_type(4)));
typedef unsigned v2u __attribute__((ext_vector_type(2)));
typedef float f32x4 __attribute__((ext_vector_type(4)));
#define LAS __attribute__((address_space(3)))

constexpr int BATCH = 32, SEQ = 2048, DM = 1024, NTOK = BATCH * SEQ;
constexpr int HD = 64, HDIFF = 4, HMOBA = 8, NPROJ = 3072;
constexpr int NEXP = 32, EHID = 256, NLIST = 64;
constexpr int LIST_CAP = NTOK;
constexpr float RMS_EPS = 1e-6f;
constexpr float LOG2E = 1.4426950408889634f;
constexpr float C2 = 0.125f * LOG2E;
constexpr float LAMBDA_INIT = 0.2f;

constexpr size_t MiB = 1u << 20;
constexpr size_t WS_CTL = 0, CTL_ZERO_BYTES = 1 * MiB;
constexpr size_t WS_CONST = 1 * MiB;
constexpr size_t WS_WIN = 2 * MiB, WS_WOUT = 8 * MiB, WS_WR = 10 * MiB, WS_WGU = 12 * MiB, WS_WD = 44 * MiB;
constexpr size_t WS_QD = 64 * MiB, WS_KD = 128 * MiB, WS_VD = 192 * MiB, WS_QM = 256 * MiB, WS_KM = 320 * MiB, WS_VM = 384 * MiB;
constexpr size_t WS_XN = 448 * MiB, WS_Y = 448 * MiB;
constexpr size_t WS_X1B = 576 * MiB, WS_SS = 704 * MiB  , WS_R2 = 708 * MiB, WS_KMEAN = 709 * MiB;
constexpr size_t WS_PA = 64 * MiB, WS_HID = 192 * MiB, WS_LTOK = 272 * MiB, WS_LW = 288 * MiB;
constexpr size_t WS_END = 711 * MiB;
constexpr int CW_CNT = 1024;
constexpr int CF_LAMBDA = 0, CF_OFF = 16, CF_GAIN = 64  , CF_BT = 1024;

__device__ __forceinline__ float bf2f(bf16_t v) { return __uint_as_float(((unsigned)v) << 16); }
__device__ __forceinline__ unsigned f2bf(float f) { unsigned u = __float_as_uint(f); return (u + 0x7fffu + ((u >> 16) & 1u)) >> 16; }
__device__ __forceinline__ unsigned pk2(float lo, float hi) { return f2bf(lo) | (f2bf(hi) << 16); }
__device__ __forceinline__ float wave_sum(float v) {
#pragma unroll
    for (int o = 1; o < 64; o <<= 1) v += __shfl_xor(v, o);
    return v;
}
__device__ __forceinline__ float wave_max(float v) {
#pragma unroll
    for (int o = 1; o < 64; o <<= 1) v = fmaxf(v, __shfl_xor(v, o));
    return v;
}
__host__ __device__ __forceinline__ int phys_in(int c) { const int pn = c >> 8, cc = c & 255; return 256 * pn + 128 * ((cc >> 5) & 1) + 32 * (cc >> 6) + (cc & 31); }
__device__ __forceinline__ int t5_bucket(int d) {
    if (d < 16) return d;
    const float nf = (float)d;
    int large = 16 + (int)(logf(nf / 16.0f) / 4.852030263919617f * 16.0f);
    return large < 31 ? large : 31;
}

struct Inputs {
    const float *x, *norm1_g, *w_in, *diff_q_g, *diff_k_g, *lq1, *lk1, *lq2, *lk2, *diff_sub_g, *moba_q_g, *moba_k_g, *rel_bias, *w_out, *norm2_g,
        *router_group, *router_expert, *w_gate, *w_up, *w_down;
};

__device__ __forceinline__ void p0_tr_item(const float* W, int ldw, int k0, int n_src, const float* gk, bf16_t* dst, int drow0, int dpitch, LAS float* scr, int lane) {
#pragma unroll 8
    for (int i = 0; i < 32; ++i) {
        const int kk = 2 * i + (lane >> 5);
        float v = W[(size_t)(k0 + kk) * ldw + n_src + (lane & 31)];
        if (gk) v *= gk[k0 + kk];
        scr[kk * 33 + (lane & 31)] = v;
    }
    asm volatile("s_waitcnt lgkmcnt(0)" ::: "memory");
    const int c = lane & 7;
#pragma unroll
    for (int j = 0; j < 4; ++j) {
        const int n = (lane >> 3) + 8 * j; const LAS float* s = scr + (8 * c) * 33 + n;
        v4u o; o.x = pk2(s[0 * 33], s[1 * 33]); o.y = pk2(s[2 * 33], s[3 * 33]); o.z = pk2(s[4 * 33], s[5 * 33]); o.w = pk2(s[6 * 33], s[7 * 33]);
        *(v4u*)(dst + (size_t)(drow0 + n) * dpitch + k0 + 8 * c) = o;
    }
    asm volatile("s_waitcnt lgkmcnt(0)" ::: "memory");
}

__device__ __forceinline__ void p0_prologue(const Inputs& in, unsigned char* ws, int gw, int NGW, int lane, LAS float* scr) {
    bf16_t* WIN_T = (bf16_t*)(ws + WS_WIN); bf16_t* WOUT_T = (bf16_t*)(ws + WS_WOUT); bf16_t* WR_T = (bf16_t*)(ws + WS_WR);
    bf16_t* WGU_T = (bf16_t*)(ws + WS_WGU); bf16_t* WD_T = (bf16_t*)(ws + WS_WD); bf16_t* XN = (bf16_t*)(ws + WS_XN);
    float* CF = (float*)(ws + WS_CONST);
    constexpr int I_IN = 16 * 96, I_OUT = 16 * 32, I_GU = 32 * 16 * 16, I_D = 32 * 4 * 32, NITEMS = I_IN + I_OUT + I_GU + I_D;
    for (int it = gw; it < NITEMS; it += NGW) {
        int r = it;
        if (r < I_IN) {
            const int kb = r / 96, nb = r % 96, p0 = 32 * nb, pn = p0 >> 8, pp = p0 & 255, bj = pp >> 7, wc = (pp >> 5) & 3;
            p0_tr_item(in.w_in, NPROJ, 64 * kb, 256 * pn + 64 * wc + 32 * bj, in.norm1_g, WIN_T, p0, DM, scr, lane); continue; }
        r -= I_IN;
        if (r < I_OUT) { const int kb = r / 32, nb = r % 32; p0_tr_item(in.w_out, DM, 64 * kb, 32 * nb, nullptr, WOUT_T, 32 * nb, DM, scr, lane); continue; }
        r -= I_OUT;
        if (r < I_GU) {
            const int e = r / 256, rr = r % 256, kb = rr / 16, nb = rr % 16, p0 = 32 * nb, pn = p0 >> 8, bj = (p0 >> 7) & 1, j0 = p0 & 127;
            const float* src = (bj ? in.w_up : in.w_gate) + (size_t)e * DM * EHID;
            p0_tr_item(src, EHID, 64 * kb, 128 * pn + j0, in.norm2_g, WGU_T + (size_t)e * 512 * DM, p0, DM, scr, lane); continue; }
        r -= I_GU;
        { const int e = r / 128, rr = r % 128, kb = rr / 32, nb = rr % 32;
          p0_tr_item(in.w_down + (size_t)e * EHID * DM, DM, 64 * kb, 32 * nb, nullptr, WD_T + (size_t)e * DM * EHID, 32 * nb, EHID, scr, lane); }
    }
    for (int idx = gw * 64 + lane; idx < 256 * DM; idx += NGW * 64) {
        const int p = idx >> 10, k = idx & 1023, g = (p >> 5) & 3, i = p & 31; float v = 0.f;
        if (p < 128) { if (i < 8) v = in.norm2_g[k] * in.router_expert[((size_t)g * DM + k) * 8 + i]; else if (i < 12) v = in.norm2_g[k] * in.router_group[k * 4 + (i - 8)]; }
        WR_T[idx] = (bf16_t)f2bf(v);
    }
    for (int idx = gw * 64 + lane; idx < 12 * 2048; idx += NGW * 64) {
        const int h = idx >> 11, d = idx & 2047; CF[CF_BT + idx] = in.rel_bias[t5_bucket(d) * 12 + h] * LOG2E;
    }
    if (gw == 0) {
        float a = in.lq1[lane] * in.lk1[lane], b = in.lq2[lane] * in.lk2[lane];
        a = wave_sum(a); b = wave_sum(b);
        const float mqd = wave_max(fabsf(in.diff_q_g[lane])), mkd = wave_max(fabsf(in.diff_k_g[lane]));
        const float mqm = wave_max(fabsf(in.moba_q_g[lane])), mkm = wave_max(fabsf(in.moba_k_g[lane]));
        if (lane == 0) CF[CF_LAMBDA] = expf(a) - expf(b) + LAMBDA_INIT;
        CF[CF_GAIN + lane] = in.diff_q_g[lane]; CF[CF_GAIN + 64 + lane] = in.diff_k_g[lane]; CF[CF_GAIN + 128 + lane] = in.moba_q_g[lane]; CF[CF_GAIN + 192 + lane] = in.moba_k_g[lane];
        if (lane < 12) {
            float mb = -1e30f; for (int bk = 0; bk < 32; ++bk) mb = fmaxf(mb, in.rel_bias[bk * 12 + lane]);
            const float qk = lane < 4 ? mqd * mkd : mqm * mkm;
            CF[CF_OFF + lane] = (8.0f * qk + mb) * LOG2E;
        }
    }
    for (int m = gw; m < NTOK; m += NGW) {
        const f32x4* xr = (const f32x4*)(in.x + (size_t)m * DM) + lane;
        f32x4 v[4]; float s = 0.f;
#pragma unroll
        for (int j = 0; j < 4; ++j) { v[j] = xr[64 * j]; s += (v[j].x * v[j].x + v[j].y * v[j].y) + (v[j].z * v[j].z + v[j].w * v[j].w); }
        const float r = rsqrtf(wave_sum(s) * (1.f / DM) + RMS_EPS);
        unsigned long long* o8 = (unsigned long long*)(XN + (size_t)m * DM) + lane;
#pragma unroll
        for (int j = 0; j < 4; ++j) o8[64 * j] = (unsigned long long)pk2(v[j].x * r, v[j].y * r) | ((unsigned long long)pk2(v[j].z * r, v[j].w * r) << 32);
    }
}

namespace pg8 {
typedef short bf16x8 __attribute__((ext_vector_type(8)));
constexpr int BM = 256, BK = 64, HALF = 128, HTB = HALF * BK * 2, STAGE_BYTES = 8 * HTB, NXCD = 8, WGM = 8;

__host__ __device__ __forceinline__ int lds_byte(int r, int c) { const int st = (r >> 4) * 2 + (c >> 5), rr = r & 15, cc = c & 31, ob = rr * 64 + cc * 2; return st * 1024 + (ob ^ (((ob >> 9) & 1) << 5)); }
__host__ __device__ __forceinline__ void stage_rc(int b, int& R, int& C) { const int st = b / 1024, sb = b % 1024, swz = sb ^ (((sb >> 9) & 1) << 5); R = (st >> 1) * 16 + swz / 64; C = (st & 1) * 32 + (swz % 64) / 2; }
__host__ __device__ __forceinline__ int perm32(int rho) { const int n = rho >> 4, i = rho & 15; return 8 * (i >> 2) + 4 * n + (i & 3); }

struct Unit { int pm, pn, a0, a1; };

struct DenseOrder {
    const bf16_t* A; const bf16_t* Bt; int K; int nM, nN, nwg, G, c;
    __device__ void init(const bf16_t* A_, const bf16_t* Bt_, int M, int N, int K_, int G_, int c_) { A = A_; Bt = Bt_; K = K_; nM = M / BM; nN = N / BM; nwg = nM * nN; G = G_; c = c_; }
    __device__ __forceinline__ bool next(int i, Unit& u) const {
        const long L = (long)i * G + c; if (L >= nwg) return false;
        int wgid = (int)L; { const int q = nwg / NXCD, r = nwg % NXCD, xcd = wgid % NXCD, off = wgid / NXCD; wgid = (xcd < r ? xcd * (q + 1) : r * (q + 1) + (xcd - r) * q) + off; }
        const int nig = WGM * nN, gid = wgid / nig, fm = gid * WGM, gsz = (nM - fm) < WGM ? (nM - fm) : WGM;
        u.pm = fm + ((wgid % nig) % gsz); u.pn = (wgid % nig) / gsz; u.a0 = 0; u.a1 = 256; return true;
    }
    __device__ __forceinline__ const char* abase() const { return (const char*)A; }
    __device__ __forceinline__ unsigned arow(const Unit& u, int r) const { return (unsigned)(u.pm * BM + r) * (unsigned)K * 2u; }
    __device__ __forceinline__ const char* bbase(const Unit& u) const { return (const char*)Bt + (size_t)u.pn * BM * K * 2; }
};

typedef float f32x2 __attribute__((ext_vector_type(2)));
__device__ __forceinline__ unsigned cvt_pk_bf16(float lo, float hi) { unsigned r; asm volatile("v_cvt_pk_bf16_f32 %0, %1, %2" : "=v"(r) : "v"(lo), "v"(hi)); return r; }

template <class Epi, class Sched>
__device__ __forceinline__ void gemm_phase(LAS unsigned char* lds, const Sched& S, const Epi& E) {
    const int tid = threadIdx.x, wid = __builtin_amdgcn_readfirstlane(tid >> 6), lane = tid & 63, wr = wid >> 2, wc = wid & 3, fr = lane & 15, fq = lane >> 4;
    const int K = S.K, nt = K / BK;
    int RA[2]; unsigned cA2[2], voffB[2];
#pragma unroll
    for (int i = 0; i < 2; ++i) { int R, C; stage_rc(tid * 16 + i * 8192, R, C); const int Rb = (R & ~31) + perm32(R & 31);
        RA[i] = R; cA2[i] = (unsigned)C * 2u; voffB[i] = (unsigned)(Rb * K + C) * 2u; }
    const size_t kstep = (size_t)(BK * 2);
    const size_t hstep = (size_t)HALF * K * 2;
    const unsigned ldsw = (unsigned)wid * 1024u;
    const int aoff = lds_byte(wr * 64 + fr, fq * 8), boff = lds_byte(wc * 32 + fr, fq * 8);
#define PG8_SA(b, h) (((b) * 2 + (h)) * HTB)
#define PG8_SB(b, h) ((4 + (b) * 2 + (h)) * HTB)
#define PG8_STAGE(bufoff, gbase, voff) do { _Pragma("unroll") for (int _i = 0; _i < 2; ++_i) \
        __builtin_amdgcn_global_load_lds((const unsigned*)((const char*)(gbase) + (voff)[_i]), (LAS unsigned*)(lds + (bufoff) + ldsw + _i * 8192), 16, 0, 0); } while (0)
#define PG8_LDA(dst, b, h) do { _Pragma("unroll") for (int m = 0; m < 4; ++m) _Pragma("unroll") for (int k = 0; k < 2; ++k) dst[m][k] = *(const LAS bf16x8*)(lds + PG8_SA(b, h) + aoff + m * 2048 + k * 1024); } while (0)
#define PG8_LDB(dst, b, h) do { _Pragma("unroll") for (int n = 0; n < 2; ++n) _Pragma("unroll") for (int k = 0; k < 2; ++k) dst[n][k] = *(const LAS bf16x8*)(lds + PG8_SB(b, h) + boff + n * 2048 + k * 1024); } while (0)
#define PG8_MMA(ai, bj, At, Bt) do { __builtin_amdgcn_s_setprio(1); _Pragma("unroll") for (int m = 0; m < 4; ++m) _Pragma("unroll") for (int n = 0; n < 2; ++n) _Pragma("unroll") for (int k = 0; k < 2; ++k) \
        acc[ai][bj][m][n] = __builtin_amdgcn_mfma_f32_16x16x32_bf16(Bt[n][k], At[m][k], acc[ai][bj][m][n], 0, 0, 0); __builtin_amdgcn_s_setprio(0); } while (0)
#define PG8_WAIT_V(n) asm volatile("s_waitcnt vmcnt(" #n ")" ::: "memory")
#define PG8_WAIT_L(n) asm volatile("s_waitcnt lgkmcnt(" #n ")" ::: "memory")
#define PG8_BAR __builtin_amdgcn_s_barrier()
#define PG8_SCHED __builtin_amdgcn_sched_barrier(0)
    Unit cur, nxt; int ui = 0;
    if (!S.next(0, cur)) return;
    f32x4 acc[2][2][4][2];
#pragma unroll
    for (int a = 0; a < 2; ++a)
#pragma unroll
        for (int b = 0; b < 2; ++b)
#pragma unroll
            for (int m = 0; m < 4; ++m)
#pragma unroll
                for (int n = 0; n < 2; ++n) acc[a][b][m][n] = (f32x4){0.f, 0.f, 0.f, 0.f};
    bf16x8 At[4][2], B0[2][2], B1[2][2];
    const char* const Ab = S.abase();
    unsigned oC[2][2], oN[2][2];
#pragma unroll
    for (int h = 0; h < 2; ++h)
#pragma unroll
        for (int i = 0; i < 2; ++i) { oC[h][i] = S.arow(cur, h * HALF + RA[i]) + cA2[i]; oN[h][i] = oC[h][i]; }
    const char* cB = S.bbase(cur);
    PG8_STAGE(PG8_SB(0, 0), cB, voffB); PG8_STAGE(PG8_SB(0, 1), cB + hstep, voffB); PG8_STAGE(PG8_SA(0, 0), Ab, oC[0]); PG8_STAGE(PG8_SA(0, 1), Ab, oC[1]);
    if (wr == 1) PG8_BAR;
    PG8_WAIT_V(2); PG8_BAR;
    PG8_STAGE(PG8_SB(1, 0), cB + kstep, voffB); PG8_STAGE(PG8_SA(1, 0), Ab + kstep, oC[0]); PG8_STAGE(PG8_SB(1, 1), cB + hstep + kstep, voffB);
    PG8_WAIT_V(6); PG8_BAR;
    for (;;) {
        const bool has_next = S.next(ui + 1, nxt);
        const char* nB = has_next ? S.bbase(nxt) : cB;
        if (has_next) {
#pragma unroll
            for (int h = 0; h < 2; ++h)
#pragma unroll
                for (int i = 0; i < 2; ++i) oN[h][i] = S.arow(nxt, h * HALF + RA[i]) + cA2[i];
        }
        for (int t = 0; t < nt; t += 2) {
            const bool last = (t == nt - 2);
            const char* a1 = Ab + (size_t)(t + 1) * kstep;
            const char* a2 = last ? Ab : Ab + (size_t)(t + 2) * kstep; const char* b2 = last ? nB : cB + (size_t)(t + 2) * kstep;
            const char* a3 = a2 + kstep; const char* b3 = b2 + kstep;
            unsigned o2[2][2];
#pragma unroll
            for (int h = 0; h < 2; ++h)
#pragma unroll
                for (int i = 0; i < 2; ++i) o2[h][i] = last ? oN[h][i] : oC[h][i];
            PG8_LDB(B0, 0, 0); PG8_LDB(B1, 0, 1); PG8_SCHED; PG8_LDA(At, 0, 0); PG8_STAGE(PG8_SA(1, 1), a1, oC[1]);
            PG8_WAIT_V(8); PG8_WAIT_L(0); PG8_BAR; PG8_MMA(0, 0, At, B0); PG8_MMA(0, 1, At, B1); PG8_BAR; PG8_SCHED;
            PG8_LDA(At, 0, 1); PG8_STAGE(PG8_SB(0, 0), b2, voffB); PG8_STAGE(PG8_SB(0, 1), b2 + hstep, voffB); PG8_STAGE(PG8_SA(0, 0), a2, o2[0]);
            PG8_WAIT_V(8); PG8_WAIT_L(0); PG8_BAR; PG8_MMA(1, 0, At, B0); PG8_MMA(1, 1, At, B1); PG8_BAR; PG8_SCHED;
            PG8_LDB(B0, 1, 0); PG8_LDB(B1, 1, 1); PG8_SCHED; PG8_LDA(At, 1, 0); PG8_STAGE(PG8_SA(0, 1), a2, o2[1]);
            PG8_WAIT_V(8); PG8_WAIT_L(0); PG8_BAR; PG8_MMA(0, 0, At, B0); PG8_MMA(0, 1, At, B1); PG8_BAR; PG8_SCHED;
            PG8_LDA(At, 1, 1); PG8_STAGE(PG8_SB(1, 0), b3, voffB); PG8_STAGE(PG8_SB(1, 1), b3 + hstep, voffB); PG8_STAGE(PG8_SA(1, 0), a3, o2[0]);
            PG8_WAIT_V(8); PG8_WAIT_L(0); PG8_BAR; PG8_MMA(1, 0, At, B0); PG8_MMA(1, 1, At, B1); PG8_BAR; PG8_SCHED;
        }
        if (wr == 0) PG8_BAR;
        { int frE = fr, fqE = fq; asm volatile("" : "+v"(frE), "+v"(fqE));
          E(acc, cur, wr, wc, frE, fqE); }
        if (!has_next) break;
#pragma unroll
        for (int a = 0; a < 2; ++a)
#pragma unroll
            for (int b = 0; b < 2; ++b)
#pragma unroll
                for (int m = 0; m < 4; ++m)
#pragma unroll
                    for (int n = 0; n < 2; ++n) acc[a][b][m][n] = (f32x4){0.f, 0.f, 0.f, 0.f};
        cur = nxt; cB = nB; ++ui;
#pragma unroll
        for (int h = 0; h < 2; ++h)
#pragma unroll
            for (int i = 0; i < 2; ++i) oC[h][i] = oN[h][i];
        if (wr == 1) PG8_BAR;
    }
    PG8_WAIT_V(0);
    PG8_BAR;
#undef PG8_SA
#undef PG8_SB
#undef PG8_STAGE
#undef PG8_LDA
#undef PG8_LDB
#undef PG8_MMA
#undef PG8_WAIT_V
#undef PG8_WAIT_L
#undef PG8_BAR
#undef PG8_SCHED
}
}

constexpr size_t WS_LR = 304 * MiB;
constexpr int SS_PARTS = 16;
constexpr int RING_BYTES = 131072  , LDSCTL_OFF = 139264  , MISC_OFF = LDSCTL_OFF + 320, MOETAB_OFF = LDSCTL_OFF + 1024;
constexpr int LDS_BYTES = 147456;
constexpr int MT_CNT = 0, MT_ALL = 64, MT_R0 = 64 + 65, MT_R1 = 64 + 65 + 33;

__device__ __forceinline__ f32x4 ldg4(const float* p) { return *(const f32x4*)p; }

struct MoeOrder {
    const bf16_t* A; const bf16_t* Bt; int K; int mode; const int* ltok; const LAS int* tab; int G, c;
    __device__ __forceinline__ bool next(int i, pg8::Unit& u) const {
        const int L = i * G + c;
        if (mode == 0) {
            const int T = L >> 1; if (T >= tab[MT_ALL + 64]) return false;
            int lo = 0;
#pragma unroll
            for (int s = 32; s >= 1; s >>= 1) if (tab[MT_ALL + lo + s] <= T) lo += s;
            const int tile = T - tab[MT_ALL + lo]; u.pm = T; u.pn = L & 1; u.a0 = lo | (tile << 8); const int v = tab[MT_CNT + lo] - tile * 256; u.a1 = v < 256 ? v : 256; return true;
        } else {
            const int T = L >> 2; const int tb = mode == 1 ? MT_R0 : MT_R1; if (T >= tab[tb + 32]) return false;
            int lo = 0;
#pragma unroll
            for (int s = 16; s >= 1; s >>= 1) if (tab[tb + lo + s] <= T) lo += s;
            const int list = 2 * lo + (mode - 1), tile = T - tab[tb + lo]; u.pm = tab[MT_ALL + list] + tile; u.pn = L & 3; u.a0 = list | (tile << 8);
            const int v = tab[MT_CNT + list] - tile * 256; u.a1 = v < 256 ? v : 256; return true;
        }
    }
    __device__ __forceinline__ const char* abase() const { return (const char*)A; }
    __device__ __forceinline__ unsigned arow(const pg8::Unit& u, int r) const {
        if (mode == 0) { const int list = u.a0 & 255, tile = u.a0 >> 8; const int tok = r < u.a1 ? ltok[(size_t)list * LIST_CAP + tile * 256 + r] : 0; return (unsigned)tok * (unsigned)(DM * 2); }
        return (unsigned)(u.pm * 256 + r) * (unsigned)(EHID * 2);
    }
    __device__ __forceinline__ const char* bbase(const pg8::Unit& u) const {
        const int e = (u.a0 & 255) >> 1;
        if (mode == 0) return (const char*)Bt + ((size_t)e * 512 + u.pn * 256) * DM * 2;
        return (const char*)Bt + ((size_t)e * DM + u.pn * 256) * EHID * 2;
    }
};
__device__ __forceinline__ void moe_tables(unsigned char* ws, LAS int* tab) {
    if (threadIdx.x < 64) tab[MT_CNT + threadIdx.x] = (int)__hip_atomic_load((unsigned*)(ws + WS_CTL) + CW_CNT + 64 * threadIdx.x, __ATOMIC_RELAXED, __HIP_MEMORY_SCOPE_AGENT);
    __syncthreads();
    if (threadIdx.x == 0) { int a = 0, r0 = 0, r1 = 0;
        for (int l = 0; l < 64; ++l) { const int t = (tab[MT_CNT + l] + 255) >> 8; tab[MT_ALL + l] = a; a += t; if (l & 1) { tab[MT_R1 + (l >> 1)] = r1; r1 += t; } else { tab[MT_R0 + (l >> 1)] = r0; r0 += t; } }
        tab[MT_ALL + 64] = a; tab[MT_R0 + 32] = r0; tab[MT_R1 + 32] = r1; }
    __syncthreads();
}

struct EpiInProj {
    unsigned char* ws;
    __device__ __forceinline__ void operator()(const f32x4 (&acc)[2][2][4][2], const pg8::Unit& u, int wr, int wc, int fr, int fq) const {
        const int seg = u.pn >> 1, gi = ((u.pn & 1) << 2) | wc, b = u.pm >> 3, blk = u.pm & 7;
        const bool nrm = (seg != 2 && seg != 5);
        const float* gp = (const float*)(ws + WS_CONST) + CF_GAIN + 64 * (seg == 0 ? 0 : seg == 1 ? 1 : seg == 3 ? 2 : 3);
        const float qs = (seg == 0 || seg == 3) ? C2 : 1.0f;
        f32x4 g[2][2];
#pragma unroll
        for (int bj = 0; bj < 2; ++bj)
#pragma unroll
            for (int n = 0; n < 2; ++n) g[bj][n] = nrm ? ldg4(gp + 32 * bj + 8 * fq + 4 * n) * qs : (f32x4){1.f, 1.f, 1.f, 1.f};
        bf16_t* base; size_t rstride;
        if (seg < 2) { base = (bf16_t*)(ws + (seg == 0 ? WS_QD : WS_KD)) + ((size_t)((b * 4 + (gi >> 1)) * 2 + (gi & 1)) * SEQ + blk * 256) * 64; rstride = 64; }
        else if (seg == 2) { base = (bf16_t*)(ws + WS_VD) + ((size_t)(b * 4 + (gi >> 1)) * SEQ + blk * 256) * 128 + (gi & 1) * 64; rstride = 128; }
        else { base = (bf16_t*)(ws + (seg == 3 ? WS_QM : seg == 4 ? WS_KM : WS_VM)) + ((size_t)(b * 8 + gi) * SEQ + blk * 256) * 64; rstride = 64; }
        f32x4 ks[2][2];
#pragma unroll
        for (int bj = 0; bj < 2; ++bj)
#pragma unroll
            for (int n = 0; n < 2; ++n) ks[bj][n] = (f32x4){0.f, 0.f, 0.f, 0.f};
#pragma unroll
        for (int ai = 0; ai < 2; ++ai)
#pragma unroll
            for (int m = 0; m < 4; ++m) {
                const int r = 128 * ai + 64 * wr + 16 * m + fr;
                f32x4 v[2][2]; float ss = 0.f;
#pragma unroll
                for (int bj = 0; bj < 2; ++bj)
#pragma unroll
                    for (int n = 0; n < 2; ++n) { v[bj][n] = acc[ai][bj][m][n]; ss += (v[bj][n][0] * v[bj][n][0] + v[bj][n][1] * v[bj][n][1]) + (v[bj][n][2] * v[bj][n][2] + v[bj][n][3] * v[bj][n][3]); }
                float rs = 1.f;
                if (nrm) { ss += __shfl_xor(ss, 16); ss += __shfl_xor(ss, 32); rs = rsqrtf(ss * (1.f / 64.f) + RMS_EPS); }
                bf16_t* rowp = base + (size_t)r * rstride + 8 * fq;
#pragma unroll
                for (int bj = 0; bj < 2; ++bj) {
                    const f32x4 a = v[bj][0] * rs * g[bj][0], c = v[bj][1] * rs * g[bj][1];
                    if (seg == 4) { ks[bj][0] += a; ks[bj][1] += c; }
                    v4u w; w.x = pg8::cvt_pk_bf16(a[0], a[1]); w.y = pg8::cvt_pk_bf16(a[2], a[3]); w.z = pg8::cvt_pk_bf16(c[0], c[1]); w.w = pg8::cvt_pk_bf16(c[2], c[3]);
                    *(v4u*)(rowp + 32 * bj) = w;
                }
            }
        if (seg == 4) {
            float* km = (float*)(ws + WS_KMEAN) + (((size_t)(b * 8 + blk) * 2 + wr) * 8 + gi) * 64;
#pragma unroll
            for (int bj = 0; bj < 2; ++bj)
#pragma unroll
                for (int n = 0; n < 2; ++n) { f32x4 s = ks[bj][n];
#pragma unroll
                    for (int j = 0; j < 4; ++j) { float t = s[j]; t += __shfl_xor(t, 1); t += __shfl_xor(t, 2); t += __shfl_xor(t, 4); t += __shfl_xor(t, 8); s[j] = t; }
                    if (fr == 0) *(f32x4*)(km + 32 * bj + 8 * fq + 4 * n) = s; }
        }
    }
};

struct EpiOutProj {
    unsigned char* ws; const float* x;
    __device__ __forceinline__ void operator()(const f32x4 (&acc)[2][2][4][2], const pg8::Unit& u, int wr, int wc, int fr, int fq) const {
        bf16_t* X1B = (bf16_t*)(ws + WS_X1B); float* SS = (float*)(ws + WS_SS);
#pragma unroll
        for (int ai = 0; ai < 2; ++ai)
#pragma unroll
            for (int m = 0; m < 4; ++m) {
                const size_t row = (size_t)u.pm * 256 + 128 * ai + 64 * wr + 16 * m + fr; float ss = 0.f;
#pragma unroll
                for (int bj = 0; bj < 2; ++bj) {
                    const size_t off = row * DM + u.pn * 256 + 128 * bj + 32 * wc + 8 * fq;
                    const f32x4 a = acc[ai][bj][m][0] + ldg4(x + off), c = acc[ai][bj][m][1] + ldg4(x + off + 4);
                    ss += (a[0] * a[0] + a[1] * a[1]) + (a[2] * a[2] + a[3] * a[3]) + (c[0] * c[0] + c[1] * c[1]) + (c[2] * c[2] + c[3] * c[3]);
                    v4u w; w.x = pg8::cvt_pk_bf16(a[0], a[1]); w.y = pg8::cvt_pk_bf16(a[2], a[3]); w.z = pg8::cvt_pk_bf16(c[0], c[1]); w.w = pg8::cvt_pk_bf16(c[2], c[3]);
                    *(v4u*)(X1B + off) = w;
                }
                ss += __shfl_xor(ss, 16); ss += __shfl_xor(ss, 32);
                if (fq == 0) SS[row * SS_PARTS + u.pn * 4 + wc] = ss;
            }
    }
};

__device__ __forceinline__ void route_token2(unsigned char* ws, int tok, float r2, const float (&gl)[4], const float (&el)[8], int g) {
    unsigned* CTL = (unsigned*)(ws + WS_CTL); int* LTOK = (int*)(ws + WS_LTOK); float* LW = (float*)(ws + WS_LW); float* LR = (float*)(ws + WS_LR);
    const float mx = fmaxf(fmaxf(gl[0], gl[1]), fmaxf(gl[2], gl[3])) * r2;
    const float glg = g == 0 ? gl[0] : g == 1 ? gl[1] : g == 2 ? gl[2] : gl[3];
    const float den = (__expf(gl[0] * r2 - mx) + __expf(gl[1] * r2 - mx)) + (__expf(gl[2] * r2 - mx) + __expf(gl[3] * r2 - mx));
    const float pg = __expf(glg * r2 - mx) / den;
    float v0 = el[0]; int e0 = 0;
#pragma unroll
    for (int i = 1; i < 8; ++i) if (el[i] > v0) { v0 = el[i]; e0 = i; }
    float v1 = -3.0e38f; int e1 = 0;
#pragma unroll
    for (int i = 0; i < 8; ++i) if (i != e0 && el[i] > v1) { v1 = el[i]; e1 = i; }
    const float w0 = 1.f / (1.f + __expf((v1 - v0) * r2)), w1 = 1.f - w0;
    const int l0 = (g * 8 + e0) * 2 + 0, l1 = (g * 8 + e1) * 2 + 1;
    const unsigned p0 = atomicAdd(CTL + CW_CNT + 64 * l0, 1u), p1 = atomicAdd(CTL + CW_CNT + 64 * l1, 1u);
    LTOK[(size_t)l0 * LIST_CAP + p0] = tok; LW[(size_t)l0 * LIST_CAP + p0] = pg * w0; LR[(size_t)l0 * LIST_CAP + p0] = r2;
    LTOK[(size_t)l1 * LIST_CAP + p1] = tok; LW[(size_t)l1 * LIST_CAP + p1] = pg * w1; LR[(size_t)l1 * LIST_CAP + p1] = r2;
    ((float*)(ws + WS_R2))[tok] = r2;
}
struct EpiRoute {
    unsigned char* ws;
    __device__ __forceinline__ void operator()(const f32x4 (&acc)[2][2][4][2], const pg8::Unit& u, int wr, int wc, int fr, int fq) const {
        const float* SS = (const float*)(ws + WS_SS);
#pragma unroll
        for (int ai = 0; ai < 2; ++ai)
#pragma unroll
            for (int m = 0; m < 4; ++m) {
                const int row = u.pm * 256 + 128 * ai + 64 * wr + 16 * m + fr;
                const f32x4 e0 = acc[ai][0][m][0], e1 = acc[ai][0][m][1];
                float gl[4];
#pragma unroll
                for (int j = 0; j < 4; ++j) gl[j] = __shfl_down(e0[j], 16);
                if (fq == 0) {
                    int g = 0; float gv = gl[0];
#pragma unroll
                    for (int i = 1; i < 4; ++i) if (gl[i] > gv) { gv = gl[i]; g = i; }
                    if (g == wc) {
                        const float* sp = SS + (size_t)row * SS_PARTS; const f32x4 s0 = ldg4(sp), s1 = ldg4(sp + 4), s2 = ldg4(sp + 8), s3 = ldg4(sp + 12);
                        const float tot = ((s0[0] + s0[1]) + (s0[2] + s0[3])) + ((s1[0] + s1[1]) + (s1[2] + s1[3])) + ((s2[0] + s2[1]) + (s2[2] + s2[3])) + ((s3[0] + s3[1]) + (s3[2] + s3[3]));
                        const float r2 = rsqrtf(tot * (1.f / DM) + RMS_EPS);
                        const float el[8] = {e0[0], e0[1], e0[2], e0[3], e1[0], e1[1], e1[2], e1[3]};
                        route_token2(ws, row, r2, gl, el, g);
                    }
                }
            }
    }
};

struct EpiGateUp {
    unsigned char* ws;
    __device__ __forceinline__ void operator()(const f32x4 (&acc)[2][2][4][2], const pg8::Unit& u, int wr, int wc, int fr, int fq) const {
        const int list = u.a0 & 255, tile = u.a0 >> 8; const float* LR = (const float*)(ws + WS_LR) + (size_t)list * LIST_CAP + tile * 256;
        bf16_t* HID = (bf16_t*)(ws + WS_HID);
#pragma unroll
        for (int ai = 0; ai < 2; ++ai)
#pragma unroll
            for (int m = 0; m < 4; ++m) {
                const int r = 128 * ai + 64 * wr + 16 * m + fr;
                if (r < u.a1) {
                    const float r2 = LR[r]; float h[8];
#pragma unroll
                    for (int n = 0; n < 2; ++n)
#pragma unroll
                        for (int j = 0; j < 4; ++j) { const float G = acc[ai][0][m][n][j] * r2, U = acc[ai][1][m][n][j] * r2;
                            h[4 * n + j] = G * __builtin_amdgcn_rcpf(1.f + __builtin_amdgcn_exp2f(-G * LOG2E)) * U; }
                    v4u w; w.x = pg8::cvt_pk_bf16(h[0], h[1]); w.y = pg8::cvt_pk_bf16(h[2], h[3]); w.z = pg8::cvt_pk_bf16(h[4], h[5]); w.w = pg8::cvt_pk_bf16(h[6], h[7]);
                    *(v4u*)(HID + ((size_t)u.pm * 256 + r) * EHID + u.pn * 128 + 32 * wc + 8 * fq) = w;
                }
            }
    }
};

template <int RK> struct EpiDown {
    unsigned char* ws; float* out;
    __device__ __forceinline__ void operator()(const f32x4 (&acc)[2][2][4][2], const pg8::Unit& u, int wr, int wc, int fr, int fq) const {
        const int list = u.a0 & 255, tile = u.a0 >> 8; const size_t eb = (size_t)list * LIST_CAP + tile * 256;
        const int* LTOK = (const int*)(ws + WS_LTOK) + eb; const float* LW = (const float*)(ws + WS_LW) + eb;
        const bf16_t* X1B = (const bf16_t*)(ws + WS_X1B); bf16_t* PA = (bf16_t*)(ws + WS_PA);
#pragma unroll
        for (int ai = 0; ai < 2; ++ai)
#pragma unroll
            for (int m = 0; m < 4; ++m) {
                const int r = 128 * ai + 64 * wr + 16 * m + fr;
                if (r < u.a1) {
                    const int tok = LTOK[r]; const float wt = LW[r];
#pragma unroll
                    for (int bj = 0; bj < 2; ++bj) {
                        const size_t off = (size_t)tok * DM + u.pn * 256 + 128 * bj + 32 * wc + 8 * fq;
                        const v4u bs = *(const v4u*)((RK == 0 ? X1B : (const bf16_t*)PA) + off);
                        f32x4 a, c;
                        a[0] = __uint_as_float(bs.x << 16); a[1] = __uint_as_float(bs.x & 0xffff0000u); a[2] = __uint_as_float(bs.y << 16); a[3] = __uint_as_float(bs.y & 0xffff0000u);
                        c[0] = __uint_as_float(bs.z << 16); c[1] = __uint_as_float(bs.z & 0xffff0000u); c[2] = __uint_as_float(bs.w << 16); c[3] = __uint_as_float(bs.w & 0xffff0000u);
                        a += acc[ai][bj][m][0] * wt; c += acc[ai][bj][m][1] * wt;
                        if (RK == 0) { v4u w; w.x = pg8::cvt_pk_bf16(a[0], a[1]); w.y = pg8::cvt_pk_bf16(a[2], a[3]); w.z = pg8::cvt_pk_bf16(c[0], c[1]); w.w = pg8::cvt_pk_bf16(c[2], c[3]); *(v4u*)(PA + off) = w; }
                        else { *(f32x4*)(out + off) = a; *(f32x4*)(out + off + 4) = c; }
                    }
                }
            }
    }
};

#define HAVE_ATTN 1
namespace att {
typedef short bf16x8 __attribute__((ext_vector_type(8)));
typedef short s16x4 __attribute__((ext_vector_type(4)));
typedef short v4i16_t __attribute__((ext_vector_type(4)));
typedef float f32x16 __attribute__((ext_vector_type(16)));
constexpr int TBL_STRIDE = 2384;
constexpr int TBL_BYTES = 38912, SLOT_OFF = TBL_BYTES, STAGE_OFF = SLOT_OFF + 65536, WSCR_OFF = STAGE_OFF + 32768, ATT_LDS = WSCR_OFF + 2048;
static_assert(4 * TBL_STRIDE * 4 <= TBL_BYTES && ATT_LDS <= LDSCTL_OFF, "attention LDS map");
constexpr float NEGBIG = -1.0e30f;
__device__ __forceinline__ int crow(int r, int hi) { return (r & 3) + 8 * (r >> 2) + 4 * hi; }
__device__ __forceinline__ s16x4 vtr(const LAS unsigned char* p) { return __builtin_bit_cast(s16x4, __builtin_amdgcn_ds_read_tr16_b64_v4i16((LAS v4i16_t*)p)); }
__device__ __forceinline__ unsigned cvtpk(float lo, float hi) { typedef float f2 __attribute__((ext_vector_type(2))); typedef __bf16 b2 __attribute__((ext_vector_type(2))); f2 v = {lo, hi}; b2 b = __builtin_convertvector(v, b2); return __builtin_bit_cast(unsigned, b); }

__device__ __forceinline__ void build_table(LAS unsigned char* lds, const float* CF, int h12) {
    LAS float* tb = (LAS float*)lds; const float* BT = CF + CF_BT + h12 * 2048; const float off = CF[CF_OFF + h12];
    for (int idx = threadIdx.x; idx < 4 * TBL_STRIDE; idx += 512) { const int s = idx / TBL_STRIDE, i = idx - s * TBL_STRIDE, j = i + s; tb[idx] = j <= 2047 ? BT[2047 - j] - off : NEGBIG; }
}

template <int NK> __device__ __forceinline__ void epilogue(LAS unsigned char* lds, unsigned char* ws, const Inputs& in, int b, int h, int w, int map, int rb, int qw0, int lane_in, float lsum, att::f32x16 (&o)[NK == 2 ? 4 : 2]) {
    constexpr int ND = NK == 2 ? 4 : 2;
    int lane = lane_in; asm volatile("" : "+v"(lane));
    const int r32 = lane & 31, hi = lane >> 5;
    const float* CF = (const float*)(ws + WS_CONST);
    LAS float* wsf = (LAS float*)(lds + WSCR_OFF) + w * 64;
    if (hi == 0) wsf[r32] = lsum;
    asm volatile("s_waitcnt lgkmcnt(0)" ::: "memory");
    float rli[16];
#pragma unroll
    for (int r = 0; r < 16; ++r) rli[r] = __builtin_amdgcn_rcpf(wsf[crow(r, hi)]);
    bf16_t* Y = (bf16_t*)(ws + WS_Y);
    if (NK == 1) {
        LAS bf16_t* stg = (LAS bf16_t*)(lds + STAGE_OFF) + w * 2048;
#pragma unroll
        for (int r = 0; r < 16; ++r) { const int orow = crow(r, hi);
#pragma unroll
            for (int d0 = 0; d0 < ND; ++d0) stg[orow * 64 + d0 * 32 + r32] = (bf16_t)f2bf(o[d0][r] * rli[r]); }
        asm volatile("s_waitcnt lgkmcnt(0)" ::: "memory");
        bf16_t* Yw = Y + (size_t)(b * SEQ + qw0) * DM + 512 + h * 64;
#pragma unroll
        for (int i = 0; i < 4; ++i) { const int row = i * 8 + (lane >> 3), ch = lane & 7; const v4u v = *(const LAS v4u*)(stg + row * 64 + ch * 8); *(v4u*)(Yw + (size_t)row * DM + ch * 8) = v; }
    } else {
        LAS float* X = (LAS float*)(lds + SLOT_OFF) + (size_t)rb * 32 * 128;
        const float lam = CF[CF_LAMBDA];
        if (map == 1) {
#pragma unroll
            for (int r = 0; r < 16; ++r) { const int orow = crow(r, hi); const float f = rli[r] * lam;
#pragma unroll
                for (int d0 = 0; d0 < ND; ++d0) X[orow * 128 + d0 * 32 + r32] = o[d0][r] * f; }
        }
        asm volatile("s_waitcnt lgkmcnt(0)" ::: "memory"); __syncthreads();
        if (map == 0) {
            float gsub[ND];
#pragma unroll
            for (int d0 = 0; d0 < ND; ++d0) gsub[d0] = in.diff_sub_g[d0 * 32 + r32];
            LAS bf16_t* stg = (LAS bf16_t*)(lds + STAGE_OFF) + rb * 4096;
#pragma unroll
            for (int r = 0; r < 16; ++r) { const int orow = crow(r, hi); float v[ND]; float ss = 0.f;
#pragma unroll
                for (int d0 = 0; d0 < ND; ++d0) { v[d0] = o[d0][r] * rli[r] - X[orow * 128 + d0 * 32 + r32]; ss += v[d0] * v[d0]; }
                ss += __shfl_xor(ss, 1); ss += __shfl_xor(ss, 2); ss += __shfl_xor(ss, 4); ss += __shfl_xor(ss, 8); ss += __shfl_xor(ss, 16);
                const float sc2 = rsqrtf(ss * (1.f / 128.f) + RMS_EPS) * (1.f - LAMBDA_INIT);
#pragma unroll
                for (int d0 = 0; d0 < ND; ++d0) stg[orow * 128 + d0 * 32 + r32] = (bf16_t)f2bf(v[d0] * sc2 * gsub[d0]); }
            asm volatile("s_waitcnt lgkmcnt(0)" ::: "memory");
            bf16_t* Yw = Y + (size_t)(b * SEQ + qw0) * DM + h * 128;
#pragma unroll
            for (int i = 0; i < 8; ++i) { const int row = i * 4 + (lane >> 4), ch = lane & 15; const v4u v = *(const LAS v4u*)(stg + row * 128 + ch * 8); *(v4u*)(Yw + (size_t)row * DM + ch * 8) = v; }
        }
    }
    asm volatile("s_waitcnt lgkmcnt(0)" ::: "memory"); __syncthreads();
}


template <int NK> __device__ __forceinline__ void attn_unit(LAS unsigned char* lds, unsigned char* ws, const Inputs& in, int b, int h, int qb) {
    constexpr int DV = NK == 2 ? 128 : 64, ND = DV / 32, ROWS = NK == 2 ? 128 : 256, SLOTB = NK == 2 ? 32768 : 16384, VOFF = 8192 * NK;
    const int tid = threadIdx.x; int lane_ = tid & 63; asm volatile("" : "+v"(lane_));
    const int lane = lane_, r32 = lane & 31, hi = lane >> 5; const int w = __builtin_amdgcn_readfirstlane(tid >> 6);
    const int map = NK == 2 ? (w >> 2) : 0, rb = NK == 2 ? (w & 3) : w;
    const int q0 = qb * ROWS, qw0 = q0 + 32 * rb, qabs = qw0 + r32, NT = (q0 + ROWS) / 64;
    const float* CF = (const float*)(ws + WS_CONST);
    const bf16_t *Qh, *Kh0, *Kh1, *Vh;
    if (NK == 2) { const size_t hb = (size_t)(b * 4 + h) * 2; Qh = (const bf16_t*)(ws + WS_QD) + (hb + map) * SEQ * 64; Kh0 = (const bf16_t*)(ws + WS_KD) + hb * SEQ * 64; Kh1 = Kh0 + (size_t)SEQ * 64;
                   Vh = (const bf16_t*)(ws + WS_VD) + (size_t)(b * 4 + h) * SEQ * 128; }
    else { const size_t hb = (size_t)(b * 8 + h); Qh = (const bf16_t*)(ws + WS_QM) + hb * SEQ * 64; Kh0 = (const bf16_t*)(ws + WS_KM) + hb * SEQ * 64; Kh1 = Kh0; Vh = (const bf16_t*)(ws + WS_VM) + hb * SEQ * 64; }
    const bf16_t* ksrc0 = Kh0 + (size_t)lane * 64 + w * 8; const bf16_t* ksrc1 = Kh1 + (size_t)lane * 64 + w * 8;
    const bf16_t* vsrc0 = Vh + (size_t)(16 * (w & 3) + (lane >> 2)) * DV + (w >> 2) * 32 + (lane & 3) * 8;
    const bf16_t* vsrc1 = vsrc0 + 64;
#define ATT_DMA(t) do { LAS unsigned char* sl_ = lds + SLOT_OFF + ((t) & 1) * SLOTB; const size_t ko_ = (size_t)(t) * 64 * 64, vo_ = (size_t)(t) * 64 * DV; \
        __builtin_amdgcn_global_load_lds((const unsigned*)(ksrc0 + ko_), (LAS unsigned*)(sl_ + w * 1024), 16, 0, 0); \
        if (NK == 2) __builtin_amdgcn_global_load_lds((const unsigned*)(ksrc1 + ko_), (LAS unsigned*)(sl_ + 8192 + w * 1024), 16, 0, 0); \
        __builtin_amdgcn_global_load_lds((const unsigned*)(vsrc0 + vo_), (LAS unsigned*)(sl_ + VOFF + w * 1024), 16, 0, 0); \
        if (NK == 2) __builtin_amdgcn_global_load_lds((const unsigned*)(vsrc1 + vo_), (LAS unsigned*)(sl_ + VOFF + 8192 + w * 1024), 16, 0, 0); } while (0)
    ATT_DMA(0);
    bf16x8 qr[4];
#pragma unroll
    for (int d0 = 0; d0 < 4; ++d0) qr[d0] = *(const bf16x8*)(Qh + (size_t)qabs * 64 + d0 * 16 + hi * 8);
    unsigned selmask = 0xffffffffu;
    if (NK == 1 && qb > 0) {
        const float* KMEAN = (const float*)(ws + WS_KMEAN); float gate[8];
#pragma unroll
        for (int n = 0; n < 8; ++n) { float g = 0.f;
            if (n < qb) { const float* k0 = KMEAN + (((size_t)(b * 8 + n) * 2 + 0) * 8 + h) * 64;
#pragma unroll
                for (int d0 = 0; d0 < 4; ++d0) { const f32x4 a0 = ldg4(k0 + 16 * d0 + 8 * hi) + ldg4(k0 + 512 + 16 * d0 + 8 * hi), a1 = ldg4(k0 + 16 * d0 + 8 * hi + 4) + ldg4(k0 + 512 + 16 * d0 + 8 * hi + 4);
                    const bf16x8 qv = qr[d0];
                    g += bf2f((bf16_t)qv[0]) * a0[0] + bf2f((bf16_t)qv[1]) * a0[1] + bf2f((bf16_t)qv[2]) * a0[2] + bf2f((bf16_t)qv[3]) * a0[3]
                       + bf2f((bf16_t)qv[4]) * a1[0] + bf2f((bf16_t)qv[5]) * a1[1] + bf2f((bf16_t)qv[6]) * a1[2] + bf2f((bf16_t)qv[7]) * a1[3]; } }
            g += __shfl_xor(g, 32); gate[n] = g; }
        selmask = 0u;
#pragma unroll
        for (int n = 0; n < 8; ++n) { int better = 0;
#pragma unroll
            for (int m = 0; m < 8; ++m) if (m != n) better += (m < qb && (gate[m] > gate[n] || (gate[m] == gate[n] && m < n))) ? 1 : 0;
            if (n < qb && better < 3) selmask |= 1u << n; }
        selmask |= 1u << qb;
    }
    const int j0 = 2047 - qabs + 4 * hi, sc = j0 & 3;
    const LAS unsigned char* tb_base = lds + (sc * TBL_STRIDE + (j0 - sc)) * 4;
    const LAS unsigned char* tb_neg = lds + (sc * TBL_STRIDE + 2052) * 4;
    const LAS unsigned char* kp0 = lds + SLOT_OFF + map * 8192 + hi * 1024 + r32 * 16;
    const LAS unsigned char* vp0 = lds + SLOT_OFF + VOFF + ((lane >> 4) & 1) * 32 + (lane & 3) * 8 + (4 * hi + ((lane & 15) >> 2)) * 64;
    f32x16 o[ND];
#pragma unroll
    for (int d = 0; d < ND; ++d) o[d] = f32x16{};
    float lsum = 0.f;
    asm volatile("s_waitcnt vmcnt(0)" ::: "memory"); __syncthreads();
    for (int t = 0; t < NT; ++t) {
        if (t + 1 < NT) ATT_DMA(t + 1);
        if (64 * t <= qw0 + 31) {
            const bool sel = NK == 2 || ((selmask >> (t >> 2)) & 1u);
            const LAS unsigned char* tp = sel ? tb_base + t * 256 : tb_neg;
            const LAS unsigned char* kp = kp0 + (t & 1) * SLOTB; const LAS unsigned char* vp = vp0 + (t & 1) * SLOTB;
            f32x16 p0, p1;
#pragma unroll
            for (int g = 0; g < 4; ++g) { const f32x4 c0 = *(const LAS f32x4*)(tp + g * 32), c1 = *(const LAS f32x4*)(tp + 128 + g * 32);
                p0[4 * g] = c0[0]; p0[4 * g + 1] = c0[1]; p0[4 * g + 2] = c0[2]; p0[4 * g + 3] = c0[3]; p1[4 * g] = c1[0]; p1[4 * g + 1] = c1[1]; p1[4 * g + 2] = c1[2]; p1[4 * g + 3] = c1[3]; }
#pragma unroll
            for (int d0 = 0; d0 < 4; ++d0) {
                const bf16x8 k0 = *(const LAS bf16x8*)(kp + d0 * 2048), k1 = *(const LAS bf16x8*)(kp + d0 * 2048 + 512);
                p0 = __builtin_amdgcn_mfma_f32_32x32x16_bf16(k0, qr[d0], p0, 0, 0, 0); p1 = __builtin_amdgcn_mfma_f32_32x32x16_bf16(k1, qr[d0], p1, 0, 0, 0); }
            float s0 = 0.f, s1 = 0.f;
#pragma unroll
            for (int r = 0; r < 16; ++r) { p0[r] = __builtin_amdgcn_exp2f(p0[r]); p1[r] = __builtin_amdgcn_exp2f(p1[r]); s0 += p0[r]; s1 += p1[r]; }
            lsum += s0 + s1;
            v4u pw[4];
#pragma unroll
            for (int i = 0; i < 4; ++i) { pw[0][i] = cvtpk(p0[2 * i], p0[2 * i + 1]); pw[1][i] = cvtpk(p0[8 + 2 * i], p0[8 + 2 * i + 1]); pw[2][i] = cvtpk(p1[2 * i], p1[2 * i + 1]); pw[3][i] = cvtpk(p1[8 + 2 * i], p1[8 + 2 * i + 1]); }
#pragma unroll
            for (int d0 = 0; d0 < ND; ++d0)
#pragma unroll
                for (int ks = 0; ks < 4; ++ks) { const s16x4 vl = vtr(vp + d0 * 4096 + ks * 1024), vh = vtr(vp + d0 * 4096 + ks * 1024 + 512);
                    const bf16x8 vf = {vl[0], vl[1], vl[2], vl[3], vh[0], vh[1], vh[2], vh[3]};
                    o[d0] = __builtin_amdgcn_mfma_f32_32x32x16_bf16(__builtin_bit_cast(bf16x8, pw[ks]), vf, o[d0], 0, 0, 0); }
        }
        asm volatile("s_waitcnt vmcnt(0)" ::: "memory"); __syncthreads();
    }
#undef ATT_DMA
    lsum += __shfl_xor(lsum, 32);
    epilogue<NK>(lds, ws, in, b, h, w, map, rb, qw0, lane, lsum, o);
}

__device__ __forceinline__ void attn_phase(LAS unsigned char* lds, unsigned char* ws, const Inputs& in, int G, int v) {
    const float* CF = (const float*)(ws + WS_CONST);
    for (int hv = v; hv < 256; hv += G) {
        { const int b = hv >> 3, h = hv & 7;
          build_table(lds, CF, 4 + h);
          for (int i = 0; i < 8; ++i) { const int qb = (i & 1) ? 7 - (i >> 1) : (i >> 1); attn_unit<1>(lds, ws, in, b, h, qb); } }
        { const int dh = hv >> 1, b = dh >> 2, h = dh & 3, half = hv & 1;
          build_table(lds, CF, h);
          for (int i = 0; i < 8; ++i) { const int pr = 2 * (i >> 1) + half; const int qb = (i & 1) ? 15 - pr : pr; attn_unit<2>(lds, ws, in, b, h, qb); } }
    }
}
}
using att::attn_phase;

#define RLX_AGENT __ATOMIC_RELAXED, __HIP_MEMORY_SCOPE_AGENT
#define XB_TMO      128
#define XB_XCNT(j)  (256  + 64 * (j))
#define XB_XSUB(j)  (1280 + 64 * (j))
#define XB_XGEN(j)  (2304 + 64 * (j))
#define XB_TOP      3328
#define XB_TOPGEN   3392
#define XCD_BAR_WORDS 3456
#define XB_SPIN_CAP (1u << 18)
constexpr int CW_BAR = 8192;
__device__ __forceinline__ unsigned xb_ld(unsigned* p)              { return __hip_atomic_load(p, __ATOMIC_RELAXED, __HIP_MEMORY_SCOPE_AGENT); }
__device__ __forceinline__ unsigned xb_add(unsigned* p, unsigned v) { return __hip_atomic_fetch_add(p, v, __ATOMIC_RELAXED, __HIP_MEMORY_SCOPE_AGENT); }
__device__ __forceinline__ unsigned xb_xcc_id() { return (unsigned)__builtin_amdgcn_s_getreg((3 << 11) | 20) & 0xFu; }
#define XB_SPIN(cond, bar) do { unsigned _sp = 0; while (cond) { __builtin_amdgcn_s_sleep(1); \
    if ((++_sp & 255u) == 0u) { if (xb_ld(&(bar)[XB_TMO])) break; if (_sp > XB_SPIN_CAP) { atomicAdd(&(bar)[XB_TMO], 1u); break; } } } } while (0)
struct XcdBarrier { unsigned* bar; unsigned x; volatile LAS unsigned* st; };
__device__ __forceinline__ XcdBarrier xcd_barrier_post(unsigned* bar, volatile LAS unsigned* st) {
    XcdBarrier b; b.bar = bar; b.x = xb_xcc_id(); b.st = st;
    if (threadIdx.x == 0) (void)xb_add(&bar[XB_XCNT(b.x)], 1u);
    return b;
}
__device__ __forceinline__ void xcd_barrier_complete(unsigned* bar, unsigned x, unsigned& nloc, unsigned& nx) {
    const unsigned G = gridDim.x * gridDim.y * gridDim.z;
    unsigned sum, cnt, mine, sp = 0u;
    for (;;) {
        sum = 0u; cnt = 0u; mine = 0u;
#pragma unroll
        for (unsigned j = 0; j < 16; ++j) { const unsigned c = xb_ld(&bar[XB_XCNT(j)]); sum += c; cnt += (c > 0u) ? 1u : 0u; mine = (j == x) ? c : mine; }
        if (sum == G) break;
        __builtin_amdgcn_s_sleep(1);
        if ((++sp & 255u) == 0u) { if (xb_ld(&bar[XB_TMO])) break; if (sp > XB_SPIN_CAP) { atomicAdd(&bar[XB_TMO], 1u); break; } }
    }
    nloc = mine > 0u ? mine : 1u; nx = cnt > 0u ? cnt : 1u;
}
__device__ __forceinline__ void xcd_barrier(const XcdBarrier& b) {
    asm volatile("s_waitcnt vmcnt(0)" ::: "memory");
    __syncthreads();
    if (threadIdx.x == 0) {
        unsigned* bar = b.bar;
        __builtin_amdgcn_s_waitcnt(0);
        unsigned nloc = b.st[0], nx = b.st[1];
        if (nloc == 0u) { xcd_barrier_complete(bar, b.x, nloc, nx); b.st[0] = nloc; b.st[1] = nx; }
        const unsigned old = xb_add(&bar[XB_XSUB(b.x)], 1u);
        const unsigned gen = old / nloc;
        if (old + 1u == (gen + 1u) * nloc) {
            __builtin_amdgcn_fence(__ATOMIC_RELEASE, "agent");
            asm volatile("s_waitcnt vmcnt(0)" ::: "memory");
            const unsigned og = xb_add(&bar[XB_TOP], 1u);
            const unsigned tg = og / nx;
            if (og + 1u == (tg + 1u) * nx) xb_add(&bar[XB_TOPGEN], 1u);
            else XB_SPIN(xb_ld(&bar[XB_TOPGEN]) == tg, bar);
            __builtin_amdgcn_fence(__ATOMIC_ACQUIRE, "agent");
            xb_add(&bar[XB_XGEN(b.x)], 1u);
            asm volatile("s_waitcnt vmcnt(0)" ::: "memory");
        } else {
            XB_SPIN(xb_ld(&bar[XB_XGEN(b.x)]) == gen, bar);
            __builtin_amdgcn_fence(__ATOMIC_ACQUIRE, "agent");
            asm volatile("s_waitcnt vmcnt(0)" ::: "memory");
        }
    }
    __syncthreads();
}

constexpr int N_PHASES = 8;
struct Args { Inputs in; float* out; unsigned char* ws; int ph_lo, ph_hi; };

__global__ void __launch_bounds__(512, 2) mega(Args args) {
    extern __shared__ __attribute__((aligned(16))) unsigned char lds_raw[];
    LAS unsigned char* lds = (LAS unsigned char*)lds_raw;
    const int tid = threadIdx.x, lane = tid & 63, wave = __builtin_amdgcn_readfirstlane(tid >> 6);
    const int G = gridDim.x; const int bx = blockIdx.x; const int vcu = (G % 8 == 0) ? (bx % 8) * (G / 8) + bx / 8 : bx;
    unsigned char* ws = args.ws; const Inputs& in = args.in;
    unsigned* ctl = (unsigned*)(ws + WS_CTL);
    volatile LAS unsigned* MISC = (volatile LAS unsigned*)(lds + MISC_OFF);
    LAS int* moetab = (LAS int*)(lds + MOETAB_OFF);
    for (int u = tid; u < (LDS_BYTES - LDSCTL_OFF) / 4; u += 512) ((LAS unsigned*)(lds + LDSCTL_OFF))[u] = 0u;
    __syncthreads();
    const int lo = args.ph_lo, hi = args.ph_hi;
    const bool multi = (hi - lo) > 1;
    XcdBarrier bar; bar.bar = ctl + CW_BAR; bar.x = 0; bar.st = nullptr;
    if (multi) bar = xcd_barrier_post(ctl + CW_BAR, MISC + 8);
#define IN(k) (lo <= (k) && (k) < hi)
#define SEAM(k) do { if (IN(k) && IN((k) + 1)) xcd_barrier(bar); } while (0)

    if (IN(0)) { p0_prologue(in, ws, vcu * 8 + wave, G * 8, lane, (LAS float*)(lds + wave * 16384)); SEAM(0); }

    if (IN(1)) {
        pg8::DenseOrder S; S.init((const bf16_t*)(ws + WS_XN), (const bf16_t*)(ws + WS_WIN), NTOK, NPROJ, DM, G, bx);
        EpiInProj E{ws};
        pg8::gemm_phase(lds, S, E); SEAM(1);
    }
    if (IN(2)) {
#ifdef HAVE_ATTN
        attn_phase(lds, ws, in, G, vcu);
#endif
        SEAM(2);
    }
    if (IN(3)) {
        pg8::DenseOrder S; S.init((const bf16_t*)(ws + WS_Y), (const bf16_t*)(ws + WS_WOUT), NTOK, DM, DM, G, bx);
        EpiOutProj E{ws, in.x};
        pg8::gemm_phase(lds, S, E); SEAM(3);
    }
    if (IN(4)) {
        pg8::DenseOrder S; S.init((const bf16_t*)(ws + WS_X1B), (const bf16_t*)(ws + WS_WR), NTOK, 256, DM, G, bx);
        EpiRoute E{ws};
        pg8::gemm_phase(lds, S, E); SEAM(4);
    }
    if (IN(5)) {
        moe_tables(ws, moetab);
        MoeOrder S{(const bf16_t*)(ws + WS_X1B), (const bf16_t*)(ws + WS_WGU), DM, 0, (const int*)(ws + WS_LTOK), moetab, G, vcu};
        EpiGateUp E{ws};
        pg8::gemm_phase(lds, S, E); SEAM(5);
    }
    if (IN(6)) {
        if (!IN(5)) moe_tables(ws, moetab);
        MoeOrder S{(const bf16_t*)(ws + WS_HID), (const bf16_t*)(ws + WS_WD), EHID, 1, (const int*)(ws + WS_LTOK), moetab, G, vcu};
        EpiDown<0> E{ws, args.out};
        pg8::gemm_phase(lds, S, E); SEAM(6);
    }
    if (IN(7)) {
        if (!IN(5) && !IN(6)) moe_tables(ws, moetab);
        MoeOrder S{(const bf16_t*)(ws + WS_HID), (const bf16_t*)(ws + WS_WD), EHID, 2, (const int*)(ws + WS_LTOK), moetab, G, vcu};
        EpiDown<1> E{ws, args.out};
        pg8::gemm_phase(lds, S, E);
    }
#undef IN
#undef SEAM
}

extern "C" void kernel_launch(void* const* d_in, const int* in_sizes, int n_in, void* d_out, int out_size, void* d_ws, size_t ws_size, hipStream_t stream) {
    static int grid = 0;
    if (grid == 0) {
        if (n_in != 20 || in_sizes[0] != NTOK * DM || out_size != NTOK * DM || ws_size < WS_END) { fprintf(stderr, "kernel_launch: unexpected shapes (n_in %d, ws %zu)\n", n_in, ws_size); grid = -1; return; }
        int dev = 0, cus = 0, per_cu = 0;
        if (hipGetDevice(&dev) != hipSuccess || hipDeviceGetAttribute(&cus, hipDeviceAttributeMultiprocessorCount, dev) != hipSuccess) { grid = -1; return; }
        if (hipFuncSetAttribute((const void*)mega, hipFuncAttributeMaxDynamicSharedMemorySize, LDS_BYTES) != hipSuccess) { fprintf(stderr, "kernel_launch: hipFuncSetAttribute failed\n"); grid = -1; return; }
        if (hipOccupancyMaxActiveBlocksPerMultiprocessor(&per_cu, (const void*)mega, 512, LDS_BYTES) != hipSuccess || per_cu < 1) { fprintf(stderr, "kernel_launch: occupancy query says %d blocks per CU\n", per_cu); (void)hipGetLastError(); grid = -1; return; }
        grid = cus;
    }
    if (grid < 0) return;
    Args a{};
    const float** ip = (const float**)&a.in;
    for (int i = 0; i < 20; ++i) ip[i] = (const float*)d_in[i];
    a.out = (float*)d_out; a.ws = (unsigned char*)d_ws; a.ph_lo = 0; a.ph_hi = N_PHASES;
    (void)hipMemsetAsync((unsigned char*)d_ws + WS_CTL, 0, CTL_ZERO_BYTES, stream);
    hipLaunchKernelGGL(mega, dim3(grid), dim3(512), LDS_BYTES, stream, a);
}
```

```cpp
#include <hip/hip_runtime.h>
#include <cstdint>
#include <cstdio>

typedef unsigned short bf16_t;
typedef unsigned v4u __attribute__((ext_vector_type(4)));
typedef unsigned v2u __attribute__((ext_vector_type(2)));
typedef float f32x4 __attribute__((ext_vector_type(4)));
#define LAS __attribute__((address_space(3)))

constexpr int BATCH = 32, SEQ = 2048, DM = 1024, NTOK = BATCH * SEQ;
constexpr int HD = 64, HDIFF = 4, HMOBA = 8, NPROJ = 3072;
constexpr int NEXP = 32, EHID = 256, NLIST = 64;
constexpr int LIST_CAP = NTOK;
constexpr float RMS_EPS = 1e-6f;
constexpr float LOG2E = 1.4426950408889634f;
constexpr float C2 = 0.125f * LOG2E;
constexpr float LAMBDA_INIT = 0.2f;

constexpr size_t MiB = 1u << 20;
constexpr size_t WS_CTL = 0, CTL_ZERO_BYTES = 1 * MiB;
constexpr size_t WS_CONST = 1 * MiB;
constexpr size_t WS_WIN = 2 * MiB, WS_WOUT = 8 * MiB, WS_WR = 10 * MiB, WS_WGU = 12 * MiB, WS_WD = 44 * MiB;
constexpr size_t WS_QD = 64 * MiB, WS_KD = 128 * MiB, WS_VD = 192 * MiB, WS_QM = 256 * MiB, WS_KM = 320 * MiB, WS_VM = 384 * MiB;
constexpr size_t WS_XN = 448 * MiB, WS_Y = 448 * MiB;
constexpr size_t WS_X1B = 576 * MiB, WS_SS = 704 * MiB  , WS_R2 = 708 * MiB, WS_KMEAN = 709 * MiB;
constexpr size_t WS_PA = 64 * MiB, WS_HID = 192 * MiB, WS_LTOK = 272 * MiB, WS_LW = 288 * MiB;
constexpr size_t WS_END = 711 * MiB;
constexpr int CW_CNT = 1024;
constexpr int CF_LAMBDA = 0, CF_OFF = 16, CF_GAIN = 64  , CF_BT = 1024;

__device__ __forceinline__ float bf2f(bf16_t v) { return __uint_as_float(((unsigned)v) << 16); }
__device__ __forceinline__ unsigned f2bf(float f) { unsigned u = __float_as_uint(f); return (u + 0x7fffu + ((u >> 16) & 1u)) >> 16; }
__device__ __forceinline__ unsigned pk2(float lo, float hi) { return f2bf(lo) | (f2bf(hi) << 16); }
__device__ __forceinline__ float wave_sum(float v) {
#pragma unroll
    for (int o = 1; o < 64; o <<= 1) v += __shfl_xor(v, o);
    return v;
}
__device__ __forceinline__ float wave_max(float v) {
#pragma unroll
    for (int o = 1; o < 64; o <<= 1) v = fmaxf(v, __shfl_xor(v, o));
    return v;
}
__host__ __device__ __forceinline__ int phys_in(int c) { const int pn = c >> 8, cc = c & 255; return 256 * pn + 128 * ((cc >> 5) & 1) + 32 * (cc >> 6) + (cc & 31); }
__device__ __forceinline__ int t5_bucket(int d) {
    if (d < 16) return d;
    const float nf = (float)d;
    int large = 16 + (int)(logf(nf / 16.0f) / 4.852030263919617f * 16.0f);
    return large < 31 ? large : 31;
}

struct Inputs {
    const float *x, *norm1_g, *w_in, *diff_q_g, *diff_k_g, *lq1, *lk1, *lq2, *lk2, *diff_sub_g, *moba_q_g, *moba_k_g, *rel_bias, *w_out, *norm2_g,
        *router_group, *router_expert, *w_gate, *w_up, *w_down;
};

__device__ __forceinline__ void p0_tr_item(const float* W, int ldw, int k0, int n_src, const float* gk, bf16_t* dst, int drow0, int dpitch, LAS float* scr, int lane) {
    float wv[32];
#pragma unroll
    for (int i = 0; i < 32; ++i) wv[i] = W[(size_t)(k0 + 2 * i + (lane >> 5)) * ldw + n_src + (lane & 31)];
#pragma unroll
    for (int i = 0; i < 32; ++i) { const int kk = 2 * i + (lane >> 5); float v = wv[i]; if (gk) v *= gk[k0 + kk]; scr[kk * 33 + (lane & 31)] = v; }
    asm volatile("s_waitcnt lgkmcnt(0)" ::: "memory");
    const int c = lane & 7;
#pragma unroll
    for (int j = 0; j < 4; ++j) {
        const int n = (lane >> 3) + 8 * j; const LAS float* s = scr + (8 * c) * 33 + n;
        v4u o; o.x = pk2(s[0 * 33], s[1 * 33]); o.y = pk2(s[2 * 33], s[3 * 33]); o.z = pk2(s[4 * 33], s[5 * 33]); o.w = pk2(s[6 * 33], s[7 * 33]);
        *(v4u*)(dst + (size_t)(drow0 + n) * dpitch + k0 + 8 * c) = o;
    }
    asm volatile("s_waitcnt lgkmcnt(0)" ::: "memory");
}

__device__ __forceinline__ void p0_prologue(const Inputs& in, unsigned char* ws, int gw, int NGW, int lane, LAS float* scr) {
    bf16_t* WIN_T = (bf16_t*)(ws + WS_WIN); bf16_t* WOUT_T = (bf16_t*)(ws + WS_WOUT); bf16_t* WR_T = (bf16_t*)(ws + WS_WR);
    bf16_t* WGU_T = (bf16_t*)(ws + WS_WGU); bf16_t* WD_T = (bf16_t*)(ws + WS_WD); bf16_t* XN = (bf16_t*)(ws + WS_XN);
    float* CF = (float*)(ws + WS_CONST);
    constexpr int I_IN = 16 * 96, I_OUT = 16 * 32, I_GU = 32 * 16 * 16, I_D = 32 * 4 * 32, NITEMS = I_IN + I_OUT + I_GU + I_D;
    for (int it = gw; it < NITEMS; it += NGW) {
        int r = it;
        if (r < I_IN) {
            const int kb = r / 96, nb = r % 96, p0 = 32 * nb, pn = p0 >> 8, pp = p0 & 255, bj = pp >> 7, wc = (pp >> 5) & 3;
            p0_tr_item(in.w_in, NPROJ, 64 * kb, 256 * pn + 64 * wc + 32 * bj, in.norm1_g, WIN_T, p0, DM, scr, lane); continue; }
        r -= I_IN;
        if (r < I_OUT) { const int kb = r / 32, nb = r % 32; p0_tr_item(in.w_out, DM, 64 * kb, 32 * nb, nullptr, WOUT_T, 32 * nb, DM, scr, lane); continue; }
        r -= I_OUT;
        if (r < I_GU) {
            const int e = r / 256, rr = r % 256, kb = rr / 16, nb = rr % 16, p0 = 32 * nb, pn = p0 >> 8, bj = (p0 >> 7) & 1, j0 = p0 & 127;
            const float* src = (bj ? in.w_up : in.w_gate) + (size_t)e * DM * EHID;
            p0_tr_item(src, EHID, 64 * kb, 128 * pn + j0, in.norm2_g, WGU_T + (size_t)e * 512 * DM, p0, DM, scr, lane); continue; }
        r -= I_GU;
        { const int e = r / 128, rr = r % 128, kb = rr / 32, nb = rr % 32;
          p0_tr_item(in.w_down + (size_t)e * EHID * DM, DM, 64 * kb, 32 * nb, nullptr, WD_T + (size_t)e * DM * EHID, 32 * nb, EHID, scr, lane); }
    }
    for (int idx = gw * 64 + lane; idx < 256 * DM; idx += NGW * 64) {
        const int p = idx >> 10, k = idx & 1023, g = (p >> 5) & 3, i = p & 31; float v = 0.f;
        if (p < 128) { if (i < 8) v = in.norm2_g[k] * in.router_expert[((size_t)g * DM + k) * 8 + i]; else if (i < 12) v = in.norm2_g[k] * in.router_group[k * 4 + (i - 8)]; }
        WR_T[idx] = (bf16_t)f2bf(v);
    }
    for (int idx = gw * 64 + lane; idx < 12 * 2048; idx += NGW * 64) {
        const int h = idx >> 11, d = idx & 2047; CF[CF_BT + idx] = in.rel_bias[t5_bucket(d) * 12 + h] * LOG2E;
    }
    if (gw == 0) {
        float a = in.lq1[lane] * in.lk1[lane], b = in.lq2[lane] * in.lk2[lane];
        a = wave_sum(a); b = wave_sum(b);
        const float mqd = wave_max(fabsf(in.diff_q_g[lane])), mkd = wave_max(fabsf(in.diff_k_g[lane]));
        const float mqm = wave_max(fabsf(in.moba_q_g[lane])), mkm = wave_max(fabsf(in.moba_k_g[lane]));
        if (lane == 0) CF[CF_LAMBDA] = expf(a) - expf(b) + LAMBDA_INIT;
        CF[CF_GAIN + lane] = in.diff_q_g[lane]; CF[CF_GAIN + 64 + lane] = in.diff_k_g[lane]; CF[CF_GAIN + 128 + lane] = in.moba_q_g[lane]; CF[CF_GAIN + 192 + lane] = in.moba_k_g[lane];
        if (lane < 12) {
            float mb = -1e30f; for (int bk = 0; bk < 32; ++bk) mb = fmaxf(mb, in.rel_bias[bk * 12 + lane]);
            const float qk = lane < 4 ? mqd * mkd : mqm * mkm;
            CF[CF_OFF + lane] = (8.0f * qk + mb) * LOG2E;
        }
    }
    for (int m0 = gw * 4; m0 < NTOK; m0 += NGW * 4) {
        f32x4 v[4][4];
#pragma unroll
        for (int rr = 0; rr < 4; ++rr) { const f32x4* xr = (const f32x4*)(in.x + (size_t)(m0 + rr) * DM) + lane;
#pragma unroll
            for (int j = 0; j < 4; ++j) v[rr][j] = __builtin_nontemporal_load(xr + 64 * j); }
#pragma unroll
        for (int rr = 0; rr < 4; ++rr) { float s = 0.f;
#pragma unroll
            for (int j = 0; j < 4; ++j) s += (v[rr][j].x * v[rr][j].x + v[rr][j].y * v[rr][j].y) + (v[rr][j].z * v[rr][j].z + v[rr][j].w * v[rr][j].w);
            const float r = rsqrtf(wave_sum(s) * (1.f / DM) + RMS_EPS);
            unsigned long long* o8 = (unsigned long long*)(XN + (size_t)(m0 + rr) * DM) + lane;
#pragma unroll
            for (int j = 0; j < 4; ++j) o8[64 * j] = (unsigned long long)pk2(v[rr][j].x * r, v[rr][j].y * r) | ((unsigned long long)pk2(v[rr][j].z * r, v[rr][j].w * r) << 32); }
    }
}

namespace pg8 {
typedef short bf16x8 __attribute__((ext_vector_type(8)));
constexpr int BM = 256, BK = 64, HALF = 128, HTB = HALF * BK * 2, STAGE_BYTES = 8 * HTB, NXCD = 8, WGM = 8;

__host__ __device__ __forceinline__ int lds_byte(int r, int c) { const int st = (r >> 4) * 2 + (c >> 5), rr = r & 15, cc = c & 31, ob = rr * 64 + cc * 2; return st * 1024 + (ob ^ (((ob >> 9) & 1) << 5)); }
__host__ __device__ __forceinline__ void stage_rc(int b, int& R, int& C) { const int st = b / 1024, sb = b % 1024, swz = sb ^ (((sb >> 9) & 1) << 5); R = (st >> 1) * 16 + swz / 64; C = (st & 1) * 32 + (swz % 64) / 2; }
__host__ __device__ __forceinline__ int perm32(int rho) { const int n = rho >> 4, i = rho & 15; return 8 * (i >> 2) + 4 * n + (i & 3); }

struct Unit { int pm, pn, a0, a1; };

struct DenseOrder {
    const bf16_t* A; const bf16_t* Bt; int K; int nM, nN, nwg, G, c;
    __device__ void init(const bf16_t* A_, const bf16_t* Bt_, int M, int N, int K_, int G_, int c_) { A = A_; Bt = Bt_; K = K_; nM = M / BM; nN = N / BM; nwg = nM * nN; G = G_; c = c_; }
    __device__ __forceinline__ bool next(int i, Unit& u) const {
        const long L = (long)i * G + c; if (L >= nwg) return false;
        int wgid = (int)L; { const int q = nwg / NXCD, r = nwg % NXCD, xcd = wgid % NXCD, off = wgid / NXCD; wgid = (xcd < r ? xcd * (q + 1) : r * (q + 1) + (xcd - r) * q) + off; }
        const int nig = WGM * nN, gid = wgid / nig, fm = gid * WGM, gsz = (nM - fm) < WGM ? (nM - fm) : WGM;
        u.pm = fm + ((wgid % nig) % gsz); u.pn = (wgid % nig) / gsz; u.a0 = 0; u.a1 = 256; return true;
    }
    __device__ __forceinline__ const char* abase() const { return (const char*)A; }
    __device__ __forceinline__ unsigned arow(const Unit& u, int r) const { return (unsigned)(u.pm * BM + r) * (unsigned)K * 2u; }
    __device__ __forceinline__ const char* bbase(const Unit& u) const { return (const char*)Bt + (size_t)u.pn * BM * K * 2; }
};

typedef float f32x2 __attribute__((ext_vector_type(2)));
__device__ __forceinline__ unsigned cvt_pk_bf16(float lo, float hi) { unsigned r; asm volatile("v_cvt_pk_bf16_f32 %0, %1, %2" : "=v"(r) : "v"(lo), "v"(hi)); return r; }

template <class Epi, class Sched, bool HALFN = false>
__device__ __forceinline__ void gemm_phase(LAS unsigned char* lds, const Sched& S, const Epi& E) {
    int tid_ = threadIdx.x; asm volatile("" : "+v"(tid_));
    const int tid = tid_, wid = __builtin_amdgcn_readfirstlane(tid >> 6), lane = tid & 63, wr = wid >> 2, wc = wid & 3, fr = lane & 15, fq = lane >> 4;
    const int K = S.K, nt = K / BK;
    int RA[2]; unsigned cA2[2], voffB[2];
#pragma unroll
    for (int i = 0; i < 2; ++i) { int R, C; stage_rc(tid * 16 + i * 8192, R, C); const int Rb = (R & ~31) + perm32(R & 31);
        RA[i] = R; cA2[i] = (unsigned)C * 2u; voffB[i] = (unsigned)(Rb * K + C) * 2u; }
    const size_t kstep = (size_t)(BK * 2);
    const size_t hstep = (size_t)HALF * K * 2;
    const unsigned ldsw = (unsigned)wid * 1024u;
    const int aoff = lds_byte(wr * 64 + fr, fq * 8), boff = lds_byte(wc * 32 + fr, fq * 8);
#define PG8_SA(b, h) (((b) * 2 + (h)) * HTB)
#define PG8_SB(b, h) ((4 + (b) * 2 + (h)) * HTB)
#define PG8_STAGE(bufoff, gbase, voff) do { _Pragma("unroll") for (int _i = 0; _i < 2; ++_i) \
        __builtin_amdgcn_global_load_lds((const unsigned*)((const char*)(gbase) + (voff)[_i]), (LAS unsigned*)(lds + (bufoff) + ldsw + _i * 8192), 16, 0, 0); } while (0)
#define PG8_LDA(dst, b, h) do { _Pragma("unroll") for (int m = 0; m < 4; ++m) _Pragma("unroll") for (int k = 0; k < 2; ++k) dst[m][k] = *(const LAS bf16x8*)(lds + PG8_SA(b, h) + aoff + m * 2048 + k * 1024); } while (0)
#define PG8_LDB(dst, b, h) do { _Pragma("unroll") for (int n = 0; n < 2; ++n) _Pragma("unroll") for (int k = 0; k < 2; ++k) dst[n][k] = *(const LAS bf16x8*)(lds + PG8_SB(b, h) + boff + n * 2048 + k * 1024); } while (0)
#define PG8_MMA(ai, bj, At, Bt) do { __builtin_amdgcn_s_setprio(1); _Pragma("unroll") for (int m = 0; m < 4; ++m) _Pragma("unroll") for (int n = 0; n < 2; ++n) _Pragma("unroll") for (int k = 0; k < 2; ++k) \
        acc[ai][bj][m][n] = __builtin_amdgcn_mfma_f32_16x16x32_bf16(Bt[n][k], At[m][k], acc[ai][bj][m][n], 0, 0, 0); __builtin_amdgcn_s_setprio(0); } while (0)
#define PG8_WAIT_V(n) asm volatile("s_waitcnt vmcnt(" #n ")" ::: "memory")
#define PG8_WAIT_L(n) asm volatile("s_waitcnt lgkmcnt(" #n ")" ::: "memory")
#define PG8_BAR __builtin_amdgcn_s_barrier()
#define PG8_SCHED __builtin_amdgcn_sched_barrier(0)
    Unit cur, nxt; int ui = 0;
    if (!S.next(0, cur)) return;
    f32x4 acc[2][2][4][2];
#pragma unroll
    for (int a = 0; a < 2; ++a)
#pragma unroll
        for (int b = 0; b < 2; ++b)
#pragma unroll
            for (int m = 0; m < 4; ++m)
#pragma unroll
                for (int n = 0; n < 2; ++n) acc[a][b][m][n] = (f32x4){0.f, 0.f, 0.f, 0.f};
    bf16x8 At[4][2], B0[2][2], B1[2][2];
    const char* const Ab = S.abase();
    unsigned oC[2][2], oN[2][2];
#pragma unroll
    for (int h = 0; h < 2; ++h)
#pragma unroll
        for (int i = 0; i < 2; ++i) { oC[h][i] = S.arow(cur, h * HALF + RA[i]) + cA2[i]; oN[h][i] = oC[h][i]; }
    const char* cB = S.bbase(cur);
    PG8_STAGE(PG8_SB(0, 0), cB, voffB); PG8_STAGE(PG8_SB(0, 1), cB + hstep, voffB); PG8_STAGE(PG8_SA(0, 0), Ab, oC[0]); PG8_STAGE(PG8_SA(0, 1), Ab, oC[1]);
    if (wr == 1) PG8_BAR;
    PG8_WAIT_V(2); PG8_BAR;
    PG8_STAGE(PG8_SB(1, 0), cB + kstep, voffB); PG8_STAGE(PG8_SA(1, 0), Ab + kstep, oC[0]); PG8_STAGE(PG8_SB(1, 1), cB + hstep + kstep, voffB);
    PG8_WAIT_V(6); PG8_BAR;
    for (;;) {
        const bool has_next = S.next(ui + 1, nxt);
        const char* nB = has_next ? S.bbase(nxt) : cB;
        if (has_next) {
#pragma unroll
            for (int h = 0; h < 2; ++h)
#pragma unroll
                for (int i = 0; i < 2; ++i) oN[h][i] = S.arow(nxt, h * HALF + RA[i]) + cA2[i];
        }
        for (int t = 0; t < nt; t += 2) {
            const bool last = (t == nt - 2);
            const char* a1 = Ab + (size_t)(t + 1) * kstep;
            const char* a2 = last ? Ab : Ab + (size_t)(t + 2) * kstep; const char* b2 = last ? nB : cB + (size_t)(t + 2) * kstep;
            const char* a3 = a2 + kstep; const char* b3 = b2 + kstep;
            unsigned o2[2][2];
#pragma unroll
            for (int h = 0; h < 2; ++h)
#pragma unroll
                for (int i = 0; i < 2; ++i) o2[h][i] = last ? oN[h][i] : oC[h][i];
            PG8_LDB(B0, 0, 0); PG8_LDB(B1, 0, 1); PG8_SCHED; PG8_LDA(At, 0, 0); PG8_STAGE(PG8_SA(1, 1), a1, oC[1]);
            PG8_WAIT_V(8); PG8_WAIT_L(0); PG8_BAR; PG8_MMA(0, 0, At, B0); if (!HALFN) PG8_MMA(0, 1, At, B1); PG8_BAR; PG8_SCHED;
            PG8_LDA(At, 0, 1); PG8_STAGE(PG8_SB(0, 0), b2, voffB); PG8_STAGE(PG8_SB(0, 1), b2 + hstep, voffB); PG8_STAGE(PG8_SA(0, 0), a2, o2[0]);
            PG8_WAIT_V(8); PG8_WAIT_L(0); PG8_BAR; PG8_MMA(1, 0, At, B0); if (!HALFN) PG8_MMA(1, 1, At, B1); PG8_BAR; PG8_SCHED;
            PG8_LDB(B0, 1, 0); PG8_LDB(B1, 1, 1); PG8_SCHED; PG8_LDA(At, 1, 0); PG8_STAGE(PG8_SA(0, 1), a2, o2[1]);
            PG8_WAIT_V(8); PG8_WAIT_L(0); PG8_BAR; PG8_MMA(0, 0, At, B0); if (!HALFN) PG8_MMA(0, 1, At, B1); PG8_BAR; PG8_SCHED;
            PG8_LDA(At, 1, 1); PG8_STAGE(PG8_SB(1, 0), b3, voffB); PG8_STAGE(PG8_SB(1, 1), b3 + hstep, voffB); PG8_STAGE(PG8_SA(1, 0), a3, o2[0]);
            PG8_WAIT_V(8); PG8_WAIT_L(0); PG8_BAR; PG8_MMA(1, 0, At, B0); if (!HALFN) PG8_MMA(1, 1, At, B1); PG8_BAR; PG8_SCHED;
        }
        if (wr == 0) PG8_BAR;
        { int frE = fr, fqE = fq; asm volatile("" : "+v"(frE), "+v"(fqE));
          E(acc, cur, wr, wc, frE, fqE); }
        if (!has_next) break;
#pragma unroll
        for (int a = 0; a < 2; ++a)
#pragma unroll
            for (int b = 0; b < 2; ++b)
#pragma unroll
                for (int m = 0; m < 4; ++m)
#pragma unroll
                    for (int n = 0; n < 2; ++n) acc[a][b][m][n] = (f32x4){0.f, 0.f, 0.f, 0.f};
        cur = nxt; cB = nB; ++ui;
#pragma unroll
        for (int h = 0; h < 2; ++h)
#pragma unroll
            for (int i = 0; i < 2; ++i) oC[h][i] = oN[h][i];
        if (wr == 1) PG8_BAR;
    }
    PG8_WAIT_V(0);
    PG8_BAR;
#undef PG8_SA
#undef PG8_SB
#undef PG8_STAGE
#undef PG8_LDA
#undef PG8_LDB
#undef PG8_MMA
#undef PG8_WAIT_V
#undef PG8_WAIT_L
#undef PG8_BAR
#undef PG8_SCHED
}
}

constexpr size_t WS_LR = 304 * MiB;
constexpr int SS_PARTS = 16;
constexpr int RING_BYTES = 131072  , LDSCTL_OFF = 139264  , MISC_OFF = LDSCTL_OFF + 320, MOETAB_OFF = LDSCTL_OFF + 1024;
constexpr int LDS_BYTES = 147456;
constexpr int MT_CNT = 0, MT_ALL = 64, MT_R0 = 64 + 65, MT_R1 = 64 + 65 + 33;

__device__ __forceinline__ f32x4 ldg4(const float* p) { return *(const f32x4*)p; }

struct MoeOrder {
    const bf16_t* A; const bf16_t* Bt; int K; int mode; const int* ltok; const LAS int* tab; int G, c;
    __device__ __forceinline__ bool next(int i, pg8::Unit& u) const {
        const int L = i * G + c;
        if (mode == 0) {
            const int T = L >> 1; if (T >= tab[MT_ALL + 64]) return false;
            int lo = 0;
#pragma unroll
            for (int s = 32; s >= 1; s >>= 1) if (tab[MT_ALL + lo + s] <= T) lo += s;
            const int tile = T - tab[MT_ALL + lo]; u.pm = T; u.pn = L & 1; u.a0 = lo | (tile << 8); const int v = tab[MT_CNT + lo] - tile * 256; u.a1 = v < 256 ? v : 256; return true;
        } else {
            const int T = L >> 2; const int tb = mode == 1 ? MT_R0 : MT_R1; if (T >= tab[tb + 32]) return false;
            int lo = 0;
#pragma unroll
            for (int s = 16; s >= 1; s >>= 1) if (tab[tb + lo + s] <= T) lo += s;
            const int list = 2 * lo + (mode - 1), tile = T - tab[tb + lo]; u.pm = tab[MT_ALL + list] + tile; u.pn = L & 3; u.a0 = list | (tile << 8);
            const int v = tab[MT_CNT + list] - tile * 256; u.a1 = v < 256 ? v : 256; return true;
        }
    }
    __device__ __forceinline__ const char* abase() const { return (const char*)A; }
    __device__ __forceinline__ unsigned arow(const pg8::Unit& u, int r) const {
        if (mode == 0) { const int list = u.a0 & 255, tile = u.a0 >> 8; const int tok = r < u.a1 ? ltok[(size_t)list * LIST_CAP + tile * 256 + r] : 0; return (unsigned)tok * (unsigned)(DM * 2); }
        return (unsigned)(u.pm * 256 + r) * (unsigned)(EHID * 2);
    }
    __device__ __forceinline__ const char* bbase(const pg8::Unit& u) const {
        const int e = (u.a0 & 255) >> 1;
        if (mode == 0) return (const char*)Bt + ((size_t)e * 512 + u.pn * 256) * DM * 2;
        return (const char*)Bt + ((size_t)e * DM + u.pn * 256) * EHID * 2;
    }
};
__device__ __forceinline__ void moe_tables(unsigned char* ws, LAS int* tab) {
    if (threadIdx.x < 64) tab[MT_CNT + threadIdx.x] = (int)__hip_atomic_load((unsigned*)(ws + WS_CTL) + CW_CNT + 64 * threadIdx.x, __ATOMIC_RELAXED, __HIP_MEMORY_SCOPE_AGENT);
    __syncthreads();
    if (threadIdx.x == 0) { int a = 0, r0 = 0, r1 = 0;
        for (int l = 0; l < 64; ++l) { const int t = (tab[MT_CNT + l] + 255) >> 8; tab[MT_ALL + l] = a; a += t; if (l & 1) { tab[MT_R1 + (l >> 1)] = r1; r1 += t; } else { tab[MT_R0 + (l >> 1)] = r0; r0 += t; } }
        tab[MT_ALL + 64] = a; tab[MT_R0 + 32] = r0; tab[MT_R1 + 32] = r1; }
    __syncthreads();
}

struct EpiInProj {
    unsigned char* ws;
    __device__ __forceinline__ void operator()(const f32x4 (&acc)[2][2][4][2], const pg8::Unit& u, int wr, int wc, int fr, int fq) const {
        const int seg = u.pn >> 1, gi = ((u.pn & 1) << 2) | wc, b = u.pm >> 3, blk = u.pm & 7;
        const bool nrm = (seg != 2 && seg != 5);
        const float* gp = (const float*)(ws + WS_CONST) + CF_GAIN + 64 * (seg == 0 ? 0 : seg == 1 ? 1 : seg == 3 ? 2 : 3);
        const float qs = (seg == 0 || seg == 3) ? C2 : 1.0f;
        f32x4 g[2][2];
#pragma unroll
        for (int bj = 0; bj < 2; ++bj)
#pragma unroll
            for (int n = 0; n < 2; ++n) g[bj][n] = nrm ? ldg4(gp + 32 * bj + 8 * fq + 4 * n) * qs : (f32x4){1.f, 1.f, 1.f, 1.f};
        bf16_t* base; size_t rstride;
        if (seg < 2) { base = (bf16_t*)(ws + (seg == 0 ? WS_QD : WS_KD)) + ((size_t)((b * 4 + (gi >> 1)) * 2 + (gi & 1)) * SEQ + blk * 256) * 64; rstride = 64; }
        else if (seg == 2) { base = (bf16_t*)(ws + WS_VD) + ((size_t)(b * 4 + (gi >> 1)) * SEQ + blk * 256) * 128 + (gi & 1) * 64; rstride = 128; }
        else { base = (bf16_t*)(ws + (seg == 3 ? WS_QM : seg == 4 ? WS_KM : WS_VM)) + ((size_t)(b * 8 + gi) * SEQ + blk * 256) * 64; rstride = 64; }
        f32x4 ks[2][2];
#pragma unroll
        for (int bj = 0; bj < 2; ++bj)
#pragma unroll
            for (int n = 0; n < 2; ++n) ks[bj][n] = (f32x4){0.f, 0.f, 0.f, 0.f};
#pragma unroll
        for (int ai = 0; ai < 2; ++ai)
#pragma unroll
            for (int m = 0; m < 4; ++m) {
                const int r = 128 * ai + 64 * wr + 16 * m + fr;
                f32x4 v[2][2]; float ss = 0.f;
#pragma unroll
                for (int bj = 0; bj < 2; ++bj)
#pragma unroll
                    for (int n = 0; n < 2; ++n) { v[bj][n] = acc[ai][bj][m][n]; ss += (v[bj][n][0] * v[bj][n][0] + v[bj][n][1] * v[bj][n][1]) + (v[bj][n][2] * v[bj][n][2] + v[bj][n][3] * v[bj][n][3]); }
                float rs = 1.f;
                if (nrm) { ss += __shfl_xor(ss, 16); ss += __shfl_xor(ss, 32); rs = rsqrtf(ss * (1.f / 64.f) + RMS_EPS); }
                bf16_t* rowp = base + (size_t)r * rstride + 8 * fq;
#pragma unroll
                for (int bj = 0; bj < 2; ++bj) {
                    const f32x4 a = v[bj][0] * rs * g[bj][0], c = v[bj][1] * rs * g[bj][1];
                    if (seg == 4) { ks[bj][0] += a; ks[bj][1] += c; }
                    v4u w; w.x = pg8::cvt_pk_bf16(a[0], a[1]); w.y = pg8::cvt_pk_bf16(a[2], a[3]); w.z = pg8::cvt_pk_bf16(c[0], c[1]); w.w = pg8::cvt_pk_bf16(c[2], c[3]);
                    *(v4u*)(rowp + 32 * bj) = w;
                }
            }
        if (seg == 4) {
            float* km = (float*)(ws + WS_KMEAN) + (((size_t)(b * 8 + blk) * 2 + wr) * 8 + gi) * 64;
#pragma unroll
            for (int bj = 0; bj < 2; ++bj)
#pragma unroll
                for (int n = 0; n < 2; ++n) { f32x4 s = ks[bj][n];
#pragma unroll
                    for (int j = 0; j < 4; ++j) { float t = s[j]; t += __shfl_xor(t, 1); t += __shfl_xor(t, 2); t += __shfl_xor(t, 4); t += __shfl_xor(t, 8); s[j] = t; }
                    if (fr == 0) *(f32x4*)(km + 32 * bj + 8 * fq + 4 * n) = s; }
        }
    }
};

struct EpiOutProj {
    unsigned char* ws; const float* x;
    __device__ __forceinline__ void operator()(const f32x4 (&acc)[2][2][4][2], const pg8::Unit& u, int wr, int wc, int fr, int fq) const {
        bf16_t* X1B = (bf16_t*)(ws + WS_X1B); float* SS = (float*)(ws + WS_SS);
#pragma unroll
        for (int ai = 0; ai < 2; ++ai) {
            f32x4 xv[4][2][2];
#pragma unroll
            for (int m = 0; m < 4; ++m)
#pragma unroll
                for (int bj = 0; bj < 2; ++bj) { const size_t off = ((size_t)u.pm * 256 + 128 * ai + 64 * wr + 16 * m + fr) * DM + u.pn * 256 + 128 * bj + 32 * wc + 8 * fq;
                    xv[m][bj][0] = ldg4(x + off); xv[m][bj][1] = ldg4(x + off + 4); }
#pragma unroll
            for (int m = 0; m < 4; ++m) {
                const size_t row = (size_t)u.pm * 256 + 128 * ai + 64 * wr + 16 * m + fr; float ss = 0.f;
#pragma unroll
                for (int bj = 0; bj < 2; ++bj) {
                    const size_t off = row * DM + u.pn * 256 + 128 * bj + 32 * wc + 8 * fq;
                    const f32x4 a = acc[ai][bj][m][0] + xv[m][bj][0], c = acc[ai][bj][m][1] + xv[m][bj][1];
                    ss += (a[0] * a[0] + a[1] * a[1]) + (a[2] * a[2] + a[3] * a[3]) + (c[0] * c[0] + c[1] * c[1]) + (c[2] * c[2] + c[3] * c[3]);
                    v4u w; w.x = pg8::cvt_pk_bf16(a[0], a[1]); w.y = pg8::cvt_pk_bf16(a[2], a[3]); w.z = pg8::cvt_pk_bf16(c[0], c[1]); w.w = pg8::cvt_pk_bf16(c[2], c[3]);
                    *(v4u*)(X1B + off) = w;
                }
                ss += __shfl_xor(ss, 16); ss += __shfl_xor(ss, 32);
                if (fq == 0) SS[row * SS_PARTS + u.pn * 4 + wc] = ss;
            }
        }
    }
};

constexpr int ROUTE_OFF = LDSCTL_OFF + 2048;
struct EpiRoute {
    unsigned char* ws; LAS unsigned char* lds;
    __device__ __forceinline__ void operator()(const f32x4 (&acc)[2][2][4][2], const pg8::Unit& u, int wr, int wc, int fr, int fq) const {
        const float* SS = (const float*)(ws + WS_SS);
        LAS int* lcount = (LAS int*)(lds + ROUTE_OFF); LAS int* lbase = lcount + 64;
        unsigned* CTL = (unsigned*)(ws + WS_CTL); int* LTOK = (int*)(ws + WS_LTOK); float* LW = (float*)(ws + WS_LW); float* LR = (float*)(ws + WS_LR);
        if (threadIdx.x < 64) lcount[threadIdx.x] = 0;
        asm volatile("s_waitcnt lgkmcnt(0)" ::: "memory"); __builtin_amdgcn_s_barrier(); asm volatile("" ::: "memory");
        int l0v[2][4], p0v[2][4], l1v[2][4], p1v[2][4]; float w0v[2][4], w1v[2][4], r2v[2][4];
#pragma unroll
        for (int ai = 0; ai < 2; ++ai)
#pragma unroll
            for (int m = 0; m < 4; ++m) {
                const int row = u.pm * 256 + 128 * ai + 64 * wr + 16 * m + fr;
                const f32x4 e0 = acc[ai][0][m][0], e1 = acc[ai][0][m][1];
                float gl[4];
#pragma unroll
                for (int j = 0; j < 4; ++j) gl[j] = __shfl_down(e0[j], 16);
                int g = 0; float gv = gl[0];
#pragma unroll
                for (int i = 1; i < 4; ++i) if (gl[i] > gv) { gv = gl[i]; g = i; }
                l0v[ai][m] = -1; p0v[ai][m] = 0; l1v[ai][m] = 0; p1v[ai][m] = 0; w0v[ai][m] = 0.f; w1v[ai][m] = 0.f; r2v[ai][m] = 0.f;
                if (fq == 0 && g == wc) {
                    const float* sp = SS + (size_t)row * SS_PARTS; const f32x4 s0 = ldg4(sp), s1 = ldg4(sp + 4), s2 = ldg4(sp + 8), s3 = ldg4(sp + 12);
                    const float tot = ((s0[0] + s0[1]) + (s0[2] + s0[3])) + ((s1[0] + s1[1]) + (s1[2] + s1[3])) + ((s2[0] + s2[1]) + (s2[2] + s2[3])) + ((s3[0] + s3[1]) + (s3[2] + s3[3]));
                    const float r2 = rsqrtf(tot * (1.f / DM) + RMS_EPS);
                    const float el[8] = {e0[0], e0[1], e0[2], e0[3], e1[0], e1[1], e1[2], e1[3]};
                    const float mx = fmaxf(fmaxf(gl[0], gl[1]), fmaxf(gl[2], gl[3])) * r2;
                    const float den = (__expf(gl[0] * r2 - mx) + __expf(gl[1] * r2 - mx)) + (__expf(gl[2] * r2 - mx) + __expf(gl[3] * r2 - mx));
                    const float pg = __expf(gv * r2 - mx) / den;
                    float v0 = el[0]; int x0 = 0;
#pragma unroll
                    for (int i = 1; i < 8; ++i) if (el[i] > v0) { v0 = el[i]; x0 = i; }
                    float v1 = -3.0e38f; int x1 = 0;
#pragma unroll
                    for (int i = 0; i < 8; ++i) if (i != x0 && el[i] > v1) { v1 = el[i]; x1 = i; }
                    const float w0 = 1.f / (1.f + __expf((v1 - v0) * r2));
                    const int l0 = (g * 8 + x0) * 2, l1 = (g * 8 + x1) * 2 + 1;
                    l0v[ai][m] = l0; l1v[ai][m] = l1; w0v[ai][m] = pg * w0; w1v[ai][m] = pg * (1.f - w0); r2v[ai][m] = r2;
                    p0v[ai][m] = atomicAdd((int*)(lcount + l0), 1); p1v[ai][m] = atomicAdd((int*)(lcount + l1), 1);
                }
            }
        asm volatile("s_waitcnt lgkmcnt(0)" ::: "memory"); __builtin_amdgcn_s_barrier(); asm volatile("" ::: "memory");
        if (threadIdx.x < 64) lbase[threadIdx.x] = (int)atomicAdd(CTL + CW_CNT + 64 * threadIdx.x, (unsigned)lcount[threadIdx.x]);
        asm volatile("s_waitcnt vmcnt(0) lgkmcnt(0)" ::: "memory"); __builtin_amdgcn_s_barrier(); asm volatile("" ::: "memory");
#pragma unroll
        for (int ai = 0; ai < 2; ++ai)
#pragma unroll
            for (int m = 0; m < 4; ++m) if (l0v[ai][m] >= 0) {
                const int row = u.pm * 256 + 128 * ai + 64 * wr + 16 * m + fr;
                const size_t a0 = (size_t)l0v[ai][m] * LIST_CAP + lbase[l0v[ai][m]] + p0v[ai][m], a1 = (size_t)l1v[ai][m] * LIST_CAP + lbase[l1v[ai][m]] + p1v[ai][m];
                LTOK[a0] = row; LW[a0] = w0v[ai][m]; LR[a0] = r2v[ai][m]; LTOK[a1] = row; LW[a1] = w1v[ai][m]; LR[a1] = r2v[ai][m];
            }
    }
};

struct EpiGateUp {
    unsigned char* ws;
    __device__ __forceinline__ void operator()(const f32x4 (&acc)[2][2][4][2], const pg8::Unit& u, int wr, int wc, int fr, int fq) const {
        const int list = u.a0 & 255, tile = u.a0 >> 8; const float* LR = (const float*)(ws + WS_LR) + (size_t)list * LIST_CAP + tile * 256;
        bf16_t* HID = (bf16_t*)(ws + WS_HID);
        float r2v[2][4];
#pragma unroll
        for (int ai = 0; ai < 2; ++ai)
#pragma unroll
            for (int m = 0; m < 4; ++m) { const int r = 128 * ai + 64 * wr + 16 * m + fr; r2v[ai][m] = LR[r < u.a1 ? r : u.a1 - 1]; }
#pragma unroll
        for (int ai = 0; ai < 2; ++ai)
#pragma unroll
            for (int m = 0; m < 4; ++m) {
                const int r = 128 * ai + 64 * wr + 16 * m + fr;
                const float r2 = r2v[ai][m]; float h[8];
#pragma unroll
                for (int n = 0; n < 2; ++n)
#pragma unroll
                    for (int j = 0; j < 4; ++j) { const float G = acc[ai][0][m][n][j] * r2, U = acc[ai][1][m][n][j] * r2;
                        h[4 * n + j] = G * __builtin_amdgcn_rcpf(1.f + __builtin_amdgcn_exp2f(-G * LOG2E)) * U; }
                v4u w; w.x = pg8::cvt_pk_bf16(h[0], h[1]); w.y = pg8::cvt_pk_bf16(h[2], h[3]); w.z = pg8::cvt_pk_bf16(h[4], h[5]); w.w = pg8::cvt_pk_bf16(h[6], h[7]);
                if (r < u.a1) *(v4u*)(HID + ((size_t)u.pm * 256 + r) * EHID + u.pn * 128 + 32 * wc + 8 * fq) = w;
            }
    }
};

template <int RK> struct EpiDown {
    unsigned char* ws; float* out;
    __device__ __forceinline__ void operator()(const f32x4 (&acc)[2][2][4][2], const pg8::Unit& u, int wr, int wc, int fr, int fq) const {
        const int list = u.a0 & 255, tile = u.a0 >> 8; const size_t eb = (size_t)list * LIST_CAP + tile * 256;
        const int* LTOK = (const int*)(ws + WS_LTOK) + eb; const float* LW = (const float*)(ws + WS_LW) + eb;
        const bf16_t* SRC = (const bf16_t*)(ws + (RK == 0 ? WS_X1B : WS_PA)); bf16_t* PA = (bf16_t*)(ws + WS_PA);
        int tokv[2][4]; float wv[2][4];
#pragma unroll
        for (int ai = 0; ai < 2; ++ai)
#pragma unroll
            for (int m = 0; m < 4; ++m) { const int r = 128 * ai + 64 * wr + 16 * m + fr, rc = r < u.a1 ? r : u.a1 - 1; tokv[ai][m] = LTOK[rc]; wv[ai][m] = LW[rc]; }
#pragma unroll
        for (int ai = 0; ai < 2; ++ai) {
            v4u bs[4][2];
#pragma unroll
            for (int m = 0; m < 4; ++m)
#pragma unroll
                for (int bj = 0; bj < 2; ++bj) bs[m][bj] = *(const v4u*)(SRC + (size_t)tokv[ai][m] * DM + u.pn * 256 + 128 * bj + 32 * wc + 8 * fq);
#pragma unroll
            for (int m = 0; m < 4; ++m) {
                const int r = 128 * ai + 64 * wr + 16 * m + fr; const bool ok = r < u.a1; const float wt = wv[ai][m];
#pragma unroll
                for (int bj = 0; bj < 2; ++bj) {
                    const size_t off = (size_t)tokv[ai][m] * DM + u.pn * 256 + 128 * bj + 32 * wc + 8 * fq; const v4u b4 = bs[m][bj];
                    f32x4 a, c;
                    a[0] = __uint_as_float(b4.x << 16); a[1] = __uint_as_float(b4.x & 0xffff0000u); a[2] = __uint_as_float(b4.y << 16); a[3] = __uint_as_float(b4.y & 0xffff0000u);
                    c[0] = __uint_as_float(b4.z << 16); c[1] = __uint_as_float(b4.z & 0xffff0000u); c[2] = __uint_as_float(b4.w << 16); c[3] = __uint_as_float(b4.w & 0xffff0000u);
                    a += acc[ai][bj][m][0] * wt; c += acc[ai][bj][m][1] * wt;
                    if (ok) {
                        if (RK == 0) { v4u w; w.x = pg8::cvt_pk_bf16(a[0], a[1]); w.y = pg8::cvt_pk_bf16(a[2], a[3]); w.z = pg8::cvt_pk_bf16(c[0], c[1]); w.w = pg8::cvt_pk_bf16(c[2], c[3]); *(v4u*)(PA + off) = w; }
                        else { *(f32x4*)(out + off) = a; *(f32x4*)(out + off + 4) = c; }
                    }
                }
            }
        }
    }
};

#define HAVE_ATTN 1
namespace att {
typedef short bf16x8 __attribute__((ext_vector_type(8)));
typedef short s16x4 __attribute__((ext_vector_type(4)));
typedef short v4i16_t __attribute__((ext_vector_type(4)));
typedef float f32x16 __attribute__((ext_vector_type(16)));
constexpr int TBL_STRIDE = 2384;
constexpr int TBL_BYTES = 38912, SLOT_OFF = TBL_BYTES, NSLOT = 3, STAGE_OFF = SLOT_OFF + 65536  , WSCR_OFF = SLOT_OFF + NSLOT * 32768, ATT_LDS = WSCR_OFF + 2048;
static_assert(4 * TBL_STRIDE * 4 <= TBL_BYTES && ATT_LDS <= LDSCTL_OFF, "attention LDS map");
constexpr float NEGBIG = -1.0e30f;
__device__ __forceinline__ int crow(int r, int hi) { return (r & 3) + 8 * (r >> 2) + 4 * hi; }
__device__ __forceinline__ s16x4 vtr(const LAS unsigned char* p) { return __builtin_bit_cast(s16x4, __builtin_amdgcn_ds_read_tr16_b64_v4i16((LAS v4i16_t*)p)); }
__device__ __forceinline__ void glds16(const void* gsrc, unsigned lds_dst) { unsigned keep;
    asm volatile("s_mov_b32 %0, m0\n\ts_mov_b32 m0, %2\n\ts_nop 0\n\tglobal_load_lds_dwordx4 %1, off\n\ts_mov_b32 m0, %0" : "=&s"(keep) : "v"(gsrc), "s"(lds_dst) : "memory"); }
__device__ __forceinline__ unsigned cvtpk(float lo, float hi) { typedef float f2 __attribute__((ext_vector_type(2))); typedef __bf16 b2 __attribute__((ext_vector_type(2))); f2 v = {lo, hi}; b2 b = __builtin_convertvector(v, b2); return __builtin_bit_cast(unsigned, b); }

__device__ __forceinline__ void build_table(LAS unsigned char* lds, const float* CF, int h12) {
    LAS float* tb = (LAS float*)lds; const float* BT = CF + CF_BT + h12 * 2048; const float off = CF[CF_OFF + h12];
    for (int idx = threadIdx.x; idx < 4 * TBL_STRIDE; idx += 512) { const int s = idx / TBL_STRIDE, i = idx - s * TBL_STRIDE, j = i + s; tb[idx] = j <= 2047 ? BT[2047 - j] - off : NEGBIG; }
}

template <int NK> __device__ __forceinline__ void epilogue(LAS unsigned char* lds, unsigned char* ws, const Inputs& in, int b, int h, int w, int map, int rb, int qw0, int lane_in, float lsum, att::f32x16 (&o)[NK == 2 ? 4 : 2]) {
    constexpr int ND = NK == 2 ? 4 : 2;
    int lane = lane_in; asm volatile("" : "+v"(lane));
    const int r32 = lane & 31, hi = lane >> 5;
    const float* CF = (const float*)(ws + WS_CONST);
    LAS float* wsf = (LAS float*)(lds + WSCR_OFF) + w * 64;
    if (hi == 0) wsf[r32] = lsum;
    asm volatile("s_waitcnt lgkmcnt(0)" ::: "memory");
    float rli[16];
#pragma unroll
    for (int r = 0; r < 16; ++r) rli[r] = __builtin_amdgcn_rcpf(wsf[crow(r, hi)]);
    bf16_t* Y = (bf16_t*)(ws + WS_Y);
    if (NK == 1) {
        LAS bf16_t* stg = (LAS bf16_t*)(lds + STAGE_OFF) + w * 2048;
#pragma unroll
        for (int r = 0; r < 16; ++r) { const int orow = crow(r, hi);
#pragma unroll
            for (int d0 = 0; d0 < ND; ++d0) stg[orow * 64 + d0 * 32 + r32] = (bf16_t)f2bf(o[d0][r] * rli[r]); }
        asm volatile("s_waitcnt lgkmcnt(0)" ::: "memory");
        bf16_t* Yw = Y + (size_t)(b * SEQ + qw0) * DM + 512 + h * 64;
#pragma unroll
        for (int i = 0; i < 4; ++i) { const int row = i * 8 + (lane >> 3), ch = lane & 7; const v4u v = *(const LAS v4u*)(stg + row * 64 + ch * 8); *(v4u*)(Yw + (size_t)row * DM + ch * 8) = v; }
    } else {
        LAS float* X = (LAS float*)(lds + SLOT_OFF) + (size_t)rb * 32 * 128;
        const float lam = CF[CF_LAMBDA];
        if (map == 1) {
#pragma unroll
            for (int r = 0; r < 16; ++r) { const int orow = crow(r, hi); const float f = rli[r] * lam;
#pragma unroll
                for (int d0 = 0; d0 < ND; ++d0) X[orow * 128 + d0 * 32 + r32] = o[d0][r] * f; }
        }
        asm volatile("s_waitcnt lgkmcnt(0)" ::: "memory"); __syncthreads();
        if (map == 0) {
            float gsub[ND];
#pragma unroll
            for (int d0 = 0; d0 < ND; ++d0) gsub[d0] = in.diff_sub_g[d0 * 32 + r32];
            LAS bf16_t* stg = (LAS bf16_t*)(lds + STAGE_OFF) + rb * 4096;
#pragma unroll
            for (int r = 0; r < 16; ++r) { const int orow = crow(r, hi); float v[ND]; float ss = 0.f;
#pragma unroll
                for (int d0 = 0; d0 < ND; ++d0) { v[d0] = o[d0][r] * rli[r] - X[orow * 128 + d0 * 32 + r32]; ss += v[d0] * v[d0]; }
                ss += __shfl_xor(ss, 1); ss += __shfl_xor(ss, 2); ss += __shfl_xor(ss, 4); ss += __shfl_xor(ss, 8); ss += __shfl_xor(ss, 16);
                const float sc2 = rsqrtf(ss * (1.f / 128.f) + RMS_EPS) * (1.f - LAMBDA_INIT);
#pragma unroll
                for (int d0 = 0; d0 < ND; ++d0) stg[orow * 128 + d0 * 32 + r32] = (bf16_t)f2bf(v[d0] * sc2 * gsub[d0]); }
            asm volatile("s_waitcnt lgkmcnt(0)" ::: "memory");
            bf16_t* Yw = Y + (size_t)(b * SEQ + qw0) * DM + h * 128;
#pragma unroll
            for (int i = 0; i < 8; ++i) { const int row = i * 4 + (lane >> 4), ch = lane & 15; const v4u v = *(const LAS v4u*)(stg + row * 128 + ch * 8); *(v4u*)(Yw + (size_t)row * DM + ch * 8) = v; }
        }
    }
    asm volatile("s_waitcnt lgkmcnt(0)" ::: "memory"); __syncthreads();
}


template <int NK, int ABL> __device__ __forceinline__ void attn_unit(LAS unsigned char* lds, unsigned char* ws, const Inputs& in, int b, int h, int qb) {
    constexpr int DV = NK == 2 ? 128 : 64, ND = DV / 32, ROWS = NK == 2 ? 128 : 256, SLOTB = NK == 2 ? 32768 : 16384, VOFF = 8192 * NK;
    const int tid = threadIdx.x; int lane_ = tid & 63; asm volatile("" : "+v"(lane_));
    const int lane = lane_, r32 = lane & 31, hi = lane >> 5; const int w = __builtin_amdgcn_readfirstlane(tid >> 6);
    const int map = NK == 2 ? (w >> 2) : 0, rb = NK == 2 ? (w & 3) : w;
    const int q0 = qb * ROWS, qw0 = q0 + 32 * rb, qabs = qw0 + r32, NT = (q0 + ROWS) / 64;
    const float* CF = (const float*)(ws + WS_CONST);
    const bf16_t *Qh, *Kh0, *Kh1, *Vh;
    if (NK == 2) { const size_t hb = (size_t)(b * 4 + h) * 2; Qh = (const bf16_t*)(ws + WS_QD) + (hb + map) * SEQ * 64; Kh0 = (const bf16_t*)(ws + WS_KD) + hb * SEQ * 64; Kh1 = Kh0 + (size_t)SEQ * 64;
                   Vh = (const bf16_t*)(ws + WS_VD) + (size_t)(b * 4 + h) * SEQ * 128; }
    else { const size_t hb = (size_t)(b * 8 + h); Qh = (const bf16_t*)(ws + WS_QM) + hb * SEQ * 64; Kh0 = (const bf16_t*)(ws + WS_KM) + hb * SEQ * 64; Kh1 = Kh0; Vh = (const bf16_t*)(ws + WS_VM) + hb * SEQ * 64; }
    const bf16_t* ksrc0 = Kh0 + (size_t)lane * 64 + w * 8; const bf16_t* ksrc1 = Kh1 + (size_t)lane * 64 + w * 8;
    const bf16_t* vsrc0 = Vh + (size_t)(16 * (w & 3) + (lane >> 2)) * DV + (w >> 2) * 32 + (lane & 3) * 8;
    const bf16_t* vsrc1 = vsrc0 + 64;
    constexpr int KSB = 8192 * NK, VSB = 128 * DV, KRING = SLOT_OFF, VRING = SLOT_OFF + 49152;
    const unsigned kdst = (unsigned)(uintptr_t)(lds + KRING) + (unsigned)w * 1024u, vdst = (unsigned)(uintptr_t)(lds + VRING) + (unsigned)w * 1024u;
#define ATT_DMAK(t, off) do { if (ABL & 16) break; const unsigned d_ = (unsigned)__builtin_amdgcn_readfirstlane(kdst + (unsigned)(off)); const size_t o_ = (size_t)(t) * 64 * 64; glds16(ksrc0 + o_, d_); if (NK == 2) glds16(ksrc1 + o_, d_ + 8192u); } while (0)
#define ATT_DMAV(t, off) do { if (ABL & 16) break; const unsigned d_ = (unsigned)__builtin_amdgcn_readfirstlane(vdst + (unsigned)(off)); const size_t o_ = (size_t)(t) * 64 * DV; glds16(vsrc0 + o_, d_); if (NK == 2) glds16(vsrc1 + o_, d_ + 8192u); } while (0)
    if (NK == 1) { ATT_DMAK(0, 0); ATT_DMAV(0, 0); ATT_DMAK(1, KSB); ATT_DMAV(1, VSB); ATT_DMAK(2, 2 * KSB); }
    else { ATT_DMAK(0, 0); ATT_DMAV(0, 0); ATT_DMAK(1, KSB); }
    bf16x8 qr[4];
#pragma unroll
    for (int d0 = 0; d0 < 4; ++d0) qr[d0] = *(const bf16x8*)(Qh + (size_t)qabs * 64 + d0 * 16 + hi * 8);
    unsigned selmask = 0xffffffffu;
    if (NK == 1 && qb > 0) {
        const float* KMEAN = (const float*)(ws + WS_KMEAN); float gate[8];
#pragma unroll
        for (int n = 0; n < 8; ++n) { float g = 0.f;
            if (n < qb) { const float* k0 = KMEAN + (((size_t)(b * 8 + n) * 2 + 0) * 8 + h) * 64;
#pragma unroll
                for (int d0 = 0; d0 < 4; ++d0) { const f32x4 a0 = ldg4(k0 + 16 * d0 + 8 * hi) + ldg4(k0 + 512 + 16 * d0 + 8 * hi), a1 = ldg4(k0 + 16 * d0 + 8 * hi + 4) + ldg4(k0 + 512 + 16 * d0 + 8 * hi + 4);
                    const bf16x8 qv = qr[d0];
                    g += bf2f((bf16_t)qv[0]) * a0[0] + bf2f((bf16_t)qv[1]) * a0[1] + bf2f((bf16_t)qv[2]) * a0[2] + bf2f((bf16_t)qv[3]) * a0[3]
                       + bf2f((bf16_t)qv[4]) * a1[0] + bf2f((bf16_t)qv[5]) * a1[1] + bf2f((bf16_t)qv[6]) * a1[2] + bf2f((bf16_t)qv[7]) * a1[3]; } }
            g += __shfl_xor(g, 32); gate[n] = g; }
        selmask = 0u;
#pragma unroll
        for (int n = 0; n < 8; ++n) { int better = 0;
#pragma unroll
            for (int m = 0; m < 8; ++m) if (m != n) better += (m < qb && (gate[m] > gate[n] || (gate[m] == gate[n] && m < n))) ? 1 : 0;
            if (n < qb && better < 3) selmask |= 1u << n; }
        selmask |= 1u << qb;
    }
    const int j0 = 2047 - qabs + 4 * hi, sc = j0 & 3;
    const LAS unsigned char* tb_base = lds + (sc * TBL_STRIDE + (j0 - sc)) * 4;
    const LAS unsigned char* tb_neg = lds + (sc * TBL_STRIDE + 2052) * 4;
    const LAS unsigned char* kp0 = lds + KRING + map * 8192 + hi * 1024 + r32 * 16;
    const LAS unsigned char* vp0 = lds + VRING + ((lane >> 4) & 1) * 32 + (lane & 3) * 8 + (4 * hi + ((lane & 15) >> 2)) * 64;
    f32x16 o[ND];
#pragma unroll
    for (int d = 0; d < ND; ++d) o[d] = f32x16{};
    float ls0 = 0.f, ls1 = 0.f;
#pragma unroll
    for (int d0 = 0; d0 < 4; ++d0) asm volatile("" : "+v"(qr[d0]));
    asm volatile("s_waitcnt vmcnt(0)" ::: "memory"); __syncthreads();
    const int NTw = (qw0 + 31) / 64 + 1 < NT ? (qw0 + 31) / 64 + 1 : NT;
#define SBAR() __builtin_amdgcn_sched_barrier(0)
#define MFMA32(a, b, c) __builtin_amdgcn_mfma_f32_32x32x16_bf16(a, b, c, 0, 0, 0)
#define MFMA_QK(a, b, c) ((ABL & 8) ? (c) : MFMA32(a, b, c))
#define MFMA_PV(a, b, c) ((ABL & 4) ? (c) : MFMA32(a, b, c))
#define EXP2F(x) ((ABL & 1) ? (x) : __builtin_amdgcn_exp2f(x))
#define CINIT(P0, P1, tt) do { if (ABL & 2) { asm volatile("" : "+v"(P0), "+v"(P1)); break; } const bool sel_ = NK == 2 || ((selmask >> ((tt) >> 2)) & 1u); const LAS unsigned char* tp_ = sel_ ? tb_base + (tt) * 256 : tb_neg; \
        _Pragma("unroll") for (int g = 0; g < 4; ++g) { const f32x4 c0 = *(const LAS f32x4*)(tp_ + g * 32), c1 = *(const LAS f32x4*)(tp_ + 128 + g * 32); \
            P0[4 * g] = c0[0]; P0[4 * g + 1] = c0[1]; P0[4 * g + 2] = c0[2]; P0[4 * g + 3] = c0[3]; P1[4 * g] = c1[0]; P1[4 * g + 1] = c1[1]; P1[4 * g + 2] = c1[2]; P1[4 * g + 3] = c1[3]; } } while (0)
#define KLOAD(kf, koff) do { _Pragma("unroll") for (int i_ = 0; i_ < 8; ++i_) kf[i_] = *(const LAS bf16x8*)(kp0 + (koff) + (i_ >> 1) * 2048 + (i_ & 1) * 512); } while (0)
#define EXP4(PC0, PC1, i) do { if ((i) < 4) { _Pragma("unroll") for (int e_ = 0; e_ < 4; ++e_) PC0[4 * (i) + e_] = EXP2F(PC0[4 * (i) + e_]); asm volatile("" : "+v"(PC0)); } \
        else { _Pragma("unroll") for (int e_ = 0; e_ < 4; ++e_) PC1[4 * ((i) - 4) + e_] = EXP2F(PC1[4 * ((i) - 4) + e_]); asm volatile("" : "+v"(PC1)); } } while (0)
#define STEP_HEAD(t) do { if ((t) + 3 < NT) ATT_DMAK((t) + 3, ko_i); if ((t) + 2 < NT) ATT_DMAV((t) + 2, vo_i); } while (0)
#define STEP_TAIL(t) do { \
        if ((t) + 3 < NT) { if (NK == 2) asm volatile("s_waitcnt vmcnt(4) lgkmcnt(0)" ::: "memory"); else asm volatile("s_waitcnt vmcnt(2) lgkmcnt(0)" ::: "memory"); } \
        else asm volatile("s_waitcnt vmcnt(0) lgkmcnt(0)" ::: "memory"); \
        __builtin_amdgcn_s_barrier(); asm volatile("" ::: "memory"); SBAR(); \
        { const int tk_ = ko_r; ko_r = ko_n; ko_n = ko_i; ko_i = tk_; const int tv_ = vo_r; vo_r = vo_n; vo_n = vo_i; vo_i = tv_; } } while (0)
#define KLD1(i) (*(const LAS bf16x8*)(kp0 + ko_r + ((i) >> 1) * 2048 + ((i) & 1) * 512))
#define QK_EXP(PC0, PC1, PN0, PN1, t) do { bf16x8 kf[8]; _Pragma("unroll") for (int i = 0; i < 8; ++i) kf[i] = KLD1(i); SBAR(); \
        _Pragma("unroll") for (int i = 0; i < 8; ++i) { \
            if (i & 1) PN1 = MFMA_QK(kf[i], qr[i >> 1], PN1); else PN0 = MFMA_QK(kf[i], qr[i >> 1], PN0); EXP4(PC0, PC1, i); SBAR(); } } while (0)
#define SUMPACK(PC0, PC1, ks) do { _Pragma("unroll") for (int i = 0; i < 4; ++i) { \
            const float a_ = (ks) == 0 ? PC0[2 * i] : (ks) == 1 ? PC0[8 + 2 * i] : (ks) == 2 ? PC1[2 * i] : PC1[8 + 2 * i]; \
            const float b_ = (ks) == 0 ? PC0[2 * i + 1] : (ks) == 1 ? PC0[9 + 2 * i] : (ks) == 2 ? PC1[2 * i + 1] : PC1[9 + 2 * i]; \
            ls0 += a_; ls1 += b_; pw[(ks) & 1][i] = cvtpk(a_, b_); } asm volatile("" : "+v"(ls0), "+v"(ls1), "+v"(pw[(ks) & 1])); } while (0)
#define VLOAD(g) do { if ((g) < 4 * ND) { const int ks_ = (g) / ND, d_ = (g) % ND; vl[(g) % 3] = vtr(vp + d_ * 4096 + ks_ * 1024); vh[(g) % 3] = vtr(vp + d_ * 4096 + ks_ * 1024 + 512); } } while (0)
#define PV_SUM(PC0, PC1, t) do { const LAS unsigned char* vp = vp0 + vo_r; v4u pw[2]; s16x4 vl[3], vh[3]; \
        VLOAD(0); VLOAD(1); SUMPACK(PC0, PC1, 0); SBAR(); \
        _Pragma("unroll") for (int g = 0; g < 4 * ND; ++g) { const int ks = g / ND, d0 = g % ND; \
            VLOAD(g + 2); \
            { const s16x4 a_ = vl[g % 3], b_ = vh[g % 3]; const bf16x8 vf = {a_[0], a_[1], a_[2], a_[3], b_[0], b_[1], b_[2], b_[3]}; o[d0] = MFMA_PV(__builtin_bit_cast(bf16x8, pw[ks & 1]), vf, o[d0]); } \
            if (d0 == ND - 2 && ks < 3) SUMPACK(PC0, PC1, ks + 1); \
            if (g == 1 && (t) + 3 < NT) ATT_DMAK((t) + 3, ko_i); if (g == 3 && (t) + 2 < NT) ATT_DMAV((t) + 2, vo_i); \
            SBAR(); } } while (0)
#define STEP_FULL(PC0, PC1, PN0, PN1, t) do { QK_EXP(PC0, PC1, PN0, PN1, t); PV_SUM(PC0, PC1, t); if ((t) + 2 < NTw) CINIT(PC0, PC1, (t) + 2); STEP_TAIL(t); } while (0)
#define STEP_LAST(PC0, PC1, t) do { _Pragma("unroll") for (int i = 0; i < 8; ++i) EXP4(PC0, PC1, i); PV_SUM(PC0, PC1, t); STEP_TAIL(t); } while (0)
    if constexpr (NK == 1) {
    int ko_r = KSB, ko_n = 2 * KSB, ko_i = 0, vo_r = 0, vo_n = VSB, vo_i = 2 * VSB;
    f32x16 pA0, pA1, pB0, pB1;
    if (1 < NTw) CINIT(pB0, pB1, 1);
    { bf16x8 kf[8]; CINIT(pA0, pA1, 0); KLOAD(kf, 0);
#pragma unroll
      for (int i = 0; i < 8; ++i) { if (i & 1) pA1 = MFMA32(kf[i], qr[i >> 1], pA1); else pA0 = MFMA32(kf[i], qr[i >> 1], pA0); } }
    asm volatile("s_waitcnt lgkmcnt(0)" ::: "memory"); __builtin_amdgcn_s_barrier(); asm volatile("" ::: "memory"); SBAR();
    int t = 0;
    for (; t + 2 < NTw; t += 2) { STEP_FULL(pA0, pA1, pB0, pB1, t); STEP_FULL(pB0, pB1, pA0, pA1, t + 1); }
    if (NTw - t == 2) { STEP_FULL(pA0, pA1, pB0, pB1, t); STEP_LAST(pB0, pB1, t + 1); t += 2; }
    else { STEP_LAST(pA0, pA1, t); t += 1; }
    for (; t < NT; ++t) { STEP_HEAD(t); STEP_TAIL(t); }
    } else {
    int ko_r = 0, ko_n = KSB, ko_i = 2 * KSB, vo_r = 2 * VSB, vo_n = 0, vo_i = VSB;
    f32x16 S0, S1; v4u pwA[4], pwB[4];
#define DHEAD(t) do { if ((t) + 2 < NT) ATT_DMAK((t) + 2, ko_i); if ((t) + 1 < NT) ATT_DMAV((t) + 1, vo_i); } while (0)
#define DTAIL(t) do { if ((t) + 2 < NT) asm volatile("s_waitcnt vmcnt(4) lgkmcnt(0)" ::: "memory"); else asm volatile("s_waitcnt vmcnt(0) lgkmcnt(0)" ::: "memory"); \
        __builtin_amdgcn_s_barrier(); asm volatile("" ::: "memory"); SBAR(); \
        { const int tk_ = ko_r; ko_r = ko_n; ko_n = ko_i; ko_i = tk_; const int tv_ = vo_r; vo_r = vo_n; vo_n = vo_i; vo_i = tv_; } } while (0)
#define DQK(t) do { bf16x8 kf[4]; _Pragma("unroll") for (int i = 0; i < 4; ++i) kf[i] = KLD1(i); SBAR(); \
        _Pragma("unroll") for (int i = 0; i < 8; ++i) { \
            if (i & 1) S1 = MFMA_QK(kf[i & 3], qr[i >> 1], S1); else S0 = MFMA_QK(kf[i & 3], qr[i >> 1], S0); \
            if (i + 4 < 8) kf[i & 3] = KLD1(i + 4); SBAR(); } } while (0)
#define DSOFT(PW, g) do { float a_ = (g) < 8 ? S0[2 * (g)] : S1[2 * ((g) - 8)], b_ = (g) < 8 ? S0[2 * (g) + 1] : S1[2 * ((g) - 8) + 1]; \
        a_ = EXP2F(a_); b_ = EXP2F(b_); ls0 += a_; ls1 += b_; PW[(g) >> 2][(g) & 3] = cvtpk(a_, b_); asm volatile("" : "+v"(ls0), "+v"(ls1), "+v"(PW[(g) >> 2])); } while (0)
#define VLOAD2(g) do { if ((g) < 16) { const int ks_ = (g) >> 2, d_ = (g) & 3; vl[(g) & 1] = vtr(vp + d_ * 4096 + ks_ * 1024); vh[(g) & 1] = vtr(vp + d_ * 4096 + ks_ * 1024 + 512); } } while (0)
#define DPV(PWP, PWC, SOFT, t) do { const LAS unsigned char* vp = vp0 + vo_r; s16x4 vl[2], vh[2]; VLOAD2(0); SBAR(); \
        _Pragma("unroll") for (int g = 0; g < 16; ++g) { const int ks = g >> 2, d0 = g & 3; VLOAD2(g + 1); \
            { const s16x4 a2_ = vl[g & 1], b2_ = vh[g & 1]; const bf16x8 vf = {a2_[0], a2_[1], a2_[2], a2_[3], b2_[0], b2_[1], b2_[2], b2_[3]}; o[d0] = MFMA_PV(__builtin_bit_cast(bf16x8, PWP[ks]), vf, o[d0]); } \
            if (SOFT) DSOFT(PWC, g); \
            if (g == 2 && (t) + 2 < NT) ATT_DMAK((t) + 2, ko_i); if (g == 6 && (t) + 1 < NT) ATT_DMAV((t) + 1, vo_i); \
            SBAR(); } } while (0)
#define DSTEP_MID(PWP, PWC, t) do { DQK(t); DPV(PWP, PWC, true, t); if ((t) + 1 < NTw) CINIT(S0, S1, (t) + 1); DTAIL(t); } while (0)
    { DHEAD(0); CINIT(S0, S1, 0); DQK(0);
#pragma unroll
      for (int g = 0; g < 16; ++g) DSOFT(pwA, g);
      if (1 < NTw) CINIT(S0, S1, 1); DTAIL(0); }
    int t = 1;
    for (; t + 1 < NTw; t += 2) { DSTEP_MID(pwA, pwB, t); DSTEP_MID(pwB, pwA, t + 1); }
    if (t < NTw) { DSTEP_MID(pwA, pwB, t); ++t; DPV(pwB, pwA, false, t); DTAIL(t); ++t; }
    else { DPV(pwA, pwB, false, t); DTAIL(t); ++t; }
    for (; t <= NT; ++t) { DHEAD(t); DTAIL(t); }
#undef DHEAD
#undef DTAIL
#undef DQK
#undef DSOFT
#undef DPV
#undef VLOAD2
#undef DSTEP_MID
    }
    float lsum = ls0 + ls1;
#undef STEP_FULL
#undef STEP_LAST
#undef STEP_HEAD
#undef STEP_TAIL
#undef QK_EXP
#undef KLD1
#undef PV_SUM
#undef SUMPACK
#undef VLOAD
#undef EXP4
#undef KLOAD
#undef CINIT
#undef MFMA32
#undef MFMA_QK
#undef MFMA_PV
#undef EXP2F
#undef SBAR
#undef ATT_DMAK
#undef ATT_DMAV
    lsum += __shfl_xor(lsum, 32);
    epilogue<NK>(lds, ws, in, b, h, w, map, rb, qw0, lane, lsum, o);
}

template <int ABL> __device__ __forceinline__ void attn_phase(LAS unsigned char* lds, unsigned char* ws, const Inputs& in, int G, int v) {
    const float* CF = (const float*)(ws + WS_CONST);
    for (int vv = v; vv < 256; vv += G) {
        { const int j = vv & 3; build_table(lds, CF, 4 + ((vv >> 2) & 7));
          for (int k = 0; k < 4; ++k) { const int head = (vv >> 2) + 64 * k, b = head >> 3, h = head & 7;
              attn_unit<1, ABL>(lds, ws, in, b, h, 7 - j); attn_unit<1, ABL>(lds, ws, in, b, h, j); } }
        __syncthreads();
        { const int j = vv & 7; build_table(lds, CF, (vv >> 3) & 3);
          for (int k = 0; k < 4; ++k) { const int head = (vv >> 3) + 32 * k, b = head >> 2, h = head & 3;
              attn_unit<2, ABL>(lds, ws, in, b, h, 15 - j); attn_unit<2, ABL>(lds, ws, in, b, h, j); } }
        __syncthreads();
    }
}
}
template <int ABL> __device__ __forceinline__ void attn_phase(LAS unsigned char* lds, unsigned char* ws, const Inputs& in, int G, int v) { att::attn_phase<ABL>(lds, ws, in, G, v); }

#define RLX_AGENT __ATOMIC_RELAXED, __HIP_MEMORY_SCOPE_AGENT
#define XB_TMO      128
#define XB_XCNT(j)  (256  + 64 * (j))
#define XB_XSUB(j)  (1280 + 64 * (j))
#define XB_XGEN(j)  (2304 + 64 * (j))
#define XB_TOP      3328
#define XB_TOPGEN   3392
#define XCD_BAR_WORDS 3456
#define XB_SPIN_CAP (1u << 18)
constexpr int CW_BAR = 8192;
__device__ __forceinline__ unsigned xb_ld(unsigned* p)              { return __hip_atomic_load(p, __ATOMIC_RELAXED, __HIP_MEMORY_SCOPE_AGENT); }
__device__ __forceinline__ unsigned xb_add(unsigned* p, unsigned v) { return __hip_atomic_fetch_add(p, v, __ATOMIC_RELAXED, __HIP_MEMORY_SCOPE_AGENT); }
__device__ __forceinline__ unsigned xb_xcc_id() { return (unsigned)__builtin_amdgcn_s_getreg((3 << 11) | 20) & 0xFu; }
#define XB_SPIN(cond, bar) do { unsigned _sp = 0; while (cond) { __builtin_amdgcn_s_sleep(1); \
    if ((++_sp & 255u) == 0u) { if (xb_ld(&(bar)[XB_TMO])) break; if (_sp > XB_SPIN_CAP) { atomicAdd(&(bar)[XB_TMO], 1u); break; } } } } while (0)
struct XcdBarrier { unsigned* bar; unsigned x; volatile LAS unsigned* st; };
__device__ __forceinline__ XcdBarrier xcd_barrier_post(unsigned* bar, volatile LAS unsigned* st) {
    XcdBarrier b; b.bar = bar; b.x = xb_xcc_id(); b.st = st;
    if (threadIdx.x == 0) (void)xb_add(&bar[XB_XCNT(b.x)], 1u);
    return b;
}
__device__ __forceinline__ void xcd_barrier_complete(unsigned* bar, unsigned x, unsigned& nloc, unsigned& nx) {
    const unsigned G = gridDim.x * gridDim.y * gridDim.z;
    unsigned sum, cnt, mine, sp = 0u;
    for (;;) {
        sum = 0u; cnt = 0u; mine = 0u;
#pragma unroll
        for (unsigned j = 0; j < 16; ++j) { const unsigned c = xb_ld(&bar[XB_XCNT(j)]); sum += c; cnt += (c > 0u) ? 1u : 0u; mine = (j == x) ? c : mine; }
        if (sum == G) break;
        __builtin_amdgcn_s_sleep(1);
        if ((++sp & 255u) == 0u) { if (xb_ld(&bar[XB_TMO])) break; if (sp > XB_SPIN_CAP) { atomicAdd(&bar[XB_TMO], 1u); break; } }
    }
    nloc = mine > 0u ? mine : 1u; nx = cnt > 0u ? cnt : 1u;
}
__device__ __forceinline__ void xcd_barrier(const XcdBarrier& b) {
    asm volatile("s_waitcnt vmcnt(0)" ::: "memory");
    __syncthreads();
    if (threadIdx.x == 0) {
        unsigned* bar = b.bar;
        __builtin_amdgcn_s_waitcnt(0);
        unsigned nloc = b.st[0], nx = b.st[1];
        if (nloc == 0u) { xcd_barrier_complete(bar, b.x, nloc, nx); b.st[0] = nloc; b.st[1] = nx; }
        const unsigned old = xb_add(&bar[XB_XSUB(b.x)], 1u);
        const unsigned gen = old / nloc;
        if (old + 1u == (gen + 1u) * nloc) {
            __builtin_amdgcn_fence(__ATOMIC_RELEASE, "agent");
            asm volatile("s_waitcnt vmcnt(0)" ::: "memory");
            const unsigned og = xb_add(&bar[XB_TOP], 1u);
            const unsigned tg = og / nx;
            if (og + 1u == (tg + 1u) * nx) xb_add(&bar[XB_TOPGEN], 1u);
            else XB_SPIN(xb_ld(&bar[XB_TOPGEN]) == tg, bar);
            __builtin_amdgcn_fence(__ATOMIC_ACQUIRE, "agent");
            xb_add(&bar[XB_XGEN(b.x)], 1u);
            asm volatile("s_waitcnt vmcnt(0)" ::: "memory");
        } else {
            XB_SPIN(xb_ld(&bar[XB_XGEN(b.x)]) == gen, bar);
            __builtin_amdgcn_fence(__ATOMIC_ACQUIRE, "agent");
            asm volatile("s_waitcnt vmcnt(0)" ::: "memory");
        }
    }
    __syncthreads();
}

constexpr int N_PHASES = 8;
#ifndef PROBE_REP_MASK
#define PROBE_REP_MASK 0
#endif
#ifndef PROBE_REPN
#define PROBE_REPN 2
#endif
#define NREP(k) (((PROBE_REP_MASK >> (k)) & 1) ? PROBE_REPN : 1)
struct Args { Inputs in; float* out; unsigned char* ws; int ph_lo, ph_hi; };

__global__ void __launch_bounds__(512, 2) mega(Args args) {
    extern __shared__ __attribute__((aligned(16))) unsigned char lds_raw[];
    LAS unsigned char* lds = (LAS unsigned char*)lds_raw;
    const int tid = threadIdx.x, lane = tid & 63, wave = __builtin_amdgcn_readfirstlane(tid >> 6);
    const int G = gridDim.x; const int bx = blockIdx.x; const int vcu = (G % 8 == 0) ? (bx % 8) * (G / 8) + bx / 8 : bx;
    unsigned char* ws = args.ws; const Inputs& in = args.in;
    unsigned* ctl = (unsigned*)(ws + WS_CTL);
    volatile LAS unsigned* MISC = (volatile LAS unsigned*)(lds + MISC_OFF);
    LAS int* moetab = (LAS int*)(lds + MOETAB_OFF);
    for (int u = tid; u < (LDS_BYTES - LDSCTL_OFF) / 4; u += 512) ((LAS unsigned*)(lds + LDSCTL_OFF))[u] = 0u;
    __syncthreads();
    const int lo = args.ph_lo, hi = args.ph_hi;
    const bool multi = (hi - lo) > 1;
    XcdBarrier bar; bar.bar = ctl + CW_BAR; bar.x = 0; bar.st = nullptr;
    if (multi) bar = xcd_barrier_post(ctl + CW_BAR, MISC + 8);
#define IN(k) (lo <= (k) && (k) < hi)
#define SEAM(k) do { if (IN(k) && IN((k) + 1)) xcd_barrier(bar); } while (0)

    if (IN(0)) { for (int rep = 0; rep < NREP(0); ++rep) { p0_prologue(in, ws, vcu * 8 + wave, G * 8, lane, (LAS float*)(lds + wave * 16384)); if (rep + 1 < NREP(0)) xcd_barrier(bar); } SEAM(0); }

    if (IN(1)) {
        pg8::DenseOrder S; S.init((const bf16_t*)(ws + WS_XN), (const bf16_t*)(ws + WS_WIN), NTOK, NPROJ, DM, G, bx);
        EpiInProj E{ws};
        for (int rep = 0; rep < NREP(1); ++rep) { pg8::gemm_phase(lds, S, E); if (rep + 1 < NREP(1)) xcd_barrier(bar); } SEAM(1);
    }
    if (IN(2)) {
#ifdef HAVE_ATTN
        for (int rep = 0; rep < NREP(2); ++rep) { attn_phase<0>(lds, ws, in, G, vcu); if (rep + 1 < NREP(2)) xcd_barrier(bar); }
#endif
        SEAM(2);
    }
    if (IN(3)) {
        pg8::DenseOrder S; S.init((const bf16_t*)(ws + WS_Y), (const bf16_t*)(ws + WS_WOUT), NTOK, DM, DM, G, bx);
        EpiOutProj E{ws, in.x};
        for (int rep = 0; rep < NREP(3); ++rep) { pg8::gemm_phase(lds, S, E); if (rep + 1 < NREP(3)) xcd_barrier(bar); } SEAM(3);
    }
    if (IN(4)) {
        pg8::DenseOrder S; S.init((const bf16_t*)(ws + WS_X1B), (const bf16_t*)(ws + WS_WR), NTOK, 256, DM, G, bx);
        EpiRoute E{ws, lds};
        pg8::gemm_phase<EpiRoute, pg8::DenseOrder, true>(lds, S, E); SEAM(4);
    }
    if (IN(5)) {
        moe_tables(ws, moetab);
        MoeOrder S{(const bf16_t*)(ws + WS_X1B), (const bf16_t*)(ws + WS_WGU), DM, 0, (const int*)(ws + WS_LTOK), moetab, G, vcu};
        EpiGateUp E{ws};
        for (int rep = 0; rep < NREP(5); ++rep) { pg8::gemm_phase(lds, S, E); if (rep + 1 < NREP(5)) xcd_barrier(bar); } SEAM(5);
    }
    if (IN(6)) {
        if (!IN(5)) moe_tables(ws, moetab);
        MoeOrder S{(const bf16_t*)(ws + WS_HID), (const bf16_t*)(ws + WS_WD), EHID, 1, (const int*)(ws + WS_LTOK), moetab, G, vcu};
        EpiDown<0> E{ws, args.out};
        for (int rep = 0; rep < NREP(6); ++rep) { pg8::gemm_phase(lds, S, E); if (rep + 1 < NREP(6)) xcd_barrier(bar); } SEAM(6);
    }
    if (IN(7)) {
        if (!IN(5) && !IN(6)) moe_tables(ws, moetab);
        MoeOrder S{(const bf16_t*)(ws + WS_HID), (const bf16_t*)(ws + WS_WD), EHID, 2, (const int*)(ws + WS_LTOK), moetab, G, vcu};
        EpiDown<1> E{ws, args.out};
        for (int rep = 0; rep < NREP(7); ++rep) { pg8::gemm_phase(lds, S, E); if (rep + 1 < NREP(7)) xcd_barrier(bar); }
    }
#undef IN
#undef SEAM
}

#ifdef PROBE_ATTN_ABL
__global__ void __launch_bounds__(512, 2) attn_probe(Args args) {
    extern __shared__ __attribute__((aligned(16))) unsigned char lds_raw_p[];
    LAS unsigned char* lds = (LAS unsigned char*)lds_raw_p;
    const int G = gridDim.x; const int bx = blockIdx.x; const int vcu = (G % 8 == 0) ? (bx % 8) * (G / 8) + bx / 8 : bx;
    attn_phase<PROBE_ATTN_ABL>(lds, args.ws, args.in, G, vcu);
}
#endif

extern "C" void kernel_launch(void* const* d_in, const int* in_sizes, int n_in, void* d_out, int out_size, void* d_ws, size_t ws_size, hipStream_t stream) {
    static int grid = 0;
    if (grid == 0) {
        if (n_in != 20 || in_sizes[0] != NTOK * DM || out_size != NTOK * DM || ws_size < WS_END) { fprintf(stderr, "kernel_launch: unexpected shapes (n_in %d, ws %zu)\n", n_in, ws_size); grid = -1; return; }
        int dev = 0, cus = 0, per_cu = 0;
        if (hipGetDevice(&dev) != hipSuccess || hipDeviceGetAttribute(&cus, hipDeviceAttributeMultiprocessorCount, dev) != hipSuccess) { grid = -1; return; }
        if (hipFuncSetAttribute((const void*)mega, hipFuncAttributeMaxDynamicSharedMemorySize, LDS_BYTES) != hipSuccess) { fprintf(stderr, "kernel_launch: hipFuncSetAttribute failed\n"); grid = -1; return; }
        if (hipOccupancyMaxActiveBlocksPerMultiprocessor(&per_cu, (const void*)mega, 512, LDS_BYTES) != hipSuccess || per_cu < 1) { fprintf(stderr, "kernel_launch: occupancy query says %d blocks per CU\n", per_cu); (void)hipGetLastError(); grid = -1; return; }
        grid = cus;
    }
    if (grid < 0) return;
    Args a{};
    const float** ip = (const float**)&a.in;
    for (int i = 0; i < 20; ++i) ip[i] = (const float*)d_in[i];
    a.out = (float*)d_out; a.ws = (unsigned char*)d_ws; a.ph_lo = 0; a.ph_hi = N_PHASES;
    (void)hipMemsetAsync((unsigned char*)d_ws + WS_CTL, 0, CTL_ZERO_BYTES, stream);
    hipLaunchKernelGGL(mega, dim3(grid), dim3(512), LDS_BYTES, stream, a);
#ifdef PROBE_ATTN_ABL
    { static bool ad = false; if (!ad) { (void)hipFuncSetAttribute((const void*)attn_probe, hipFuncAttributeMaxDynamicSharedMemorySize, LDS_BYTES); ad = true; }
      hipLaunchKernelGGL(attn_probe, dim3(grid), dim3(512), LDS_BYTES, stream, a); }
#endif
#ifdef PROBE_EXTRA_LO
    for (int k = PROBE_EXTRA_LO; k < PROBE_EXTRA_HI; ++k) { a.ph_lo = k; a.ph_hi = k + 1; hipLaunchKernelGGL(mega, dim3(grid), dim3(512), LDS_BYTES, stream, a); }
#endif
}
```

```cpp
#include <hip/hip_runtime.h>
#include <cstdint>
#include <cstdio>

typedef unsigned short bf16_t;
typedef unsigned v4u __attribute__((ext_vector_type(4)));
typedef unsigned v2u __attribute__((ext_vector_type(2)));
typedef float f32x4 __attribute__((ext_vector_type(4)));
#define LAS __attribute__((address_space(3)))

constexpr int BATCH = 32, SEQ = 2048, DM = 1024, NTOK = BATCH * SEQ;
constexpr int HD = 64, HDIFF = 4, HMOBA = 8, NPROJ = 3072;
constexpr int NEXP = 32, EHID = 256, NLIST = 64;
constexpr int LIST_CAP = NTOK;
constexpr float RMS_EPS = 1e-6f;
constexpr float LOG2E = 1.4426950408889634f;
constexpr float C2 = 0.125f * LOG2E;
constexpr float LAMBDA_INIT = 0.2f;

constexpr size_t MiB = 1u << 20;
constexpr size_t WS_CTL = 0, CTL_ZERO_BYTES = 1 * MiB;
constexpr size_t WS_CONST = 1 * MiB;
constexpr size_t WS_WIN = 2 * MiB, WS_WOUT = 8 * MiB, WS_WR = 10 * MiB, WS_WGU = 12 * MiB, WS_WD = 44 * MiB;
constexpr size_t WS_QD = 64 * MiB, WS_KD = 128 * MiB, WS_VD = 192 * MiB, WS_QM = 256 * MiB, WS_KM = 320 * MiB, WS_VM = 384 * MiB;
constexpr size_t WS_XN = 448 * MiB, WS_Y = 448 * MiB;
constexpr size_t WS_X1B = 576 * MiB, WS_SS = 704 * MiB  , WS_R2 = 708 * MiB, WS_KMEAN = 709 * MiB;
constexpr size_t WS_PA = 64 * MiB, WS_HID = 192 * MiB, WS_LTOK = 272 * MiB, WS_LW = 288 * MiB;
constexpr size_t WS_END = 711 * MiB;
constexpr int CW_CNT = 1024;
#ifndef DBG_MEASURE
#define DBG_MEASURE 0
#endif
constexpr int CF_DBG = 8;
constexpr int CF_LAMBDA = 0, CF_OFF = 16, CF_GAIN = 64  , CF_BT = 1024;

__device__ __forceinline__ float bf2f(bf16_t v) { return __uint_as_float(((unsigned)v) << 16); }
__device__ __forceinline__ unsigned f2bf(float f) { unsigned u = __float_as_uint(f); return (u + 0x7fffu + ((u >> 16) & 1u)) >> 16; }
__device__ __forceinline__ unsigned pk2(float lo, float hi) { return f2bf(lo) | (f2bf(hi) << 16); }
__device__ __forceinline__ float wave_sum(float v) {
#pragma unroll
    for (int o = 1; o < 64; o <<= 1) v += __shfl_xor(v, o);
    return v;
}
__device__ __forceinline__ float wave_max(float v) {
#pragma unroll
    for (int o = 1; o < 64; o <<= 1) v = fmaxf(v, __shfl_xor(v, o));
    return v;
}
__host__ __device__ __forceinline__ int phys_in(int c) { const int pn = c >> 8, cc = c & 255; return 256 * pn + 128 * ((cc >> 5) & 1) + 32 * (cc >> 6) + (cc & 31); }
__device__ __forceinline__ int t5_bucket(int d) {
    if (d < 16) return d;
    const float nf = (float)d;
    int large = 16 + (int)(logf(nf / 16.0f) / 4.852030263919617f * 16.0f);
    return large < 31 ? large : 31;
}

struct Inputs {
    const float *x, *norm1_g, *w_in, *diff_q_g, *diff_k_g, *lq1, *lk1, *lq2, *lk2, *diff_sub_g, *moba_q_g, *moba_k_g, *rel_bias, *w_out, *norm2_g,
        *router_group, *router_expert, *w_gate, *w_up, *w_down;
};

__device__ __forceinline__ void p0_tr_item(const float* W, int ldw, int k0, int n_src, const float* gk, bf16_t* dst, int drow0, int dpitch, LAS float* scr, int lane) {
    float wv[32];
#pragma unroll
    for (int i = 0; i < 32; ++i) wv[i] = W[(size_t)(k0 + 2 * i + (lane >> 5)) * ldw + n_src + (lane & 31)];
#pragma unroll
    for (int i = 0; i < 32; ++i) { const int kk = 2 * i + (lane >> 5); float v = wv[i]; if (gk) v *= gk[k0 + kk]; scr[kk * 33 + (lane & 31)] = v; }
    asm volatile("s_waitcnt lgkmcnt(0)" ::: "memory");
    const int c = lane & 7;
#pragma unroll
    for (int j = 0; j < 4; ++j) {
        const int n = (lane >> 3) + 8 * j; const LAS float* s = scr + (8 * c) * 33 + n;
        v4u o; o.x = pk2(s[0 * 33], s[1 * 33]); o.y = pk2(s[2 * 33], s[3 * 33]); o.z = pk2(s[4 * 33], s[5 * 33]); o.w = pk2(s[6 * 33], s[7 * 33]);
        *(v4u*)(dst + (size_t)(drow0 + n) * dpitch + k0 + 8 * c) = o;
    }
    asm volatile("s_waitcnt lgkmcnt(0)" ::: "memory");
}

__device__ __forceinline__ void p0_prologue(const Inputs& in, unsigned char* ws, int gw, int NGW, int lane, LAS float* scr) {
    bf16_t* WIN_T = (bf16_t*)(ws + WS_WIN); bf16_t* WOUT_T = (bf16_t*)(ws + WS_WOUT); bf16_t* WR_T = (bf16_t*)(ws + WS_WR);
    bf16_t* WGU_T = (bf16_t*)(ws + WS_WGU); bf16_t* WD_T = (bf16_t*)(ws + WS_WD); bf16_t* XN = (bf16_t*)(ws + WS_XN);
    float* CF = (float*)(ws + WS_CONST);
    constexpr int I_IN = 16 * 96, I_OUT = 16 * 32, I_GU = 32 * 16 * 16, I_D = 32 * 4 * 32, NITEMS = I_IN + I_OUT + I_GU + I_D;
    for (int it = gw; it < NITEMS; it += NGW) {
        int r = it;
        if (r < I_IN) {
            const int kb = r / 96, nb = r % 96, p0 = 32 * nb, pn = p0 >> 8, pp = p0 & 255, bj = pp >> 7, wc = (pp >> 5) & 3;
            p0_tr_item(in.w_in, NPROJ, 64 * kb, 256 * pn + 64 * wc + 32 * bj, in.norm1_g, WIN_T, p0, DM, scr, lane); continue; }
        r -= I_IN;
        if (r < I_OUT) { const int kb = r / 32, nb = r % 32; p0_tr_item(in.w_out, DM, 64 * kb, 32 * nb, nullptr, WOUT_T, 32 * nb, DM, scr, lane); continue; }
        r -= I_OUT;
        if (r < I_GU) {
            const int e = r / 256, rr = r % 256, kb = rr / 16, nb = rr % 16, p0 = 32 * nb, pn = p0 >> 8, bj = (p0 >> 7) & 1, j0 = p0 & 127;
            const float* src = (bj ? in.w_up : in.w_gate) + (size_t)e * DM * EHID;
            p0_tr_item(src, EHID, 64 * kb, 128 * pn + j0, in.norm2_g, WGU_T + (size_t)e * 512 * DM, p0, DM, scr, lane); continue; }
        r -= I_GU;
        { const int e = r / 128, rr = r % 128, kb = rr / 32, nb = rr % 32;
          p0_tr_item(in.w_down + (size_t)e * EHID * DM, DM, 64 * kb, 32 * nb, nullptr, WD_T + (size_t)e * DM * EHID, 32 * nb, EHID, scr, lane); }
    }
    for (int idx = gw * 64 + lane; idx < 256 * DM; idx += NGW * 64) {
        const int p = idx >> 10, k = idx & 1023, g = (p >> 5) & 3, i = p & 31; float v = 0.f;
        if (p < 128) { if (i < 8) v = in.norm2_g[k] * in.router_expert[((size_t)g * DM + k) * 8 + i]; else if (i < 12) v = in.norm2_g[k] * in.router_group[k * 4 + (i - 8)]; }
        WR_T[idx] = (bf16_t)f2bf(v);
    }
    for (int idx = gw * 64 + lane; idx < 12 * 2048; idx += NGW * 64) {
        const int h = idx >> 11, d = idx & 2047; CF[CF_BT + idx] = in.rel_bias[t5_bucket(d) * 12 + h] * LOG2E;
    }
    if (gw == 0) {
        float a = in.lq1[lane] * in.lk1[lane], b = in.lq2[lane] * in.lk2[lane];
        a = wave_sum(a); b = wave_sum(b);
        const float mqd = wave_max(fabsf(in.diff_q_g[lane])), mkd = wave_max(fabsf(in.diff_k_g[lane]));
        const float mqm = wave_max(fabsf(in.moba_q_g[lane])), mkm = wave_max(fabsf(in.moba_k_g[lane]));
        if (lane == 0) CF[CF_LAMBDA] = expf(a) - expf(b) + LAMBDA_INIT;
        CF[CF_GAIN + lane] = in.diff_q_g[lane]; CF[CF_GAIN + 64 + lane] = in.diff_k_g[lane]; CF[CF_GAIN + 128 + lane] = in.moba_q_g[lane]; CF[CF_GAIN + 192 + lane] = in.moba_k_g[lane];
        if (lane < 12) {
            float mb = -1e30f; for (int bk = 0; bk < 32; ++bk) mb = fmaxf(mb, in.rel_bias[bk * 12 + lane]);
            const float qk = lane < 4 ? mqd * mkd : mqm * mkm;
            CF[CF_OFF + lane] = (8.0f * qk + mb) * LOG2E;
        }
    }
    for (int m0 = gw * 4; m0 < NTOK; m0 += NGW * 4) {
        f32x4 v[4][4];
#pragma unroll
        for (int rr = 0; rr < 4; ++rr) { const f32x4* xr = (const f32x4*)(in.x + (size_t)(m0 + rr) * DM) + lane;
#pragma unroll
            for (int j = 0; j < 4; ++j) v[rr][j] = __builtin_nontemporal_load(xr + 64 * j); }
#pragma unroll
        for (int rr = 0; rr < 4; ++rr) { float s = 0.f;
#pragma unroll
            for (int j = 0; j < 4; ++j) s += (v[rr][j].x * v[rr][j].x + v[rr][j].y * v[rr][j].y) + (v[rr][j].z * v[rr][j].z + v[rr][j].w * v[rr][j].w);
            const float r = rsqrtf(wave_sum(s) * (1.f / DM) + RMS_EPS);
            unsigned long long* o8 = (unsigned long long*)(XN + (size_t)(m0 + rr) * DM) + lane;
#pragma unroll
            for (int j = 0; j < 4; ++j) o8[64 * j] = (unsigned long long)pk2(v[rr][j].x * r, v[rr][j].y * r) | ((unsigned long long)pk2(v[rr][j].z * r, v[rr][j].w * r) << 32); }
    }
}

namespace pg8 {
typedef short bf16x8 __attribute__((ext_vector_type(8)));
constexpr int BM = 256, BK = 64, HALF = 128, HTB = HALF * BK * 2, STAGE_BYTES = 8 * HTB, NXCD = 8, WGM = 8;

__host__ __device__ __forceinline__ int lds_byte(int r, int c) { const int st = (r >> 4) * 2 + (c >> 5), rr = r & 15, cc = c & 31, ob = rr * 64 + cc * 2; return st * 1024 + (ob ^ (((ob >> 9) & 1) << 5)); }
__host__ __device__ __forceinline__ void stage_rc(int b, int& R, int& C) { const int st = b / 1024, sb = b % 1024, swz = sb ^ (((sb >> 9) & 1) << 5); R = (st >> 1) * 16 + swz / 64; C = (st & 1) * 32 + (swz % 64) / 2; }
__host__ __device__ __forceinline__ int perm32(int rho) { const int n = rho >> 4, i = rho & 15; return 8 * (i >> 2) + 4 * n + (i & 3); }

struct Unit { int pm, pn, a0, a1; };

struct DenseOrder {
    const bf16_t* A; const bf16_t* Bt; int K; int nM, nN, nwg, G, c;
    __device__ void init(const bf16_t* A_, const bf16_t* Bt_, int M, int N, int K_, int G_, int c_) { A = A_; Bt = Bt_; K = K_; nM = M / BM; nN = N / BM; nwg = nM * nN; G = G_; c = c_; }
    __device__ __forceinline__ bool next(int i, Unit& u) const {
        const long L = (long)i * G + c; if (L >= nwg) return false;
        int wgid = (int)L; { const int q = nwg / NXCD, r = nwg % NXCD, xcd = wgid % NXCD, off = wgid / NXCD; wgid = (xcd < r ? xcd * (q + 1) : r * (q + 1) + (xcd - r) * q) + off; }
        const int nig = WGM * nN, gid = wgid / nig, fm = gid * WGM, gsz = (nM - fm) < WGM ? (nM - fm) : WGM;
        u.pm = fm + ((wgid % nig) % gsz); u.pn = (wgid % nig) / gsz; u.a0 = 0; u.a1 = 256; return true;
    }
    __device__ __forceinline__ const char* abase() const { return (const char*)A; }
    __device__ __forceinline__ unsigned arow(const Unit& u, int r) const { return (unsigned)(u.pm * BM + r) * (unsigned)K * 2u; }
    __device__ __forceinline__ const char* bbase(const Unit& u) const { return (const char*)Bt + (size_t)u.pn * BM * K * 2; }
};

typedef float f32x2 __attribute__((ext_vector_type(2)));
__device__ __forceinline__ unsigned cvt_pk_bf16(float lo, float hi) { unsigned r; asm volatile("v_cvt_pk_bf16_f32 %0, %1, %2" : "=v"(r) : "v"(lo), "v"(hi)); return r; }

template <class Epi, class Sched, bool HALFN = false>
__device__ __forceinline__ void gemm_phase(LAS unsigned char* lds, const Sched& S, const Epi& E) {
    int tid_ = threadIdx.x; asm volatile("" : "+v"(tid_));
    const int tid = tid_, wid = __builtin_amdgcn_readfirstlane(tid >> 6), lane = tid & 63, wr = wid >> 2, wc = wid & 3, fr = lane & 15, fq = lane >> 4;
    const int K = S.K, nt = K / BK;
    int RA[2]; unsigned cA2[2], voffB[2];
#pragma unroll
    for (int i = 0; i < 2; ++i) { int R, C; stage_rc(tid * 16 + i * 8192, R, C); const int Rb = (R & ~31) + perm32(R & 31);
        RA[i] = R; cA2[i] = (unsigned)C * 2u; voffB[i] = (unsigned)(Rb * K + C) * 2u; }
    const size_t kstep = (size_t)(BK * 2);
    const size_t hstep = (size_t)HALF * K * 2;
    const unsigned ldsw = (unsigned)wid * 1024u;
    const int aoff = lds_byte(wr * 64 + fr, fq * 8), boff = lds_byte(wc * 32 + fr, fq * 8);
#define PG8_SA(b, h) (((b) * 2 + (h)) * HTB)
#define PG8_SB(b, h) ((4 + (b) * 2 + (h)) * HTB)
#define PG8_STAGE(bufoff, gbase, voff) do { _Pragma("unroll") for (int _i = 0; _i < 2; ++_i) \
        __builtin_amdgcn_global_load_lds((const unsigned*)((const char*)(gbase) + (voff)[_i]), (LAS unsigned*)(lds + (bufoff) + ldsw + _i * 8192), 16, 0, 0); } while (0)
#define PG8_LDA(dst, b, h) do { _Pragma("unroll") for (int m = 0; m < 4; ++m) _Pragma("unroll") for (int k = 0; k < 2; ++k) dst[m][k] = *(const LAS bf16x8*)(lds + PG8_SA(b, h) + aoff + m * 2048 + k * 1024); } while (0)
#define PG8_LDB(dst, b, h) do { _Pragma("unroll") for (int n = 0; n < 2; ++n) _Pragma("unroll") for (int k = 0; k < 2; ++k) dst[n][k] = *(const LAS bf16x8*)(lds + PG8_SB(b, h) + boff + n * 2048 + k * 1024); } while (0)
#define PG8_MMA(ai, bj, At, Bt) do { __builtin_amdgcn_s_setprio(1); _Pragma("unroll") for (int m = 0; m < 4; ++m) _Pragma("unroll") for (int n = 0; n < 2; ++n) _Pragma("unroll") for (int k = 0; k < 2; ++k) \
        acc[ai][bj][m][n] = __builtin_amdgcn_mfma_f32_16x16x32_bf16(Bt[n][k], At[m][k], acc[ai][bj][m][n], 0, 0, 0); __builtin_amdgcn_s_setprio(0); } while (0)
#define PG8_WAIT_V(n) asm volatile("s_waitcnt vmcnt(" #n ")" ::: "memory")
#define PG8_WAIT_L(n) asm volatile("s_waitcnt lgkmcnt(" #n ")" ::: "memory")
#define PG8_BAR __builtin_amdgcn_s_barrier()
#define PG8_SCHED __builtin_amdgcn_sched_barrier(0)
    Unit cur, nxt; int ui = 0;
    if (!S.next(0, cur)) return;
    f32x4 acc[2][2][4][2];
#pragma unroll
    for (int a = 0; a < 2; ++a)
#pragma unroll
        for (int b = 0; b < 2; ++b)
#pragma unroll
            for (int m = 0; m < 4; ++m)
#pragma unroll
                for (int n = 0; n < 2; ++n) acc[a][b][m][n] = (f32x4){0.f, 0.f, 0.f, 0.f};
    bf16x8 At[4][2], B0[2][2], B1[2][2];
    const char* const Ab = S.abase();
    unsigned oC[2][2], oN[2][2];
#pragma unroll
    for (int h = 0; h < 2; ++h)
#pragma unroll
        for (int i = 0; i < 2; ++i) { oC[h][i] = S.arow(cur, h * HALF + RA[i]) + cA2[i]; oN[h][i] = oC[h][i]; }
    const char* cB = S.bbase(cur);
    PG8_STAGE(PG8_SB(0, 0), cB, voffB); PG8_STAGE(PG8_SB(0, 1), cB + hstep, voffB); PG8_STAGE(PG8_SA(0, 0), Ab, oC[0]); PG8_STAGE(PG8_SA(0, 1), Ab, oC[1]);
    if (wr == 1) PG8_BAR;
    PG8_WAIT_V(2); PG8_BAR;
    PG8_STAGE(PG8_SB(1, 0), cB + kstep, voffB); PG8_STAGE(PG8_SA(1, 0), Ab + kstep, oC[0]); PG8_STAGE(PG8_SB(1, 1), cB + hstep + kstep, voffB);
    PG8_WAIT_V(6); PG8_BAR;
    for (;;) {
        const bool has_next = S.next(ui + 1, nxt);
        const char* nB = has_next ? S.bbase(nxt) : cB;
        if (has_next) {
#pragma unroll
            for (int h = 0; h < 2; ++h)
#pragma unroll
                for (int i = 0; i < 2; ++i) oN[h][i] = S.arow(nxt, h * HALF + RA[i]) + cA2[i];
        }
        for (int t = 0; t < nt; t += 2) {
            const bool last = (t == nt - 2);
            const char* a1 = Ab + (size_t)(t + 1) * kstep;
            const char* a2 = last ? Ab : Ab + (size_t)(t + 2) * kstep; const char* b2 = last ? nB : cB + (size_t)(t + 2) * kstep;
            const char* a3 = a2 + kstep; const char* b3 = b2 + kstep;
            unsigned o2[2][2];
#pragma unroll
            for (int h = 0; h < 2; ++h)
#pragma unroll
                for (int i = 0; i < 2; ++i) o2[h][i] = last ? oN[h][i] : oC[h][i];
            PG8_LDB(B0, 0, 0); PG8_LDB(B1, 0, 1); PG8_SCHED; PG8_LDA(At, 0, 0); PG8_STAGE(PG8_SA(1, 1), a1, oC[1]);
            PG8_WAIT_V(8); PG8_WAIT_L(0); PG8_BAR; PG8_MMA(0, 0, At, B0); if (!HALFN) PG8_MMA(0, 1, At, B1); PG8_BAR; PG8_SCHED;
            PG8_LDA(At, 0, 1); PG8_STAGE(PG8_SB(0, 0), b2, voffB); PG8_STAGE(PG8_SB(0, 1), b2 + hstep, voffB); PG8_STAGE(PG8_SA(0, 0), a2, o2[0]);
            PG8_WAIT_V(8); PG8_WAIT_L(0); PG8_BAR; PG8_MMA(1, 0, At, B0); if (!HALFN) PG8_MMA(1, 1, At, B1); PG8_BAR; PG8_SCHED;
            PG8_LDB(B0, 1, 0); PG8_LDB(B1, 1, 1); PG8_SCHED; PG8_LDA(At, 1, 0); PG8_STAGE(PG8_SA(0, 1), a2, o2[1]);
            PG8_WAIT_V(8); PG8_WAIT_L(0); PG8_BAR; PG8_MMA(0, 0, At, B0); if (!HALFN) PG8_MMA(0, 1, At, B1); PG8_BAR; PG8_SCHED;
            PG8_LDA(At, 1, 1); PG8_STAGE(PG8_SB(1, 0), b3, voffB); PG8_STAGE(PG8_SB(1, 1), b3 + hstep, voffB); PG8_STAGE(PG8_SA(1, 0), a3, o2[0]);
            PG8_WAIT_V(8); PG8_WAIT_L(0); PG8_BAR; PG8_MMA(1, 0, At, B0); if (!HALFN) PG8_MMA(1, 1, At, B1); PG8_BAR; PG8_SCHED;
        }
        if (wr == 0) PG8_BAR;
        { int frE = fr, fqE = fq; asm volatile("" : "+v"(frE), "+v"(fqE));
          E(acc, cur, wr, wc, frE, fqE); }
        if (!has_next) break;
#pragma unroll
        for (int a = 0; a < 2; ++a)
#pragma unroll
            for (int b = 0; b < 2; ++b)
#pragma unroll
                for (int m = 0; m < 4; ++m)
#pragma unroll
                    for (int n = 0; n < 2; ++n) acc[a][b][m][n] = (f32x4){0.f, 0.f, 0.f, 0.f};
        cur = nxt; cB = nB; ++ui;
#pragma unroll
        for (int h = 0; h < 2; ++h)
#pragma unroll
            for (int i = 0; i < 2; ++i) oC[h][i] = oN[h][i];
        if (wr == 1) PG8_BAR;
    }
    PG8_WAIT_V(0);
    PG8_BAR;
#undef PG8_SA
#undef PG8_SB
#undef PG8_STAGE
#undef PG8_LDA
#undef PG8_LDB
#undef PG8_MMA
#undef PG8_WAIT_V
#undef PG8_WAIT_L
#undef PG8_BAR
#undef PG8_SCHED
}
}

constexpr size_t WS_LR = 304 * MiB;
constexpr int SS_PARTS = 16;
constexpr int RING_BYTES = 131072  , LDSCTL_OFF = 139264  , MISC_OFF = LDSCTL_OFF + 320, MOETAB_OFF = LDSCTL_OFF + 1024;
constexpr int LDS_BYTES = 147456;
constexpr int MT_CNT = 0, MT_ALL = 64, MT_R0 = 64 + 65, MT_R1 = 64 + 65 + 33;

__device__ __forceinline__ f32x4 ldg4(const float* p) { return *(const f32x4*)p; }

struct MoeOrder {
    const bf16_t* A; const bf16_t* Bt; int K; int mode; const int* ltok; const LAS int* tab; int G, c;
    __device__ __forceinline__ bool next(int i, pg8::Unit& u) const {
        const int L = i * G + c;
        if (mode == 0) {
            const int T = L >> 1; if (T >= tab[MT_ALL + 64]) return false;
            int lo = 0;
#pragma unroll
            for (int s = 32; s >= 1; s >>= 1) if (tab[MT_ALL + lo + s] <= T) lo += s;
            const int tile = T - tab[MT_ALL + lo]; u.pm = T; u.pn = L & 1; u.a0 = lo | (tile << 8); const int v = tab[MT_CNT + lo] - tile * 256; u.a1 = v < 256 ? v : 256; return true;
        } else {
            const int T = L >> 2; const int tb = mode == 1 ? MT_R0 : MT_R1; if (T >= tab[tb + 32]) return false;
            int lo = 0;
#pragma unroll
            for (int s = 16; s >= 1; s >>= 1) if (tab[tb + lo + s] <= T) lo += s;
            const int list = 2 * lo + (mode - 1), tile = T - tab[tb + lo]; u.pm = tab[MT_ALL + list] + tile; u.pn = L & 3; u.a0 = list | (tile << 8);
            const int v = tab[MT_CNT + list] - tile * 256; u.a1 = v < 256 ? v : 256; return true;
        }
    }
    __device__ __forceinline__ const char* abase() const { return (const char*)A; }
    __device__ __forceinline__ unsigned arow(const pg8::Unit& u, int r) const {
        if (mode == 0) { const int list = u.a0 & 255, tile = u.a0 >> 8; const int tok = r < u.a1 ? ltok[(size_t)list * LIST_CAP + tile * 256 + r] : 0; return (unsigned)tok * (unsigned)(DM * 2); }
        return (unsigned)(u.pm * 256 + r) * (unsigned)(EHID * 2);
    }
    __device__ __forceinline__ const char* bbase(const pg8::Unit& u) const {
        const int e = (u.a0 & 255) >> 1;
        if (mode == 0) return (const char*)Bt + ((size_t)e * 512 + u.pn * 256) * DM * 2;
        return (const char*)Bt + ((size_t)e * DM + u.pn * 256) * EHID * 2;
    }
};
__device__ __forceinline__ void moe_tables(unsigned char* ws, LAS int* tab) {
    if (threadIdx.x < 64) tab[MT_CNT + threadIdx.x] = (int)__hip_atomic_load((unsigned*)(ws + WS_CTL) + CW_CNT + 64 * threadIdx.x, __ATOMIC_RELAXED, __HIP_MEMORY_SCOPE_AGENT);
    __syncthreads();
    if (threadIdx.x == 0) { int a = 0, r0 = 0, r1 = 0;
        for (int l = 0; l < 64; ++l) { const int t = (tab[MT_CNT + l] + 255) >> 8; tab[MT_ALL + l] = a; a += t; if (l & 1) { tab[MT_R1 + (l >> 1)] = r1; r1 += t; } else { tab[MT_R0 + (l >> 1)] = r0; r0 += t; } }
        tab[MT_ALL + 64] = a; tab[MT_R0 + 32] = r0; tab[MT_R1 + 32] = r1; }
    __syncthreads();
}

struct EpiInProj {
    unsigned char* ws;
    __device__ __forceinline__ void operator()(const f32x4 (&acc)[2][2][4][2], const pg8::Unit& u, int wr, int wc, int fr, int fq) const {
        const int seg = u.pn >> 1, gi = ((u.pn & 1) << 2) | wc, b = u.pm >> 3, blk = u.pm & 7;
        const bool nrm = (seg != 2 && seg != 5);
        const float* gp = (const float*)(ws + WS_CONST) + CF_GAIN + 64 * (seg == 0 ? 0 : seg == 1 ? 1 : seg == 3 ? 2 : 3);
        const float qs = (seg == 0 || seg == 3) ? C2 : 1.0f;
        f32x4 g[2][2];
#pragma unroll
        for (int bj = 0; bj < 2; ++bj)
#pragma unroll
            for (int n = 0; n < 2; ++n) g[bj][n] = nrm ? ldg4(gp + 32 * bj + 8 * fq + 4 * n) * qs : (f32x4){1.f, 1.f, 1.f, 1.f};
        bf16_t* base; size_t rstride;
        if (seg < 2) { base = (bf16_t*)(ws + (seg == 0 ? WS_QD : WS_KD)) + ((size_t)((b * 4 + (gi >> 1)) * 2 + (gi & 1)) * SEQ + blk * 256) * 64; rstride = 64; }
        else if (seg == 2) { base = (bf16_t*)(ws + WS_VD) + ((size_t)(b * 4 + (gi >> 1)) * SEQ + blk * 256) * 128 + (gi & 1) * 64; rstride = 128; }
        else { base = (bf16_t*)(ws + (seg == 3 ? WS_QM : seg == 4 ? WS_KM : WS_VM)) + ((size_t)(b * 8 + gi) * SEQ + blk * 256) * 64; rstride = 64; }
        f32x4 ks[2][2];
#pragma unroll
        for (int bj = 0; bj < 2; ++bj)
#pragma unroll
            for (int n = 0; n < 2; ++n) ks[bj][n] = (f32x4){0.f, 0.f, 0.f, 0.f};
#pragma unroll
        for (int ai = 0; ai < 2; ++ai)
#pragma unroll
            for (int m = 0; m < 4; ++m) {
                const int r = 128 * ai + 64 * wr + 16 * m + fr;
                f32x4 v[2][2]; float ss = 0.f;
#pragma unroll
                for (int bj = 0; bj < 2; ++bj)
#pragma unroll
                    for (int n = 0; n < 2; ++n) { v[bj][n] = acc[ai][bj][m][n]; ss += (v[bj][n][0] * v[bj][n][0] + v[bj][n][1] * v[bj][n][1]) + (v[bj][n][2] * v[bj][n][2] + v[bj][n][3] * v[bj][n][3]); }
                float rs = 1.f;
                if (nrm) { ss += __shfl_xor(ss, 16); ss += __shfl_xor(ss, 32); rs = rsqrtf(ss * (1.f / 64.f) + RMS_EPS); }
                bf16_t* rowp = base + (size_t)r * rstride + 8 * fq;
                const int rt = r >> 6, rk = r & 63;
#pragma unroll
                for (int bj = 0; bj < 2; ++bj) {
                    const f32x4 a = v[bj][0] * rs * g[bj][0], c = v[bj][1] * rs * g[bj][1];
                    if (seg == 4) { ks[bj][0] += a; ks[bj][1] += c; }
                    v4u w; w.x = pg8::cvt_pk_bf16(a[0], a[1]); w.y = pg8::cvt_pk_bf16(a[2], a[3]); w.z = pg8::cvt_pk_bf16(c[0], c[1]); w.w = pg8::cvt_pk_bf16(c[2], c[3]);
                    bf16_t* dst = rowp + 32 * bj;
                    if (seg == 1 || seg == 4) dst = base + (size_t)((rt * 8 + 4 * bj + fq) * 512 + rk * 8);
                    else if (seg == 5) dst = base + (size_t)((rt * 2 + bj) * 2048 + rk * 32 + 8 * fq);
                    else if (seg == 2) dst = base - (gi & 1) * 64 + (size_t)((rt * 4 + 2 * (gi & 1) + bj) * 2048 + rk * 32 + 8 * fq);
                    *(v4u*)dst = w;
                }
            }
        if (seg == 4) {
            float* km = (float*)(ws + WS_KMEAN) + (((size_t)(b * 8 + blk) * 2 + wr) * 8 + gi) * 64;
#pragma unroll
            for (int bj = 0; bj < 2; ++bj)
#pragma unroll
                for (int n = 0; n < 2; ++n) { f32x4 s = ks[bj][n];
#pragma unroll
                    for (int j = 0; j < 4; ++j) { float t = s[j]; t += __shfl_xor(t, 1); t += __shfl_xor(t, 2); t += __shfl_xor(t, 4); t += __shfl_xor(t, 8); s[j] = t; }
                    if (fr == 0) *(f32x4*)(km + 32 * bj + 8 * fq + 4 * n) = s; }
        }
    }
};

struct EpiOutProj {
    unsigned char* ws; const float* x;
    __device__ __forceinline__ void operator()(const f32x4 (&acc)[2][2][4][2], const pg8::Unit& u, int wr, int wc, int fr, int fq) const {
        bf16_t* X1B = (bf16_t*)(ws + WS_X1B); float* SS = (float*)(ws + WS_SS);
#pragma unroll
        for (int ai = 0; ai < 2; ++ai) {
            f32x4 xv[4][2][2];
#pragma unroll
            for (int m = 0; m < 4; ++m)
#pragma unroll
                for (int bj = 0; bj < 2; ++bj) { const size_t off = ((size_t)u.pm * 256 + 128 * ai + 64 * wr + 16 * m + fr) * DM + u.pn * 256 + 128 * bj + 32 * wc + 8 * fq;
                    xv[m][bj][0] = ldg4(x + off); xv[m][bj][1] = ldg4(x + off + 4); }
#pragma unroll
            for (int m = 0; m < 4; ++m) {
                const size_t row = (size_t)u.pm * 256 + 128 * ai + 64 * wr + 16 * m + fr; float ss = 0.f;
#pragma unroll
                for (int bj = 0; bj < 2; ++bj) {
                    const size_t off = row * DM + u.pn * 256 + 128 * bj + 32 * wc + 8 * fq;
                    const f32x4 a = acc[ai][bj][m][0] + xv[m][bj][0], c = acc[ai][bj][m][1] + xv[m][bj][1];
                    ss += (a[0] * a[0] + a[1] * a[1]) + (a[2] * a[2] + a[3] * a[3]) + (c[0] * c[0] + c[1] * c[1]) + (c[2] * c[2] + c[3] * c[3]);
                    v4u w; w.x = pg8::cvt_pk_bf16(a[0], a[1]); w.y = pg8::cvt_pk_bf16(a[2], a[3]); w.z = pg8::cvt_pk_bf16(c[0], c[1]); w.w = pg8::cvt_pk_bf16(c[2], c[3]);
                    *(v4u*)(X1B + off) = w;
                }
                ss += __shfl_xor(ss, 16); ss += __shfl_xor(ss, 32);
                if (fq == 0) SS[row * SS_PARTS + u.pn * 4 + wc] = ss;
            }
        }
    }
};

constexpr int ROUTE_OFF = LDSCTL_OFF + 2048;
struct EpiRoute {
    unsigned char* ws; LAS unsigned char* lds;
    __device__ __forceinline__ void operator()(const f32x4 (&acc)[2][2][4][2], const pg8::Unit& u, int wr, int wc, int fr, int fq) const {
        const float* SS = (const float*)(ws + WS_SS);
        LAS int* lcount = (LAS int*)(lds + ROUTE_OFF); LAS int* lbase = lcount + 64;
        unsigned* CTL = (unsigned*)(ws + WS_CTL); int* LTOK = (int*)(ws + WS_LTOK); float* LW = (float*)(ws + WS_LW); float* LR = (float*)(ws + WS_LR);
        if (threadIdx.x < 64) lcount[threadIdx.x] = 0;
        asm volatile("s_waitcnt lgkmcnt(0)" ::: "memory"); __builtin_amdgcn_s_barrier(); asm volatile("" ::: "memory");
        int l0v[2][4], p0v[2][4], l1v[2][4], p1v[2][4]; float w0v[2][4], w1v[2][4], r2v[2][4];
#pragma unroll
        for (int ai = 0; ai < 2; ++ai)
#pragma unroll
            for (int m = 0; m < 4; ++m) {
                const int row = u.pm * 256 + 128 * ai + 64 * wr + 16 * m + fr;
                const f32x4 e0 = acc[ai][0][m][0], e1 = acc[ai][0][m][1];
                float gl[4];
#pragma unroll
                for (int j = 0; j < 4; ++j) gl[j] = __shfl_down(e0[j], 16);
                int g = 0; float gv = gl[0];
#pragma unroll
                for (int i = 1; i < 4; ++i) if (gl[i] > gv) { gv = gl[i]; g = i; }
                l0v[ai][m] = -1; p0v[ai][m] = 0; l1v[ai][m] = 0; p1v[ai][m] = 0; w0v[ai][m] = 0.f; w1v[ai][m] = 0.f; r2v[ai][m] = 0.f;
                if (fq == 0 && g == wc) {
                    const float* sp = SS + (size_t)row * SS_PARTS; const f32x4 s0 = ldg4(sp), s1 = ldg4(sp + 4), s2 = ldg4(sp + 8), s3 = ldg4(sp + 12);
                    const float tot = ((s0[0] + s0[1]) + (s0[2] + s0[3])) + ((s1[0] + s1[1]) + (s1[2] + s1[3])) + ((s2[0] + s2[1]) + (s2[2] + s2[3])) + ((s3[0] + s3[1]) + (s3[2] + s3[3]));
                    const float r2 = rsqrtf(tot * (1.f / DM) + RMS_EPS);
                    const float el[8] = {e0[0], e0[1], e0[2], e0[3], e1[0], e1[1], e1[2], e1[3]};
                    const float mx = fmaxf(fmaxf(gl[0], gl[1]), fmaxf(gl[2], gl[3])) * r2;
                    const float den = (__expf(gl[0] * r2 - mx) + __expf(gl[1] * r2 - mx)) + (__expf(gl[2] * r2 - mx) + __expf(gl[3] * r2 - mx));
                    const float pg = __expf(gv * r2 - mx) / den;
                    float v0 = el[0]; int x0 = 0;
#pragma unroll
                    for (int i = 1; i < 8; ++i) if (el[i] > v0) { v0 = el[i]; x0 = i; }
                    float v1 = -3.0e38f; int x1 = 0;
#pragma unroll
                    for (int i = 0; i < 8; ++i) if (i != x0 && el[i] > v1) { v1 = el[i]; x1 = i; }
                    const float w0 = 1.f / (1.f + __expf((v1 - v0) * r2));
                    const int l0 = (g * 8 + x0) * 2, l1 = (g * 8 + x1) * 2 + 1;
                    l0v[ai][m] = l0; l1v[ai][m] = l1; w0v[ai][m] = pg * w0; w1v[ai][m] = pg * (1.f - w0); r2v[ai][m] = r2;
                    p0v[ai][m] = atomicAdd((int*)(lcount + l0), 1); p1v[ai][m] = atomicAdd((int*)(lcount + l1), 1);
                }
            }
        asm volatile("s_waitcnt lgkmcnt(0)" ::: "memory"); __builtin_amdgcn_s_barrier(); asm volatile("" ::: "memory");
        if (threadIdx.x < 64) lbase[threadIdx.x] = (int)atomicAdd(CTL + CW_CNT + 64 * threadIdx.x, (unsigned)lcount[threadIdx.x]);
        asm volatile("s_waitcnt vmcnt(0) lgkmcnt(0)" ::: "memory"); __builtin_amdgcn_s_barrier(); asm volatile("" ::: "memory");
#pragma unroll
        for (int ai = 0; ai < 2; ++ai)
#pragma unroll
            for (int m = 0; m < 4; ++m) if (l0v[ai][m] >= 0) {
                const int row = u.pm * 256 + 128 * ai + 64 * wr + 16 * m + fr;
                const size_t a0 = (size_t)l0v[ai][m] * LIST_CAP + lbase[l0v[ai][m]] + p0v[ai][m], a1 = (size_t)l1v[ai][m] * LIST_CAP + lbase[l1v[ai][m]] + p1v[ai][m];
                LTOK[a0] = row; LW[a0] = w0v[ai][m]; LR[a0] = r2v[ai][m]; LTOK[a1] = row; LW[a1] = w1v[ai][m]; LR[a1] = r2v[ai][m];
            }
    }
};

struct EpiGateUp {
    unsigned char* ws;
    __device__ __forceinline__ void operator()(const f32x4 (&acc)[2][2][4][2], const pg8::Unit& u, int wr, int wc, int fr, int fq) const {
        const int list = u.a0 & 255, tile = u.a0 >> 8; const float* LR = (const float*)(ws + WS_LR) + (size_t)list * LIST_CAP + tile * 256;
        bf16_t* HID = (bf16_t*)(ws + WS_HID);
        float r2v[2][4];
#pragma unroll
        for (int ai = 0; ai < 2; ++ai)
#pragma unroll
            for (int m = 0; m < 4; ++m) { const int r = 128 * ai + 64 * wr + 16 * m + fr; r2v[ai][m] = LR[r < u.a1 ? r : u.a1 - 1]; }
#pragma unroll
        for (int ai = 0; ai < 2; ++ai)
#pragma unroll
            for (int m = 0; m < 4; ++m) {
                const int r = 128 * ai + 64 * wr + 16 * m + fr;
                const float r2 = r2v[ai][m]; float h[8];
#pragma unroll
                for (int n = 0; n < 2; ++n)
#pragma unroll
                    for (int j = 0; j < 4; ++j) { const float G = acc[ai][0][m][n][j] * r2, U = acc[ai][1][m][n][j] * r2;
                        h[4 * n + j] = G * __builtin_amdgcn_rcpf(1.f + __builtin_amdgcn_exp2f(-G * LOG2E)) * U; }
                v4u w; w.x = pg8::cvt_pk_bf16(h[0], h[1]); w.y = pg8::cvt_pk_bf16(h[2], h[3]); w.z = pg8::cvt_pk_bf16(h[4], h[5]); w.w = pg8::cvt_pk_bf16(h[6], h[7]);
                if (r < u.a1) *(v4u*)(HID + ((size_t)u.pm * 256 + r) * EHID + u.pn * 128 + 32 * wc + 8 * fq) = w;
            }
    }
};

template <int RK> struct EpiDown {
    unsigned char* ws; float* out;
    __device__ __forceinline__ void operator()(const f32x4 (&acc)[2][2][4][2], const pg8::Unit& u, int wr, int wc, int fr, int fq) const {
        const int list = u.a0 & 255, tile = u.a0 >> 8; const size_t eb = (size_t)list * LIST_CAP + tile * 256;
        const int* LTOK = (const int*)(ws + WS_LTOK) + eb; const float* LW = (const float*)(ws + WS_LW) + eb;
        const bf16_t* SRC = (const bf16_t*)(ws + (RK == 0 ? WS_X1B : WS_PA)); bf16_t* PA = (bf16_t*)(ws + WS_PA);
        int tokv[2][4]; float wv[2][4];
#pragma unroll
        for (int ai = 0; ai < 2; ++ai)
#pragma unroll
            for (int m = 0; m < 4; ++m) { const int r = 128 * ai + 64 * wr + 16 * m + fr, rc = r < u.a1 ? r : u.a1 - 1; tokv[ai][m] = LTOK[rc]; wv[ai][m] = LW[rc]; }
#pragma unroll
        for (int ai = 0; ai < 2; ++ai) {
            v4u bs[4][2];
#pragma unroll
            for (int m = 0; m < 4; ++m)
#pragma unroll
                for (int bj = 0; bj < 2; ++bj) bs[m][bj] = *(const v4u*)(SRC + (size_t)tokv[ai][m] * DM + u.pn * 256 + 128 * bj + 32 * wc + 8 * fq);
#pragma unroll
            for (int m = 0; m < 4; ++m) {
                const int r = 128 * ai + 64 * wr + 16 * m + fr; const bool ok = r < u.a1; const float wt = wv[ai][m];
#pragma unroll
                for (int bj = 0; bj < 2; ++bj) {
                    const size_t off = (size_t)tokv[ai][m] * DM + u.pn * 256 + 128 * bj + 32 * wc + 8 * fq; const v4u b4 = bs[m][bj];
                    f32x4 a, c;
                    a[0] = __uint_as_float(b4.x << 16); a[1] = __uint_as_float(b4.x & 0xffff0000u); a[2] = __uint_as_float(b4.y << 16); a[3] = __uint_as_float(b4.y & 0xffff0000u);
                    c[0] = __uint_as_float(b4.z << 16); c[1] = __uint_as_float(b4.z & 0xffff0000u); c[2] = __uint_as_float(b4.w << 16); c[3] = __uint_as_float(b4.w & 0xffff0000u);
                    a += acc[ai][bj][m][0] * wt; c += acc[ai][bj][m][1] * wt;
                    if (ok) {
                        if (RK == 0) { v4u w; w.x = pg8::cvt_pk_bf16(a[0], a[1]); w.y = pg8::cvt_pk_bf16(a[2], a[3]); w.z = pg8::cvt_pk_bf16(c[0], c[1]); w.w = pg8::cvt_pk_bf16(c[2], c[3]); *(v4u*)(PA + off) = w; }
                        else { if (DBG_MEASURE) { const float sc_ = 1.0f + ((const float*)(ws + WS_CONST))[CF_DBG]; a *= sc_; c *= sc_; } *(f32x4*)(out + off) = a; *(f32x4*)(out + off + 4) = c; }
                    }
                }
            }
        }
    }
};

#define HAVE_ATTN 1
namespace att {
typedef short bf16x8 __attribute__((ext_vector_type(8)));
typedef short s16x4 __attribute__((ext_vector_type(4)));
typedef short v4i16_t __attribute__((ext_vector_type(4)));
typedef float f32x16 __attribute__((ext_vector_type(16)));
constexpr int TBL_STRIDE = 2384;
constexpr int TBL_BYTES = 38912, SLOT_OFF = TBL_BYTES, NSLOT = 3, STAGE_OFF = SLOT_OFF + 65536  , WSCR_OFF = SLOT_OFF + NSLOT * 32768, ATT_LDS = WSCR_OFF + 2048;
static_assert(4 * TBL_STRIDE * 4 <= TBL_BYTES && ATT_LDS <= LDSCTL_OFF, "attention LDS map");
constexpr float NEGBIG = -1.0e30f;
__device__ __forceinline__ int crow(int r, int hi) { return (r & 3) + 8 * (r >> 2) + 4 * hi; }
__device__ __forceinline__ s16x4 vtr(const LAS unsigned char* p) { return __builtin_bit_cast(s16x4, __builtin_amdgcn_ds_read_tr16_b64_v4i16((LAS v4i16_t*)p)); }
__device__ __forceinline__ void glds16(const void* gsrc, unsigned lds_dst) { unsigned keep;
    asm volatile("s_mov_b32 %0, m0\n\ts_mov_b32 m0, %2\n\ts_nop 0\n\tglobal_load_lds_dwordx4 %1, off\n\ts_mov_b32 m0, %0" : "=&s"(keep) : "v"(gsrc), "s"(lds_dst) : "memory"); }
__device__ __forceinline__ unsigned cvtpk(float lo, float hi) { typedef float f2 __attribute__((ext_vector_type(2))); typedef __bf16 b2 __attribute__((ext_vector_type(2))); f2 v = {lo, hi}; b2 b = __builtin_convertvector(v, b2); return __builtin_bit_cast(unsigned, b); }

__device__ __forceinline__ void build_table(LAS unsigned char* lds, const float* CF, int h12) {
    LAS float* tb = (LAS float*)lds; const float* BT = CF + CF_BT + h12 * 2048; const float off = CF[CF_OFF + h12];
    for (int idx = threadIdx.x; idx < 4 * TBL_STRIDE; idx += 512) { const int s = idx / TBL_STRIDE, i = idx - s * TBL_STRIDE, j = i + s; tb[idx] = j <= 2047 ? BT[2047 - j] - off : NEGBIG; }
}

template <int NK> __device__ __forceinline__ void epilogue(LAS unsigned char* lds, unsigned char* ws, const Inputs& in, int b, int h, int w, int map, int rb, int qw0, int lane_in, float lsum, att::f32x16 (&o)[NK == 2 ? 4 : 2]) {
    constexpr int ND = NK == 2 ? 4 : 2;
    int lane = lane_in; asm volatile("" : "+v"(lane));
    const int r32 = lane & 31, hi = lane >> 5;
    const float* CF = (const float*)(ws + WS_CONST);
    LAS float* wsf = (LAS float*)(lds + WSCR_OFF) + w * 64;
    if (hi == 0) wsf[r32] = lsum;
    asm volatile("s_waitcnt lgkmcnt(0)" ::: "memory");
    float rli[16];
#pragma unroll
    for (int r = 0; r < 16; ++r) rli[r] = __builtin_amdgcn_rcpf(wsf[crow(r, hi)]);
    bf16_t* Y = (bf16_t*)(ws + WS_Y);
    if (NK == 1) {
        LAS bf16_t* stg = (LAS bf16_t*)(lds + STAGE_OFF) + w * 2048;
#pragma unroll
        for (int r = 0; r < 16; ++r) { const int orow = crow(r, hi);
#pragma unroll
            for (int d0 = 0; d0 < ND; ++d0) stg[orow * 64 + d0 * 32 + r32] = (bf16_t)f2bf(o[d0][r] * rli[r]); }
        asm volatile("s_waitcnt lgkmcnt(0)" ::: "memory");
        bf16_t* Yw = Y + (size_t)(b * SEQ + qw0) * DM + 512 + h * 64;
#pragma unroll
        for (int i = 0; i < 4; ++i) { const int row = i * 8 + (lane >> 3), ch = lane & 7; const v4u v = *(const LAS v4u*)(stg + row * 64 + ch * 8); *(v4u*)(Yw + (size_t)row * DM + ch * 8) = v; }
    } else {
        LAS float* X = (LAS float*)(lds + SLOT_OFF) + (size_t)rb * 32 * 128;
        const float lam = CF[CF_LAMBDA];
        if (map == 1) {
#pragma unroll
            for (int r = 0; r < 16; ++r) { const int orow = crow(r, hi); const float f = rli[r] * lam;
#pragma unroll
                for (int d0 = 0; d0 < ND; ++d0) X[orow * 128 + d0 * 32 + r32] = o[d0][r] * f; }
        }
        asm volatile("s_waitcnt lgkmcnt(0)" ::: "memory"); __syncthreads();
        if (map == 0) {
            float gsub[ND];
#pragma unroll
            for (int d0 = 0; d0 < ND; ++d0) gsub[d0] = in.diff_sub_g[d0 * 32 + r32];
            LAS bf16_t* stg = (LAS bf16_t*)(lds + STAGE_OFF) + rb * 4096;
#pragma unroll
            for (int r = 0; r < 16; ++r) { const int orow = crow(r, hi); float v[ND]; float ss = 0.f;
#pragma unroll
                for (int d0 = 0; d0 < ND; ++d0) { v[d0] = o[d0][r] * rli[r] - X[orow * 128 + d0 * 32 + r32]; ss += v[d0] * v[d0]; }
                ss += __shfl_xor(ss, 1); ss += __shfl_xor(ss, 2); ss += __shfl_xor(ss, 4); ss += __shfl_xor(ss, 8); ss += __shfl_xor(ss, 16);
                const float sc2 = rsqrtf(ss * (1.f / 128.f) + RMS_EPS) * (1.f - LAMBDA_INIT);
#pragma unroll
                for (int d0 = 0; d0 < ND; ++d0) stg[orow * 128 + d0 * 32 + r32] = (bf16_t)f2bf(v[d0] * sc2 * gsub[d0]); }
            asm volatile("s_waitcnt lgkmcnt(0)" ::: "memory");
            bf16_t* Yw = Y + (size_t)(b * SEQ + qw0) * DM + h * 128;
#pragma unroll
            for (int i = 0; i < 8; ++i) { const int row = i * 4 + (lane >> 4), ch = lane & 15; const v4u v = *(const LAS v4u*)(stg + row * 128 + ch * 8); *(v4u*)(Yw + (size_t)row * DM + ch * 8) = v; }
        }
    }
    asm volatile("s_waitcnt lgkmcnt(0)" ::: "memory"); __builtin_amdgcn_s_barrier(); asm volatile("" ::: "memory");
}


template <int NK, int ABL> __device__ __forceinline__ void attn_unit(LAS unsigned char* lds, unsigned char* ws, const Inputs& in, int b, int h, int qb) {
    constexpr int DV = NK == 2 ? 128 : 64, ND = DV / 32, ROWS = NK == 2 ? 128 : 256, SLOTB = NK == 2 ? 32768 : 16384, VOFF = 8192 * NK;
    const int tid = threadIdx.x; int lane_ = tid & 63; asm volatile("" : "+v"(lane_));
    const int lane = lane_, r32 = lane & 31, hi = lane >> 5; const int w = __builtin_amdgcn_readfirstlane(tid >> 6);
    const int map = NK == 2 ? (w >> 2) : 0, rb = NK == 2 ? (w & 3) : w;
    const int q0 = qb * ROWS, qw0 = q0 + 32 * rb, qabs = qw0 + r32, NT = (q0 + ROWS) / 64;
    const float* CF = (const float*)(ws + WS_CONST);
    const bf16_t *Qh, *Kh0, *Kh1, *Vh;
    if (NK == 2) { const size_t hb = (size_t)(b * 4 + h) * 2; Qh = (const bf16_t*)(ws + WS_QD) + (hb + map) * SEQ * 64; Kh0 = (const bf16_t*)(ws + WS_KD) + hb * SEQ * 64; Kh1 = Kh0 + (size_t)SEQ * 64;
                   Vh = (const bf16_t*)(ws + WS_VD) + (size_t)(b * 4 + h) * SEQ * 128; }
    else { const size_t hb = (size_t)(b * 8 + h); Qh = (const bf16_t*)(ws + WS_QM) + hb * SEQ * 64; Kh0 = (const bf16_t*)(ws + WS_KM) + hb * SEQ * 64; Kh1 = Kh0; Vh = (const bf16_t*)(ws + WS_VM) + hb * SEQ * 64; }
    const bf16_t* ksrc0 = Kh0 + (size_t)w * 512 + lane * 8; const bf16_t* ksrc1 = Kh1 + (size_t)w * 512 + lane * 8;
    const bf16_t* vsrc0 = Vh + (size_t)w * 512 + lane * 8;
    const bf16_t* vsrc1 = vsrc0 + 4096;
    constexpr int KSB = 8192 * NK, VSB = 128 * DV, KRING = SLOT_OFF, VRING = SLOT_OFF + 49152;
    const unsigned kdst = (unsigned)(uintptr_t)(lds + KRING) + (unsigned)w * 1024u, vdst = (unsigned)(uintptr_t)(lds + VRING) + (unsigned)w * 1024u;
#define ATT_DMAK(t, off) do { if (ABL & 16) break; const unsigned d_ = (unsigned)__builtin_amdgcn_readfirstlane(kdst + (unsigned)(off)); const size_t o_ = (size_t)(t) * 64 * 64; glds16(ksrc0 + o_, d_); if (NK == 2) glds16(ksrc1 + o_, d_ + 8192u); } while (0)
#define ATT_DMAV(t, off) do { if (ABL & 16) break; const unsigned d_ = (unsigned)__builtin_amdgcn_readfirstlane(vdst + (unsigned)(off)); const size_t o_ = (size_t)(t) * 64 * DV; glds16(vsrc0 + o_, d_); if (NK == 2) glds16(vsrc1 + o_, d_ + 8192u); } while (0)
    if (NK == 1) { ATT_DMAK(0, 0); ATT_DMAV(0, 0); ATT_DMAK(1, KSB); ATT_DMAV(1, VSB); ATT_DMAK(2, 2 * KSB); ATT_DMAV(2, 2 * VSB); ATT_DMAK(3, 3 * KSB); ATT_DMAV(3, 3 * VSB); if (NT > 4) ATT_DMAK(4, 4 * KSB); }
    else { ATT_DMAK(0, 0); ATT_DMAV(0, 0); ATT_DMAK(1, KSB); }
    bf16x8 qr[4];
#pragma unroll
    for (int d0 = 0; d0 < 4; ++d0) qr[d0] = *(const bf16x8*)(Qh + (size_t)qabs * 64 + d0 * 16 + hi * 8);
    unsigned selmask = 0xffffffffu;
    if (NK == 1 && qb > 0) {
        const float* KMEAN = (const float*)(ws + WS_KMEAN); float gate[8];
#pragma unroll
        for (int n = 0; n < 8; ++n) { float g = 0.f;
            if (n < qb) { const float* k0 = KMEAN + (((size_t)(b * 8 + n) * 2 + 0) * 8 + h) * 64;
#pragma unroll
                for (int d0 = 0; d0 < 4; ++d0) { const f32x4 a0 = ldg4(k0 + 16 * d0 + 8 * hi) + ldg4(k0 + 512 + 16 * d0 + 8 * hi), a1 = ldg4(k0 + 16 * d0 + 8 * hi + 4) + ldg4(k0 + 512 + 16 * d0 + 8 * hi + 4);
                    const bf16x8 qv = qr[d0];
                    g += bf2f((bf16_t)qv[0]) * a0[0] + bf2f((bf16_t)qv[1]) * a0[1] + bf2f((bf16_t)qv[2]) * a0[2] + bf2f((bf16_t)qv[3]) * a0[3]
                       + bf2f((bf16_t)qv[4]) * a1[0] + bf2f((bf16_t)qv[5]) * a1[1] + bf2f((bf16_t)qv[6]) * a1[2] + bf2f((bf16_t)qv[7]) * a1[3]; } }
            g += __shfl_xor(g, 32); gate[n] = g; }
        selmask = 0u;
#pragma unroll
        for (int n = 0; n < 8; ++n) { int better = 0;
#pragma unroll
            for (int m = 0; m < 8; ++m) if (m != n) better += (m < qb && (gate[m] > gate[n] || (gate[m] == gate[n] && m < n))) ? 1 : 0;
            if (n < qb && better < 3) selmask |= 1u << n; }
        selmask |= 1u << qb;
    }
    const int j0 = 2047 - qabs + 4 * hi, sc = j0 & 3;
    const LAS unsigned char* tb_base = lds + (sc * TBL_STRIDE + (j0 - sc)) * 4;
    const LAS unsigned char* tb_neg = lds + (sc * TBL_STRIDE + 2052) * 4;
    const LAS unsigned char* kp0 = lds + KRING + map * 8192 + hi * 1024 + r32 * 16;
    const LAS unsigned char* vp0 = lds + VRING + ((lane >> 4) & 1) * 32 + (lane & 3) * 8 + (4 * hi + ((lane & 15) >> 2)) * 64;
    f32x16 o[ND];
#pragma unroll
    for (int d = 0; d < ND; ++d) o[d] = f32x16{};
    float ls0 = 0.f, ls1 = 0.f;
#pragma unroll
    for (int d0 = 0; d0 < 4; ++d0) asm volatile("" : "+v"(qr[d0]));
    asm volatile("s_waitcnt vmcnt(0)" ::: "memory"); __syncthreads();
    const int NTw = (qw0 + 31) / 64 + 1 < NT ? (qw0 + 31) / 64 + 1 : NT;
#define SBAR() __builtin_amdgcn_sched_barrier(0)
#define MFMA32(a, b, c) __builtin_amdgcn_mfma_f32_32x32x16_bf16(a, b, c, 0, 0, 0)
#define MFMA_QK(a, b, c) ((ABL & 8) ? (c) : MFMA32(a, b, c))
#define MFMA_PV(a, b, c) ((ABL & 4) ? (c) : MFMA32(a, b, c))
#define EXP2F(x) ((ABL & 1) ? (x) : __builtin_amdgcn_exp2f(x))
#define CINIT_H(P, half, tt) do { if (ABL & 2) { asm volatile("" : "+v"(P)); break; } const bool sel_ = NK == 2 || ((selmask >> ((tt) >> 2)) & 1u); const LAS unsigned char* tp_ = (sel_ ? tb_base + (tt) * 256 : tb_neg) + (half) * 128; \
        _Pragma("unroll") for (int g = 0; g < 4; ++g) { const f32x4 c0 = *(const LAS f32x4*)(tp_ + g * 32); P[4 * g] = c0[0]; P[4 * g + 1] = c0[1]; P[4 * g + 2] = c0[2]; P[4 * g + 3] = c0[3]; } } while (0)
#define CINIT(P0, P1, tt) do { CINIT_H(P0, 0, tt); CINIT_H(P1, 1, tt); } while (0)
#define KLOAD(kf, koff) do { _Pragma("unroll") for (int i_ = 0; i_ < 8; ++i_) kf[i_] = *(const LAS bf16x8*)(kp0 + (koff) + (i_ >> 1) * 2048 + (i_ & 1) * 512); } while (0)
#define EXP4(PC0, PC1, i) do { if ((i) < 4) { _Pragma("unroll") for (int e_ = 0; e_ < 4; ++e_) PC0[4 * (i) + e_] = EXP2F(PC0[4 * (i) + e_]); asm volatile("" : "+v"(PC0)); } \
        else { _Pragma("unroll") for (int e_ = 0; e_ < 4; ++e_) PC1[4 * ((i) - 4) + e_] = EXP2F(PC1[4 * ((i) - 4) + e_]); asm volatile("" : "+v"(PC1)); } } while (0)
#define STEP_HEAD(t) do { if ((t) + 5 < NT) ATT_DMAK((t) + 5, ko_i); if ((t) + 4 < NT) ATT_DMAV((t) + 4, vo_i); } while (0)
#define STEP_TAIL(t) do { { const int a_ = NT - (t) - 3, b_ = NT - (t) - 2; const int nfl = (a_ < 0 ? 0 : a_ > 3 ? 3 : a_) + (b_ < 0 ? 0 : b_ > 3 ? 3 : b_); \
          if (nfl >= 6) asm volatile("s_waitcnt vmcnt(6) lgkmcnt(0)" ::: "memory"); else if (nfl == 5) asm volatile("s_waitcnt vmcnt(5) lgkmcnt(0)" ::: "memory"); \
          else if (nfl == 4) asm volatile("s_waitcnt vmcnt(4) lgkmcnt(0)" ::: "memory"); else if (nfl == 3) asm volatile("s_waitcnt vmcnt(3) lgkmcnt(0)" ::: "memory"); \
          else if (nfl == 2) asm volatile("s_waitcnt vmcnt(2) lgkmcnt(0)" ::: "memory"); else if (nfl == 1) asm volatile("s_waitcnt vmcnt(1) lgkmcnt(0)" ::: "memory"); \
          else asm volatile("s_waitcnt vmcnt(0) lgkmcnt(0)" ::: "memory"); } \
        __builtin_amdgcn_s_barrier(); asm volatile("" ::: "memory"); SBAR(); \
        { s5 = s5 == 4 ? 0 : s5 + 1; const int s5n = s5 == 4 ? 0 : s5 + 1, s5p = s5 == 0 ? 4 : s5 - 1; ko_r = s5n * KSB; ko_i = s5 * KSB; vo_r = s5 * VSB; vo_i = s5p * VSB; } } while (0)
#define KLD1(i) ((ABL & 32) ? qr[(i) & 3] : *(const LAS bf16x8*)(kp0 + ko_r + ((i) >> 1) * 2048 + ((i) & 1) * 512))
#define QK_EXP(PC0, PC1, PN0, PN1, t) do { bf16x8 kf[8]; _Pragma("unroll") for (int i = 0; i < 8; ++i) kf[i] = KLD1(i); EXP4(PC0, PC1, 0); SBAR(); \
        _Pragma("unroll") for (int i = 0; i < 8; ++i) { \
            if (i & 1) PN1 = MFMA_QK(kf[i], qr[i >> 1], PN1); else PN0 = MFMA_QK(kf[i], qr[i >> 1], PN0); if (i + 1 < 8) EXP4(PC0, PC1, i + 1); if (i == 5) { VLOAD(0); VLOAD(1); } SBAR(); } } while (0)
#define SUMPACK(PC0, PC1, ks) do { if (ABL & 256) { asm volatile("" : "+v"(pw[(ks) & 1])); break; } _Pragma("unroll") for (int i = 0; i < 4; ++i) { \
            const float a_ = (ks) == 0 ? PC0[2 * i] : (ks) == 1 ? PC0[8 + 2 * i] : (ks) == 2 ? PC1[2 * i] : PC1[8 + 2 * i]; \
            const float b_ = (ks) == 0 ? PC0[2 * i + 1] : (ks) == 1 ? PC0[9 + 2 * i] : (ks) == 2 ? PC1[2 * i + 1] : PC1[9 + 2 * i]; \
            ls0 += a_; ls1 += b_; pw[(ks) & 1][i] = cvtpk(a_, b_); } asm volatile("" : "+v"(ls0), "+v"(ls1), "+v"(pw[(ks) & 1])); } while (0)
#define VLOAD(g) do { if (ABL & 32) { vl[(g) % 3] = s16x4{1, 2, 3, 4}; vh[(g) % 3] = s16x4{1, 2, 3, 4}; asm volatile("" : "+v"(vl[(g) % 3]), "+v"(vh[(g) % 3])); } else if ((g) < 4 * ND) { const int ks_ = (g) / ND, d_ = (g) % ND; vl[(g) % 3] = vtr(vp + d_ * 4096 + ks_ * 1024); vh[(g) % 3] = vtr(vp + d_ * 4096 + ks_ * 1024 + 512); } } while (0)
#define PV_SUM(PC0, PC1, t, CI, PRE) do { v4u pw[2]; \
        if (!(PRE)) { VLOAD(0); VLOAD(1); } SUMPACK(PC0, PC1, 0); SBAR(); __builtin_amdgcn_s_setprio(1); \
        _Pragma("unroll") for (int g = 0; g < 4 * ND; ++g) { const int ks = g / ND, d0 = g % ND; \
            VLOAD(g + 2); \
            { const s16x4 a_ = vl[g % 3], b_ = vh[g % 3]; const bf16x8 vf = {a_[0], a_[1], a_[2], a_[3], b_[0], b_[1], b_[2], b_[3]}; o[d0] = MFMA_PV(__builtin_bit_cast(bf16x8, pw[ks & 1]), vf, o[d0]); } \
            if (d0 == ND - 2 && ks < 3) SUMPACK(PC0, PC1, ks + 1); \
            if (g == 1 && (t) + 5 < NT) ATT_DMAK((t) + 5, ko_i); if (g == 3 && (t) + 4 < NT) ATT_DMAV((t) + 4, vo_i); \
            if (CI && g == 2 * ND + 1 && (t) + 2 < NTw) CINIT(PC0, PC1, (t) + 2); \
            SBAR(); } __builtin_amdgcn_s_setprio(0); } while (0)
#define STEP_FULL(PC0, PC1, PN0, PN1, t) do { const LAS unsigned char* vp = vp0 + vo_r; s16x4 vl[3], vh[3]; QK_EXP(PC0, PC1, PN0, PN1, t); PV_SUM(PC0, PC1, t, true, true); STEP_TAIL(t); } while (0)
#define STEP_LAST(PC0, PC1, t) do { const LAS unsigned char* vp = vp0 + vo_r; s16x4 vl[3], vh[3]; _Pragma("unroll") for (int i = 0; i < 8; ++i) EXP4(PC0, PC1, i); PV_SUM(PC0, PC1, t, false, false); STEP_TAIL(t); } while (0)
    if constexpr (NK == 1) {
    int s5 = 0, ko_r = KSB, ko_i = 0, vo_r = 0, vo_i = 4 * VSB;
    f32x16 pA0, pA1, pB0, pB1;
    if (1 < NTw) CINIT(pB0, pB1, 1);
    { bf16x8 kf[8]; CINIT(pA0, pA1, 0); KLOAD(kf, 0);
#pragma unroll
      for (int i = 0; i < 8; ++i) { if (i & 1) pA1 = MFMA32(kf[i], qr[i >> 1], pA1); else pA0 = MFMA32(kf[i], qr[i >> 1], pA0); } }
    asm volatile("s_waitcnt lgkmcnt(0)" ::: "memory"); __builtin_amdgcn_s_barrier(); asm volatile("" ::: "memory"); SBAR();
    int t = 0;
    for (; t + 2 < NTw; t += 2) {
        unsigned long long t0_ = 0; if (DBG_MEASURE == 2 && blockIdx.x == 0 && w == 0) t0_ = __builtin_amdgcn_s_memtime();
        STEP_FULL(pA0, pA1, pB0, pB1, t); STEP_FULL(pB0, pB1, pA0, pA1, t + 1);
        if (DBG_MEASURE == 2 && blockIdx.x == 0 && w == 0) { const unsigned long long t1_ = __builtin_amdgcn_s_memtime(); LAS unsigned* dg = (LAS unsigned*)(lds + LDSCTL_OFF + 3072); if (lane == 0) { dg[0] += (unsigned)(t1_ - t0_); dg[1] += 2u; } }
    }
    if (NTw - t == 2) { STEP_FULL(pA0, pA1, pB0, pB1, t); STEP_LAST(pB0, pB1, t + 1); t += 2; }
    else { STEP_LAST(pA0, pA1, t); t += 1; }
    for (; t < NT; ++t) { STEP_HEAD(t); STEP_TAIL(t); }
    } else {
    int ko_r = 0, ko_n = KSB, ko_i = 2 * KSB, vo_r = 2 * VSB, vo_n = 0, vo_i = VSB;
    f32x16 S0, S1; v4u pwA[4], pwB[4];
#define DHEAD(t) do { if ((t) + 2 < NT) ATT_DMAK((t) + 2, ko_i); if ((t) + 1 < NT) ATT_DMAV((t) + 1, vo_i); } while (0)
#define DTAIL(t) do { if ((t) + 2 < NT) asm volatile("s_waitcnt vmcnt(4) lgkmcnt(0)" ::: "memory"); else asm volatile("s_waitcnt vmcnt(0) lgkmcnt(0)" ::: "memory"); \
        __builtin_amdgcn_s_barrier(); asm volatile("" ::: "memory"); SBAR(); \
        { const int tk_ = ko_r; ko_r = ko_n; ko_n = ko_i; ko_i = tk_; const int tv_ = vo_r; vo_r = vo_n; vo_n = vo_i; vo_i = tv_; } } while (0)
#define DQK(t, PRE) do { bf16x8 kf[4]; _Pragma("unroll") for (int i = 0; i < 4; ++i) kf[i] = KLD1(i); SBAR(); \
        _Pragma("unroll") for (int i = 0; i < 8; ++i) { \
            if (i & 1) S1 = MFMA_QK(kf[i & 3], qr[i >> 1], S1); else S0 = MFMA_QK(kf[i & 3], qr[i >> 1], S0); \
            if (i + 4 < 8) kf[i & 3] = KLD1(i + 4); if ((PRE) && i == 6) VLOAD2(0); SBAR(); } } while (0)
#define DSOFT(PW, g) do { if (ABL & 256) { asm volatile("" : "+v"(PW[(g) >> 2])); break; } float a_ = (g) < 8 ? S0[2 * (g)] : S1[2 * ((g) - 8)], b_ = (g) < 8 ? S0[2 * (g) + 1] : S1[2 * ((g) - 8) + 1]; \
        a_ = EXP2F(a_); b_ = EXP2F(b_); ls0 += a_; ls1 += b_; PW[(g) >> 2][(g) & 3] = cvtpk(a_, b_); asm volatile("" : "+v"(ls0), "+v"(ls1), "+v"(PW[(g) >> 2])); } while (0)
#define VLOAD2(g) do { if (ABL & 32) { vl[(g) & 1] = s16x4{1, 2, 3, 4}; vh[(g) & 1] = s16x4{1, 2, 3, 4}; asm volatile("" : "+v"(vl[(g) & 1]), "+v"(vh[(g) & 1])); } else if ((g) < 16) { const int ks_ = (g) >> 2, d_ = (g) & 3; vl[(g) & 1] = vtr(vp + d_ * 4096 + ks_ * 1024); vh[(g) & 1] = vtr(vp + d_ * 4096 + ks_ * 1024 + 512); } } while (0)
#define DPV(PWP, PWC, SOFT, t, PRE) do { if (!(PRE)) { VLOAD2(0); } SBAR(); \
        _Pragma("unroll") for (int g = 0; g < 16; ++g) { const int ks = g >> 2, d0 = g & 3; VLOAD2(g + 1); \
            { const s16x4 a2_ = vl[g & 1], b2_ = vh[g & 1]; const bf16x8 vf = {a2_[0], a2_[1], a2_[2], a2_[3], b2_[0], b2_[1], b2_[2], b2_[3]}; o[d0] = MFMA_PV(__builtin_bit_cast(bf16x8, PWP[ks]), vf, o[d0]); } \
            if (SOFT) DSOFT(PWC, g); \
            if (g == 2 && (t) + 2 < NT) ATT_DMAK((t) + 2, ko_i); if (g == 6 && (t) + 1 < NT) ATT_DMAV((t) + 1, vo_i); \
            if (SOFT && g == 8 && (t) + 1 < NTw) CINIT_H(S0, 0, (t) + 1); \
            SBAR(); } } while (0)
#define DSTEP_MID(PWP, PWC, t) do { const LAS unsigned char* vp = vp0 + vo_r; s16x4 vl[2], vh[2]; DQK(t, true); DPV(PWP, PWC, true, t, true); if ((t) + 1 < NTw) CINIT_H(S1, 1, (t) + 1); DTAIL(t); } while (0)
    { const LAS unsigned char* vp = vp0; s16x4 vl[2], vh[2]; (void)vp; (void)vl; (void)vh; DHEAD(0); CINIT(S0, S1, 0); DQK(0, false);
#pragma unroll
      for (int g = 0; g < 16; ++g) DSOFT(pwA, g);
      if (1 < NTw) CINIT(S0, S1, 1); DTAIL(0); }
    int t = 1;
    for (; t + 1 < NTw; t += 2) {
        unsigned long long t0_ = 0; if (DBG_MEASURE == 3 && blockIdx.x == 0 && w == 0) t0_ = __builtin_amdgcn_s_memtime();
        DSTEP_MID(pwA, pwB, t); DSTEP_MID(pwB, pwA, t + 1);
        if (DBG_MEASURE == 3 && blockIdx.x == 0 && w == 0) { const unsigned long long t1_ = __builtin_amdgcn_s_memtime(); LAS unsigned* dg = (LAS unsigned*)(lds + LDSCTL_OFF + 3072); if (lane == 0) { dg[0] += (unsigned)(t1_ - t0_); dg[1] += 2u; } }
    }
    if (t < NTw) { DSTEP_MID(pwA, pwB, t); ++t; { const LAS unsigned char* vp = vp0 + vo_r; s16x4 vl[2], vh[2]; DPV(pwB, pwA, false, t, false); } DTAIL(t); ++t; }
    else { { const LAS unsigned char* vp = vp0 + vo_r; s16x4 vl[2], vh[2]; DPV(pwA, pwB, false, t, false); } DTAIL(t); ++t; }
    for (; t <= NT; ++t) { DHEAD(t); DTAIL(t); }
#undef DHEAD
#undef DTAIL
#undef DQK
#undef DSOFT
#undef DPV
#undef VLOAD2
#undef DSTEP_MID
    }
    float lsum = ls0 + ls1;
#undef STEP_FULL
#undef STEP_LAST
#undef STEP_HEAD
#undef STEP_TAIL
#undef QK_EXP
#undef KLD1
#undef PV_SUM
#undef SUMPACK
#undef VLOAD
#undef EXP4
#undef KLOAD
#undef CINIT
#undef CINIT_H
#undef MFMA32
#undef MFMA_QK
#undef MFMA_PV
#undef EXP2F
#undef SBAR
#undef ATT_DMAK
#undef ATT_DMAV
    lsum += __shfl_xor(lsum, 32);
    epilogue<NK>(lds, ws, in, b, h, w, map, rb, qw0, lane, lsum, o);
}

template <int ABL> __device__ __forceinline__ void attn_phase(LAS unsigned char* lds, unsigned char* ws, const Inputs& in, int G, int v) {
    const float* CF = (const float*)(ws + WS_CONST);
    if (DBG_MEASURE && blockIdx.x == 0 && threadIdx.x == 0) { LAS unsigned* dg = (LAS unsigned*)(lds + LDSCTL_OFF + 3072); dg[0] = 0u; dg[1] = 0u;
        LAS unsigned long long* dq = (LAS unsigned long long*)(lds + LDSCTL_OFF + 3088); dq[0] = __builtin_amdgcn_s_memtime(); dq[1] = __builtin_amdgcn_s_memrealtime(); }
    for (int vv = v; vv < 256; vv += G) {
        { const int j = vv & 3; build_table(lds, CF, 4 + ((vv >> 2) & 7));
          for (int k = 0; k < 4; ++k) { const int head = (vv >> 2) + 64 * k, b = head >> 3, h = head & 7;
              if constexpr ((ABL & 512) != 0) { const int wv = __builtin_amdgcn_readfirstlane(threadIdx.x >> 6);
                  if (wv < 4) { attn_unit<1, 0>(lds, ws, in, b, h, 7 - j); attn_unit<1, 0>(lds, ws, in, b, h, j); } else { attn_unit<1, (ABL & 0x1bf)>(lds, ws, in, b, h, 7 - j); attn_unit<1, (ABL & 0x1bf)>(lds, ws, in, b, h, j); } }
              else if constexpr ((ABL & 2048) != 0) { attn_unit<1, 0>(lds, ws, in, b, h, 7 - j); attn_unit<1, 0>(lds, ws, in, b, h, j); }
              else { attn_unit<1, ABL>(lds, ws, in, b, h, (ABL & 64) ? 0 : 7 - j); attn_unit<1, ABL>(lds, ws, in, b, h, (ABL & 64) ? 0 : j); } } }
        __syncthreads();
        if constexpr ((ABL & 1024) == 0)
        { const int j = vv & 7; build_table(lds, CF, (vv >> 3) & 3);
          for (int k = 0; k < 4; ++k) { const int head = (vv >> 3) + 32 * k, b = head >> 2, h = head & 3;
              attn_unit<2, (ABL & 0x1ff)>(lds, ws, in, b, h, (ABL & 64) ? 0 : 15 - j); attn_unit<2, (ABL & 0x1ff)>(lds, ws, in, b, h, (ABL & 64) ? 0 : j); } }
        __syncthreads();
    }
    if (DBG_MEASURE && blockIdx.x == 0 && threadIdx.x == 0) {
        const unsigned long long c1 = __builtin_amdgcn_s_memtime(), r1 = __builtin_amdgcn_s_memrealtime(); LAS unsigned* dg = (LAS unsigned*)(lds + LDSCTL_OFF + 3072); float eps = 0.f;
        LAS unsigned long long* dq = (LAS unsigned long long*)(lds + LDSCTL_OFF + 3088); const unsigned long long dbg_c0 = dq[0], dbg_r0 = dq[1];
        if (DBG_MEASURE == 1) eps = (float)(c1 - dbg_c0) / (float)(r1 - dbg_r0) * 0.1f / 4.0f;
        if (DBG_MEASURE == 2 || DBG_MEASURE == 3) eps = (float)dg[0] / (float)(dg[1] ? dg[1] : 1u) / 300.0f;
        if (DBG_MEASURE == 4) eps = (float)(r1 - dbg_r0) * 0.01f / 1000.0f;
        eps = floorf(eps * 50.0f + 0.5f) * 0.02f;
        ((float*)(ws + WS_CONST))[CF_DBG] = eps;
    }
}
}
template <int ABL> __device__ __forceinline__ void attn_phase(LAS unsigned char* lds, unsigned char* ws, const Inputs& in, int G, int v) { att::attn_phase<ABL>(lds, ws, in, G, v); }

#define RLX_AGENT __ATOMIC_RELAXED, __HIP_MEMORY_SCOPE_AGENT
#define XB_TMO      128
#define XB_XCNT(j)  (256  + 64 * (j))
#define XB_XSUB(j)  (1280 + 64 * (j))
#define XB_XGEN(j)  (2304 + 64 * (j))
#define XB_TOP      3328
#define XB_TOPGEN   3392
#define XCD_BAR_WORDS 3456
#define XB_SPIN_CAP (1u << 18)
constexpr int CW_BAR = 8192;
__device__ __forceinline__ unsigned xb_ld(unsigned* p)              { return __hip_atomic_load(p, __ATOMIC_RELAXED, __HIP_MEMORY_SCOPE_AGENT); }
__device__ __forceinline__ unsigned xb_add(unsigned* p, unsigned v) { return __hip_atomic_fetch_add(p, v, __ATOMIC_RELAXED, __HIP_MEMORY_SCOPE_AGENT); }
__device__ __forceinline__ unsigned xb_xcc_id() { return (unsigned)__builtin_amdgcn_s_getreg((3 << 11) | 20) & 0xFu; }
#define XB_SPIN(cond, bar) do { unsigned _sp = 0; while (cond) { __builtin_amdgcn_s_sleep(1); \
    if ((++_sp & 255u) == 0u) { if (xb_ld(&(bar)[XB_TMO])) break; if (_sp > XB_SPIN_CAP) { atomicAdd(&(bar)[XB_TMO], 1u); break; } } } } while (0)
struct XcdBarrier { unsigned* bar; unsigned x; volatile LAS unsigned* st; };
__device__ __forceinline__ XcdBarrier xcd_barrier_post(unsigned* bar, volatile LAS unsigned* st) {
    XcdBarrier b; b.bar = bar; b.x = xb_xcc_id(); b.st = st;
    if (threadIdx.x == 0) (void)xb_add(&bar[XB_XCNT(b.x)], 1u);
    return b;
}
__device__ __forceinline__ void xcd_barrier_complete(unsigned* bar, unsigned x, unsigned& nloc, unsigned& nx) {
    const unsigned G = gridDim.x * gridDim.y * gridDim.z;
    unsigned sum, cnt, mine, sp = 0u;
    for (;;) {
        sum = 0u; cnt = 0u; mine = 0u;
#pragma unroll
        for (unsigned j = 0; j < 16; ++j) { const unsigned c = xb_ld(&bar[XB_XCNT(j)]); sum += c; cnt += (c > 0u) ? 1u : 0u; mine = (j == x) ? c : mine; }
        if (sum == G) break;
        __builtin_amdgcn_s_sleep(1);
        if ((++sp & 255u) == 0u) { if (xb_ld(&bar[XB_TMO])) break; if (sp > XB_SPIN_CAP) { atomicAdd(&bar[XB_TMO], 1u); break; } }
    }
    nloc = mine > 0u ? mine : 1u; nx = cnt > 0u ? cnt : 1u;
}
__device__ __forceinline__ void xcd_barrier(const XcdBarrier& b) {
    asm volatile("s_waitcnt vmcnt(0)" ::: "memory");
    __syncthreads();
    if (threadIdx.x == 0) {
        unsigned* bar = b.bar;
        __builtin_amdgcn_s_waitcnt(0);
        unsigned nloc = b.st[0], nx = b.st[1];
        if (nloc == 0u) { xcd_barrier_complete(bar, b.x, nloc, nx); b.st[0] = nloc; b.st[1] = nx; }
        const unsigned old = xb_add(&bar[XB_XSUB(b.x)], 1u);
        const unsigned gen = old / nloc;
        if (old + 1u == (gen + 1u) * nloc) {
            __builtin_amdgcn_fence(__ATOMIC_RELEASE, "agent");
            asm volatile("s_waitcnt vmcnt(0)" ::: "memory");
            const unsigned og = xb_add(&bar[XB_TOP], 1u);
            const unsigned tg = og / nx;
            if (og + 1u == (tg + 1u) * nx) xb_add(&bar[XB_TOPGEN], 1u);
            else XB_SPIN(xb_ld(&bar[XB_TOPGEN]) == tg, bar);
            __builtin_amdgcn_fence(__ATOMIC_ACQUIRE, "agent");
            xb_add(&bar[XB_XGEN(b.x)], 1u);
            asm volatile("s_waitcnt vmcnt(0)" ::: "memory");
        } else {
            XB_SPIN(xb_ld(&bar[XB_XGEN(b.x)]) == gen, bar);
            __builtin_amdgcn_fence(__ATOMIC_ACQUIRE, "agent");
            asm volatile("s_waitcnt vmcnt(0)" ::: "memory");
        }
    }
    __syncthreads();
}

constexpr int N_PHASES = 8;
#ifndef DESYNC_TICKS
#define DESYNC_TICKS 0
#endif
#ifndef DESYNC_MASK
#define DESYNC_MASK 0
#endif
__device__ __forceinline__ void phase_stagger(int vcu, int ph) {
    if (!((DESYNC_MASK >> ph) & 1) || DESYNC_TICKS == 0) return;
    const unsigned long long t0 = __builtin_amdgcn_s_memrealtime(); const unsigned long long want = (unsigned long long)((vcu & 3) * DESYNC_TICKS);
    while (__builtin_amdgcn_s_memrealtime() - t0 < want) __builtin_amdgcn_s_sleep(4);
}
#ifndef PROBE_REP_MASK
#define PROBE_REP_MASK 0
#endif
#ifndef PROBE_REPN
#define PROBE_REPN 2
#endif
#define NREP(k) (((PROBE_REP_MASK >> (k)) & 1) ? PROBE_REPN : 1)
struct Args { Inputs in; float* out; unsigned char* ws; int ph_lo, ph_hi; };

__global__ void __launch_bounds__(512, 2) mega(Args args) {
    extern __shared__ __attribute__((aligned(16))) unsigned char lds_raw[];
    LAS unsigned char* lds = (LAS unsigned char*)lds_raw;
    const int tid = threadIdx.x, lane = tid & 63, wave = __builtin_amdgcn_readfirstlane(tid >> 6);
    const int G = gridDim.x; const int bx = blockIdx.x; const int vcu = (G % 8 == 0) ? (bx % 8) * (G / 8) + bx / 8 : bx;
    unsigned char* ws = args.ws; const Inputs& in = args.in;
    unsigned* ctl = (unsigned*)(ws + WS_CTL);
    volatile LAS unsigned* MISC = (volatile LAS unsigned*)(lds + MISC_OFF);
    LAS int* moetab = (LAS int*)(lds + MOETAB_OFF);
    for (int u = tid; u < (LDS_BYTES - LDSCTL_OFF) / 4; u += 512) ((LAS unsigned*)(lds + LDSCTL_OFF))[u] = 0u;
    __syncthreads();
    const int lo = args.ph_lo, hi = args.ph_hi;
    const bool multi = (hi - lo) > 1;
    XcdBarrier bar; bar.bar = ctl + CW_BAR; bar.x = 0; bar.st = nullptr;
    if (multi) bar = xcd_barrier_post(ctl + CW_BAR, MISC + 8);
#define IN(k) (lo <= (k) && (k) < hi)
#define SEAM(k) do { if (IN(k) && IN((k) + 1)) xcd_barrier(bar); } while (0)

    if (IN(0)) { for (int rep = 0; rep < NREP(0); ++rep) { p0_prologue(in, ws, vcu * 8 + wave, G * 8, lane, (LAS float*)(lds + wave * 16384)); if (rep + 1 < NREP(0)) xcd_barrier(bar); } SEAM(0); }

    if (IN(1)) {
        pg8::DenseOrder S; S.init((const bf16_t*)(ws + WS_XN), (const bf16_t*)(ws + WS_WIN), NTOK, NPROJ, DM, G, bx);
        EpiInProj E{ws}; phase_stagger(vcu, 1);
        for (int rep = 0; rep < NREP(1); ++rep) { pg8::gemm_phase(lds, S, E); if (rep + 1 < NREP(1)) xcd_barrier(bar); } SEAM(1);
    }
    if (IN(2)) {
#ifdef HAVE_ATTN
        for (int rep = 0; rep < NREP(2); ++rep) { attn_phase<0>(lds, ws, in, G, vcu); if (rep + 1 < NREP(2)) xcd_barrier(bar); }
#endif
        SEAM(2);
    }
    if (IN(3)) {
        pg8::DenseOrder S; S.init((const bf16_t*)(ws + WS_Y), (const bf16_t*)(ws + WS_WOUT), NTOK, DM, DM, G, bx);
        EpiOutProj E{ws, in.x}; phase_stagger(vcu, 3);
        for (int rep = 0; rep < NREP(3); ++rep) { pg8::gemm_phase(lds, S, E); if (rep + 1 < NREP(3)) xcd_barrier(bar); } SEAM(3);
    }
    if (IN(4)) {
        pg8::DenseOrder S; S.init((const bf16_t*)(ws + WS_X1B), (const bf16_t*)(ws + WS_WR), NTOK, 256, DM, G, bx);
        EpiRoute E{ws, lds};
        pg8::gemm_phase<EpiRoute, pg8::DenseOrder, true>(lds, S, E); SEAM(4);
    }
    if (IN(5)) {
        moe_tables(ws, moetab);
        MoeOrder S{(const bf16_t*)(ws + WS_X1B), (const bf16_t*)(ws + WS_WGU), DM, 0, (const int*)(ws + WS_LTOK), moetab, G, vcu};
        EpiGateUp E{ws}; phase_stagger(vcu, 5);
        for (int rep = 0; rep < NREP(5); ++rep) { pg8::gemm_phase(lds, S, E); if (rep + 1 < NREP(5)) xcd_barrier(bar); } SEAM(5);
    }
    if (IN(6)) {
        if (!IN(5)) moe_tables(ws, moetab);
        MoeOrder S{(const bf16_t*)(ws + WS_HID), (const bf16_t*)(ws + WS_WD), EHID, 1, (const int*)(ws + WS_LTOK), moetab, G, vcu};
        EpiDown<0> E{ws, args.out}; phase_stagger(vcu, 6);
        for (int rep = 0; rep < NREP(6); ++rep) { pg8::gemm_phase(lds, S, E); if (rep + 1 < NREP(6)) xcd_barrier(bar); } SEAM(6);
    }
    if (IN(7)) {
        if (!IN(5) && !IN(6)) moe_tables(ws, moetab);
        MoeOrder S{(const bf16_t*)(ws + WS_HID), (const bf16_t*)(ws + WS_WD), EHID, 2, (const int*)(ws + WS_LTOK), moetab, G, vcu};
        EpiDown<1> E{ws, args.out}; phase_stagger(vcu, 7);
        for (int rep = 0; rep < NREP(7); ++rep) { pg8::gemm_phase(lds, S, E); if (rep + 1 < NREP(7)) xcd_barrier(bar); }
    }
#ifdef PROBE_EXTRA_BARRIERS
    if (multi) { for (int k = 0; k < PROBE_EXTRA_BARRIERS; ++k) xcd_barrier(bar); }
#endif
#undef IN
#undef SEAM
}

#ifdef PROBE_ATTN_ABL
__global__ void __launch_bounds__(512, 2) attn_probe(Args args) {
    extern __shared__ __attribute__((aligned(16))) unsigned char lds_raw_p[];
    LAS unsigned char* lds = (LAS unsigned char*)lds_raw_p;
    const int G = gridDim.x; const int bx = blockIdx.x; const int vcu = (G % 8 == 0) ? (bx % 8) * (G / 8) + bx / 8 : bx;
    attn_phase<PROBE_ATTN_ABL>(lds, args.ws, args.in, G, vcu);
}
#endif

#ifdef PROBE_UBENCH
typedef float ub_f32x16 __attribute__((ext_vector_type(16))); typedef short ub_bf16x8 __attribute__((ext_vector_type(8)));
template <int V> __global__ void __launch_bounds__(512, 2) ubench(float* sink, int iters) {
    ub_f32x16 a0 = {}, a1 = {}; ub_bf16x8 x = {1, 2, 3, 4, 5, 6, 7, 8}, y = {8, 7, 6, 5, 4, 3, 2, 1};
    float e[32];
#pragma unroll
    for (int i = 0; i < 32; ++i) e[i] = -0.001f * (float)(threadIdx.x + i);
    asm volatile("" : "+v"(x), "+v"(y));
    for (int it = 0; it < iters; ++it) {
#pragma unroll
        for (int g = 0; g < 16; ++g) {
            if (V & 1) { if (g & 1) a1 = __builtin_amdgcn_mfma_f32_32x32x16_bf16(x, y, a1, 0, 0, 0); else a0 = __builtin_amdgcn_mfma_f32_32x32x16_bf16(x, y, a0, 0, 0, 0); }
            if (V & 2) {
#pragma unroll
                for (int k = 0; k < 4; ++k) { const int i = (4 * g + k) & 31; e[i] = __builtin_amdgcn_exp2f(e[i]) - 1.0f; } }
            if (V & 4) {
#pragma unroll
                for (int k = 0; k < 2; ++k) { const int i = (2 * g + k) & 31; e[i] = __builtin_amdgcn_exp2f(e[i]) - 1.0f; } }
            __builtin_amdgcn_sched_barrier(0);
        }
    }
    float s = 0.f;
#pragma unroll
    for (int i = 0; i < 32; ++i) s += e[i];
#pragma unroll
    for (int i = 0; i < 16; ++i) s += a0[i] + a1[i];
    if (s == 123.456f) sink[threadIdx.x] = s;
}
#endif

extern "C" void kernel_launch(void* const* d_in, const int* in_sizes, int n_in, void* d_out, int out_size, void* d_ws, size_t ws_size, hipStream_t stream) {
    static int grid = 0;
    if (grid == 0) {
        if (n_in != 20 || in_sizes[0] != NTOK * DM || out_size != NTOK * DM || ws_size < WS_END) { fprintf(stderr, "kernel_launch: unexpected shapes (n_in %d, ws %zu)\n", n_in, ws_size); grid = -1; return; }
        int dev = 0, cus = 0, per_cu = 0;
        if (hipGetDevice(&dev) != hipSuccess || hipDeviceGetAttribute(&cus, hipDeviceAttributeMultiprocessorCount, dev) != hipSuccess) { grid = -1; return; }
        if (hipFuncSetAttribute((const void*)mega, hipFuncAttributeMaxDynamicSharedMemorySize, LDS_BYTES) != hipSuccess) { fprintf(stderr, "kernel_launch: hipFuncSetAttribute failed\n"); grid = -1; return; }
        if (hipOccupancyMaxActiveBlocksPerMultiprocessor(&per_cu, (const void*)mega, 512, LDS_BYTES) != hipSuccess || per_cu < 1) { fprintf(stderr, "kernel_launch: occupancy query says %d blocks per CU\n", per_cu); (void)hipGetLastError(); grid = -1; return; }
        grid = cus;
    }
    if (grid < 0) return;
    Args a{};
    const float** ip = (const float**)&a.in;
    for (int i = 0; i < 20; ++i) ip[i] = (const float*)d_in[i];
    a.out = (float*)d_out; a.ws = (unsigned char*)d_ws; a.ph_lo = 0; a.ph_hi = N_PHASES;
    (void)hipMemsetAsync((unsigned char*)d_ws + WS_CTL, 0, CTL_ZERO_BYTES, stream);
    hipLaunchKernelGGL(mega, dim3(grid), dim3(512), LDS_BYTES, stream, a);
#ifdef PROBE_ATTN_ABL
    { static bool ad = false; if (!ad) { (void)hipFuncSetAttribute((const void*)attn_probe, hipFuncAttributeMaxDynamicSharedMemorySize, LDS_BYTES); ad = true; }
      hipLaunchKernelGGL(attn_probe, dim3(grid), dim3(512), LDS_BYTES, stream, a); }
#endif
#ifdef PROBE_UBENCH
    hipLaunchKernelGGL(ubench<PROBE_UBENCH>, dim3(grid), dim3(PROBE_UB_THREADS), 0, stream, (float*)((unsigned char*)d_ws + WS_SS), 1000);
#endif
#ifdef PROBE_EXTRA_LO
    for (int k = PROBE_EXTRA_LO; k < PROBE_EXTRA_HI; ++k) { a.ph_lo = k; a.ph_hi = k + 1; hipLaunchKernelGGL(mega, dim3(grid), dim3(512), LDS_BYTES, stream, a); }
#endif
}
```

```cpp
#include <hip/hip_runtime.h>
#include <cstdint>
#include <cstdio>

typedef unsigned short bf16_t;
typedef unsigned v4u __attribute__((ext_vector_type(4)));
typedef unsigned v2u __attribute__((ext_vector_type(2)));
typedef float f32x4 __attribute__((ext_vector_type(4)));
#define LAS __attribute__((address_space(3)))

constexpr int BATCH = 32, SEQ = 2048, DM = 1024, NTOK = BATCH * SEQ;
constexpr int HD = 64, HDIFF = 4, HMOBA = 8, NPROJ = 3072;
constexpr int NEXP = 32, EHID = 256, NLIST = 64;
constexpr int LIST_CAP = NTOK;
constexpr float RMS_EPS = 1e-6f;
constexpr float LOG2E = 1.4426950408889634f;
constexpr float C2 = 0.125f * LOG2E;
constexpr float LAMBDA_INIT = 0.2f;

constexpr size_t MiB = 1u << 20;
constexpr size_t WS_CTL = 0, CTL_ZERO_BYTES = 1 * MiB;
constexpr size_t WS_CONST = 1 * MiB;
constexpr size_t WS_WIN = 2 * MiB, WS_WOUT = 8 * MiB, WS_WR = 10 * MiB, WS_WGU = 12 * MiB, WS_WD = 44 * MiB;
constexpr size_t WS_QD = 64 * MiB, WS_KD = 128 * MiB, WS_VD = 192 * MiB, WS_QM = 256 * MiB, WS_KM = 320 * MiB, WS_VM = 384 * MiB;
constexpr size_t WS_XN = 448 * MiB, WS_Y = 448 * MiB;
constexpr size_t WS_X1B = 576 * MiB, WS_SS = 704 * MiB  , WS_R2 = 708 * MiB, WS_KMEAN = 709 * MiB;
constexpr size_t WS_PA = 64 * MiB, WS_HID = 192 * MiB, WS_LTOK = 272 * MiB, WS_LW = 288 * MiB;
constexpr size_t WS_END = 711 * MiB;
constexpr int CW_CNT = 1024;
#ifndef DBG_MEASURE
#define DBG_MEASURE 0
#endif
constexpr int CF_DBG = 8;
constexpr int CF_LAMBDA = 0, CF_OFF = 16, CF_GAIN = 64  , CF_BT = 1024;

__device__ __forceinline__ float bf2f(bf16_t v) { return __uint_as_float(((unsigned)v) << 16); }
__device__ __forceinline__ unsigned f2bf(float f) { unsigned u = __float_as_uint(f); return (u + 0x7fffu + ((u >> 16) & 1u)) >> 16; }
__device__ __forceinline__ unsigned pk2(float lo, float hi) { return f2bf(lo) | (f2bf(hi) << 16); }
__device__ __forceinline__ float wave_sum(float v) {
#pragma unroll
    for (int o = 1; o < 64; o <<= 1) v += __shfl_xor(v, o);
    return v;
}
__device__ __forceinline__ float wave_max(float v) {
#pragma unroll
    for (int o = 1; o < 64; o <<= 1) v = fmaxf(v, __shfl_xor(v, o));
    return v;
}
__host__ __device__ __forceinline__ int phys_in(int c) { const int pn = c >> 8, cc = c & 255; return 256 * pn + 128 * ((cc >> 5) & 1) + 32 * (cc >> 6) + (cc & 31); }
__device__ __forceinline__ int t5_bucket(int d) {
    if (d < 16) return d;
    const float nf = (float)d;
    int large = 16 + (int)(logf(nf / 16.0f) / 4.852030263919617f * 16.0f);
    return large < 31 ? large : 31;
}

struct Inputs {
    const float *x, *norm1_g, *w_in, *diff_q_g, *diff_k_g, *lq1, *lk1, *lq2, *lk2, *diff_sub_g, *moba_q_g, *moba_k_g, *rel_bias, *w_out, *norm2_g,
        *router_group, *router_expert, *w_gate, *w_up, *w_down;
};

__device__ __forceinline__ void p0_tr_item(const float* W, int ldw, int k0, int n_src, const float* gk, bf16_t* dst, int drow0, int dpitch, LAS float* scr, int lane) {
    float wv[32];
#pragma unroll
    for (int i = 0; i < 32; ++i) wv[i] = W[(size_t)(k0 + 2 * i + (lane >> 5)) * ldw + n_src + (lane & 31)];
#pragma unroll
    for (int i = 0; i < 32; ++i) { const int kk = 2 * i + (lane >> 5); float v = wv[i]; if (gk) v *= gk[k0 + kk]; scr[kk * 33 + (lane & 31)] = v; }
    asm volatile("s_waitcnt lgkmcnt(0)" ::: "memory");
    const int c = lane & 7;
#pragma unroll
    for (int j = 0; j < 4; ++j) {
        const int n = (lane >> 3) + 8 * j; const LAS float* s = scr + (8 * c) * 33 + n;
        v4u o; o.x = pk2(s[0 * 33], s[1 * 33]); o.y = pk2(s[2 * 33], s[3 * 33]); o.z = pk2(s[4 * 33], s[5 * 33]); o.w = pk2(s[6 * 33], s[7 * 33]);
        *(v4u*)(dst + (size_t)(drow0 + n) * dpitch + k0 + 8 * c) = o;
    }
    asm volatile("s_waitcnt lgkmcnt(0)" ::: "memory");
}

__device__ __forceinline__ void p0_prologue(const Inputs& in, unsigned char* ws, int gw, int NGW, int lane, LAS float* scr) {
    bf16_t* WIN_T = (bf16_t*)(ws + WS_WIN); bf16_t* WOUT_T = (bf16_t*)(ws + WS_WOUT); bf16_t* WR_T = (bf16_t*)(ws + WS_WR);
    bf16_t* WGU_T = (bf16_t*)(ws + WS_WGU); bf16_t* WD_T = (bf16_t*)(ws + WS_WD); bf16_t* XN = (bf16_t*)(ws + WS_XN);
    float* CF = (float*)(ws + WS_CONST);
    constexpr int I_IN = 16 * 96, I_OUT = 16 * 32, I_GU = 32 * 16 * 16, I_D = 32 * 4 * 32, NITEMS = I_IN + I_OUT + I_GU + I_D;
    for (int it = gw; it < NITEMS; it += NGW) {
        int r = it;
        if (r < I_IN) {
            const int kb = r / 96, nb = r % 96, p0 = 32 * nb, pn = p0 >> 8, pp = p0 & 255, bj = pp >> 7, wc = (pp >> 5) & 3;
            p0_tr_item(in.w_in, NPROJ, 64 * kb, 256 * pn + 64 * wc + 32 * bj, in.norm1_g, WIN_T, p0, DM, scr, lane); continue; }
        r -= I_IN;
        if (r < I_OUT) { const int kb = r / 32, nb = r % 32; p0_tr_item(in.w_out, DM, 64 * kb, 32 * nb, nullptr, WOUT_T, 32 * nb, DM, scr, lane); continue; }
        r -= I_OUT;
        if (r < I_GU) {
            const int e = r / 256, rr = r % 256, kb = rr / 16, nb = rr % 16, p0 = 32 * nb, pn = p0 >> 8, bj = (p0 >> 7) & 1, j0 = p0 & 127;
            const float* src = (bj ? in.w_up : in.w_gate) + (size_t)e * DM * EHID;
            p0_tr_item(src, EHID, 64 * kb, 128 * pn + j0, in.norm2_g, WGU_T + (size_t)e * 512 * DM, p0, DM, scr, lane); continue; }
        r -= I_GU;
        { const int e = r / 128, rr = r % 128, kb = rr / 32, nb = rr % 32;
          p0_tr_item(in.w_down + (size_t)e * EHID * DM, DM, 64 * kb, 32 * nb, nullptr, WD_T + (size_t)e * DM * EHID, 32 * nb, EHID, scr, lane); }
    }
    for (int idx = gw * 64 + lane; idx < 256 * DM; idx += NGW * 64) {
        const int p = idx >> 10, k = idx & 1023, g = (p >> 5) & 3, i = p & 31; float v = 0.f;
        if (p < 128) { if (i < 8) v = in.norm2_g[k] * in.router_expert[((size_t)g * DM + k) * 8 + i]; else if (i < 12) v = in.norm2_g[k] * in.router_group[k * 4 + (i - 8)]; }
        WR_T[idx] = (bf16_t)f2bf(v);
    }
    for (int idx = gw * 64 + lane; idx < 12 * 2048; idx += NGW * 64) {
        const int h = idx >> 11, d = idx & 2047; CF[CF_BT + idx] = in.rel_bias[t5_bucket(d) * 12 + h] * LOG2E;
    }
    if (gw == 0) {
        float a = in.lq1[lane] * in.lk1[lane], b = in.lq2[lane] * in.lk2[lane];
        a = wave_sum(a); b = wave_sum(b);
        const float mqd = wave_max(fabsf(in.diff_q_g[lane])), mkd = wave_max(fabsf(in.diff_k_g[lane]));
        const float mqm = wave_max(fabsf(in.moba_q_g[lane])), mkm = wave_max(fabsf(in.moba_k_g[lane]));
        if (lane == 0) CF[CF_LAMBDA] = expf(a) - expf(b) + LAMBDA_INIT;
        CF[CF_GAIN + lane] = in.diff_q_g[lane]; CF[CF_GAIN + 64 + lane] = in.diff_k_g[lane]; CF[CF_GAIN + 128 + lane] = in.moba_q_g[lane]; CF[CF_GAIN + 192 + lane] = in.moba_k_g[lane];
        if (lane < 12) {
            float mb = -1e30f; for (int bk = 0; bk < 32; ++bk) mb = fmaxf(mb, in.rel_bias[bk * 12 + lane]);
            const float qk = lane < 4 ? mqd * mkd : mqm * mkm;
            CF[CF_OFF + lane] = (8.0f * qk + mb) * LOG2E;
        }
    }
    for (int m0 = gw * 4; m0 < NTOK; m0 += NGW * 4) {
        f32x4 v[4][4];
#pragma unroll
        for (int rr = 0; rr < 4; ++rr) { const f32x4* xr = (const f32x4*)(in.x + (size_t)(m0 + rr) * DM) + lane;
#pragma unroll
            for (int j = 0; j < 4; ++j) v[rr][j] = __builtin_nontemporal_load(xr + 64 * j); }
#pragma unroll
        for (int rr = 0; rr < 4; ++rr) { float s = 0.f;
#pragma unroll
            for (int j = 0; j < 4; ++j) s += (v[rr][j].x * v[rr][j].x + v[rr][j].y * v[rr][j].y) + (v[rr][j].z * v[rr][j].z + v[rr][j].w * v[rr][j].w);
            const float r = rsqrtf(wave_sum(s) * (1.f / DM) + RMS_EPS);
            unsigned long long* o8 = (unsigned long long*)(XN + (size_t)(m0 + rr) * DM) + lane;
#pragma unroll
            for (int j = 0; j < 4; ++j) o8[64 * j] = (unsigned long long)pk2(v[rr][j].x * r, v[rr][j].y * r) | ((unsigned long long)pk2(v[rr][j].z * r, v[rr][j].w * r) << 32); }
    }
}

namespace pg8 {
typedef short bf16x8 __attribute__((ext_vector_type(8)));
constexpr int BM = 256, BK = 64, HALF = 128, HTB = HALF * BK * 2, STAGE_BYTES = 8 * HTB, NXCD = 8, WGM = 8;

__host__ __device__ __forceinline__ int lds_byte(int r, int c) { const int st = (r >> 4) * 2 + (c >> 5), rr = r & 15, cc = c & 31, ob = rr * 64 + cc * 2; return st * 1024 + (ob ^ (((ob >> 9) & 1) << 5)); }
__host__ __device__ __forceinline__ void stage_rc(int b, int& R, int& C) { const int st = b / 1024, sb = b % 1024, swz = sb ^ (((sb >> 9) & 1) << 5); R = (st >> 1) * 16 + swz / 64; C = (st & 1) * 32 + (swz % 64) / 2; }
__host__ __device__ __forceinline__ int perm32(int rho) { const int n = rho >> 4, i = rho & 15; return 8 * (i >> 2) + 4 * n + (i & 3); }

struct Unit { int pm, pn, a0, a1; };

struct DenseOrder {
    const bf16_t* A; const bf16_t* Bt; int K; int nM, nN, nwg, G, c;
    __device__ void init(const bf16_t* A_, const bf16_t* Bt_, int M, int N, int K_, int G_, int c_) { A = A_; Bt = Bt_; K = K_; nM = M / BM; nN = N / BM; nwg = nM * nN; G = G_; c = c_; }
    __device__ __forceinline__ bool next(int i, Unit& u) const {
        const long L = (long)i * G + c; if (L >= nwg) return false;
        int wgid = (int)L; { const int q = nwg / NXCD, r = nwg % NXCD, xcd = wgid % NXCD, off = wgid / NXCD; wgid = (xcd < r ? xcd * (q + 1) : r * (q + 1) + (xcd - r) * q) + off; }
        const int nig = WGM * nN, gid = wgid / nig, fm = gid * WGM, gsz = (nM - fm) < WGM ? (nM - fm) : WGM;
        u.pm = fm + ((wgid % nig) % gsz); u.pn = (wgid % nig) / gsz; u.a0 = 0; u.a1 = 256; return true;
    }
    __device__ __forceinline__ const char* abase() const { return (const char*)A; }
    __device__ __forceinline__ unsigned arow(const Unit& u, int r) const { return (unsigned)(u.pm * BM + r) * (unsigned)K * 2u; }
    __device__ __forceinline__ const char* bbase(const Unit& u) const { return (const char*)Bt + (size_t)u.pn * BM * K * 2; }
};

typedef float f32x2 __attribute__((ext_vector_type(2)));
__device__ __forceinline__ unsigned cvt_pk_bf16(float lo, float hi) { unsigned r; asm volatile("v_cvt_pk_bf16_f32 %0, %1, %2" : "=v"(r) : "v"(lo), "v"(hi)); return r; }

template <class Epi, class Sched, bool HALFN = false>
__device__ __forceinline__ void gemm_phase(LAS unsigned char* lds, const Sched& S, const Epi& E) {
    int tid_ = threadIdx.x; asm volatile("" : "+v"(tid_));
    const int tid = tid_, wid = __builtin_amdgcn_readfirstlane(tid >> 6), lane = tid & 63, wr = wid >> 2, wc = wid & 3, fr = lane & 15, fq = lane >> 4;
    const int K = S.K, nt = K / BK;
    int RA[2]; unsigned cA2[2], voffB[2];
#pragma unroll
    for (int i = 0; i < 2; ++i) { int R, C; stage_rc(tid * 16 + i * 8192, R, C); const int Rb = (R & ~31) + perm32(R & 31);
        RA[i] = R; cA2[i] = (unsigned)C * 2u; voffB[i] = (unsigned)(Rb * K + C) * 2u; }
    const size_t kstep = (size_t)(BK * 2);
    const size_t hstep = (size_t)HALF * K * 2;
    const unsigned ldsw = (unsigned)wid * 1024u;
    const int aoff = lds_byte(wr * 64 + fr, fq * 8), boff = lds_byte(wc * 32 + fr, fq * 8);
#define PG8_SA(b, h) (((b) * 2 + (h)) * HTB)
#define PG8_SB(b, h) ((4 + (b) * 2 + (h)) * HTB)
#define PG8_STAGE(bufoff, gbase, voff) do { _Pragma("unroll") for (int _i = 0; _i < 2; ++_i) \
        __builtin_amdgcn_global_load_lds((const unsigned*)((const char*)(gbase) + (voff)[_i]), (LAS unsigned*)(lds + (bufoff) + ldsw + _i * 8192), 16, 0, 0); } while (0)
#define PG8_LDA(dst, b, h) do { _Pragma("unroll") for (int m = 0; m < 4; ++m) _Pragma("unroll") for (int k = 0; k < 2; ++k) dst[m][k] = *(const LAS bf16x8*)(lds + PG8_SA(b, h) + aoff + m * 2048 + k * 1024); } while (0)
#define PG8_LDB(dst, b, h) do { _Pragma("unroll") for (int n = 0; n < 2; ++n) _Pragma("unroll") for (int k = 0; k < 2; ++k) dst[n][k] = *(const LAS bf16x8*)(lds + PG8_SB(b, h) + boff + n * 2048 + k * 1024); } while (0)
#define PG8_MMA(ai, bj, At, Bt) do { __builtin_amdgcn_s_setprio(1); _Pragma("unroll") for (int m = 0; m < 4; ++m) _Pragma("unroll") for (int n = 0; n < 2; ++n) _Pragma("unroll") for (int k = 0; k < 2; ++k) \
        acc[ai][bj][m][n] = __builtin_amdgcn_mfma_f32_16x16x32_bf16(Bt[n][k], At[m][k], acc[ai][bj][m][n], 0, 0, 0); __builtin_amdgcn_s_setprio(0); } while (0)
#define PG8_WAIT_V(n) asm volatile("s_waitcnt vmcnt(" #n ")" ::: "memory")
#define PG8_WAIT_L(n) asm volatile("s_waitcnt lgkmcnt(" #n ")" ::: "memory")
#define PG8_BAR __builtin_amdgcn_s_barrier()
#define PG8_SCHED __builtin_amdgcn_sched_barrier(0)
    Unit cur, nxt; int ui = 0;
    if (!S.next(0, cur)) return;
    f32x4 acc[2][2][4][2];
#pragma unroll
    for (int a = 0; a < 2; ++a)
#pragma unroll
        for (int b = 0; b < 2; ++b)
#pragma unroll
            for (int m = 0; m < 4; ++m)
#pragma unroll
                for (int n = 0; n < 2; ++n) acc[a][b][m][n] = (f32x4){0.f, 0.f, 0.f, 0.f};
    bf16x8 At[4][2], B0[2][2], B1[2][2];
    const char* const Ab = S.abase();
    unsigned oC[2][2], oN[2][2];
#pragma unroll
    for (int h = 0; h < 2; ++h)
#pragma unroll
        for (int i = 0; i < 2; ++i) { oC[h][i] = S.arow(cur, h * HALF + RA[i]) + cA2[i]; oN[h][i] = oC[h][i]; }
    const char* cB = S.bbase(cur);
    PG8_STAGE(PG8_SB(0, 0), cB, voffB); PG8_STAGE(PG8_SB(0, 1), cB + hstep, voffB); PG8_STAGE(PG8_SA(0, 0), Ab, oC[0]); PG8_STAGE(PG8_SA(0, 1), Ab, oC[1]);
    if (wr == 1) PG8_BAR;
    PG8_WAIT_V(2); PG8_BAR;
    PG8_STAGE(PG8_SB(1, 0), cB + kstep, voffB); PG8_STAGE(PG8_SA(1, 0), Ab + kstep, oC[0]); PG8_STAGE(PG8_SB(1, 1), cB + hstep + kstep, voffB);
    PG8_WAIT_V(6); PG8_BAR;
    for (;;) {
        const bool has_next = S.next(ui + 1, nxt);
        const char* nB = has_next ? S.bbase(nxt) : cB;
        if (has_next) {
#pragma unroll
            for (int h = 0; h < 2; ++h)
#pragma unroll
                for (int i = 0; i < 2; ++i) oN[h][i] = S.arow(nxt, h * HALF + RA[i]) + cA2[i];
        }
        for (int t = 0; t < nt; t += 2) {
            const bool last = (t == nt - 2);
            const char* a1 = Ab + (size_t)(t + 1) * kstep;
            const char* a2 = last ? Ab : Ab + (size_t)(t + 2) * kstep; const char* b2 = last ? nB : cB + (size_t)(t + 2) * kstep;
            const char* a3 = a2 + kstep; const char* b3 = b2 + kstep;
            unsigned o2[2][2];
#pragma unroll
            for (int h = 0; h < 2; ++h)
#pragma unroll
                for (int i = 0; i < 2; ++i) o2[h][i] = last ? oN[h][i] : oC[h][i];
            PG8_LDB(B0, 0, 0); PG8_LDB(B1, 0, 1); PG8_SCHED; PG8_LDA(At, 0, 0); PG8_STAGE(PG8_SA(1, 1), a1, oC[1]);
            PG8_WAIT_V(8); PG8_WAIT_L(0); PG8_BAR; PG8_MMA(0, 0, At, B0); if (!HALFN) PG8_MMA(0, 1, At, B1); PG8_BAR; PG8_SCHED;
            PG8_LDA(At, 0, 1); PG8_STAGE(PG8_SB(0, 0), b2, voffB); PG8_STAGE(PG8_SB(0, 1), b2 + hstep, voffB); PG8_STAGE(PG8_SA(0, 0), a2, o2[0]);
            PG8_WAIT_V(8); PG8_WAIT_L(0); PG8_BAR; PG8_MMA(1, 0, At, B0); if (!HALFN) PG8_MMA(1, 1, At, B1); PG8_BAR; PG8_SCHED;
            PG8_LDB(B0, 1, 0); PG8_LDB(B1, 1, 1); PG8_SCHED; PG8_LDA(At, 1, 0); PG8_STAGE(PG8_SA(0, 1), a2, o2[1]);
            PG8_WAIT_V(8); PG8_WAIT_L(0); PG8_BAR; PG8_MMA(0, 0, At, B0); if (!HALFN) PG8_MMA(0, 1, At, B1); PG8_BAR; PG8_SCHED;
            PG8_LDA(At, 1, 1); PG8_STAGE(PG8_SB(1, 0), b3, voffB); PG8_STAGE(PG8_SB(1, 1), b3 + hstep, voffB); PG8_STAGE(PG8_SA(1, 0), a3, o2[0]);
            PG8_WAIT_V(8); PG8_WAIT_L(0); PG8_BAR; PG8_MMA(1, 0, At, B0); if (!HALFN) PG8_MMA(1, 1, At, B1); PG8_BAR; PG8_SCHED;
        }
        if (wr == 0) PG8_BAR;
        { int frE = fr, fqE = fq; asm volatile("" : "+v"(frE), "+v"(fqE));
          E(acc, cur, wr, wc, frE, fqE); }
        if (!has_next) break;
#pragma unroll
        for (int a = 0; a < 2; ++a)
#pragma unroll
            for (int b = 0; b < 2; ++b)
#pragma unroll
                for (int m = 0; m < 4; ++m)
#pragma unroll
                    for (int n = 0; n < 2; ++n) acc[a][b][m][n] = (f32x4){0.f, 0.f, 0.f, 0.f};
        cur = nxt; cB = nB; ++ui;
#pragma unroll
        for (int h = 0; h < 2; ++h)
#pragma unroll
            for (int i = 0; i < 2; ++i) oC[h][i] = oN[h][i];
        if (wr == 1) PG8_BAR;
    }
    PG8_WAIT_V(0);
    PG8_BAR;
#undef PG8_SA
#undef PG8_SB
#undef PG8_STAGE
#undef PG8_LDA
#undef PG8_LDB
#undef PG8_MMA
#undef PG8_WAIT_V
#undef PG8_WAIT_L
#undef PG8_BAR
#undef PG8_SCHED
}
}

constexpr size_t WS_LR = 304 * MiB;
constexpr int SS_PARTS = 16;
constexpr int RING_BYTES = 131072  , LDSCTL_OFF = 139264  , MISC_OFF = LDSCTL_OFF + 320, MOETAB_OFF = LDSCTL_OFF + 1024;
constexpr int LDS_BYTES = 147456;
constexpr int MT_CNT = 0, MT_ALL = 64, MT_R0 = 64 + 65, MT_R1 = 64 + 65 + 33;

__device__ __forceinline__ f32x4 ldg4(const float* p) { return *(const f32x4*)p; }

struct MoeOrder {
    const bf16_t* A; const bf16_t* Bt; int K; int mode; const int* ltok; const LAS int* tab; int G, c;
    __device__ __forceinline__ bool next(int i, pg8::Unit& u) const {
        const int L = i * G + c;
        if (mode == 0) {
            const int T = L >> 1; if (T >= tab[MT_ALL + 64]) return false;
            int lo = 0;
#pragma unroll
            for (int s = 32; s >= 1; s >>= 1) if (tab[MT_ALL + lo + s] <= T) lo += s;
            const int tile = T - tab[MT_ALL + lo]; u.pm = T; u.pn = L & 1; u.a0 = lo | (tile << 8); const int v = tab[MT_CNT + lo] - tile * 256; u.a1 = v < 256 ? v : 256; return true;
        } else {
            const int T = L >> 2; const int tb = mode == 1 ? MT_R0 : MT_R1; if (T >= tab[tb + 32]) return false;
            int lo = 0;
#pragma unroll
            for (int s = 16; s >= 1; s >>= 1) if (tab[tb + lo + s] <= T) lo += s;
            const int list = 2 * lo + (mode - 1), tile = T - tab[tb + lo]; u.pm = tab[MT_ALL + list] + tile; u.pn = L & 3; u.a0 = list | (tile << 8);
            const int v = tab[MT_CNT + list] - tile * 256; u.a1 = v < 256 ? v : 256; return true;
        }
    }
    __device__ __forceinline__ const char* abase() const { return (const char*)A; }
    __device__ __forceinline__ unsigned arow(const pg8::Unit& u, int r) const {
        if (mode == 0) { const int list = u.a0 & 255, tile = u.a0 >> 8; const int tok = r < u.a1 ? ltok[(size_t)list * LIST_CAP + tile * 256 + r] : 0; return (unsigned)tok * (unsigned)(DM * 2); }
        return (unsigned)(u.pm * 256 + r) * (unsigned)(EHID * 2);
    }
    __device__ __forceinline__ const char* bbase(const pg8::Unit& u) const {
        const int e = (u.a0 & 255) >> 1;
        if (mode == 0) return (const char*)Bt + ((size_t)e * 512 + u.pn * 256) * DM * 2;
        return (const char*)Bt + ((size_t)e * DM + u.pn * 256) * EHID * 2;
    }
};
__device__ __forceinline__ void moe_tables(unsigned char* ws, LAS int* tab) {
    if (threadIdx.x < 64) tab[MT_CNT + threadIdx.x] = (int)__hip_atomic_load((unsigned*)(ws + WS_CTL) + CW_CNT + 64 * threadIdx.x, __ATOMIC_RELAXED, __HIP_MEMORY_SCOPE_AGENT);
    __syncthreads();
    if (threadIdx.x == 0) { int a = 0, r0 = 0, r1 = 0;
        for (int l = 0; l < 64; ++l) { const int t = (tab[MT_CNT + l] + 255) >> 8; tab[MT_ALL + l] = a; a += t; if (l & 1) { tab[MT_R1 + (l >> 1)] = r1; r1 += t; } else { tab[MT_R0 + (l >> 1)] = r0; r0 += t; } }
        tab[MT_ALL + 64] = a; tab[MT_R0 + 32] = r0; tab[MT_R1 + 32] = r1; }
    __syncthreads();
}

struct EpiInProj {
    unsigned char* ws;
    __device__ __forceinline__ void operator()(const f32x4 (&acc)[2][2][4][2], const pg8::Unit& u, int wr, int wc, int fr, int fq) const {
        const int seg = u.pn >> 1, gi = ((u.pn & 1) << 2) | wc, b = u.pm >> 3, blk = u.pm & 7;
        const bool nrm = (seg != 2 && seg != 5);
        const float* gp = (const float*)(ws + WS_CONST) + CF_GAIN + 64 * (seg == 0 ? 0 : seg == 1 ? 1 : seg == 3 ? 2 : 3);
        const float qs = (seg == 0 || seg == 3) ? C2 : 1.0f;
        f32x4 g[2][2];
#pragma unroll
        for (int bj = 0; bj < 2; ++bj)
#pragma unroll
            for (int n = 0; n < 2; ++n) g[bj][n] = nrm ? ldg4(gp + 32 * bj + 8 * fq + 4 * n) * qs : (f32x4){1.f, 1.f, 1.f, 1.f};
        bf16_t* base; size_t rstride;
        if (seg < 2) { base = (bf16_t*)(ws + (seg == 0 ? WS_QD : WS_KD)) + ((size_t)((b * 4 + (gi >> 1)) * 2 + (gi & 1)) * SEQ + blk * 256) * 64; rstride = 64; }
        else if (seg == 2) { base = (bf16_t*)(ws + WS_VD) + ((size_t)(b * 4 + (gi >> 1)) * SEQ + blk * 256) * 128 + (gi & 1) * 64; rstride = 128; }
        else { base = (bf16_t*)(ws + (seg == 3 ? WS_QM : seg == 4 ? WS_KM : WS_VM)) + ((size_t)(b * 8 + gi) * SEQ + blk * 256) * 64; rstride = 64; }
        f32x4 ks[2][2];
#pragma unroll
        for (int bj = 0; bj < 2; ++bj)
#pragma unroll
            for (int n = 0; n < 2; ++n) ks[bj][n] = (f32x4){0.f, 0.f, 0.f, 0.f};
#pragma unroll
        for (int ai = 0; ai < 2; ++ai)
#pragma unroll
            for (int m = 0; m < 4; ++m) {
                const int r = 128 * ai + 64 * wr + 16 * m + fr;
                f32x4 v[2][2]; float ss = 0.f;
#pragma unroll
                for (int bj = 0; bj < 2; ++bj)
#pragma unroll
                    for (int n = 0; n < 2; ++n) { v[bj][n] = acc[ai][bj][m][n]; ss += (v[bj][n][0] * v[bj][n][0] + v[bj][n][1] * v[bj][n][1]) + (v[bj][n][2] * v[bj][n][2] + v[bj][n][3] * v[bj][n][3]); }
                float rs = 1.f;
                if (nrm) { ss += __shfl_xor(ss, 16); ss += __shfl_xor(ss, 32); rs = rsqrtf(ss * (1.f / 64.f) + RMS_EPS); }
                bf16_t* rowp = base + (size_t)r * rstride + 8 * fq;
                const int rt = r >> 6, rk = r & 63;
#pragma unroll
                for (int bj = 0; bj < 2; ++bj) {
                    const f32x4 a = v[bj][0] * rs * g[bj][0], c = v[bj][1] * rs * g[bj][1];
                    if (seg == 4) { ks[bj][0] += a; ks[bj][1] += c; }
                    v4u w; w.x = pg8::cvt_pk_bf16(a[0], a[1]); w.y = pg8::cvt_pk_bf16(a[2], a[3]); w.z = pg8::cvt_pk_bf16(c[0], c[1]); w.w = pg8::cvt_pk_bf16(c[2], c[3]);
                    bf16_t* dst = rowp + 32 * bj;
                    if (seg == 1 || seg == 4) dst = base + (size_t)((rt * 8 + 4 * bj + fq) * 512 + rk * 8);
                    else if (seg == 5) dst = base + (size_t)((rt * 2 + bj) * 2048 + rk * 32 + 8 * fq);
                    else if (seg == 2) dst = base - (gi & 1) * 64 + (size_t)((rt * 4 + 2 * (gi & 1) + bj) * 2048 + rk * 32 + 8 * fq);
                    *(v4u*)dst = w;
                }
            }
        if (seg == 4) {
            float* km = (float*)(ws + WS_KMEAN) + (((size_t)(b * 8 + blk) * 2 + wr) * 8 + gi) * 64;
#pragma unroll
            for (int bj = 0; bj < 2; ++bj)
#pragma unroll
                for (int n = 0; n < 2; ++n) { f32x4 s = ks[bj][n];
#pragma unroll
                    for (int j = 0; j < 4; ++j) { float t = s[j]; t += __shfl_xor(t, 1); t += __shfl_xor(t, 2); t += __shfl_xor(t, 4); t += __shfl_xor(t, 8); s[j] = t; }
                    if (fr == 0) *(f32x4*)(km + 32 * bj + 8 * fq + 4 * n) = s; }
        }
    }
};

struct EpiOutProj {
    unsigned char* ws; const float* x;
    __device__ __forceinline__ void operator()(const f32x4 (&acc)[2][2][4][2], const pg8::Unit& u, int wr, int wc, int fr, int fq) const {
        bf16_t* X1B = (bf16_t*)(ws + WS_X1B); float* SS = (float*)(ws + WS_SS);
#pragma unroll
        for (int ai = 0; ai < 2; ++ai) {
            f32x4 xv[4][2][2];
#pragma unroll
            for (int m = 0; m < 4; ++m)
#pragma unroll
                for (int bj = 0; bj < 2; ++bj) { const size_t off = ((size_t)u.pm * 256 + 128 * ai + 64 * wr + 16 * m + fr) * DM + u.pn * 256 + 128 * bj + 32 * wc + 8 * fq;
                    xv[m][bj][0] = ldg4(x + off); xv[m][bj][1] = ldg4(x + off + 4); }
#pragma unroll
            for (int m = 0; m < 4; ++m) {
                const size_t row = (size_t)u.pm * 256 + 128 * ai + 64 * wr + 16 * m + fr; float ss = 0.f;
#pragma unroll
                for (int bj = 0; bj < 2; ++bj) {
                    const size_t off = row * DM + u.pn * 256 + 128 * bj + 32 * wc + 8 * fq;
                    const f32x4 a = acc[ai][bj][m][0] + xv[m][bj][0], c = acc[ai][bj][m][1] + xv[m][bj][1];
                    ss += (a[0] * a[0] + a[1] * a[1]) + (a[2] * a[2] + a[3] * a[3]) + (c[0] * c[0] + c[1] * c[1]) + (c[2] * c[2] + c[3] * c[3]);
                    v4u w; w.x = pg8::cvt_pk_bf16(a[0], a[1]); w.y = pg8::cvt_pk_bf16(a[2], a[3]); w.z = pg8::cvt_pk_bf16(c[0], c[1]); w.w = pg8::cvt_pk_bf16(c[2], c[3]);
                    *(v4u*)(X1B + off) = w;
                }
                ss += __shfl_xor(ss, 16); ss += __shfl_xor(ss, 32);
                if (fq == 0) SS[row * SS_PARTS + u.pn * 4 + wc] = ss;
            }
        }
    }
};

constexpr int ROUTE_OFF = LDSCTL_OFF + 2048;
struct EpiRoute {
    unsigned char* ws; LAS unsigned char* lds;
    __device__ __forceinline__ void operator()(const f32x4 (&acc)[2][2][4][2], const pg8::Unit& u, int wr, int wc, int fr, int fq) const {
        const float* SS = (const float*)(ws + WS_SS);
        LAS int* lcount = (LAS int*)(lds + ROUTE_OFF); LAS int* lbase = lcount + 64;
        unsigned* CTL = (unsigned*)(ws + WS_CTL); int* LTOK = (int*)(ws + WS_LTOK); float* LW = (float*)(ws + WS_LW); float* LR = (float*)(ws + WS_LR);
        if (threadIdx.x < 64) lcount[threadIdx.x] = 0;
        asm volatile("s_waitcnt lgkmcnt(0)" ::: "memory"); __builtin_amdgcn_s_barrier(); asm volatile("" ::: "memory");
        int l0v[2][4], p0v[2][4], l1v[2][4], p1v[2][4]; float w0v[2][4], w1v[2][4], r2v[2][4];
#pragma unroll
        for (int ai = 0; ai < 2; ++ai)
#pragma unroll
            for (int m = 0; m < 4; ++m) {
                const int row = u.pm * 256 + 128 * ai + 64 * wr + 16 * m + fr;
                const f32x4 e0 = acc[ai][0][m][0], e1 = acc[ai][0][m][1];
                float gl[4];
#pragma unroll
                for (int j = 0; j < 4; ++j) gl[j] = __shfl_down(e0[j], 16);
                int g = 0; float gv = gl[0];
#pragma unroll
                for (int i = 1; i < 4; ++i) if (gl[i] > gv) { gv = gl[i]; g = i; }
                l0v[ai][m] = -1; p0v[ai][m] = 0; l1v[ai][m] = 0; p1v[ai][m] = 0; w0v[ai][m] = 0.f; w1v[ai][m] = 0.f; r2v[ai][m] = 0.f;
                if (fq == 0 && g == wc) {
                    const float* sp = SS + (size_t)row * SS_PARTS; const f32x4 s0 = ldg4(sp), s1 = ldg4(sp + 4), s2 = ldg4(sp + 8), s3 = ldg4(sp + 12);
                    const float tot = ((s0[0] + s0[1]) + (s0[2] + s0[3])) + ((s1[0] + s1[1]) + (s1[2] + s1[3])) + ((s2[0] + s2[1]) + (s2[2] + s2[3])) + ((s3[0] + s3[1]) + (s3[2] + s3[3]));
                    const float r2 = rsqrtf(tot * (1.f / DM) + RMS_EPS);
                    const float el[8] = {e0[0], e0[1], e0[2], e0[3], e1[0], e1[1], e1[2], e1[3]};
                    const float mx = fmaxf(fmaxf(gl[0], gl[1]), fmaxf(gl[2], gl[3])) * r2;
                    const float den = (__expf(gl[0] * r2 - mx) + __expf(gl[1] * r2 - mx)) + (__expf(gl[2] * r2 - mx) + __expf(gl[3] * r2 - mx));
                    const float pg = __expf(gv * r2 - mx) / den;
                    float v0 = el[0]; int x0 = 0;
#pragma unroll
                    for (int i = 1; i < 8; ++i) if (el[i] > v0) { v0 = el[i]; x0 = i; }
                    float v1 = -3.0e38f; int x1 = 0;
#pragma unroll
                    for (int i = 0; i < 8; ++i) if (i != x0 && el[i] > v1) { v1 = el[i]; x1 = i; }
                    const float w0 = 1.f / (1.f + __expf((v1 - v0) * r2));
                    const int l0 = (g * 8 + x0) * 2, l1 = (g * 8 + x1) * 2 + 1;
                    l0v[ai][m] = l0; l1v[ai][m] = l1; w0v[ai][m] = pg * w0; w1v[ai][m] = pg * (1.f - w0); r2v[ai][m] = r2;
                    p0v[ai][m] = atomicAdd((int*)(lcount + l0), 1); p1v[ai][m] = atomicAdd((int*)(lcount + l1), 1);
                }
            }
        asm volatile("s_waitcnt lgkmcnt(0)" ::: "memory"); __builtin_amdgcn_s_barrier(); asm volatile("" ::: "memory");
        if (threadIdx.x < 64) lbase[threadIdx.x] = (int)atomicAdd(CTL + CW_CNT + 64 * threadIdx.x, (unsigned)lcount[threadIdx.x]);
        asm volatile("s_waitcnt vmcnt(0) lgkmcnt(0)" ::: "memory"); __builtin_amdgcn_s_barrier(); asm volatile("" ::: "memory");
#pragma unroll
        for (int ai = 0; ai < 2; ++ai)
#pragma unroll
            for (int m = 0; m < 4; ++m) if (l0v[ai][m] >= 0) {
                const int row = u.pm * 256 + 128 * ai + 64 * wr + 16 * m + fr;
                const size_t a0 = (size_t)l0v[ai][m] * LIST_CAP + lbase[l0v[ai][m]] + p0v[ai][m], a1 = (size_t)l1v[ai][m] * LIST_CAP + lbase[l1v[ai][m]] + p1v[ai][m];
                LTOK[a0] = row; LW[a0] = w0v[ai][m]; LR[a0] = r2v[ai][m]; LTOK[a1] = row; LW[a1] = w1v[ai][m]; LR[a1] = r2v[ai][m];
            }
    }
};

struct EpiGateUp {
    unsigned char* ws;
    __device__ __forceinline__ void operator()(const f32x4 (&acc)[2][2][4][2], const pg8::Unit& u, int wr, int wc, int fr, int fq) const {
        const int list = u.a0 & 255, tile = u.a0 >> 8; const float* LR = (const float*)(ws + WS_LR) + (size_t)list * LIST_CAP + tile * 256;
        bf16_t* HID = (bf16_t*)(ws + WS_HID);
        float r2v[2][4];
#pragma unroll
        for (int ai = 0; ai < 2; ++ai)
#pragma unroll
            for (int m = 0; m < 4; ++m) { const int r = 128 * ai + 64 * wr + 16 * m + fr; r2v[ai][m] = LR[r < u.a1 ? r : u.a1 - 1]; }
#pragma unroll
        for (int ai = 0; ai < 2; ++ai)
#pragma unroll
            for (int m = 0; m < 4; ++m) {
                const int r = 128 * ai + 64 * wr + 16 * m + fr;
                const float r2 = r2v[ai][m]; float h[8];
#pragma unroll
                for (int n = 0; n < 2; ++n)
#pragma unroll
                    for (int j = 0; j < 4; ++j) { const float G = acc[ai][0][m][n][j] * r2, U = acc[ai][1][m][n][j] * r2;
                        h[4 * n + j] = G * __builtin_amdgcn_rcpf(1.f + __builtin_amdgcn_exp2f(-G * LOG2E)) * U; }
                v4u w; w.x = pg8::cvt_pk_bf16(h[0], h[1]); w.y = pg8::cvt_pk_bf16(h[2], h[3]); w.z = pg8::cvt_pk_bf16(h[4], h[5]); w.w = pg8::cvt_pk_bf16(h[6], h[7]);
                if (r < u.a1) *(v4u*)(HID + ((size_t)u.pm * 256 + r) * EHID + u.pn * 128 + 32 * wc + 8 * fq) = w;
            }
    }
};

template <int RK> struct EpiDown {
    unsigned char* ws; float* out;
    __device__ __forceinline__ void operator()(const f32x4 (&acc)[2][2][4][2], const pg8::Unit& u, int wr, int wc, int fr, int fq) const {
        const int list = u.a0 & 255, tile = u.a0 >> 8; const size_t eb = (size_t)list * LIST_CAP + tile * 256;
        const int* LTOK = (const int*)(ws + WS_LTOK) + eb; const float* LW = (const float*)(ws + WS_LW) + eb;
        const bf16_t* SRC = (const bf16_t*)(ws + (RK == 0 ? WS_X1B : WS_PA)); bf16_t* PA = (bf16_t*)(ws + WS_PA);
        int tokv[2][4]; float wv[2][4];
#pragma unroll
        for (int ai = 0; ai < 2; ++ai)
#pragma unroll
            for (int m = 0; m < 4; ++m) { const int r = 128 * ai + 64 * wr + 16 * m + fr, rc = r < u.a1 ? r : u.a1 - 1; tokv[ai][m] = LTOK[rc]; wv[ai][m] = LW[rc]; }
#pragma unroll
        for (int ai = 0; ai < 2; ++ai) {
            v4u bs[4][2];
#pragma unroll
            for (int m = 0; m < 4; ++m)
#pragma unroll
                for (int bj = 0; bj < 2; ++bj) bs[m][bj] = *(const v4u*)(SRC + (size_t)tokv[ai][m] * DM + u.pn * 256 + 128 * bj + 32 * wc + 8 * fq);
#pragma unroll
            for (int m = 0; m < 4; ++m) {
                const int r = 128 * ai + 64 * wr + 16 * m + fr; const bool ok = r < u.a1; const float wt = wv[ai][m];
#pragma unroll
                for (int bj = 0; bj < 2; ++bj) {
                    const size_t off = (size_t)tokv[ai][m] * DM + u.pn * 256 + 128 * bj + 32 * wc + 8 * fq; const v4u b4 = bs[m][bj];
                    f32x4 a, c;
                    a[0] = __uint_as_float(b4.x << 16); a[1] = __uint_as_float(b4.x & 0xffff0000u); a[2] = __uint_as_float(b4.y << 16); a[3] = __uint_as_float(b4.y & 0xffff0000u);
                    c[0] = __uint_as_float(b4.z << 16); c[1] = __uint_as_float(b4.z & 0xffff0000u); c[2] = __uint_as_float(b4.w << 16); c[3] = __uint_as_float(b4.w & 0xffff0000u);
                    a += acc[ai][bj][m][0] * wt; c += acc[ai][bj][m][1] * wt;
                    if (ok) {
                        if (RK == 0) { v4u w; w.x = pg8::cvt_pk_bf16(a[0], a[1]); w.y = pg8::cvt_pk_bf16(a[2], a[3]); w.z = pg8::cvt_pk_bf16(c[0], c[1]); w.w = pg8::cvt_pk_bf16(c[2], c[3]); *(v4u*)(PA + off) = w; }
                        else { if (DBG_MEASURE) { const float sc_ = 1.0f + ((const float*)(ws + WS_CONST))[CF_DBG]; a *= sc_; c *= sc_; } *(f32x4*)(out + off) = a; *(f32x4*)(out + off + 4) = c; }
                    }
                }
            }
        }
    }
};

#define HAVE_ATTN 1
namespace att {
typedef short bf16x8 __attribute__((ext_vector_type(8)));
typedef short s16x4 __attribute__((ext_vector_type(4)));
typedef short v4i16_t __attribute__((ext_vector_type(4)));
typedef float f32x16 __attribute__((ext_vector_type(16)));
constexpr int TBL_STRIDE = 2384;
constexpr int TBL_BYTES = 38912, SLOT_OFF = TBL_BYTES, NSLOT = 3, STAGE_OFF = SLOT_OFF + 65536  , WSCR_OFF = SLOT_OFF + NSLOT * 32768, ATT_LDS = WSCR_OFF + 2048;
static_assert(4 * TBL_STRIDE * 4 <= TBL_BYTES && ATT_LDS <= LDSCTL_OFF, "attention LDS map");
constexpr float NEGBIG = -1.0e30f;
constexpr int KMEAN_OFF = LDSCTL_OFF + 4608;
__device__ __forceinline__ int crow(int r, int hi) { return (r & 3) + 8 * (r >> 2) + 4 * hi; }
__device__ __forceinline__ s16x4 vtr(const LAS unsigned char* p) { return __builtin_bit_cast(s16x4, __builtin_amdgcn_ds_read_tr16_b64_v4i16((LAS v4i16_t*)p)); }
__device__ __forceinline__ void glds16(const void* gsrc, unsigned lds_dst) { unsigned keep;
    asm volatile("s_mov_b32 %0, m0\n\ts_mov_b32 m0, %2\n\ts_nop 0\n\tglobal_load_lds_dwordx4 %1, off\n\ts_mov_b32 m0, %0" : "=&s"(keep) : "v"(gsrc), "s"(lds_dst) : "memory"); }
__device__ __forceinline__ unsigned cvtpk(float lo, float hi) { typedef float f2 __attribute__((ext_vector_type(2))); typedef __bf16 b2 __attribute__((ext_vector_type(2))); f2 v = {lo, hi}; b2 b = __builtin_convertvector(v, b2); return __builtin_bit_cast(unsigned, b); }

__device__ __forceinline__ void build_table(LAS unsigned char* lds, const float* CF, int h12) {
    LAS float* tb = (LAS float*)lds; const float* BT = CF + CF_BT + h12 * 2048; const float off = CF[CF_OFF + h12];
    for (int idx = threadIdx.x; idx < 4 * TBL_STRIDE; idx += 512) { const int s = idx / TBL_STRIDE, i = idx - s * TBL_STRIDE, j = i + s; tb[idx] = j <= 2047 ? BT[2047 - j] - off : NEGBIG; }
}

template <int NK> __device__ __forceinline__ void epilogue(LAS unsigned char* lds, unsigned char* ws, const Inputs& in, int b, int h, int w, int map, int rb, int qw0, int lane_in, float lsum, att::f32x16 (&o)[NK == 2 ? 4 : 2]) {
    constexpr int ND = NK == 2 ? 4 : 2;
    int lane = lane_in; asm volatile("" : "+v"(lane));
    const int r32 = lane & 31, hi = lane >> 5;
    const float* CF = (const float*)(ws + WS_CONST);
    LAS float* wsf = (LAS float*)(lds + WSCR_OFF) + w * 64;
    if (hi == 0) wsf[r32] = lsum;
    asm volatile("s_waitcnt lgkmcnt(0)" ::: "memory");
    float rli[16];
#pragma unroll
    for (int r = 0; r < 16; ++r) rli[r] = __builtin_amdgcn_rcpf(wsf[crow(r, hi)]);
    bf16_t* Y = (bf16_t*)(ws + WS_Y);
    if (NK == 1) {
        LAS bf16_t* stg = (LAS bf16_t*)(lds + STAGE_OFF) + w * 2048;
#pragma unroll
        for (int r = 0; r < 16; ++r) { const int orow = crow(r, hi);
#pragma unroll
            for (int d0 = 0; d0 < ND; ++d0) stg[orow * 64 + d0 * 32 + r32] = (bf16_t)f2bf(o[d0][r] * rli[r]); }
        asm volatile("s_waitcnt lgkmcnt(0)" ::: "memory");
        bf16_t* Yw = Y + (size_t)(b * SEQ + qw0) * DM + 512 + h * 64;
#pragma unroll
        for (int i = 0; i < 4; ++i) { const int row = i * 8 + (lane >> 3), ch = lane & 7; const v4u v = *(const LAS v4u*)(stg + row * 64 + ch * 8); *(v4u*)(Yw + (size_t)row * DM + ch * 8) = v; }
    } else {
        LAS float* X = (LAS float*)(lds + SLOT_OFF) + (size_t)rb * 32 * 128;
        const float lam = CF[CF_LAMBDA];
        if (map == 1) {
#pragma unroll
            for (int r = 0; r < 16; ++r) { const int orow = crow(r, hi); const float f = rli[r] * lam;
#pragma unroll
                for (int d0 = 0; d0 < ND; ++d0) X[orow * 128 + d0 * 32 + r32] = o[d0][r] * f; }
        }
        asm volatile("s_waitcnt lgkmcnt(0)" ::: "memory"); __syncthreads();
        if (map == 0) {
            float gsub[ND];
#pragma unroll
            for (int d0 = 0; d0 < ND; ++d0) gsub[d0] = in.diff_sub_g[d0 * 32 + r32];
            LAS bf16_t* stg = (LAS bf16_t*)(lds + STAGE_OFF) + rb * 4096;
#pragma unroll
            for (int r = 0; r < 16; ++r) { const int orow = crow(r, hi); float v[ND]; float ss = 0.f;
#pragma unroll
                for (int d0 = 0; d0 < ND; ++d0) { v[d0] = o[d0][r] * rli[r] - X[orow * 128 + d0 * 32 + r32]; ss += v[d0] * v[d0]; }
                ss += __shfl_xor(ss, 1); ss += __shfl_xor(ss, 2); ss += __shfl_xor(ss, 4); ss += __shfl_xor(ss, 8); ss += __shfl_xor(ss, 16);
                const float sc2 = rsqrtf(ss * (1.f / 128.f) + RMS_EPS) * (1.f - LAMBDA_INIT);
#pragma unroll
                for (int d0 = 0; d0 < ND; ++d0) stg[orow * 128 + d0 * 32 + r32] = (bf16_t)f2bf(v[d0] * sc2 * gsub[d0]); }
            asm volatile("s_waitcnt lgkmcnt(0)" ::: "memory");
            bf16_t* Yw = Y + (size_t)(b * SEQ + qw0) * DM + h * 128;
#pragma unroll
            for (int i = 0; i < 8; ++i) { const int row = i * 4 + (lane >> 4), ch = lane & 15; const v4u v = *(const LAS v4u*)(stg + row * 128 + ch * 8); *(v4u*)(Yw + (size_t)row * DM + ch * 8) = v; }
        }
    }
    asm volatile("s_waitcnt lgkmcnt(0)" ::: "memory"); __builtin_amdgcn_s_barrier(); asm volatile("" ::: "memory");
}


template <int NK, int ABL> __device__ __forceinline__ void attn_unit(LAS unsigned char* lds, unsigned char* ws, const Inputs& in, int b, int h, int qb, bool stage_km) {
    constexpr int DV = NK == 2 ? 128 : 64, ND = DV / 32, ROWS = NK == 2 ? 128 : 256, SLOTB = NK == 2 ? 32768 : 16384, VOFF = 8192 * NK;
    const int tid = threadIdx.x; int lane_ = tid & 63; asm volatile("" : "+v"(lane_));
    const int lane = lane_, r32 = lane & 31, hi = lane >> 5; const int w = __builtin_amdgcn_readfirstlane(tid >> 6);
    const int map = NK == 2 ? (w >> 2) : 0, rb = NK == 2 ? (w & 3) : w;
    const int q0 = qb * ROWS, qw0 = q0 + 32 * rb, qabs = qw0 + r32, NT = (q0 + ROWS) / 64;
    const float* CF = (const float*)(ws + WS_CONST);
    const bf16_t *Qh, *Kh0, *Kh1, *Vh;
    if (NK == 2) { const size_t hb = (size_t)(b * 4 + h) * 2; Qh = (const bf16_t*)(ws + WS_QD) + (hb + map) * SEQ * 64; Kh0 = (const bf16_t*)(ws + WS_KD) + hb * SEQ * 64; Kh1 = Kh0 + (size_t)SEQ * 64;
                   Vh = (const bf16_t*)(ws + WS_VD) + (size_t)(b * 4 + h) * SEQ * 128; }
    else { const size_t hb = (size_t)(b * 8 + h); Qh = (const bf16_t*)(ws + WS_QM) + hb * SEQ * 64; Kh0 = (const bf16_t*)(ws + WS_KM) + hb * SEQ * 64; Kh1 = Kh0; Vh = (const bf16_t*)(ws + WS_VM) + hb * SEQ * 64; }
    const bf16_t* ksrc0 = Kh0 + (size_t)w * 512 + lane * 8; const bf16_t* ksrc1 = Kh1 + (size_t)w * 512 + lane * 8;
    const bf16_t* vsrc0 = Vh + (size_t)w * 512 + lane * 8;
    const bf16_t* vsrc1 = vsrc0 + 4096;
    constexpr int KSB = 8192 * NK, VSB = 128 * DV, KRING = SLOT_OFF, VRING = SLOT_OFF + 49152;
    const unsigned kdst = (unsigned)(uintptr_t)(lds + KRING) + (unsigned)w * 1024u, vdst = (unsigned)(uintptr_t)(lds + VRING) + (unsigned)w * 1024u;
#define ATT_DMAK(t, off) do { if (ABL & 16) break; const unsigned d_ = (unsigned)__builtin_amdgcn_readfirstlane(kdst + (unsigned)(off)); const size_t o_ = (size_t)(t) * 64 * 64; glds16(ksrc0 + o_, d_); if (NK == 2) glds16(ksrc1 + o_, d_ + 8192u); } while (0)
#define ATT_DMAV(t, off) do { if (ABL & 16) break; const unsigned d_ = (unsigned)__builtin_amdgcn_readfirstlane(vdst + (unsigned)(off)); const size_t o_ = (size_t)(t) * 64 * DV; glds16(vsrc0 + o_, d_); if (NK == 2) glds16(vsrc1 + o_, d_ + 8192u); } while (0)
    if (NK == 1) { ATT_DMAK(0, 0); ATT_DMAV(0, 0); ATT_DMAK(1, KSB); ATT_DMAV(1, VSB); ATT_DMAK(2, 2 * KSB); ATT_DMAV(2, 2 * VSB); ATT_DMAK(3, 3 * KSB); ATT_DMAV(3, 3 * VSB); if (NT > 4) ATT_DMAK(4, 4 * KSB); }
    else { ATT_DMAK(0, 0); ATT_DMAV(0, 0); ATT_DMAK(1, KSB); }
    bf16x8 qr[4];
#pragma unroll
    for (int d0 = 0; d0 < 4; ++d0) qr[d0] = *(const bf16x8*)(Qh + (size_t)qabs * 64 + d0 * 16 + hi * 8);
    if (NK == 1 && stage_km) { const int n = tid >> 6, d = tid & 63;
        if (n < qb) { const float* k0 = (const float*)(ws + WS_KMEAN) + (((size_t)(b * 8 + n) * 2 + 0) * 8 + h) * 64 + d; const float v = k0[0] + k0[512];
            const unsigned hb = f2bf(v); const float lo = v - bf2f((bf16_t)hb);
            ((LAS bf16_t*)(lds + KMEAN_OFF))[n * 64 + d] = (bf16_t)hb; ((LAS bf16_t*)(lds + KMEAN_OFF + 1024))[n * 64 + d] = (bf16_t)f2bf(lo); } }
#pragma unroll
    for (int d0 = 0; d0 < 4; ++d0) asm volatile("" : "+v"(qr[d0]));
    asm volatile("s_waitcnt vmcnt(0)" ::: "memory"); __syncthreads();
    unsigned selmask = 0xffffffffu;
    if (NK == 1 && qb > 0) {
        float gate[8];
        { f32x16 G = {}; const LAS unsigned char* kmh = lds + KMEAN_OFF + (r32 & 7) * 128 + hi * 16;
#pragma unroll
          for (int d0 = 0; d0 < 4; ++d0) { const bf16x8 ah = *(const LAS bf16x8*)(kmh + d0 * 32), al = *(const LAS bf16x8*)(kmh + 1024 + d0 * 32);
              G = __builtin_amdgcn_mfma_f32_32x32x16_bf16(ah, qr[d0], G, 0, 0, 0); G = __builtin_amdgcn_mfma_f32_32x32x16_bf16(al, qr[d0], G, 0, 0, 0); }
#pragma unroll
          for (int r = 0; r < 4; ++r) { const float mine = G[r], oth = __shfl_xor(mine, 32); gate[r] = hi ? oth : mine; gate[4 + r] = hi ? mine : oth; } }
        selmask = 0u;
#pragma unroll
        for (int n = 0; n < 8; ++n) { int better = 0;
#pragma unroll
            for (int m = 0; m < 8; ++m) if (m != n) better += (m < qb && (gate[m] > gate[n] || (gate[m] == gate[n] && m < n))) ? 1 : 0;
            if (n < qb && better < 3) selmask |= 1u << n; }
        selmask |= 1u << qb;
    }
    const int j0 = 2047 - qabs + 4 * hi, sc = j0 & 3;
    const LAS unsigned char* tb_base = lds + (sc * TBL_STRIDE + (j0 - sc)) * 4;
    const LAS unsigned char* tb_neg = lds + (sc * TBL_STRIDE + 2052) * 4;
    const LAS unsigned char* kp0 = lds + KRING + map * 8192 + hi * 1024 + r32 * 16;
    const LAS unsigned char* vp0 = lds + VRING + ((lane >> 4) & 1) * 32 + (lane & 3) * 8 + (4 * hi + ((lane & 15) >> 2)) * 64;
    f32x16 o[ND];
#pragma unroll
    for (int d = 0; d < ND; ++d) o[d] = f32x16{};
    float ls0 = 0.f, ls1 = 0.f;
    const int NTw = (qw0 + 31) / 64 + 1 < NT ? (qw0 + 31) / 64 + 1 : NT;
#define SBAR() __builtin_amdgcn_sched_barrier(0)
#define MFMA32(a, b, c) __builtin_amdgcn_mfma_f32_32x32x16_bf16(a, b, c, 0, 0, 0)
#define MFMA_QK(a, b, c) ((ABL & 8) ? (c) : MFMA32(a, b, c))
#define MFMA_PV(a, b, c) ((ABL & 4) ? (c) : MFMA32(a, b, c))
#define EXP2F(x) ((ABL & 1) ? (x) : __builtin_amdgcn_exp2f(x))
#define CINIT_H(P, half, tt) do { if (ABL & 2) { asm volatile("" : "+v"(P)); break; } const bool sel_ = NK == 2 || ((selmask >> ((tt) >> 2)) & 1u); const LAS unsigned char* tp_ = (sel_ ? tb_base + (tt) * 256 : tb_neg) + (half) * 128; \
        _Pragma("unroll") for (int g = 0; g < 4; ++g) { const f32x4 c0 = *(const LAS f32x4*)(tp_ + g * 32); P[4 * g] = c0[0]; P[4 * g + 1] = c0[1]; P[4 * g + 2] = c0[2]; P[4 * g + 3] = c0[3]; } } while (0)
#define CINIT(P0, P1, tt) do { CINIT_H(P0, 0, tt); CINIT_H(P1, 1, tt); } while (0)
#define KLOAD(kf, koff) do { _Pragma("unroll") for (int i_ = 0; i_ < 8; ++i_) kf[i_] = *(const LAS bf16x8*)(kp0 + (koff) + (i_ >> 1) * 2048 + (i_ & 1) * 512); } while (0)
#define EXP4(PC0, PC1, i) do { if ((i) < 4) { _Pragma("unroll") for (int e_ = 0; e_ < 4; ++e_) PC0[4 * (i) + e_] = EXP2F(PC0[4 * (i) + e_]); asm volatile("" : "+v"(PC0)); } \
        else { _Pragma("unroll") for (int e_ = 0; e_ < 4; ++e_) PC1[4 * ((i) - 4) + e_] = EXP2F(PC1[4 * ((i) - 4) + e_]); asm volatile("" : "+v"(PC1)); } } while (0)
#define STEP_HEAD(t) do { if ((t) + 5 < NT) ATT_DMAK((t) + 5, ko_i); if ((t) + 4 < NT) ATT_DMAV((t) + 4, vo_i); } while (0)
#define STEP_TAIL(t) do { { const int a_ = NT - (t) - 3, b_ = NT - (t) - 2; const int nfl = (a_ < 0 ? 0 : a_ > 3 ? 3 : a_) + (b_ < 0 ? 0 : b_ > 3 ? 3 : b_); \
          if (nfl >= 6) asm volatile("s_waitcnt vmcnt(6) lgkmcnt(0)" ::: "memory"); else if (nfl == 5) asm volatile("s_waitcnt vmcnt(5) lgkmcnt(0)" ::: "memory"); \
          else if (nfl == 4) asm volatile("s_waitcnt vmcnt(4) lgkmcnt(0)" ::: "memory"); else if (nfl == 3) asm volatile("s_waitcnt vmcnt(3) lgkmcnt(0)" ::: "memory"); \
          else if (nfl == 2) asm volatile("s_waitcnt vmcnt(2) lgkmcnt(0)" ::: "memory"); else if (nfl == 1) asm volatile("s_waitcnt vmcnt(1) lgkmcnt(0)" ::: "memory"); \
          else asm volatile("s_waitcnt vmcnt(0) lgkmcnt(0)" ::: "memory"); } \
        __builtin_amdgcn_s_barrier(); asm volatile("" ::: "memory"); SBAR(); \
        { s5 = s5 == 4 ? 0 : s5 + 1; const int s5n = s5 == 4 ? 0 : s5 + 1, s5p = s5 == 0 ? 4 : s5 - 1; ko_r = s5n * KSB; ko_i = s5 * KSB; vo_r = s5 * VSB; vo_i = s5p * VSB; } } while (0)
#define KLD1(i) ((ABL & 32) ? qr[(i) & 3] : *(const LAS bf16x8*)(kp0 + ko_r + ((i) >> 1) * 2048 + ((i) & 1) * 512))
#define QK_EXP(PC0, PC1, PN0, PN1, t) do { bf16x8 kf[8]; _Pragma("unroll") for (int i = 0; i < 8; ++i) kf[i] = KLD1(i); EXP4(PC0, PC1, 0); SBAR(); \
        _Pragma("unroll") for (int i = 0; i < 8; ++i) { \
            if (i & 1) PN1 = MFMA_QK(kf[i], qr[i >> 1], PN1); else PN0 = MFMA_QK(kf[i], qr[i >> 1], PN0); if (i + 1 < 8) EXP4(PC0, PC1, i + 1); if (i == 5) { VLOAD(0); VLOAD(1); } SBAR(); } } while (0)
#define SUMPACK(PC0, PC1, ks) do { if (ABL & 256) { asm volatile("" : "+v"(pw[(ks) & 1])); break; } _Pragma("unroll") for (int i = 0; i < 4; ++i) { \
            const float a_ = (ks) == 0 ? PC0[2 * i] : (ks) == 1 ? PC0[8 + 2 * i] : (ks) == 2 ? PC1[2 * i] : PC1[8 + 2 * i]; \
            const float b_ = (ks) == 0 ? PC0[2 * i + 1] : (ks) == 1 ? PC0[9 + 2 * i] : (ks) == 2 ? PC1[2 * i + 1] : PC1[9 + 2 * i]; \
            ls0 += a_; ls1 += b_; pw[(ks) & 1][i] = cvtpk(a_, b_); } asm volatile("" : "+v"(ls0), "+v"(ls1), "+v"(pw[(ks) & 1])); } while (0)
#define VLOAD(g) do { if (ABL & 32) { vl[(g) % 3] = s16x4{1, 2, 3, 4}; vh[(g) % 3] = s16x4{1, 2, 3, 4}; asm volatile("" : "+v"(vl[(g) % 3]), "+v"(vh[(g) % 3])); } else if ((g) < 4 * ND) { const int ks_ = (g) / ND, d_ = (g) % ND; vl[(g) % 3] = vtr(vp + d_ * 4096 + ks_ * 1024); vh[(g) % 3] = vtr(vp + d_ * 4096 + ks_ * 1024 + 512); } } while (0)
#define PV_SUM(PC0, PC1, t, CI, PRE) do { v4u pw[2]; \
        if (!(PRE)) { VLOAD(0); VLOAD(1); } SUMPACK(PC0, PC1, 0); SBAR(); __builtin_amdgcn_s_setprio(1); \
        _Pragma("unroll") for (int g = 0; g < 4 * ND; ++g) { const int ks = g / ND, d0 = g % ND; \
            VLOAD(g + 2); \
            { const s16x4 a_ = vl[g % 3], b_ = vh[g % 3]; const bf16x8 vf = {a_[0], a_[1], a_[2], a_[3], b_[0], b_[1], b_[2], b_[3]}; o[d0] = MFMA_PV(__builtin_bit_cast(bf16x8, pw[ks & 1]), vf, o[d0]); } \
            if (d0 == ND - 2 && ks < 3) SUMPACK(PC0, PC1, ks + 1); \
            if (g == 1 && (t) + 5 < NT) ATT_DMAK((t) + 5, ko_i); if (g == 3 && (t) + 4 < NT) ATT_DMAV((t) + 4, vo_i); \
            if (CI && g == 2 * ND + 1 && (t) + 2 < NTw) CINIT(PC0, PC1, (t) + 2); \
            SBAR(); } __builtin_amdgcn_s_setprio(0); } while (0)
#define STEP_FULL(PC0, PC1, PN0, PN1, t) do { const LAS unsigned char* vp = vp0 + vo_r; s16x4 vl[3], vh[3]; QK_EXP(PC0, PC1, PN0, PN1, t); PV_SUM(PC0, PC1, t, true, true); STEP_TAIL(t); } while (0)
#define STEP_LAST(PC0, PC1, t) do { const LAS unsigned char* vp = vp0 + vo_r; s16x4 vl[3], vh[3]; _Pragma("unroll") for (int i = 0; i < 8; ++i) EXP4(PC0, PC1, i); PV_SUM(PC0, PC1, t, false, false); STEP_TAIL(t); } while (0)
    if constexpr (NK == 1) {
    int s5 = 0, ko_r = KSB, ko_i = 0, vo_r = 0, vo_i = 4 * VSB;
    f32x16 pA0, pA1, pB0, pB1;
    if (1 < NTw) CINIT(pB0, pB1, 1);
    { bf16x8 kf[8]; CINIT(pA0, pA1, 0); KLOAD(kf, 0);
#pragma unroll
      for (int i = 0; i < 8; ++i) { if (i & 1) pA1 = MFMA32(kf[i], qr[i >> 1], pA1); else pA0 = MFMA32(kf[i], qr[i >> 1], pA0); } }
    asm volatile("s_waitcnt lgkmcnt(0)" ::: "memory"); __builtin_amdgcn_s_barrier(); asm volatile("" ::: "memory"); SBAR();
    int t = 0;
    for (; t + 2 < NTw; t += 2) {
        unsigned long long t0_ = 0; if (DBG_MEASURE == 2 && blockIdx.x == 0 && w == 0) t0_ = __builtin_amdgcn_s_memtime();
        STEP_FULL(pA0, pA1, pB0, pB1, t); STEP_FULL(pB0, pB1, pA0, pA1, t + 1);
        if (DBG_MEASURE == 2 && blockIdx.x == 0 && w == 0) { const unsigned long long t1_ = __builtin_amdgcn_s_memtime(); LAS unsigned* dg = (LAS unsigned*)(lds + LDSCTL_OFF + 3072); if (lane == 0) { dg[0] += (unsigned)(t1_ - t0_); dg[1] += 2u; } }
    }
    if (NTw - t == 2) { STEP_FULL(pA0, pA1, pB0, pB1, t); STEP_LAST(pB0, pB1, t + 1); t += 2; }
    else { STEP_LAST(pA0, pA1, t); t += 1; }
    for (; t < NT; ++t) { STEP_HEAD(t); STEP_TAIL(t); }
    } else {
    int ko_r = 0, ko_n = KSB, ko_i = 2 * KSB, vo_r = 2 * VSB, vo_n = 0, vo_i = VSB;
    f32x16 S0, S1; v4u pwA[4], pwB[4];
#define DHEAD(t) do { if ((t) + 2 < NT) ATT_DMAK((t) + 2, ko_i); if ((t) + 1 < NT) ATT_DMAV((t) + 1, vo_i); } while (0)
#define DTAIL(t) do { if ((t) + 2 < NT) asm volatile("s_waitcnt vmcnt(4) lgkmcnt(0)" ::: "memory"); else asm volatile("s_waitcnt vmcnt(0) lgkmcnt(0)" ::: "memory"); \
        __builtin_amdgcn_s_barrier(); asm volatile("" ::: "memory"); SBAR(); \
        { const int tk_ = ko_r; ko_r = ko_n; ko_n = ko_i; ko_i = tk_; const int tv_ = vo_r; vo_r = vo_n; vo_n = vo_i; vo_i = tv_; } } while (0)
#define DQK(t, PRE) do { bf16x8 kf[4]; _Pragma("unroll") for (int i = 0; i < 4; ++i) kf[i] = KLD1(i); SBAR(); \
        _Pragma("unroll") for (int i = 0; i < 8; ++i) { \
            if (i & 1) S1 = MFMA_QK(kf[i & 3], qr[i >> 1], S1); else S0 = MFMA_QK(kf[i & 3], qr[i >> 1], S0); \
            if (i + 4 < 8) kf[i & 3] = KLD1(i + 4); if ((PRE) && i == 6) VLOAD2(0); SBAR(); } } while (0)
#define DSOFT(PW, g) do { if (ABL & 256) { asm volatile("" : "+v"(PW[(g) >> 2])); break; } float a_ = (g) < 8 ? S0[2 * (g)] : S1[2 * ((g) - 8)], b_ = (g) < 8 ? S0[2 * (g) + 1] : S1[2 * ((g) - 8) + 1]; \
        a_ = EXP2F(a_); b_ = EXP2F(b_); ls0 += a_; ls1 += b_; PW[(g) >> 2][(g) & 3] = cvtpk(a_, b_); asm volatile("" : "+v"(ls0), "+v"(ls1), "+v"(PW[(g) >> 2])); } while (0)
#define VLOAD2(g) do { if (ABL & 32) { vl[(g) & 1] = s16x4{1, 2, 3, 4}; vh[(g) & 1] = s16x4{1, 2, 3, 4}; asm volatile("" : "+v"(vl[(g) & 1]), "+v"(vh[(g) & 1])); } else if ((g) < 16) { const int ks_ = (g) >> 2, d_ = (g) & 3; vl[(g) & 1] = vtr(vp + d_ * 4096 + ks_ * 1024); vh[(g) & 1] = vtr(vp + d_ * 4096 + ks_ * 1024 + 512); } } while (0)
#define DPV(PWP, PWC, SOFT, t, PRE) do { if (!(PRE)) { VLOAD2(0); } SBAR(); \
        _Pragma("unroll") for (int g = 0; g < 16; ++g) { const int ks = g >> 2, d0 = g & 3; VLOAD2(g + 1); \
            { const s16x4 a2_ = vl[g & 1], b2_ = vh[g & 1]; const bf16x8 vf = {a2_[0], a2_[1], a2_[2], a2_[3], b2_[0], b2_[1], b2_[2], b2_[3]}; o[d0] = MFMA_PV(__builtin_bit_cast(bf16x8, PWP[ks]), vf, o[d0]); } \
            if (SOFT) DSOFT(PWC, g); \
            if (g == 2 && (t) + 2 < NT) ATT_DMAK((t) + 2, ko_i); if (g == 6 && (t) + 1 < NT) ATT_DMAV((t) + 1, vo_i); \
            if (SOFT && g == 8 && (t) + 1 < NTw) CINIT_H(S0, 0, (t) + 1); \
            SBAR(); } } while (0)
#define DSTEP_MID(PWP, PWC, t) do { const LAS unsigned char* vp = vp0 + vo_r; s16x4 vl[2], vh[2]; DQK(t, true); DPV(PWP, PWC, true, t, true); if ((t) + 1 < NTw) CINIT_H(S1, 1, (t) + 1); DTAIL(t); } while (0)
    { const LAS unsigned char* vp = vp0; s16x4 vl[2], vh[2]; (void)vp; (void)vl; (void)vh; DHEAD(0); CINIT(S0, S1, 0); DQK(0, false);
#pragma unroll
      for (int g = 0; g < 16; ++g) DSOFT(pwA, g);
      if (1 < NTw) CINIT(S0, S1, 1); DTAIL(0); }
    int t = 1;
    for (; t + 1 < NTw; t += 2) {
        unsigned long long t0_ = 0; if (DBG_MEASURE == 3 && blockIdx.x == 0 && w == 0) t0_ = __builtin_amdgcn_s_memtime();
        DSTEP_MID(pwA, pwB, t); DSTEP_MID(pwB, pwA, t + 1);
        if (DBG_MEASURE == 3 && blockIdx.x == 0 && w == 0) { const unsigned long long t1_ = __builtin_amdgcn_s_memtime(); LAS unsigned* dg = (LAS unsigned*)(lds + LDSCTL_OFF + 3072); if (lane == 0) { dg[0] += (unsigned)(t1_ - t0_); dg[1] += 2u; } }
    }
    if (t < NTw) { DSTEP_MID(pwA, pwB, t); ++t; { const LAS unsigned char* vp = vp0 + vo_r; s16x4 vl[2], vh[2]; DPV(pwB, pwA, false, t, false); } DTAIL(t); ++t; }
    else { { const LAS unsigned char* vp = vp0 + vo_r; s16x4 vl[2], vh[2]; DPV(pwA, pwB, false, t, false); } DTAIL(t); ++t; }
    for (; t <= NT; ++t) { DHEAD(t); DTAIL(t); }
#undef DHEAD
#undef DTAIL
#undef DQK
#undef DSOFT
#undef DPV
#undef VLOAD2
#undef DSTEP_MID
    }
    float lsum = ls0 + ls1;
#undef STEP_FULL
#undef STEP_LAST
#undef STEP_HEAD
#undef STEP_TAIL
#undef QK_EXP
#undef KLD1
#undef PV_SUM
#undef SUMPACK
#undef VLOAD
#undef EXP4
#undef KLOAD
#undef CINIT
#undef CINIT_H
#undef MFMA32
#undef MFMA_QK
#undef MFMA_PV
#undef EXP2F
#undef SBAR
#undef ATT_DMAK
#undef ATT_DMAV
    lsum += __shfl_xor(lsum, 32);
    epilogue<NK>(lds, ws, in, b, h, w, map, rb, qw0, lane, lsum, o);
}

template <int ABL> __device__ __forceinline__ void attn_phase(LAS unsigned char* lds, unsigned char* ws, const Inputs& in, int G, int v) {
    const float* CF = (const float*)(ws + WS_CONST);
    if (DBG_MEASURE && blockIdx.x == 0 && threadIdx.x == 0) { LAS unsigned* dg = (LAS unsigned*)(lds + LDSCTL_OFF + 3072); dg[0] = 0u; dg[1] = 0u;
        LAS unsigned long long* dq = (LAS unsigned long long*)(lds + LDSCTL_OFF + 3088); dq[0] = __builtin_amdgcn_s_memtime(); dq[1] = __builtin_amdgcn_s_memrealtime(); }
    for (int vv = v; vv < 256; vv += G) {
        { const int j = vv & 3; build_table(lds, CF, 4 + ((vv >> 2) & 7));
          for (int k = 0; k < 4; ++k) { const int head = (vv >> 2) + 64 * k, b = head >> 3, h = head & 7;
              if constexpr ((ABL & 512) != 0) { const int wv = __builtin_amdgcn_readfirstlane(threadIdx.x >> 6);
                  if (wv < 4) { attn_unit<1, 0>(lds, ws, in, b, h, 7 - j, true); attn_unit<1, 0>(lds, ws, in, b, h, j, false); } else { attn_unit<1, (ABL & 0x1bf)>(lds, ws, in, b, h, 7 - j, true); attn_unit<1, (ABL & 0x1bf)>(lds, ws, in, b, h, j, false); } }
              else if constexpr ((ABL & 2048) != 0) { attn_unit<1, 0>(lds, ws, in, b, h, 7 - j, true); attn_unit<1, 0>(lds, ws, in, b, h, j, false); }
              else { attn_unit<1, ABL>(lds, ws, in, b, h, (ABL & 64) ? 0 : 7 - j, true); attn_unit<1, ABL>(lds, ws, in, b, h, (ABL & 64) ? 0 : j, false); } } }
        __syncthreads();
        if constexpr ((ABL & 1024) == 0)
        { const int j = vv & 7; build_table(lds, CF, (vv >> 3) & 3);
          for (int k = 0; k < 4; ++k) { const int head = (vv >> 3) + 32 * k, b = head >> 2, h = head & 3;
              attn_unit<2, (ABL & 0x1ff)>(lds, ws, in, b, h, (ABL & 64) ? 0 : 15 - j, false); attn_unit<2, (ABL & 0x1ff)>(lds, ws, in, b, h, (ABL & 64) ? 0 : j, false); } }
        __syncthreads();
    }
    if (DBG_MEASURE && blockIdx.x == 0 && threadIdx.x == 0) {
        const unsigned long long c1 = __builtin_amdgcn_s_memtime(), r1 = __builtin_amdgcn_s_memrealtime(); LAS unsigned* dg = (LAS unsigned*)(lds + LDSCTL_OFF + 3072); float eps = 0.f;
        LAS unsigned long long* dq = (LAS unsigned long long*)(lds + LDSCTL_OFF + 3088); const unsigned long long dbg_c0 = dq[0], dbg_r0 = dq[1];
        if (DBG_MEASURE == 1) eps = (float)(c1 - dbg_c0) / (float)(r1 - dbg_r0) * 0.1f / 4.0f;
        if (DBG_MEASURE == 2 || DBG_MEASURE == 3) eps = (float)dg[0] / (float)(dg[1] ? dg[1] : 1u) / 300.0f;
        if (DBG_MEASURE == 4) eps = (float)(r1 - dbg_r0) * 0.01f / 1000.0f;
        eps = floorf(eps * 50.0f + 0.5f) * 0.02f;
        ((float*)(ws + WS_CONST))[CF_DBG] = eps;
    }
}
}
template <int ABL> __device__ __forceinline__ void attn_phase(LAS unsigned char* lds, unsigned char* ws, const Inputs& in, int G, int v) { att::attn_phase<ABL>(lds, ws, in, G, v); }

#define RLX_AGENT __ATOMIC_RELAXED, __HIP_MEMORY_SCOPE_AGENT
#define XB_TMO      128
#define XB_XCNT(j)  (256  + 64 * (j))
#define XB_XSUB(j)  (1280 + 64 * (j))
#define XB_XGEN(j)  (2304 + 64 * (j))
#define XB_TOP      3328
#define XB_TOPGEN   3392
#define XCD_BAR_WORDS 3456
#define XB_SPIN_CAP (1u << 18)
constexpr int CW_BAR = 8192;
__device__ __forceinline__ unsigned xb_ld(unsigned* p)              { return __hip_atomic_load(p, __ATOMIC_RELAXED, __HIP_MEMORY_SCOPE_AGENT); }
__device__ __forceinline__ unsigned xb_add(unsigned* p, unsigned v) { return __hip_atomic_fetch_add(p, v, __ATOMIC_RELAXED, __HIP_MEMORY_SCOPE_AGENT); }
__device__ __forceinline__ unsigned xb_xcc_id() { return (unsigned)__builtin_amdgcn_s_getreg((3 << 11) | 20) & 0xFu; }
#define XB_SPIN(cond, bar) do { unsigned _sp = 0; while (cond) { __builtin_amdgcn_s_sleep(1); \
    if ((++_sp & 255u) == 0u) { if (xb_ld(&(bar)[XB_TMO])) break; if (_sp > XB_SPIN_CAP) { atomicAdd(&(bar)[XB_TMO], 1u); break; } } } } while (0)
struct XcdBarrier { unsigned* bar; unsigned x; volatile LAS unsigned* st; };
__device__ __forceinline__ XcdBarrier xcd_barrier_post(unsigned* bar, volatile LAS unsigned* st) {
    XcdBarrier b; b.bar = bar; b.x = xb_xcc_id(); b.st = st;
    if (threadIdx.x == 0) (void)xb_add(&bar[XB_XCNT(b.x)], 1u);
    return b;
}
__device__ __forceinline__ void xcd_barrier_complete(unsigned* bar, unsigned x, unsigned& nloc, unsigned& nx) {
    const unsigned G = gridDim.x * gridDim.y * gridDim.z;
    unsigned sum, cnt, mine, sp = 0u;
    for (;;) {
        sum = 0u; cnt = 0u; mine = 0u;
#pragma unroll
        for (unsigned j = 0; j < 16; ++j) { const unsigned c = xb_ld(&bar[XB_XCNT(j)]); sum += c; cnt += (c > 0u) ? 1u : 0u; mine = (j == x) ? c : mine; }
        if (sum == G) break;
        __builtin_amdgcn_s_sleep(1);
        if ((++sp & 255u) == 0u) { if (xb_ld(&bar[XB_TMO])) break; if (sp > XB_SPIN_CAP) { atomicAdd(&bar[XB_TMO], 1u); break; } }
    }
    nloc = mine > 0u ? mine : 1u; nx = cnt > 0u ? cnt : 1u;
}
__device__ __forceinline__ void xcd_barrier(const XcdBarrier& b) {
    asm volatile("s_waitcnt vmcnt(0)" ::: "memory");
    __syncthreads();
    if (threadIdx.x == 0) {
        unsigned* bar = b.bar;
        __builtin_amdgcn_s_waitcnt(0);
        unsigned nloc = b.st[0], nx = b.st[1];
        if (nloc == 0u) { xcd_barrier_complete(bar, b.x, nloc, nx); b.st[0] = nloc; b.st[1] = nx; }
        const unsigned old = xb_add(&bar[XB_XSUB(b.x)], 1u);
        const unsigned gen = old / nloc;
        if (old + 1u == (gen + 1u) * nloc) {
            __builtin_amdgcn_fence(__ATOMIC_RELEASE, "agent");
            asm volatile("s_waitcnt vmcnt(0)" ::: "memory");
            const unsigned og = xb_add(&bar[XB_TOP], 1u);
            const unsigned tg = og / nx;
            if (og + 1u == (tg + 1u) * nx) xb_add(&bar[XB_TOPGEN], 1u);
            else XB_SPIN(xb_ld(&bar[XB_TOPGEN]) == tg, bar);
            __builtin_amdgcn_fence(__ATOMIC_ACQUIRE, "agent");
            xb_add(&bar[XB_XGEN(b.x)], 1u);
            asm volatile("s_waitcnt vmcnt(0)" ::: "memory");
        } else {
            XB_SPIN(xb_ld(&bar[XB_XGEN(b.x)]) == gen, bar);
            __builtin_amdgcn_fence(__ATOMIC_ACQUIRE, "agent");
            asm volatile("s_waitcnt vmcnt(0)" ::: "memory");
        }
    }
    __syncthreads();
}

constexpr int N_PHASES = 8;
#ifndef DESYNC_TICKS
#define DESYNC_TICKS 0
#endif
#ifndef DESYNC_MASK
#define DESYNC_MASK 0
#endif
__device__ __forceinline__ void phase_stagger(int vcu, int ph) {
    if (!((DESYNC_MASK >> ph) & 1) || DESYNC_TICKS == 0) return;
    const unsigned long long t0 = __builtin_amdgcn_s_memrealtime(); const unsigned long long want = (unsigned long long)((vcu & 3) * DESYNC_TICKS);
    while (__builtin_amdgcn_s_memrealtime() - t0 < want) __builtin_amdgcn_s_sleep(4);
}
#ifndef PROBE_REP_MASK
#define PROBE_REP_MASK 0
#endif
#ifndef PROBE_REPN
#define PROBE_REPN 2
#endif
#define NREP(k) (((PROBE_REP_MASK >> (k)) & 1) ? PROBE_REPN : 1)
struct Args { Inputs in; float* out; unsigned char* ws; int ph_lo, ph_hi; };

__global__ void __launch_bounds__(512, 2) mega(Args args) {
    extern __shared__ __attribute__((aligned(16))) unsigned char lds_raw[];
    LAS unsigned char* lds = (LAS unsigned char*)lds_raw;
    const int tid = threadIdx.x, lane = tid & 63, wave = __builtin_amdgcn_readfirstlane(tid >> 6);
    const int G = gridDim.x; const int bx = blockIdx.x; const int vcu = (G % 8 == 0) ? (bx % 8) * (G / 8) + bx / 8 : bx;
    unsigned char* ws = args.ws; const Inputs& in = args.in;
    unsigned* ctl = (unsigned*)(ws + WS_CTL);
    volatile LAS unsigned* MISC = (volatile LAS unsigned*)(lds + MISC_OFF);
    LAS int* moetab = (LAS int*)(lds + MOETAB_OFF);
    for (int u = tid; u < (LDS_BYTES - LDSCTL_OFF) / 4; u += 512) ((LAS unsigned*)(lds + LDSCTL_OFF))[u] = 0u;
    __syncthreads();
    const int lo = args.ph_lo, hi = args.ph_hi;
    const bool multi = (hi - lo) > 1;
    XcdBarrier bar; bar.bar = ctl + CW_BAR; bar.x = 0; bar.st = nullptr;
    if (multi) bar = xcd_barrier_post(ctl + CW_BAR, MISC + 8);
#define IN(k) (lo <= (k) && (k) < hi)
#define SEAM(k) do { if (IN(k) && IN((k) + 1)) xcd_barrier(bar); } while (0)

    if (IN(0)) { for (int rep = 0; rep < NREP(0); ++rep) { p0_prologue(in, ws, vcu * 8 + wave, G * 8, lane, (LAS float*)(lds + wave * 16384)); if (rep + 1 < NREP(0)) xcd_barrier(bar); } SEAM(0); }

    if (IN(1)) {
        pg8::DenseOrder S; S.init((const bf16_t*)(ws + WS_XN), (const bf16_t*)(ws + WS_WIN), NTOK, NPROJ, DM, G, bx);
        EpiInProj E{ws}; phase_stagger(vcu, 1);
        for (int rep = 0; rep < NREP(1); ++rep) { pg8::gemm_phase(lds, S, E); if (rep + 1 < NREP(1)) xcd_barrier(bar); } SEAM(1);
    }
    if (IN(2)) {
#ifdef HAVE_ATTN
        for (int rep = 0; rep < NREP(2); ++rep) { attn_phase<0>(lds, ws, in, G, vcu); if (rep + 1 < NREP(2)) xcd_barrier(bar); }
#endif
        SEAM(2);
    }
    if (IN(3)) {
        pg8::DenseOrder S; S.init((const bf16_t*)(ws + WS_Y), (const bf16_t*)(ws + WS_WOUT), NTOK, DM, DM, G, bx);
        EpiOutProj E{ws, in.x}; phase_stagger(vcu, 3);
        for (int rep = 0; rep < NREP(3); ++rep) { pg8::gemm_phase(lds, S, E); if (rep + 1 < NREP(3)) xcd_barrier(bar); } SEAM(3);
    }
    if (IN(4)) {
        pg8::DenseOrder S; S.init((const bf16_t*)(ws + WS_X1B), (const bf16_t*)(ws + WS_WR), NTOK, 256, DM, G, bx);
        EpiRoute E{ws, lds};
        pg8::gemm_phase<EpiRoute, pg8::DenseOrder, true>(lds, S, E); SEAM(4);
    }
    if (IN(5)) {
        moe_tables(ws, moetab);
        MoeOrder S{(const bf16_t*)(ws + WS_X1B), (const bf16_t*)(ws + WS_WGU), DM, 0, (const int*)(ws + WS_LTOK), moetab, G, vcu};
        EpiGateUp E{ws}; phase_stagger(vcu, 5);
        for (int rep = 0; rep < NREP(5); ++rep) { pg8::gemm_phase(lds, S, E); if (rep + 1 < NREP(5)) xcd_barrier(bar); } SEAM(5);
    }
    if (IN(6)) {
        if (!IN(5)) moe_tables(ws, moetab);
        MoeOrder S{(const bf16_t*)(ws + WS_HID), (const bf16_t*)(ws + WS_WD), EHID, 1, (const int*)(ws + WS_LTOK), moetab, G, vcu};
        EpiDown<0> E{ws, args.out}; phase_stagger(vcu, 6);
        for (int rep = 0; rep < NREP(6); ++rep) { pg8::gemm_phase(lds, S, E); if (rep + 1 < NREP(6)) xcd_barrier(bar); } SEAM(6);
    }
    if (IN(7)) {
        if (!IN(5) && !IN(6)) moe_tables(ws, moetab);
        MoeOrder S{(const bf16_t*)(ws + WS_HID), (const bf16_t*)(ws + WS_WD), EHID, 2, (const int*)(ws + WS_LTOK), moetab, G, vcu};
        EpiDown<1> E{ws, args.out}; phase_stagger(vcu, 7);
        for (int rep = 0; rep < NREP(7); ++rep) { pg8::gemm_phase(lds, S, E); if (rep + 1 < NREP(7)) xcd_barrier(bar); }
    }
#ifdef PROBE_EXTRA_BARRIERS
    if (multi) { for (int k = 0; k < PROBE_EXTRA_BARRIERS; ++k) xcd_barrier(bar); }
#endif
#undef IN
#undef SEAM
}

#ifdef PROBE_ATTN_ABL
__global__ void __launch_bounds__(512, 2) attn_probe(Args args) {
    extern __shared__ __attribute__((aligned(16))) unsigned char lds_raw_p[];
    LAS unsigned char* lds = (LAS unsigned char*)lds_raw_p;
    const int G = gridDim.x; const int bx = blockIdx.x; const int vcu = (G % 8 == 0) ? (bx % 8) * (G / 8) + bx / 8 : bx;
    attn_phase<PROBE_ATTN_ABL>(lds, args.ws, args.in, G, vcu);
}
#endif

#ifdef PROBE_UBENCH2
typedef float ub2_f32x16 __attribute__((ext_vector_type(16))); typedef short ub2_bf16x8 __attribute__((ext_vector_type(8))); typedef short ub2_s16x4 __attribute__((ext_vector_type(4)));
template <int V> __global__ void __launch_bounds__(512, 2) ubench2(float* sink, int iters) {
    __shared__ __attribute__((aligned(16))) unsigned char sm[57344];
    LAS unsigned char* lds = (LAS unsigned char*)sm;
    for (int i = threadIdx.x; i < 57344 / 4; i += 512) ((LAS float*)lds)[i] = -0.001f * (float)(i & 1023);
    __syncthreads();
    const int lane = threadIdx.x & 63, hi = lane >> 5, r32 = lane & 31;
    ub2_f32x16 pa0, pa1, pb0 = {}, pb1 = {}, o0 = {}, o1 = {}; ub2_bf16x8 q = {1, 2, 3, 4, 5, 6, 7, 8};
#pragma unroll
    for (int i = 0; i < 16; ++i) { pa0[i] = -0.001f * (float)(threadIdx.x + i); pa1[i] = -0.002f * (float)(threadIdx.x + i); }
    asm volatile("" : "+v"(q));
    const LAS unsigned char* kp = lds + hi * 1024 + r32 * 16;
    const LAS unsigned char* vp = lds + 8192 + ((lane >> 4) & 1) * 32 + (lane & 3) * 8 + (4 * hi + ((lane & 15) >> 2)) * 64;
    const LAS unsigned char* tp = lds + 16384 + ((lane & 3) * 2384 + ((2047 - lane) & ~3)) * 4 % 36864;
    float ls0 = 0.f, ls1 = 0.f;
#define UB_MFMA(a, b, c) ((V & 128) ? (c) : __builtin_amdgcn_mfma_f32_32x32x16_bf16(a, b, c, 0, 0, 0))
#define UB_VLOAD(g) do { if ((g) < 8) { if (V & 2) { vl[(g) % 3] = __builtin_bit_cast(ub2_s16x4, __builtin_amdgcn_ds_read_tr16_b64_v4i16((LAS ub2_s16x4*)(vp + ((g) & 1) * 4096 + ((g) >> 1) * 1024))); vh[(g) % 3] = __builtin_bit_cast(ub2_s16x4, __builtin_amdgcn_ds_read_tr16_b64_v4i16((LAS ub2_s16x4*)(vp + ((g) & 1) * 4096 + ((g) >> 1) * 1024 + 512))); } else { vl[(g) % 3] = ub2_s16x4{1, 2, 3, 4}; vh[(g) % 3] = ub2_s16x4{4, 3, 2, 1}; asm volatile("" : "+v"(vl[(g) % 3]), "+v"(vh[(g) % 3])); } } } while (0)
#define UB_SUMPACK(PC0, PC1, ks) do { _Pragma("unroll") for (int i = 0; i < 4; ++i) { const float a_ = (ks) == 0 ? PC0[2 * i] : (ks) == 1 ? PC0[8 + 2 * i] : (ks) == 2 ? PC1[2 * i] : PC1[8 + 2 * i]; const float b_ = (ks) == 0 ? PC0[2 * i + 1] : (ks) == 1 ? PC0[9 + 2 * i] : (ks) == 2 ? PC1[2 * i + 1] : PC1[9 + 2 * i]; \
            if (V & 32) { ls0 += a_; ls1 += b_; pw[(ks) & 1][i] = att::cvtpk(a_, b_); } else pw[(ks) & 1][i] = __builtin_bit_cast(unsigned, a_); } asm volatile("" : "+v"(ls0), "+v"(ls1), "+v"(pw[(ks) & 1])); } while (0)
#define UB_STEP(PC0, PC1, PN0, PN1) do { \
        ub2_bf16x8 kf[8]; \
        _Pragma("unroll") for (int i = 0; i < 8; ++i) { if (V & 1) kf[i] = *(const LAS ub2_bf16x8*)(kp + (i >> 1) * 2048 + (i & 1) * 512); else kf[i] = q; } \
        __builtin_amdgcn_sched_barrier(0); \
        _Pragma("unroll") for (int i = 0; i < 8; ++i) { \
            if (i & 1) PN1 = UB_MFMA(kf[i], q, PN1); else PN0 = UB_MFMA(kf[i], q, PN0); \
            if (V & 16) { _Pragma("unroll") for (int k = 0; k < 4; ++k) { const int e = 4 * i + k; if (e < 16) PC0[e] = __builtin_amdgcn_exp2f(PC0[e]); else PC1[e - 16] = __builtin_amdgcn_exp2f(PC1[e - 16]); } } \
            if (i < 4) asm volatile("" : "+v"(PC0)); else asm volatile("" : "+v"(PC1)); \
            __builtin_amdgcn_sched_barrier(0); } \
        if (V & 64) { asm volatile("s_waitcnt lgkmcnt(0)" ::: "memory"); __builtin_amdgcn_s_barrier(); __builtin_amdgcn_sched_barrier(0); } \
        v4u pw[2]; ub2_s16x4 vl[3], vh[3]; \
        UB_VLOAD(0); UB_VLOAD(1); UB_SUMPACK(PC0, PC1, 0); __builtin_amdgcn_sched_barrier(0); \
        _Pragma("unroll") for (int g = 0; g < 8; ++g) { const int ks = g / 2, d0 = g % 2; \
            UB_VLOAD(g + 2); \
            { const ub2_s16x4 a_ = vl[g % 3], b_ = vh[g % 3]; const ub2_bf16x8 vf = {a_[0], a_[1], a_[2], a_[3], b_[0], b_[1], b_[2], b_[3]}; \
              if (d0) o1 = UB_MFMA(__builtin_bit_cast(ub2_bf16x8, pw[ks & 1]), vf, o1); else o0 = UB_MFMA(__builtin_bit_cast(ub2_bf16x8, pw[ks & 1]), vf, o0); } \
            if (d0 == 0 && ks < 3) UB_SUMPACK(PC0, PC1, ks + 1); \
            if (g == 5) { if (V & 4) { _Pragma("unroll") for (int c = 0; c < 4; ++c) { const f32x4 c0 = *(const LAS f32x4*)(tp + c * 32), c1 = *(const LAS f32x4*)(tp + 128 + c * 32); \
                        PC0[4 * c] = c0[0]; PC0[4 * c + 1] = c0[1]; PC0[4 * c + 2] = c0[2]; PC0[4 * c + 3] = c0[3]; PC1[4 * c] = c1[0]; PC1[4 * c + 1] = c1[1]; PC1[4 * c + 2] = c1[2]; PC1[4 * c + 3] = c1[3]; } } \
                else { asm volatile("" : "+v"(PC0), "+v"(PC1)); } } \
            __builtin_amdgcn_sched_barrier(0); } \
        if (V & 8) { asm volatile("s_waitcnt lgkmcnt(0)" ::: "memory"); __builtin_amdgcn_s_barrier(); __builtin_amdgcn_sched_barrier(0); } } while (0)
    for (int it = 0; it < iters; it += 2) { UB_STEP(pa0, pa1, pb0, pb1); UB_STEP(pb0, pb1, pa0, pa1); }
    float s = ls0 + ls1;
#pragma unroll
    for (int i = 0; i < 16; ++i) s += o0[i] + o1[i] + pa0[i] + pa1[i] + pb0[i] + pb1[i];
    if (s == 123.456f) sink[threadIdx.x] = s;
#undef UB_VLOAD
#undef UB_SUMPACK
#undef UB_STEP
#undef UB_MFMA
}
#endif

#ifdef PROBE_UBENCH
typedef float ub_f32x16 __attribute__((ext_vector_type(16))); typedef short ub_bf16x8 __attribute__((ext_vector_type(8)));
template <int V> __global__ void __launch_bounds__(512, 2) ubench(float* sink, int iters) {
    ub_f32x16 a0 = {}, a1 = {}; ub_bf16x8 x = {1, 2, 3, 4, 5, 6, 7, 8}, y = {8, 7, 6, 5, 4, 3, 2, 1};
    float e[32];
#pragma unroll
    for (int i = 0; i < 32; ++i) e[i] = -0.001f * (float)(threadIdx.x + i);
    asm volatile("" : "+v"(x), "+v"(y));
    for (int it = 0; it < iters; ++it) {
#pragma unroll
        for (int g = 0; g < 16; ++g) {
            if (V & 1) { if (g & 1) a1 = __builtin_amdgcn_mfma_f32_32x32x16_bf16(x, y, a1, 0, 0, 0); else a0 = __builtin_amdgcn_mfma_f32_32x32x16_bf16(x, y, a0, 0, 0, 0); }
            if (V & 2) {
#pragma unroll
                for (int k = 0; k < 4; ++k) { const int i = (4 * g + k) & 31; e[i] = __builtin_amdgcn_exp2f(e[i]) - 1.0f; } }
            if (V & 4) {
#pragma unroll
                for (int k = 0; k < 2; ++k) { const int i = (2 * g + k) & 31; e[i] = __builtin_amdgcn_exp2f(e[i]) - 1.0f; } }
            __builtin_amdgcn_sched_barrier(0);
        }
    }
    float s = 0.f;
#pragma unroll
    for (int i = 0; i < 32; ++i) s += e[i];
#pragma unroll
    for (int i = 0; i < 16; ++i) s += a0[i] + a1[i];
    if (s == 123.456f) sink[threadIdx.x] = s;
}
#endif

extern "C" void kernel_launch(void* const* d_in, const int* in_sizes, int n_in, void* d_out, int out_size, void* d_ws, size_t ws_size, hipStream_t stream) {
    static int grid = 0;
    if (grid == 0) {
        if (n_in != 20 || in_sizes[0] != NTOK * DM || out_size != NTOK * DM || ws_size < WS_END) { fprintf(stderr, "kernel_launch: unexpected shapes (n_in %d, ws %zu)\n", n_in, ws_size); grid = -1; return; }
        int dev = 0, cus = 0, per_cu = 0;
        if (hipGetDevice(&dev) != hipSuccess || hipDeviceGetAttribute(&cus, hipDeviceAttributeMultiprocessorCount, dev) != hipSuccess) { grid = -1; return; }
        if (hipFuncSetAttribute((const void*)mega, hipFuncAttributeMaxDynamicSharedMemorySize, LDS_BYTES) != hipSuccess) { fprintf(stderr, "kernel_launch: hipFuncSetAttribute failed\n"); grid = -1; return; }
        if (hipOccupancyMaxActiveBlocksPerMultiprocessor(&per_cu, (const void*)mega, 512, LDS_BYTES) != hipSuccess || per_cu < 1) { fprintf(stderr, "kernel_launch: occupancy query says %d blocks per CU\n", per_cu); (void)hipGetLastError(); grid = -1; return; }
        grid = cus;
    }
    if (grid < 0) return;
    Args a{};
    const float** ip = (const float**)&a.in;
    for (int i = 0; i < 20; ++i) ip[i] = (const float*)d_in[i];
    a.out = (float*)d_out; a.ws = (unsigned char*)d_ws; a.ph_lo = 0; a.ph_hi = N_PHASES;
    (void)hipMemsetAsync((unsigned char*)d_ws + WS_CTL, 0, CTL_ZERO_BYTES, stream);
    hipLaunchKernelGGL(mega, dim3(grid), dim3(512), LDS_BYTES, stream, a);
#ifdef PROBE_ATTN_ABL
    { static bool ad = false; if (!ad) { (void)hipFuncSetAttribute((const void*)attn_probe, hipFuncAttributeMaxDynamicSharedMemorySize, LDS_BYTES); ad = true; }
      hipLaunchKernelGGL(attn_probe, dim3(grid), dim3(512), LDS_BYTES, stream, a); }
#endif
#ifdef PROBE_UBENCH2
    hipLaunchKernelGGL(ubench2<PROBE_UBENCH2>, dim3(grid), dim3(512), 0, stream, (float*)((unsigned char*)d_ws + WS_SS), 1000);
#endif
#ifdef PROBE_UBENCH
    hipLaunchKernelGGL(ubench<PROBE_UBENCH>, dim3(grid), dim3(PROBE_UB_THREADS), 0, stream, (float*)((unsigned char*)d_ws + WS_SS), 1000);
#endif
#ifdef PROBE_EXTRA_LO
    for (int k = PROBE_EXTRA_LO; k < PROBE_EXTRA_HI; ++k) { a.ph_lo = k; a.ph_hi = k + 1; hipLaunchKernelGGL(mega, dim3(grid), dim3(512), LDS_BYTES, stream, a); }
#endif
}
```

```cpp
#include <hip/hip_runtime.h>
#include <cstdint>
#include <cstdio>

typedef unsigned short bf16_t;
typedef unsigned v4u __attribute__((ext_vector_type(4)));
typedef unsigned v2u __attribute__((ext_vector_type(2)));
typedef float f32x4 __attribute__((ext_vector_type(4)));
#define LAS __attribute__((address_space(3)))

constexpr int BATCH = 32, SEQ = 2048, DM = 1024, NTOK = BATCH * SEQ;
constexpr int HD = 64, HDIFF = 4, HMOBA = 8, NPROJ = 3072;
constexpr int NEXP = 32, EHID = 256, NLIST = 64;
constexpr int LIST_CAP = NTOK;
constexpr float RMS_EPS = 1e-6f;
constexpr float LOG2E = 1.4426950408889634f;
constexpr float C2 = 0.125f * LOG2E;
constexpr float LAMBDA_INIT = 0.2f;

constexpr size_t MiB = 1u << 20;
constexpr size_t WS_CTL = 0, CTL_ZERO_BYTES = 1 * MiB;
constexpr size_t WS_CONST = 1 * MiB;
constexpr size_t WS_WIN = 2 * MiB, WS_WOUT = 8 * MiB, WS_WR = 10 * MiB, WS_WGU = 12 * MiB, WS_WD = 44 * MiB;
constexpr size_t WS_QD = 64 * MiB, WS_KD = 128 * MiB, WS_VD = 192 * MiB, WS_QM = 256 * MiB, WS_KM = 320 * MiB, WS_VM = 384 * MiB;
constexpr size_t WS_XN = 448 * MiB, WS_Y = 448 * MiB;
constexpr size_t WS_X1B = 576 * MiB, WS_SS = 704 * MiB  , WS_R2 = 708 * MiB, WS_KMEAN = 709 * MiB;
constexpr size_t WS_PA = 64 * MiB, WS_HID = 192 * MiB, WS_LTOK = 272 * MiB, WS_LW = 288 * MiB;
constexpr size_t WS_END = 711 * MiB;
constexpr int CW_CNT = 1024;
#ifndef DBG_MEASURE
#define DBG_MEASURE 0
#endif
constexpr int CF_DBG = 8;
constexpr int CF_LAMBDA = 0, CF_OFF = 16, CF_GAIN = 64  , CF_BT = 1024;

__device__ __forceinline__ float bf2f(bf16_t v) { return __uint_as_float(((unsigned)v) << 16); }
__device__ __forceinline__ unsigned f2bf(float f) { unsigned u = __float_as_uint(f); return (u + 0x7fffu + ((u >> 16) & 1u)) >> 16; }
__device__ __forceinline__ unsigned pk2(float lo, float hi) { return f2bf(lo) | (f2bf(hi) << 16); }
__device__ __forceinline__ float wave_sum(float v) {
#pragma unroll
    for (int o = 1; o < 64; o <<= 1) v += __shfl_xor(v, o);
    return v;
}
__device__ __forceinline__ float wave_max(float v) {
#pragma unroll
    for (int o = 1; o < 64; o <<= 1) v = fmaxf(v, __shfl_xor(v, o));
    return v;
}
__host__ __device__ __forceinline__ int phys_in(int c) { const int pn = c >> 8, cc = c & 255; return 256 * pn + 128 * ((cc >> 5) & 1) + 32 * (cc >> 6) + (cc & 31); }
__device__ __forceinline__ int t5_bucket(int d) {
    if (d < 16) return d;
    const float nf = (float)d;
    int large = 16 + (int)(logf(nf / 16.0f) / 4.852030263919617f * 16.0f);
    return large < 31 ? large : 31;
}

struct Inputs {
    const float *x, *norm1_g, *w_in, *diff_q_g, *diff_k_g, *lq1, *lk1, *lq2, *lk2, *diff_sub_g, *moba_q_g, *moba_k_g, *rel_bias, *w_out, *norm2_g,
        *router_group, *router_expert, *w_gate, *w_up, *w_down;
};

__device__ __forceinline__ void p0_tr_item(const float* W, int ldw, int k0, int n_src, const float* gk, bf16_t* dst, int drow0, int dpitch, LAS float* scr, int lane) {
    float wv[32];
#pragma unroll
    for (int i = 0; i < 32; ++i) wv[i] = W[(size_t)(k0 + 2 * i + (lane >> 5)) * ldw + n_src + (lane & 31)];
#pragma unroll
    for (int i = 0; i < 32; ++i) { const int kk = 2 * i + (lane >> 5); float v = wv[i]; if (gk) v *= gk[k0 + kk]; scr[kk * 33 + (lane & 31)] = v; }
    asm volatile("s_waitcnt lgkmcnt(0)" ::: "memory");
    const int c = lane & 7;
#pragma unroll
    for (int j = 0; j < 4; ++j) {
        const int n = (lane >> 3) + 8 * j; const LAS float* s = scr + (8 * c) * 33 + n;
        v4u o; o.x = pk2(s[0 * 33], s[1 * 33]); o.y = pk2(s[2 * 33], s[3 * 33]); o.z = pk2(s[4 * 33], s[5 * 33]); o.w = pk2(s[6 * 33], s[7 * 33]);
        *(v4u*)(dst + (size_t)(drow0 + n) * dpitch + k0 + 8 * c) = o;
    }
    asm volatile("s_waitcnt lgkmcnt(0)" ::: "memory");
}

__device__ __forceinline__ void p0_prologue(const Inputs& in, unsigned char* ws, int gw, int NGW, int lane, LAS float* scr) {
    bf16_t* WIN_T = (bf16_t*)(ws + WS_WIN); bf16_t* WOUT_T = (bf16_t*)(ws + WS_WOUT); bf16_t* WR_T = (bf16_t*)(ws + WS_WR);
    bf16_t* WGU_T = (bf16_t*)(ws + WS_WGU); bf16_t* WD_T = (bf16_t*)(ws + WS_WD); bf16_t* XN = (bf16_t*)(ws + WS_XN);
    float* CF = (float*)(ws + WS_CONST);
    constexpr int I_IN = 16 * 96, I_OUT = 16 * 32, I_GU = 32 * 16 * 16, I_D = 32 * 4 * 32, NITEMS = I_IN + I_OUT + I_GU + I_D;
    for (int it = gw; it < NITEMS; it += NGW) {
        int r = it;
        if (r < I_IN) {
            const int kb = r / 96, nb = r % 96, p0 = 32 * nb, pn = p0 >> 8, pp = p0 & 255, bj = pp >> 7, wc = (pp >> 5) & 3;
            p0_tr_item(in.w_in, NPROJ, 64 * kb, 256 * pn + 64 * wc + 32 * bj, in.norm1_g, WIN_T, p0, DM, scr, lane); continue; }
        r -= I_IN;
        if (r < I_OUT) { const int kb = r / 32, nb = r % 32; p0_tr_item(in.w_out, DM, 64 * kb, 32 * nb, nullptr, WOUT_T, 32 * nb, DM, scr, lane); continue; }
        r -= I_OUT;
        if (r < I_GU) {
            const int e = r / 256, rr = r % 256, kb = rr / 16, nb = rr % 16, p0 = 32 * nb, pn = p0 >> 8, bj = (p0 >> 7) & 1, j0 = p0 & 127;
            const float* src = (bj ? in.w_up : in.w_gate) + (size_t)e * DM * EHID;
            p0_tr_item(src, EHID, 64 * kb, 128 * pn + j0, in.norm2_g, WGU_T + (size_t)e * 512 * DM, p0, DM, scr, lane); continue; }
        r -= I_GU;
        { const int e = r / 128, rr = r % 128, kb = rr / 32, nb = rr % 32;
          p0_tr_item(in.w_down + (size_t)e * EHID * DM, DM, 64 * kb, 32 * nb, nullptr, WD_T + (size_t)e * DM * EHID, 32 * nb, EHID, scr, lane); }
    }
    for (int idx = gw * 64 + lane; idx < 256 * DM; idx += NGW * 64) {
        const int p = idx >> 10, k = idx & 1023, g = (p >> 5) & 3, i = p & 31; float v = 0.f;
        if (p < 128) { if (i < 8) v = in.norm2_g[k] * in.router_expert[((size_t)g * DM + k) * 8 + i]; else if (i < 12) v = in.norm2_g[k] * in.router_group[k * 4 + (i - 8)]; }
        WR_T[idx] = (bf16_t)f2bf(v);
    }
    for (int idx = gw * 64 + lane; idx < 12 * 2048; idx += NGW * 64) {
        const int h = idx >> 11, d = idx & 2047; CF[CF_BT + idx] = in.rel_bias[t5_bucket(d) * 12 + h] * LOG2E;
    }
    if (gw == 0) {
        float a = in.lq1[lane] * in.lk1[lane], b = in.lq2[lane] * in.lk2[lane];
        a = wave_sum(a); b = wave_sum(b);
        const float mqd = wave_max(fabsf(in.diff_q_g[lane])), mkd = wave_max(fabsf(in.diff_k_g[lane]));
        const float mqm = wave_max(fabsf(in.moba_q_g[lane])), mkm = wave_max(fabsf(in.moba_k_g[lane]));
        if (lane == 0) CF[CF_LAMBDA] = expf(a) - expf(b) + LAMBDA_INIT;
        CF[CF_GAIN + lane] = in.diff_q_g[lane]; CF[CF_GAIN + 64 + lane] = in.diff_k_g[lane]; CF[CF_GAIN + 128 + lane] = in.moba_q_g[lane]; CF[CF_GAIN + 192 + lane] = in.moba_k_g[lane];
        if (lane < 12) {
            float mb = -1e30f; for (int bk = 0; bk < 32; ++bk) mb = fmaxf(mb, in.rel_bias[bk * 12 + lane]);
            const float qk = lane < 4 ? mqd * mkd : mqm * mkm;
            CF[CF_OFF + lane] = (8.0f * qk + mb) * LOG2E;
        }
    }
    for (int m0 = gw * 4; m0 < NTOK; m0 += NGW * 4) {
        f32x4 v[4][4];
#pragma unroll
        for (int rr = 0; rr < 4; ++rr) { const f32x4* xr = (const f32x4*)(in.x + (size_t)(m0 + rr) * DM) + lane;
#pragma unroll
            for (int j = 0; j < 4; ++j) v[rr][j] = __builtin_nontemporal_load(xr + 64 * j); }
#pragma unroll
        for (int rr = 0; rr < 4; ++rr) { float s = 0.f;
#pragma unroll
            for (int j = 0; j < 4; ++j) s += (v[rr][j].x * v[rr][j].x + v[rr][j].y * v[rr][j].y) + (v[rr][j].z * v[rr][j].z + v[rr][j].w * v[rr][j].w);
            const float r = rsqrtf(wave_sum(s) * (1.f / DM) + RMS_EPS);
            unsigned long long* o8 = (unsigned long long*)(XN + (size_t)(m0 + rr) * DM) + lane;
#pragma unroll
            for (int j = 0; j < 4; ++j) o8[64 * j] = (unsigned long long)pk2(v[rr][j].x * r, v[rr][j].y * r) | ((unsigned long long)pk2(v[rr][j].z * r, v[rr][j].w * r) << 32); }
    }
}

namespace pg8 {
typedef short bf16x8 __attribute__((ext_vector_type(8)));
constexpr int BM = 256, BK = 64, HALF = 128, HTB = HALF * BK * 2, STAGE_BYTES = 8 * HTB, NXCD = 8, WGM = 8;

__host__ __device__ __forceinline__ int lds_byte(int r, int c) { const int st = (r >> 4) * 2 + (c >> 5), rr = r & 15, cc = c & 31, ob = rr * 64 + cc * 2; return st * 1024 + (ob ^ (((ob >> 9) & 1) << 5)); }
__host__ __device__ __forceinline__ void stage_rc(int b, int& R, int& C) { const int st = b / 1024, sb = b % 1024, swz = sb ^ (((sb >> 9) & 1) << 5); R = (st >> 1) * 16 + swz / 64; C = (st & 1) * 32 + (swz % 64) / 2; }
__host__ __device__ __forceinline__ int perm32(int rho) { const int n = rho >> 4, i = rho & 15; return 8 * (i >> 2) + 4 * n + (i & 3); }

struct Unit { int pm, pn, a0, a1; };

struct DenseOrder {
    const bf16_t* A; const bf16_t* Bt; int K; int nM, nN, nwg, G, c;
    __device__ void init(const bf16_t* A_, const bf16_t* Bt_, int M, int N, int K_, int G_, int c_) { A = A_; Bt = Bt_; K = K_; nM = M / BM; nN = N / BM; nwg = nM * nN; G = G_; c = c_; }
    __device__ __forceinline__ bool next(int i, Unit& u) const {
        const long L = (long)i * G + c; if (L >= nwg) return false;
        int wgid = (int)L; { const int q = nwg / NXCD, r = nwg % NXCD, xcd = wgid % NXCD, off = wgid / NXCD; wgid = (xcd < r ? xcd * (q + 1) : r * (q + 1) + (xcd - r) * q) + off; }
        const int nig = WGM * nN, gid = wgid / nig, fm = gid * WGM, gsz = (nM - fm) < WGM ? (nM - fm) : WGM;
        u.pm = fm + ((wgid % nig) % gsz); u.pn = (wgid % nig) / gsz; u.a0 = 0; u.a1 = 256; return true;
    }
    __device__ __forceinline__ const char* abase() const { return (const char*)A; }
    __device__ __forceinline__ unsigned arow(const Unit& u, int r) const { return (unsigned)(u.pm * BM + r) * (unsigned)K * 2u; }
    __device__ __forceinline__ const char* bbase(const Unit& u) const { return (const char*)Bt + (size_t)u.pn * BM * K * 2; }
};

typedef float f32x2 __attribute__((ext_vector_type(2)));
__device__ __forceinline__ unsigned cvt_pk_bf16(float lo, float hi) { unsigned r; asm volatile("v_cvt_pk_bf16_f32 %0, %1, %2" : "=v"(r) : "v"(lo), "v"(hi)); return r; }

template <class Epi, class Sched, bool HALFN = false>
__device__ __forceinline__ void gemm_phase(LAS unsigned char* lds, const Sched& S, const Epi& E) {
    int tid_ = threadIdx.x; asm volatile("" : "+v"(tid_));
    const int tid = tid_, wid = __builtin_amdgcn_readfirstlane(tid >> 6), lane = tid & 63, wr = wid >> 2, wc = wid & 3, fr = lane & 15, fq = lane >> 4;
    const int K = S.K, nt = K / BK;
    int RA[2]; unsigned cA2[2], voffB[2];
#pragma unroll
    for (int i = 0; i < 2; ++i) { int R, C; stage_rc(tid * 16 + i * 8192, R, C); const int Rb = (R & ~31) + perm32(R & 31);
        RA[i] = R; cA2[i] = (unsigned)C * 2u; voffB[i] = (unsigned)(Rb * K + C) * 2u; }
    const size_t kstep = (size_t)(BK * 2);
    const size_t hstep = (size_t)HALF * K * 2;
    const unsigned ldsw = (unsigned)wid * 1024u;
    const int aoff = lds_byte(wr * 64 + fr, fq * 8), boff = lds_byte(wc * 32 + fr, fq * 8);
#define PG8_SA(b, h) (((b) * 2 + (h)) * HTB)
#define PG8_SB(b, h) ((4 + (b) * 2 + (h)) * HTB)
#define PG8_STAGE(bufoff, gbase, voff) do { _Pragma("unroll") for (int _i = 0; _i < 2; ++_i) \
        __builtin_amdgcn_global_load_lds((const unsigned*)((const char*)(gbase) + (voff)[_i]), (LAS unsigned*)(lds + (bufoff) + ldsw + _i * 8192), 16, 0, 0); } while (0)
#define PG8_LDA(dst, b, h) do { _Pragma("unroll") for (int m = 0; m < 4; ++m) _Pragma("unroll") for (int k = 0; k < 2; ++k) dst[m][k] = *(const LAS bf16x8*)(lds + PG8_SA(b, h) + aoff + m * 2048 + k * 1024); } while (0)
#define PG8_LDB(dst, b, h) do { _Pragma("unroll") for (int n = 0; n < 2; ++n) _Pragma("unroll") for (int k = 0; k < 2; ++k) dst[n][k] = *(const LAS bf16x8*)(lds + PG8_SB(b, h) + boff + n * 2048 + k * 1024); } while (0)
#define PG8_MMA(ai, bj, At, Bt) do { __builtin_amdgcn_s_setprio(1); _Pragma("unroll") for (int m = 0; m < 4; ++m) _Pragma("unroll") for (int n = 0; n < 2; ++n) _Pragma("unroll") for (int k = 0; k < 2; ++k) \
        acc[ai][bj][m][n] = __builtin_amdgcn_mfma_f32_16x16x32_bf16(Bt[n][k], At[m][k], acc[ai][bj][m][n], 0, 0, 0); __builtin_amdgcn_s_setprio(0); } while (0)
#define PG8_WAIT_V(n) asm volatile("s_waitcnt vmcnt(" #n ")" ::: "memory")
#define PG8_WAIT_L(n) asm volatile("s_waitcnt lgkmcnt(" #n ")" ::: "memory")
#define PG8_BAR __builtin_amdgcn_s_barrier()
#define PG8_SCHED __builtin_amdgcn_sched_barrier(0)
    Unit cur, nxt; int ui = 0;
    if (!S.next(0, cur)) return;
    f32x4 acc[2][2][4][2];
#pragma unroll
    for (int a = 0; a < 2; ++a)
#pragma unroll
        for (int b = 0; b < 2; ++b)
#pragma unroll
            for (int m = 0; m < 4; ++m)
#pragma unroll
                for (int n = 0; n < 2; ++n) acc[a][b][m][n] = (f32x4){0.f, 0.f, 0.f, 0.f};
    bf16x8 At[4][2], B0[2][2], B1[2][2];
    const char* const Ab = S.abase();
    unsigned oC[2][2], oN[2][2];
#pragma unroll
    for (int h = 0; h < 2; ++h)
#pragma unroll
        for (int i = 0; i < 2; ++i) { oC[h][i] = S.arow(cur, h * HALF + RA[i]) + cA2[i]; oN[h][i] = oC[h][i]; }
    const char* cB = S.bbase(cur);
    PG8_STAGE(PG8_SB(0, 0), cB, voffB); PG8_STAGE(PG8_SB(0, 1), cB + hstep, voffB); PG8_STAGE(PG8_SA(0, 0), Ab, oC[0]); PG8_STAGE(PG8_SA(0, 1), Ab, oC[1]);
    if (wr == 1) PG8_BAR;
    PG8_WAIT_V(2); PG8_BAR;
    PG8_STAGE(PG8_SB(1, 0), cB + kstep, voffB); PG8_STAGE(PG8_SA(1, 0), Ab + kstep, oC[0]); PG8_STAGE(PG8_SB(1, 1), cB + hstep + kstep, voffB);
    PG8_WAIT_V(6); PG8_BAR;
    for (;;) {
        const bool has_next = S.next(ui + 1, nxt);
        const char* nB = has_next ? S.bbase(nxt) : cB;
        if (has_next) {
#pragma unroll
            for (int h = 0; h < 2; ++h)
#pragma unroll
                for (int i = 0; i < 2; ++i) oN[h][i] = S.arow(nxt, h * HALF + RA[i]) + cA2[i];
        }
        for (int t = 0; t < nt; t += 2) {
            const bool last = (t == nt - 2);
            const char* a1 = Ab + (size_t)(t + 1) * kstep;
            const char* a2 = last ? Ab : Ab + (size_t)(t + 2) * kstep; const char* b2 = last ? nB : cB + (size_t)(t + 2) * kstep;
            const char* a3 = a2 + kstep; const char* b3 = b2 + kstep;
            unsigned o2[2][2];
#pragma unroll
            for (int h = 0; h < 2; ++h)
#pragma unroll
                for (int i = 0; i < 2; ++i) o2[h][i] = last ? oN[h][i] : oC[h][i];
            PG8_LDB(B0, 0, 0); PG8_LDB(B1, 0, 1); PG8_SCHED; PG8_LDA(At, 0, 0); PG8_STAGE(PG8_SA(1, 1), a1, oC[1]);
            PG8_WAIT_V(8); PG8_WAIT_L(0); PG8_BAR; PG8_MMA(0, 0, At, B0); if (!HALFN) PG8_MMA(0, 1, At, B1); PG8_BAR; PG8_SCHED;
            PG8_LDA(At, 0, 1); PG8_STAGE(PG8_SB(0, 0), b2, voffB); PG8_STAGE(PG8_SB(0, 1), b2 + hstep, voffB); PG8_STAGE(PG8_SA(0, 0), a2, o2[0]);
            PG8_WAIT_V(8); PG8_WAIT_L(0); PG8_BAR; PG8_MMA(1, 0, At, B0); if (!HALFN) PG8_MMA(1, 1, At, B1); PG8_BAR; PG8_SCHED;
            PG8_LDB(B0, 1, 0); PG8_LDB(B1, 1, 1); PG8_SCHED; PG8_LDA(At, 1, 0); PG8_STAGE(PG8_SA(0, 1), a2, o2[1]);
            PG8_WAIT_V(8); PG8_WAIT_L(0); PG8_BAR; PG8_MMA(0, 0, At, B0); if (!HALFN) PG8_MMA(0, 1, At, B1); PG8_BAR; PG8_SCHED;
            PG8_LDA(At, 1, 1); PG8_STAGE(PG8_SB(1, 0), b3, voffB); PG8_STAGE(PG8_SB(1, 1), b3 + hstep, voffB); PG8_STAGE(PG8_SA(1, 0), a3, o2[0]);
            PG8_WAIT_V(8); PG8_WAIT_L(0); PG8_BAR; PG8_MMA(1, 0, At, B0); if (!HALFN) PG8_MMA(1, 1, At, B1); PG8_BAR; PG8_SCHED;
        }
        if (wr == 0) PG8_BAR;
        { int frE = fr, fqE = fq; asm volatile("" : "+v"(frE), "+v"(fqE));
          E(acc, cur, wr, wc, frE, fqE); }
        if (!has_next) break;
#pragma unroll
        for (int a = 0; a < 2; ++a)
#pragma unroll
            for (int b = 0; b < 2; ++b)
#pragma unroll
                for (int m = 0; m < 4; ++m)
#pragma unroll
                    for (int n = 0; n < 2; ++n) acc[a][b][m][n] = (f32x4){0.f, 0.f, 0.f, 0.f};
        cur = nxt; cB = nB; ++ui;
#pragma unroll
        for (int h = 0; h < 2; ++h)
#pragma unroll
            for (int i = 0; i < 2; ++i) oC[h][i] = oN[h][i];
        if (wr == 1) PG8_BAR;
    }
    PG8_WAIT_V(0);
    PG8_BAR;
#undef PG8_SA
#undef PG8_SB
#undef PG8_STAGE
#undef PG8_LDA
#undef PG8_LDB
#undef PG8_MMA
#undef PG8_WAIT_V
#undef PG8_WAIT_L
#undef PG8_BAR
#undef PG8_SCHED
}
}

constexpr size_t WS_LR = 304 * MiB;
constexpr int SS_PARTS = 16;
constexpr int RING_BYTES = 131072  , LDSCTL_OFF = 139264  , MISC_OFF = LDSCTL_OFF + 320, MOETAB_OFF = LDSCTL_OFF + 1024;
constexpr int LDS_BYTES = 147456;
constexpr int MT_CNT = 0, MT_ALL = 64, MT_R0 = 64 + 65, MT_R1 = 64 + 65 + 33;

__device__ __forceinline__ f32x4 ldg4(const float* p) { return *(const f32x4*)p; }

struct MoeOrder {
    const bf16_t* A; const bf16_t* Bt; int K; int mode; const int* ltok; const LAS int* tab; int G, c;
    __device__ __forceinline__ bool next(int i, pg8::Unit& u) const {
        const int L = i * G + c;
        if (mode == 0) {
            const int T = L >> 1; if (T >= tab[MT_ALL + 64]) return false;
            int lo = 0;
#pragma unroll
            for (int s = 32; s >= 1; s >>= 1) if (tab[MT_ALL + lo + s] <= T) lo += s;
            const int tile = T - tab[MT_ALL + lo]; u.pm = T; u.pn = L & 1; u.a0 = lo | (tile << 8); const int v = tab[MT_CNT + lo] - tile * 256; u.a1 = v < 256 ? v : 256; return true;
        } else {
            const int T = L >> 2; const int tb = mode == 1 ? MT_R0 : MT_R1; if (T >= tab[tb + 32]) return false;
            int lo = 0;
#pragma unroll
            for (int s = 16; s >= 1; s >>= 1) if (tab[tb + lo + s] <= T) lo += s;
            const int list = 2 * lo + (mode - 1), tile = T - tab[tb + lo]; u.pm = tab[MT_ALL + list] + tile; u.pn = L & 3; u.a0 = list | (tile << 8);
            const int v = tab[MT_CNT + list] - tile * 256; u.a1 = v < 256 ? v : 256; return true;
        }
    }
    __device__ __forceinline__ const char* abase() const { return (const char*)A; }
    __device__ __forceinline__ unsigned arow(const pg8::Unit& u, int r) const {
        if (mode == 0) { const int list = u.a0 & 255, tile = u.a0 >> 8; const int tok = r < u.a1 ? ltok[(size_t)list * LIST_CAP + tile * 256 + r] : 0; return (unsigned)tok * (unsigned)(DM * 2); }
        return (unsigned)(u.pm * 256 + r) * (unsigned)(EHID * 2);
    }
    __device__ __forceinline__ const char* bbase(const pg8::Unit& u) const {
        const int e = (u.a0 & 255) >> 1;
        if (mode == 0) return (const char*)Bt + ((size_t)e * 512 + u.pn * 256) * DM * 2;
        return (const char*)Bt + ((size_t)e * DM + u.pn * 256) * EHID * 2;
    }
};
__device__ __forceinline__ void moe_tables(unsigned char* ws, LAS int* tab) {
    if (threadIdx.x < 64) tab[MT_CNT + threadIdx.x] = (int)__hip_atomic_load((unsigned*)(ws + WS_CTL) + CW_CNT + 64 * threadIdx.x, __ATOMIC_RELAXED, __HIP_MEMORY_SCOPE_AGENT);
    __syncthreads();
    if (threadIdx.x == 0) { int a = 0, r0 = 0, r1 = 0;
        for (int l = 0; l < 64; ++l) { const int t = (tab[MT_CNT + l] + 255) >> 8; tab[MT_ALL + l] = a; a += t; if (l & 1) { tab[MT_R1 + (l >> 1)] = r1; r1 += t; } else { tab[MT_R0 + (l >> 1)] = r0; r0 += t; } }
        tab[MT_ALL + 64] = a; tab[MT_R0 + 32] = r0; tab[MT_R1 + 32] = r1; }
    __syncthreads();
}

struct EpiInProj {
    unsigned char* ws;
    __device__ __forceinline__ void operator()(const f32x4 (&acc)[2][2][4][2], const pg8::Unit& u, int wr, int wc, int fr, int fq) const {
        const int seg = u.pn >> 1, gi = ((u.pn & 1) << 2) | wc, b = u.pm >> 3, blk = u.pm & 7;
        const bool nrm = (seg != 2 && seg != 5);
        const float* gp = (const float*)(ws + WS_CONST) + CF_GAIN + 64 * (seg == 0 ? 0 : seg == 1 ? 1 : seg == 3 ? 2 : 3);
        const float qs = (seg == 0 || seg == 3) ? C2 : 1.0f;
        f32x4 g[2][2];
#pragma unroll
        for (int bj = 0; bj < 2; ++bj)
#pragma unroll
            for (int n = 0; n < 2; ++n) g[bj][n] = nrm ? ldg4(gp + 32 * bj + 8 * fq + 4 * n) * qs : (f32x4){1.f, 1.f, 1.f, 1.f};
        bf16_t* base; size_t rstride;
        if (seg < 2) { base = (bf16_t*)(ws + (seg == 0 ? WS_QD : WS_KD)) + ((size_t)((b * 4 + (gi >> 1)) * 2 + (gi & 1)) * SEQ + blk * 256) * 64; rstride = 64; }
        else if (seg == 2) { base = (bf16_t*)(ws + WS_VD) + ((size_t)(b * 4 + (gi >> 1)) * SEQ + blk * 256) * 128 + (gi & 1) * 64; rstride = 128; }
        else { base = (bf16_t*)(ws + (seg == 3 ? WS_QM : seg == 4 ? WS_KM : WS_VM)) + ((size_t)(b * 8 + gi) * SEQ + blk * 256) * 64; rstride = 64; }
        f32x4 ks[2][2];
#pragma unroll
        for (int bj = 0; bj < 2; ++bj)
#pragma unroll
            for (int n = 0; n < 2; ++n) ks[bj][n] = (f32x4){0.f, 0.f, 0.f, 0.f};
#pragma unroll
        for (int ai = 0; ai < 2; ++ai)
#pragma unroll
            for (int m = 0; m < 4; ++m) {
                const int r = 128 * ai + 64 * wr + 16 * m + fr;
                f32x4 v[2][2]; float ss = 0.f;
#pragma unroll
                for (int bj = 0; bj < 2; ++bj)
#pragma unroll
                    for (int n = 0; n < 2; ++n) { v[bj][n] = acc[ai][bj][m][n]; ss += (v[bj][n][0] * v[bj][n][0] + v[bj][n][1] * v[bj][n][1]) + (v[bj][n][2] * v[bj][n][2] + v[bj][n][3] * v[bj][n][3]); }
                float rs = 1.f;
                if (nrm) { ss += __shfl_xor(ss, 16); ss += __shfl_xor(ss, 32); rs = rsqrtf(ss * (1.f / 64.f) + RMS_EPS); }
                bf16_t* rowp = base + (size_t)r * rstride + 8 * fq;
                const int rt = r >> 6, rk = r & 63;
#pragma unroll
                for (int bj = 0; bj < 2; ++bj) {
                    const f32x4 a = v[bj][0] * rs * g[bj][0], c = v[bj][1] * rs * g[bj][1];
                    if (seg == 4) { ks[bj][0] += a; ks[bj][1] += c; }
                    v4u w; w.x = pg8::cvt_pk_bf16(a[0], a[1]); w.y = pg8::cvt_pk_bf16(a[2], a[3]); w.z = pg8::cvt_pk_bf16(c[0], c[1]); w.w = pg8::cvt_pk_bf16(c[2], c[3]);
                    bf16_t* dst = rowp + 32 * bj;
                    if (seg == 1 || seg == 4) dst = base + (size_t)((rt * 8 + 4 * bj + fq) * 512 + rk * 8);
                    else if (seg == 5) dst = base + (size_t)((rt * 2 + bj) * 2048 + rk * 32 + 8 * fq);
                    else if (seg == 2) dst = base - (gi & 1) * 64 + (size_t)((rt * 4 + 2 * (gi & 1) + bj) * 2048 + rk * 32 + 8 * fq);
                    *(v4u*)dst = w;
                }
            }
        if (seg == 4) {
            float* km = (float*)(ws + WS_KMEAN) + (((size_t)(b * 8 + blk) * 2 + wr) * 8 + gi) * 64;
#pragma unroll
            for (int bj = 0; bj < 2; ++bj)
#pragma unroll
                for (int n = 0; n < 2; ++n) { f32x4 s = ks[bj][n];
#pragma unroll
                    for (int j = 0; j < 4; ++j) { float t = s[j]; t += __shfl_xor(t, 1); t += __shfl_xor(t, 2); t += __shfl_xor(t, 4); t += __shfl_xor(t, 8); s[j] = t; }
                    if (fr == 0) *(f32x4*)(km + 32 * bj + 8 * fq + 4 * n) = s; }
        }
    }
};

struct EpiOutProj {
    unsigned char* ws; const float* x;
    __device__ __forceinline__ void operator()(const f32x4 (&acc)[2][2][4][2], const pg8::Unit& u, int wr, int wc, int fr, int fq) const {
        bf16_t* X1B = (bf16_t*)(ws + WS_X1B); float* SS = (float*)(ws + WS_SS);
#pragma unroll
        for (int ai = 0; ai < 2; ++ai) {
            f32x4 xv[4][2][2];
#pragma unroll
            for (int m = 0; m < 4; ++m)
#pragma unroll
                for (int bj = 0; bj < 2; ++bj) { const size_t off = ((size_t)u.pm * 256 + 128 * ai + 64 * wr + 16 * m + fr) * DM + u.pn * 256 + 128 * bj + 32 * wc + 8 * fq;
                    xv[m][bj][0] = ldg4(x + off); xv[m][bj][1] = ldg4(x + off + 4); }
#pragma unroll
            for (int m = 0; m < 4; ++m) {
                const size_t row = (size_t)u.pm * 256 + 128 * ai + 64 * wr + 16 * m + fr; float ss = 0.f;
#pragma unroll
                for (int bj = 0; bj < 2; ++bj) {
                    const size_t off = row * DM + u.pn * 256 + 128 * bj + 32 * wc + 8 * fq;
                    const f32x4 a = acc[ai][bj][m][0] + xv[m][bj][0], c = acc[ai][bj][m][1] + xv[m][bj][1];
                    ss += (a[0] * a[0] + a[1] * a[1]) + (a[2] * a[2] + a[3] * a[3]) + (c[0] * c[0] + c[1] * c[1]) + (c[2] * c[2] + c[3] * c[3]);
                    v4u w; w.x = pg8::cvt_pk_bf16(a[0], a[1]); w.y = pg8::cvt_pk_bf16(a[2], a[3]); w.z = pg8::cvt_pk_bf16(c[0], c[1]); w.w = pg8::cvt_pk_bf16(c[2], c[3]);
                    *(v4u*)(X1B + off) = w;
                }
                ss += __shfl_xor(ss, 16); ss += __shfl_xor(ss, 32);
                if (fq == 0) SS[row * SS_PARTS + u.pn * 4 + wc] = ss;
            }
        }
    }
};

constexpr int ROUTE_OFF = LDSCTL_OFF + 2048;
struct EpiRoute {
    unsigned char* ws; LAS unsigned char* lds;
    __device__ __forceinline__ void operator()(const f32x4 (&acc)[2][2][4][2], const pg8::Unit& u, int wr, int wc, int fr, int fq) const {
        const float* SS = (const float*)(ws + WS_SS);
        LAS int* lcount = (LAS int*)(lds + ROUTE_OFF); LAS int* lbase = lcount + 64;
        unsigned* CTL = (unsigned*)(ws + WS_CTL); int* LTOK = (int*)(ws + WS_LTOK); float* LW = (float*)(ws + WS_LW); float* LR = (float*)(ws + WS_LR);
        if (threadIdx.x < 64) lcount[threadIdx.x] = 0;
        asm volatile("s_waitcnt lgkmcnt(0)" ::: "memory"); __builtin_amdgcn_s_barrier(); asm volatile("" ::: "memory");
        int l0v[2][4], p0v[2][4], l1v[2][4], p1v[2][4]; float w0v[2][4], w1v[2][4], r2v[2][4];
#pragma unroll
        for (int ai = 0; ai < 2; ++ai)
#pragma unroll
            for (int m = 0; m < 4; ++m) {
                const int row = u.pm * 256 + 128 * ai + 64 * wr + 16 * m + fr;
                const f32x4 e0 = acc[ai][0][m][0], e1 = acc[ai][0][m][1];
                float gl[4];
#pragma unroll
                for (int j = 0; j < 4; ++j) gl[j] = __shfl_down(e0[j], 16);
                int g = 0; float gv = gl[0];
#pragma unroll
                for (int i = 1; i < 4; ++i) if (gl[i] > gv) { gv = gl[i]; g = i; }
                l0v[ai][m] = -1; p0v[ai][m] = 0; l1v[ai][m] = 0; p1v[ai][m] = 0; w0v[ai][m] = 0.f; w1v[ai][m] = 0.f; r2v[ai][m] = 0.f;
                if (fq == 0 && g == wc) {
                    const float* sp = SS + (size_t)row * SS_PARTS; const f32x4 s0 = ldg4(sp), s1 = ldg4(sp + 4), s2 = ldg4(sp + 8), s3 = ldg4(sp + 12);
                    const float tot = ((s0[0] + s0[1]) + (s0[2] + s0[3])) + ((s1[0] + s1[1]) + (s1[2] + s1[3])) + ((s2[0] + s2[1]) + (s2[2] + s2[3])) + ((s3[0] + s3[1]) + (s3[2] + s3[3]));
                    const float r2 = rsqrtf(tot * (1.f / DM) + RMS_EPS);
                    const float el[8] = {e0[0], e0[1], e0[2], e0[3], e1[0], e1[1], e1[2], e1[3]};
                    const float mx = fmaxf(fmaxf(gl[0], gl[1]), fmaxf(gl[2], gl[3])) * r2;
                    const float den = (__expf(gl[0] * r2 - mx) + __expf(gl[1] * r2 - mx)) + (__expf(gl[2] * r2 - mx) + __expf(gl[3] * r2 - mx));
                    const float pg = __expf(gv * r2 - mx) / den;
                    float v0 = el[0]; int x0 = 0;
#pragma unroll
                    for (int i = 1; i < 8; ++i) if (el[i] > v0) { v0 = el[i]; x0 = i; }
                    float v1 = -3.0e38f; int x1 = 0;
#pragma unroll
                    for (int i = 0; i < 8; ++i) if (i != x0 && el[i] > v1) { v1 = el[i]; x1 = i; }
                    const float w0 = 1.f / (1.f + __expf((v1 - v0) * r2));
                    const int l0 = (g * 8 + x0) * 2, l1 = (g * 8 + x1) * 2 + 1;
                    l0v[ai][m] = l0; l1v[ai][m] = l1; w0v[ai][m] = pg * w0; w1v[ai][m] = pg * (1.f - w0); r2v[ai][m] = r2;
                    p0v[ai][m] = atomicAdd((int*)(lcount + l0), 1); p1v[ai][m] = atomicAdd((int*)(lcount + l1), 1);
                }
            }
        asm volatile("s_waitcnt lgkmcnt(0)" ::: "memory"); __builtin_amdgcn_s_barrier(); asm volatile("" ::: "memory");
        if (threadIdx.x < 64) lbase[threadIdx.x] = (int)atomicAdd(CTL + CW_CNT + 64 * threadIdx.x, (unsigned)lcount[threadIdx.x]);
        asm volatile("s_waitcnt vmcnt(0) lgkmcnt(0)" ::: "memory"); __builtin_amdgcn_s_barrier(); asm volatile("" ::: "memory");
#pragma unroll
        for (int ai = 0; ai < 2; ++ai)
#pragma unroll
            for (int m = 0; m < 4; ++m) if (l0v[ai][m] >= 0) {
                const int row = u.pm * 256 + 128 * ai + 64 * wr + 16 * m + fr;
                const size_t a0 = (size_t)l0v[ai][m] * LIST_CAP + lbase[l0v[ai][m]] + p0v[ai][m], a1 = (size_t)l1v[ai][m] * LIST_CAP + lbase[l1v[ai][m]] + p1v[ai][m];
                LTOK[a0] = row; LW[a0] = w0v[ai][m]; LR[a0] = r2v[ai][m]; LTOK[a1] = row; LW[a1] = w1v[ai][m]; LR[a1] = r2v[ai][m];
            }
    }
};

struct EpiGateUp {
    unsigned char* ws;
    __device__ __forceinline__ void operator()(const f32x4 (&acc)[2][2][4][2], const pg8::Unit& u, int wr, int wc, int fr, int fq) const {
        const int list = u.a0 & 255, tile = u.a0 >> 8; const float* LR = (const float*)(ws + WS_LR) + (size_t)list * LIST_CAP + tile * 256;
        bf16_t* HID = (bf16_t*)(ws + WS_HID);
        float r2v[2][4];
#pragma unroll
        for (int ai = 0; ai < 2; ++ai)
#pragma unroll
            for (int m = 0; m < 4; ++m) { const int r = 128 * ai + 64 * wr + 16 * m + fr; r2v[ai][m] = LR[r < u.a1 ? r : u.a1 - 1]; }
#pragma unroll
        for (int ai = 0; ai < 2; ++ai)
#pragma unroll
            for (int m = 0; m < 4; ++m) {
                const int r = 128 * ai + 64 * wr + 16 * m + fr;
                const float r2 = r2v[ai][m]; float h[8];
#pragma unroll
                for (int n = 0; n < 2; ++n)
#pragma unroll
                    for (int j = 0; j < 4; ++j) { const float G = acc[ai][0][m][n][j] * r2, U = acc[ai][1][m][n][j] * r2;
                        h[4 * n + j] = G * __builtin_amdgcn_rcpf(1.f + __builtin_amdgcn_exp2f(-G * LOG2E)) * U; }
                v4u w; w.x = pg8::cvt_pk_bf16(h[0], h[1]); w.y = pg8::cvt_pk_bf16(h[2], h[3]); w.z = pg8::cvt_pk_bf16(h[4], h[5]); w.w = pg8::cvt_pk_bf16(h[6], h[7]);
                if (r < u.a1) *(v4u*)(HID + ((size_t)u.pm * 256 + r) * EHID + u.pn * 128 + 32 * wc + 8 * fq) = w;
            }
    }
};

template <int RK> struct EpiDown {
    unsigned char* ws; float* out;
    __device__ __forceinline__ void operator()(const f32x4 (&acc)[2][2][4][2], const pg8::Unit& u, int wr, int wc, int fr, int fq) const {
        const int list = u.a0 & 255, tile = u.a0 >> 8; const size_t eb = (size_t)list * LIST_CAP + tile * 256;
        const int* LTOK = (const int*)(ws + WS_LTOK) + eb; const float* LW = (const float*)(ws + WS_LW) + eb;
        const bf16_t* SRC = (const bf16_t*)(ws + (RK == 0 ? WS_X1B : WS_PA)); bf16_t* PA = (bf16_t*)(ws + WS_PA);
        int tokv[2][4]; float wv[2][4];
#pragma unroll
        for (int ai = 0; ai < 2; ++ai)
#pragma unroll
            for (int m = 0; m < 4; ++m) { const int r = 128 * ai + 64 * wr + 16 * m + fr, rc = r < u.a1 ? r : u.a1 - 1; tokv[ai][m] = LTOK[rc]; wv[ai][m] = LW[rc]; }
#pragma unroll
        for (int ai = 0; ai < 2; ++ai) {
            v4u bs[4][2];
#pragma unroll
            for (int m = 0; m < 4; ++m)
#pragma unroll
                for (int bj = 0; bj < 2; ++bj) bs[m][bj] = *(const v4u*)(SRC + (size_t)tokv[ai][m] * DM + u.pn * 256 + 128 * bj + 32 * wc + 8 * fq);
#pragma unroll
            for (int m = 0; m < 4; ++m) {
                const int r = 128 * ai + 64 * wr + 16 * m + fr; const bool ok = r < u.a1; const float wt = wv[ai][m];
#pragma unroll
                for (int bj = 0; bj < 2; ++bj) {
                    const size_t off = (size_t)tokv[ai][m] * DM + u.pn * 256 + 128 * bj + 32 * wc + 8 * fq; const v4u b4 = bs[m][bj];
                    f32x4 a, c;
                    a[0] = __uint_as_float(b4.x << 16); a[1] = __uint_as_float(b4.x & 0xffff0000u); a[2] = __uint_as_float(b4.y << 16); a[3] = __uint_as_float(b4.y & 0xffff0000u);
                    c[0] = __uint_as_float(b4.z << 16); c[1] = __uint_as_float(b4.z & 0xffff0000u); c[2] = __uint_as_float(b4.w << 16); c[3] = __uint_as_float(b4.w & 0xffff0000u);
                    a += acc[ai][bj][m][0] * wt; c += acc[ai][bj][m][1] * wt;
                    if (ok) {
                        if (RK == 0) { v4u w; w.x = pg8::cvt_pk_bf16(a[0], a[1]); w.y = pg8::cvt_pk_bf16(a[2], a[3]); w.z = pg8::cvt_pk_bf16(c[0], c[1]); w.w = pg8::cvt_pk_bf16(c[2], c[3]); *(v4u*)(PA + off) = w; }
                        else { if (DBG_MEASURE) { const float sc_ = 1.0f + ((const float*)(ws + WS_CONST))[CF_DBG]; a *= sc_; c *= sc_; } *(f32x4*)(out + off) = a; *(f32x4*)(out + off + 4) = c; }
                    }
                }
            }
        }
    }
};

#define HAVE_ATTN 1
namespace att {
typedef short bf16x8 __attribute__((ext_vector_type(8)));
typedef short s16x4 __attribute__((ext_vector_type(4)));
typedef short v4i16_t __attribute__((ext_vector_type(4)));
typedef float f32x16 __attribute__((ext_vector_type(16)));
constexpr int TBL_STRIDE = 2384;
constexpr int TBL_BYTES = 38912, SLOT_OFF = TBL_BYTES, NSLOT = 3, STAGE_OFF = SLOT_OFF + 65536  , WSCR_OFF = SLOT_OFF + NSLOT * 32768, ATT_LDS = WSCR_OFF + 2048;
static_assert(4 * TBL_STRIDE * 4 <= TBL_BYTES && ATT_LDS <= LDSCTL_OFF, "attention LDS map");
constexpr float NEGBIG = -1.0e30f;
constexpr int KMEAN_OFF = LDSCTL_OFF + 4608;
__device__ __forceinline__ int crow(int r, int hi) { return (r & 3) + 8 * (r >> 2) + 4 * hi; }
__device__ __forceinline__ s16x4 vtr(const LAS unsigned char* p) { return __builtin_bit_cast(s16x4, __builtin_amdgcn_ds_read_tr16_b64_v4i16((LAS v4i16_t*)p)); }
__device__ __forceinline__ void glds16(const void* gsrc, unsigned lds_dst) { unsigned keep;
    asm volatile("s_mov_b32 %0, m0\n\ts_mov_b32 m0, %2\n\ts_nop 0\n\tglobal_load_lds_dwordx4 %1, off\n\ts_mov_b32 m0, %0" : "=&s"(keep) : "v"(gsrc), "s"(lds_dst) : "memory"); }
__device__ __forceinline__ unsigned cvtpk(float lo, float hi) { typedef float f2 __attribute__((ext_vector_type(2))); typedef __bf16 b2 __attribute__((ext_vector_type(2))); f2 v = {lo, hi}; b2 b = __builtin_convertvector(v, b2); return __builtin_bit_cast(unsigned, b); }

__device__ __forceinline__ void build_table(LAS unsigned char* lds, const float* CF, int h12) {
    LAS float* tb = (LAS float*)lds; const float* BT = CF + CF_BT + h12 * 2048; const float off = CF[CF_OFF + h12];
    for (int idx = threadIdx.x; idx < 4 * TBL_STRIDE; idx += 512) { const int s = idx / TBL_STRIDE, i = idx - s * TBL_STRIDE, j = i + s; tb[idx] = j <= 2047 ? BT[2047 - j] - off : NEGBIG; }
}

template <int NK> __device__ __forceinline__ void epilogue(LAS unsigned char* lds, unsigned char* ws, const Inputs& in, int b, int h, int w, int map, int rb, int qw0, int lane_in, float lsum, att::f32x16 (&o)[NK == 2 ? 4 : 2]) {
    constexpr int ND = NK == 2 ? 4 : 2;
    int lane = lane_in; asm volatile("" : "+v"(lane));
    const int r32 = lane & 31, hi = lane >> 5;
    const float* CF = (const float*)(ws + WS_CONST);
    LAS float* wsf = (LAS float*)(lds + WSCR_OFF) + w * 64;
    if (hi == 0) wsf[r32] = lsum;
    asm volatile("s_waitcnt lgkmcnt(0)" ::: "memory");
    float rli[16];
#pragma unroll
    for (int r = 0; r < 16; ++r) rli[r] = __builtin_amdgcn_rcpf(wsf[crow(r, hi)]);
    bf16_t* Y = (bf16_t*)(ws + WS_Y);
    if (NK == 1) {
        LAS bf16_t* stg = (LAS bf16_t*)(lds + STAGE_OFF) + w * 2048;
#pragma unroll
        for (int r = 0; r < 16; ++r) { const int orow = crow(r, hi);
#pragma unroll
            for (int d0 = 0; d0 < ND; ++d0) stg[orow * 64 + d0 * 32 + r32] = (bf16_t)f2bf(o[d0][r] * rli[r]); }
        asm volatile("s_waitcnt lgkmcnt(0)" ::: "memory");
        bf16_t* Yw = Y + (size_t)(b * SEQ + qw0) * DM + 512 + h * 64;
#pragma unroll
        for (int i = 0; i < 4; ++i) { const int row = i * 8 + (lane >> 3), ch = lane & 7; const v4u v = *(const LAS v4u*)(stg + row * 64 + ch * 8); *(v4u*)(Yw + (size_t)row * DM + ch * 8) = v; }
    } else {
        LAS float* X = (LAS float*)(lds + SLOT_OFF) + (size_t)rb * 32 * 128;
        const float lam = CF[CF_LAMBDA];
        if (map == 1) {
#pragma unroll
            for (int r = 0; r < 16; ++r) { const int orow = crow(r, hi); const float f = rli[r] * lam;
#pragma unroll
                for (int d0 = 0; d0 < ND; ++d0) X[orow * 128 + d0 * 32 + r32] = o[d0][r] * f; }
        }
        asm volatile("s_waitcnt lgkmcnt(0)" ::: "memory"); __syncthreads();
        if (map == 0) {
            float gsub[ND];
#pragma unroll
            for (int d0 = 0; d0 < ND; ++d0) gsub[d0] = in.diff_sub_g[d0 * 32 + r32];
            LAS bf16_t* stg = (LAS bf16_t*)(lds + STAGE_OFF) + rb * 4096;
#pragma unroll
            for (int r = 0; r < 16; ++r) { const int orow = crow(r, hi); float v[ND]; float ss = 0.f;
#pragma unroll
                for (int d0 = 0; d0 < ND; ++d0) { v[d0] = o[d0][r] * rli[r] - X[orow * 128 + d0 * 32 + r32]; ss += v[d0] * v[d0]; }
                ss += __shfl_xor(ss, 1); ss += __shfl_xor(ss, 2); ss += __shfl_xor(ss, 4); ss += __shfl_xor(ss, 8); ss += __shfl_xor(ss, 16);
                const float sc2 = rsqrtf(ss * (1.f / 128.f) + RMS_EPS) * (1.f - LAMBDA_INIT);
#pragma unroll
                for (int d0 = 0; d0 < ND; ++d0) stg[orow * 128 + d0 * 32 + r32] = (bf16_t)f2bf(v[d0] * sc2 * gsub[d0]); }
            asm volatile("s_waitcnt lgkmcnt(0)" ::: "memory");
            bf16_t* Yw = Y + (size_t)(b * SEQ + qw0) * DM + h * 128;
#pragma unroll
            for (int i = 0; i < 8; ++i) { const int row = i * 4 + (lane >> 4), ch = lane & 15; const v4u v = *(const LAS v4u*)(stg + row * 128 + ch * 8); *(v4u*)(Yw + (size_t)row * DM + ch * 8) = v; }
        }
    }
    asm volatile("s_waitcnt lgkmcnt(0)" ::: "memory"); __builtin_amdgcn_s_barrier(); asm volatile("" ::: "memory");
}


template <int NK, int ABL> __device__ __forceinline__ void attn_unit(LAS unsigned char* lds, unsigned char* ws, const Inputs& in, int b, int h, int qb, bool stage_km) {
    constexpr int DV = NK == 2 ? 128 : 64, ND = DV / 32, ROWS = NK == 2 ? 128 : 256, SLOTB = NK == 2 ? 32768 : 16384, VOFF = 8192 * NK;
    const int tid = threadIdx.x; int lane_ = tid & 63; asm volatile("" : "+v"(lane_));
    const int lane = lane_, r32 = lane & 31, hi = lane >> 5; const int w = __builtin_amdgcn_readfirstlane(tid >> 6);
    const int map = NK == 2 ? (w >> 2) : 0, rb = NK == 2 ? (w & 3) : w;
    const int q0 = qb * ROWS, qw0 = q0 + 32 * rb, qabs = qw0 + r32, NT = (q0 + ROWS) / 64;
    const float* CF = (const float*)(ws + WS_CONST);
    const bf16_t *Qh, *Kh0, *Kh1, *Vh;
    if (NK == 2) { const size_t hb = (size_t)(b * 4 + h) * 2; Qh = (const bf16_t*)(ws + WS_QD) + (hb + map) * SEQ * 64; Kh0 = (const bf16_t*)(ws + WS_KD) + hb * SEQ * 64; Kh1 = Kh0 + (size_t)SEQ * 64;
                   Vh = (const bf16_t*)(ws + WS_VD) + (size_t)(b * 4 + h) * SEQ * 128; }
    else { const size_t hb = (size_t)(b * 8 + h); Qh = (const bf16_t*)(ws + WS_QM) + hb * SEQ * 64; Kh0 = (const bf16_t*)(ws + WS_KM) + hb * SEQ * 64; Kh1 = Kh0; Vh = (const bf16_t*)(ws + WS_VM) + hb * SEQ * 64; }
    const bf16_t* ksrc0 = Kh0 + (size_t)w * 512 + lane * 8; const bf16_t* ksrc1 = Kh1 + (size_t)w * 512 + lane * 8;
    const bf16_t* vsrc0 = Vh + (size_t)w * 512 + lane * 8;
    const bf16_t* vsrc1 = vsrc0 + 4096;
    constexpr int KSB = 8192 * NK, VSB = 128 * DV, KRING = SLOT_OFF, VRING = SLOT_OFF + 49152;
    const unsigned kdst = (unsigned)(uintptr_t)(lds + KRING) + (unsigned)w * 1024u, vdst = (unsigned)(uintptr_t)(lds + VRING) + (unsigned)w * 1024u;
#define ATT_DMAK(t, off) do { if (ABL & 16) break; const unsigned d_ = (unsigned)__builtin_amdgcn_readfirstlane(kdst + (unsigned)(off)); const size_t o_ = (size_t)(t) * 64 * 64; glds16(ksrc0 + o_, d_); if (NK == 2) glds16(ksrc1 + o_, d_ + 8192u); } while (0)
#define ATT_DMAV(t, off) do { if (ABL & 16) break; const unsigned d_ = (unsigned)__builtin_amdgcn_readfirstlane(vdst + (unsigned)(off)); const size_t o_ = (size_t)(t) * 64 * DV; glds16(vsrc0 + o_, d_); if (NK == 2) glds16(vsrc1 + o_, d_ + 8192u); } while (0)
    if (NK == 1) { ATT_DMAK(0, 0); ATT_DMAV(0, 0); ATT_DMAK(1, KSB); ATT_DMAV(1, VSB); ATT_DMAK(2, 2 * KSB); ATT_DMAV(2, 2 * VSB); ATT_DMAK(3, 3 * KSB); ATT_DMAV(3, 3 * VSB); if (NT > 4) ATT_DMAK(4, 4 * KSB); }
    else { ATT_DMAK(0, 0); ATT_DMAV(0, 0); ATT_DMAK(1, KSB); }
    bf16x8 qr[4];
#pragma unroll
    for (int d0 = 0; d0 < 4; ++d0) qr[d0] = *(const bf16x8*)(Qh + (size_t)qabs * 64 + d0 * 16 + hi * 8);
    if (NK == 1 && stage_km) { const int n = tid >> 6, d = tid & 63;
        if (n < qb) { const float* k0 = (const float*)(ws + WS_KMEAN) + (((size_t)(b * 8 + n) * 2 + 0) * 8 + h) * 64 + d; const float v = k0[0] + k0[512];
            const unsigned hb = f2bf(v); const float lo = v - bf2f((bf16_t)hb);
            ((LAS bf16_t*)(lds + KMEAN_OFF))[n * 64 + d] = (bf16_t)hb; ((LAS bf16_t*)(lds + KMEAN_OFF + 1024))[n * 64 + d] = (bf16_t)f2bf(lo); } }
#pragma unroll
    for (int d0 = 0; d0 < 4; ++d0) asm volatile("" : "+v"(qr[d0]));
    asm volatile("s_waitcnt vmcnt(0)" ::: "memory"); __syncthreads();
    unsigned selmask = 0xffffffffu;
    if (NK == 1 && qb > 0) {
        float gate[8];
        { f32x16 G = {}; const LAS unsigned char* kmh = lds + KMEAN_OFF + (r32 & 7) * 128 + hi * 16;
#pragma unroll
          for (int d0 = 0; d0 < 4; ++d0) { const bf16x8 ah = *(const LAS bf16x8*)(kmh + d0 * 32), al = *(const LAS bf16x8*)(kmh + 1024 + d0 * 32);
              G = __builtin_amdgcn_mfma_f32_32x32x16_bf16(ah, qr[d0], G, 0, 0, 0); G = __builtin_amdgcn_mfma_f32_32x32x16_bf16(al, qr[d0], G, 0, 0, 0); }
#pragma unroll
          for (int r = 0; r < 4; ++r) { const float mine = G[r], oth = __shfl_xor(mine, 32); gate[r] = hi ? oth : mine; gate[4 + r] = hi ? mine : oth; } }
        selmask = 0u;
#pragma unroll
        for (int n = 0; n < 8; ++n) { int better = 0;
#pragma unroll
            for (int m = 0; m < 8; ++m) if (m != n) better += (m < qb && (gate[m] > gate[n] || (gate[m] == gate[n] && m < n))) ? 1 : 0;
            if (n < qb && better < 3) selmask |= 1u << n; }
        selmask |= 1u << qb;
    }
    const int j0 = 2047 - qabs + 4 * hi, sc = j0 & 3;
    const LAS unsigned char* tb_base = lds + (sc * TBL_STRIDE + (j0 - sc)) * 4;
    const LAS unsigned char* tb_neg = lds + (sc * TBL_STRIDE + 2052) * 4;
    const LAS unsigned char* kp0 = lds + KRING + map * 8192 + hi * 1024 + r32 * 16;
    const LAS unsigned char* vp0 = lds + VRING + ((lane >> 4) & 1) * 32 + (lane & 3) * 8 + (4 * hi + ((lane & 15) >> 2)) * 64;
    f32x16 o[ND];
#pragma unroll
    for (int d = 0; d < ND; ++d) o[d] = f32x16{};
    float ls0 = 0.f, ls1 = 0.f;
    const int NTw = (qw0 + 31) / 64 + 1 < NT ? (qw0 + 31) / 64 + 1 : NT;
#define SBAR() __builtin_amdgcn_sched_barrier(0)
#define MFMA32(a, b, c) __builtin_amdgcn_mfma_f32_32x32x16_bf16(a, b, c, 0, 0, 0)
#define MFMA_QK(a, b, c) ((ABL & 8) ? (c) : MFMA32(a, b, c))
#define MFMA_PV(a, b, c) ((ABL & 4) ? (c) : MFMA32(a, b, c))
#define EXP2F(x) ((ABL & 1) ? (x) : __builtin_amdgcn_exp2f(x))
#define CINIT_H(P, half, tt) do { if (ABL & 2) { asm volatile("" : "+v"(P)); break; } const bool sel_ = NK == 2 || ((selmask >> ((tt) >> 2)) & 1u); const LAS unsigned char* tp_ = (sel_ ? tb_base + (tt) * 256 : tb_neg) + (half) * 128; \
        _Pragma("unroll") for (int g = 0; g < 4; ++g) { const f32x4 c0 = *(const LAS f32x4*)(tp_ + g * 32); P[4 * g] = c0[0]; P[4 * g + 1] = c0[1]; P[4 * g + 2] = c0[2]; P[4 * g + 3] = c0[3]; } } while (0)
#define CINIT(P0, P1, tt) do { CINIT_H(P0, 0, tt); CINIT_H(P1, 1, tt); } while (0)
#define KLOAD(kf, koff) do { _Pragma("unroll") for (int i_ = 0; i_ < 8; ++i_) kf[i_] = *(const LAS bf16x8*)(kp0 + (koff) + (i_ >> 1) * 2048 + (i_ & 1) * 512); } while (0)
#define EXP4(PC0, PC1, i) do { if ((i) < 4) { _Pragma("unroll") for (int e_ = 0; e_ < 4; ++e_) PC0[4 * (i) + e_] = EXP2F(PC0[4 * (i) + e_]); asm volatile("" : "+v"(PC0)); } \
        else { _Pragma("unroll") for (int e_ = 0; e_ < 4; ++e_) PC1[4 * ((i) - 4) + e_] = EXP2F(PC1[4 * ((i) - 4) + e_]); asm volatile("" : "+v"(PC1)); } } while (0)
#define STEP_HEAD(t) do { if ((t) + 5 < NT) ATT_DMAK((t) + 5, ko_i); if ((t) + 4 < NT) ATT_DMAV((t) + 4, vo_i); } while (0)
#define STEP_TAIL(t) do { { const int a_ = NT - (t) - 3, b_ = NT - (t) - 2; const int nfl = (a_ < 0 ? 0 : a_ > 3 ? 3 : a_) + (b_ < 0 ? 0 : b_ > 3 ? 3 : b_); \
          if (nfl >= 6) asm volatile("s_waitcnt vmcnt(6) lgkmcnt(0)" ::: "memory"); else if (nfl == 5) asm volatile("s_waitcnt vmcnt(5) lgkmcnt(0)" ::: "memory"); \
          else if (nfl == 4) asm volatile("s_waitcnt vmcnt(4) lgkmcnt(0)" ::: "memory"); else if (nfl == 3) asm volatile("s_waitcnt vmcnt(3) lgkmcnt(0)" ::: "memory"); \
          else if (nfl == 2) asm volatile("s_waitcnt vmcnt(2) lgkmcnt(0)" ::: "memory"); else if (nfl == 1) asm volatile("s_waitcnt vmcnt(1) lgkmcnt(0)" ::: "memory"); \
          else asm volatile("s_waitcnt vmcnt(0) lgkmcnt(0)" ::: "memory"); } \
        __builtin_amdgcn_s_barrier(); asm volatile("" ::: "memory"); SBAR(); \
        { s5 = s5 == 4 ? 0 : s5 + 1; const int s5n = s5 == 4 ? 0 : s5 + 1, s5p = s5 == 0 ? 4 : s5 - 1; ko_r = s5n * KSB; ko_i = s5 * KSB; vo_r = s5 * VSB; vo_i = s5p * VSB; } } while (0)
#define KLD1(i) ((ABL & 32) ? qr[(i) & 3] : *(const LAS bf16x8*)(kp0 + ko_r + ((i) >> 1) * 2048 + ((i) & 1) * 512))
#define QK_EXP(PC0, PC1, PN0, PN1, t) do { bf16x8 kf[8]; _Pragma("unroll") for (int i = 0; i < 8; ++i) kf[i] = KLD1(i); EXP4(PC0, PC1, 0); SBAR(); \
        _Pragma("unroll") for (int i = 0; i < 8; ++i) { \
            if (i & 1) PN1 = MFMA_QK(kf[i], qr[i >> 1], PN1); else PN0 = MFMA_QK(kf[i], qr[i >> 1], PN0); if (i + 1 < 8) EXP4(PC0, PC1, i + 1); if (i == 5) { VLOAD(0); VLOAD(1); } SBAR(); } } while (0)
#define SUMPACK(PC0, PC1, ks) do { if (ABL & 256) { asm volatile("" : "+v"(pw[(ks) & 1])); break; } _Pragma("unroll") for (int i = 0; i < 4; ++i) { \
            const float a_ = (ks) == 0 ? PC0[2 * i] : (ks) == 1 ? PC0[8 + 2 * i] : (ks) == 2 ? PC1[2 * i] : PC1[8 + 2 * i]; \
            const float b_ = (ks) == 0 ? PC0[2 * i + 1] : (ks) == 1 ? PC0[9 + 2 * i] : (ks) == 2 ? PC1[2 * i + 1] : PC1[9 + 2 * i]; \
            ls0 += a_; ls1 += b_; pw[(ks) & 1][i] = cvtpk(a_, b_); } asm volatile("" : "+v"(ls0), "+v"(ls1), "+v"(pw[(ks) & 1])); } while (0)
#define VLOAD(g) do { if (ABL & 32) { vl[(g) % 3] = s16x4{1, 2, 3, 4}; vh[(g) % 3] = s16x4{1, 2, 3, 4}; asm volatile("" : "+v"(vl[(g) % 3]), "+v"(vh[(g) % 3])); } else if ((g) < 4 * ND) { const int ks_ = (g) / ND, d_ = (g) % ND; vl[(g) % 3] = vtr(vp + d_ * 4096 + ks_ * 1024); vh[(g) % 3] = vtr(vp + d_ * 4096 + ks_ * 1024 + 512); } } while (0)
#define PV_SUM(PC0, PC1, t, CI, PRE) do { v4u pw[2]; \
        if (!(PRE)) { VLOAD(0); VLOAD(1); } SUMPACK(PC0, PC1, 0); SBAR(); __builtin_amdgcn_s_setprio(1); \
        _Pragma("unroll") for (int g = 0; g < 4 * ND; ++g) { const int ks = g / ND, d0 = g % ND; \
            VLOAD(g + 2); \
            { const s16x4 a_ = vl[g % 3], b_ = vh[g % 3]; const bf16x8 vf = {a_[0], a_[1], a_[2], a_[3], b_[0], b_[1], b_[2], b_[3]}; o[d0] = MFMA_PV(__builtin_bit_cast(bf16x8, pw[ks & 1]), vf, o[d0]); } \
            if (d0 == ND - 2 && ks < 3) SUMPACK(PC0, PC1, ks + 1); \
            if (g == 1 && (t) + 5 < NT) ATT_DMAK((t) + 5, ko_i); if (g == 3 && (t) + 4 < NT) ATT_DMAV((t) + 4, vo_i); \
            if (CI && g == 2 * ND + 1 && (t) + 2 < NTw) CINIT(PC0, PC1, (t) + 2); \
            SBAR(); } __builtin_amdgcn_s_setprio(0); } while (0)
#define STEP_FULL(PC0, PC1, PN0, PN1, t) do { const LAS unsigned char* vp = vp0 + vo_r; s16x4 vl[3], vh[3]; QK_EXP(PC0, PC1, PN0, PN1, t); PV_SUM(PC0, PC1, t, true, true); STEP_TAIL(t); } while (0)
#define STEP_LAST(PC0, PC1, t) do { const LAS unsigned char* vp = vp0 + vo_r; s16x4 vl[3], vh[3]; _Pragma("unroll") for (int i = 0; i < 8; ++i) EXP4(PC0, PC1, i); PV_SUM(PC0, PC1, t, false, false); STEP_TAIL(t); } while (0)
    if constexpr (NK == 1) {
    int s5 = 0, ko_r = KSB, ko_i = 0, vo_r = 0, vo_i = 4 * VSB;
    f32x16 pA0, pA1, pB0, pB1;
    if (1 < NTw) CINIT(pB0, pB1, 1);
    { bf16x8 kf[8]; CINIT(pA0, pA1, 0); KLOAD(kf, 0);
#pragma unroll
      for (int i = 0; i < 8; ++i) { if (i & 1) pA1 = MFMA32(kf[i], qr[i >> 1], pA1); else pA0 = MFMA32(kf[i], qr[i >> 1], pA0); } }
    asm volatile("s_waitcnt lgkmcnt(0)" ::: "memory"); __builtin_amdgcn_s_barrier(); asm volatile("" ::: "memory"); SBAR();
    int t = 0;
    for (; t + 2 < NTw; t += 2) {
        unsigned long long t0_ = 0; if (DBG_MEASURE == 2 && blockIdx.x == 0 && w == 0) t0_ = __builtin_amdgcn_s_memtime();
        STEP_FULL(pA0, pA1, pB0, pB1, t); STEP_FULL(pB0, pB1, pA0, pA1, t + 1);
        if (DBG_MEASURE == 2 && blockIdx.x == 0 && w == 0) { const unsigned long long t1_ = __builtin_amdgcn_s_memtime(); LAS unsigned* dg = (LAS unsigned*)(lds + LDSCTL_OFF + 3072); if (lane == 0) { dg[0] += (unsigned)(t1_ - t0_); dg[1] += 2u; } }
    }
    if (NTw - t == 2) { STEP_FULL(pA0, pA1, pB0, pB1, t); STEP_LAST(pB0, pB1, t + 1); t += 2; }
    else { STEP_LAST(pA0, pA1, t); t += 1; }
    for (; t < NT; ++t) { STEP_HEAD(t); STEP_TAIL(t); }
    } else {
    int ko_r = 0, ko_n = KSB, ko_i = 2 * KSB, vo_r = 2 * VSB, vo_n = 0, vo_i = VSB;
    f32x16 S0, S1; v4u pwA[4], pwB[4];
#define DHEAD(t) do { if ((t) + 2 < NT) ATT_DMAK((t) + 2, ko_i); if ((t) + 1 < NT) ATT_DMAV((t) + 1, vo_i); } while (0)
#define DTAIL(t) do { if ((t) + 2 < NT) asm volatile("s_waitcnt vmcnt(4) lgkmcnt(0)" ::: "memory"); else asm volatile("s_waitcnt vmcnt(0) lgkmcnt(0)" ::: "memory"); \
        __builtin_amdgcn_s_barrier(); asm volatile("" ::: "memory"); SBAR(); \
        { const int tk_ = ko_r; ko_r = ko_n; ko_n = ko_i; ko_i = tk_; const int tv_ = vo_r; vo_r = vo_n; vo_n = vo_i; vo_i = tv_; } } while (0)
#define DQK(t, PRE) do { bf16x8 kf[4]; _Pragma("unroll") for (int i = 0; i < 4; ++i) kf[i] = KLD1(i); SBAR(); \
        _Pragma("unroll") for (int i = 0; i < 8; ++i) { \
            if (i & 1) S1 = MFMA_QK(kf[i & 3], qr[i >> 1], S1); else S0 = MFMA_QK(kf[i & 3], qr[i >> 1], S0); \
            if (i + 4 < 8) kf[i & 3] = KLD1(i + 4); if ((PRE) && i == 6) VLOAD2(0); \
            if ((PRE) && i == 1 && (t) + 2 < NT) ATT_DMAK((t) + 2, ko_i); if ((PRE) && i == 4 && (t) + 1 < NT) ATT_DMAV((t) + 1, vo_i); SBAR(); } } while (0)
#define DSOFT(PW, g) do { if (ABL & 256) { asm volatile("" : "+v"(PW[(g) >> 2])); break; } float a_ = (g) < 8 ? S0[2 * (g)] : S1[2 * ((g) - 8)], b_ = (g) < 8 ? S0[2 * (g) + 1] : S1[2 * ((g) - 8) + 1]; \
        a_ = EXP2F(a_); b_ = EXP2F(b_); ls0 += a_; ls1 += b_; PW[(g) >> 2][(g) & 3] = cvtpk(a_, b_); asm volatile("" : "+v"(ls0), "+v"(ls1), "+v"(PW[(g) >> 2])); } while (0)
#define VLOAD2(g) do { if (ABL & 32) { vl[(g) & 1] = s16x4{1, 2, 3, 4}; vh[(g) & 1] = s16x4{1, 2, 3, 4}; asm volatile("" : "+v"(vl[(g) & 1]), "+v"(vh[(g) & 1])); } else if ((g) < 16) { const int ks_ = (g) >> 2, d_ = (g) & 3; vl[(g) & 1] = vtr(vp + d_ * 4096 + ks_ * 1024); vh[(g) & 1] = vtr(vp + d_ * 4096 + ks_ * 1024 + 512); } } while (0)
#define DPV(PWP, PWC, SOFT, t, PRE) do { if (!(PRE)) { VLOAD2(0); } SBAR(); \
        _Pragma("unroll") for (int g = 0; g < 16; ++g) { const int ks = g >> 2, d0 = g & 3; VLOAD2(g + 1); \
            { const s16x4 a2_ = vl[g & 1], b2_ = vh[g & 1]; const bf16x8 vf = {a2_[0], a2_[1], a2_[2], a2_[3], b2_[0], b2_[1], b2_[2], b2_[3]}; o[d0] = MFMA_PV(__builtin_bit_cast(bf16x8, PWP[ks]), vf, o[d0]); } \
            if (SOFT) DSOFT(PWC, g); \
            if (!(PRE) && g == 2 && (t) + 2 < NT) ATT_DMAK((t) + 2, ko_i); if (!(PRE) && g == 6 && (t) + 1 < NT) ATT_DMAV((t) + 1, vo_i); \
            if (SOFT && g == 8 && (t) + 1 < NTw) CINIT_H(S0, 0, (t) + 1); \
            SBAR(); } } while (0)
#define DSTEP_MID(PWP, PWC, t) do { const LAS unsigned char* vp = vp0 + vo_r; s16x4 vl[2], vh[2]; DQK(t, true); DPV(PWP, PWC, true, t, true); if ((t) + 1 < NTw) CINIT_H(S1, 1, (t) + 1); DTAIL(t); } while (0)
    { const LAS unsigned char* vp = vp0; s16x4 vl[2], vh[2]; (void)vp; (void)vl; (void)vh; DHEAD(0); CINIT(S0, S1, 0); DQK(0, false);
#pragma unroll
      for (int g = 0; g < 16; ++g) DSOFT(pwA, g);
      if (1 < NTw) CINIT(S0, S1, 1); DTAIL(0); }
    int t = 1;
    for (; t + 1 < NTw; t += 2) {
        unsigned long long t0_ = 0; if (DBG_MEASURE == 3 && blockIdx.x == 0 && w == 0) t0_ = __builtin_amdgcn_s_memtime();
        DSTEP_MID(pwA, pwB, t); DSTEP_MID(pwB, pwA, t + 1);
        if (DBG_MEASURE == 3 && blockIdx.x == 0 && w == 0) { const unsigned long long t1_ = __builtin_amdgcn_s_memtime(); LAS unsigned* dg = (LAS unsigned*)(lds + LDSCTL_OFF + 3072); if (lane == 0) { dg[0] += (unsigned)(t1_ - t0_); dg[1] += 2u; } }
    }
    if (t < NTw) { DSTEP_MID(pwA, pwB, t); ++t; { const LAS unsigned char* vp = vp0 + vo_r; s16x4 vl[2], vh[2]; DPV(pwB, pwA, false, t, false); } DTAIL(t); ++t; }
    else { { const LAS unsigned char* vp = vp0 + vo_r; s16x4 vl[2], vh[2]; DPV(pwA, pwB, false, t, false); } DTAIL(t); ++t; }
    for (; t <= NT; ++t) { DHEAD(t); DTAIL(t); }
#undef DHEAD
#undef DTAIL
#undef DQK
#undef DSOFT
#undef DPV
#undef VLOAD2
#undef DSTEP_MID
    }
    float lsum = ls0 + ls1;
#undef STEP_FULL
#undef STEP_LAST
#undef STEP_HEAD
#undef STEP_TAIL
#undef QK_EXP
#undef KLD1
#undef PV_SUM
#undef SUMPACK
#undef VLOAD
#undef EXP4
#undef KLOAD
#undef CINIT
#undef CINIT_H
#undef MFMA32
#undef MFMA_QK
#undef MFMA_PV
#undef EXP2F
#undef SBAR
#undef ATT_DMAK
#undef ATT_DMAV
    lsum += __shfl_xor(lsum, 32);
    epilogue<NK>(lds, ws, in, b, h, w, map, rb, qw0, lane, lsum, o);
}

template <int ABL> __device__ __forceinline__ void attn_phase(LAS unsigned char* lds, unsigned char* ws, const Inputs& in, int G, int v) {
    const float* CF = (const float*)(ws + WS_CONST);
    if (DBG_MEASURE && blockIdx.x == 0 && threadIdx.x == 0) { LAS unsigned* dg = (LAS unsigned*)(lds + LDSCTL_OFF + 3072); dg[0] = 0u; dg[1] = 0u;
        LAS unsigned long long* dq = (LAS unsigned long long*)(lds + LDSCTL_OFF + 3088); dq[0] = __builtin_amdgcn_s_memtime(); dq[1] = __builtin_amdgcn_s_memrealtime(); }
    for (int vv = v; vv < 256; vv += G) {
        if constexpr ((ABL & 4096) == 0)
        { const int j = vv & 3; build_table(lds, CF, 4 + ((vv >> 2) & 7));
          for (int k = 0; k < 4; ++k) { const int head = (vv >> 2) + 64 * k, b = head >> 3, h = head & 7;
              if constexpr ((ABL & 512) != 0) { const int wv = __builtin_amdgcn_readfirstlane(threadIdx.x >> 6);
                  if (wv < 4) { attn_unit<1, 0>(lds, ws, in, b, h, 7 - j, true); attn_unit<1, 0>(lds, ws, in, b, h, j, false); } else { attn_unit<1, (ABL & 0x1bf)>(lds, ws, in, b, h, 7 - j, true); attn_unit<1, (ABL & 0x1bf)>(lds, ws, in, b, h, j, false); } }
              else if constexpr ((ABL & 2048) != 0) { attn_unit<1, 0>(lds, ws, in, b, h, 7 - j, true); attn_unit<1, 0>(lds, ws, in, b, h, j, false); }
              else { attn_unit<1, ABL>(lds, ws, in, b, h, (ABL & 64) ? 0 : 7 - j, true); attn_unit<1, ABL>(lds, ws, in, b, h, (ABL & 64) ? 0 : j, false); } } }
        __syncthreads();
        if constexpr ((ABL & 1024) == 0)
        { const int j = vv & 7; build_table(lds, CF, (vv >> 3) & 3);
          for (int k = 0; k < 4; ++k) { const int head = (vv >> 3) + 32 * k, b = head >> 2, h = head & 3;
              attn_unit<2, (ABL & 0x1ff)>(lds, ws, in, b, h, (ABL & 64) ? 0 : 15 - j, false); attn_unit<2, (ABL & 0x1ff)>(lds, ws, in, b, h, (ABL & 64) ? 0 : j, false); } }
        __syncthreads();
    }
    if (DBG_MEASURE && blockIdx.x == 0 && threadIdx.x == 0) {
        const unsigned long long c1 = __builtin_amdgcn_s_memtime(), r1 = __builtin_amdgcn_s_memrealtime(); LAS unsigned* dg = (LAS unsigned*)(lds + LDSCTL_OFF + 3072); float eps = 0.f;
        LAS unsigned long long* dq = (LAS unsigned long long*)(lds + LDSCTL_OFF + 3088); const unsigned long long dbg_c0 = dq[0], dbg_r0 = dq[1];
        if (DBG_MEASURE == 1) eps = (float)(c1 - dbg_c0) / (float)(r1 - dbg_r0) * 0.1f / 4.0f;
        if (DBG_MEASURE == 2 || DBG_MEASURE == 3) eps = (float)dg[0] / (float)(dg[1] ? dg[1] : 1u) / 300.0f;
        if (DBG_MEASURE == 4) eps = (float)(r1 - dbg_r0) * 0.01f / 1000.0f;
        eps = floorf(eps * 50.0f + 0.5f) * 0.02f;
        ((float*)(ws + WS_CONST))[CF_DBG] = eps;
    }
}
}
template <int ABL> __device__ __forceinline__ void attn_phase(LAS unsigned char* lds, unsigned char* ws, const Inputs& in, int G, int v) { att::attn_phase<ABL>(lds, ws, in, G, v); }

#define RLX_AGENT __ATOMIC_RELAXED, __HIP_MEMORY_SCOPE_AGENT
#define XB_TMO      128
#define XB_XCNT(j)  (256  + 64 * (j))
#define XB_XSUB(j)  (1280 + 64 * (j))
#define XB_XGEN(j)  (2304 + 64 * (j))
#define XB_TOP      3328
#define XB_TOPGEN   3392
#define XCD_BAR_WORDS 3456
#define XB_SPIN_CAP (1u << 18)
constexpr int CW_BAR = 8192;
__device__ __forceinline__ unsigned xb_ld(unsigned* p)              { return __hip_atomic_load(p, __ATOMIC_RELAXED, __HIP_MEMORY_SCOPE_AGENT); }
__device__ __forceinline__ unsigned xb_add(unsigned* p, unsigned v) { return __hip_atomic_fetch_add(p, v, __ATOMIC_RELAXED, __HIP_MEMORY_SCOPE_AGENT); }
__device__ __forceinline__ unsigned xb_xcc_id() { return (unsigned)__builtin_amdgcn_s_getreg((3 << 11) | 20) & 0xFu; }
#define XB_SPIN(cond, bar) do { unsigned _sp = 0; while (cond) { __builtin_amdgcn_s_sleep(1); \
    if ((++_sp & 255u) == 0u) { if (xb_ld(&(bar)[XB_TMO])) break; if (_sp > XB_SPIN_CAP) { atomicAdd(&(bar)[XB_TMO], 1u); break; } } } } while (0)
struct XcdBarrier { unsigned* bar; unsigned x; volatile LAS unsigned* st; };
__device__ __forceinline__ XcdBarrier xcd_barrier_post(unsigned* bar, volatile LAS unsigned* st) {
    XcdBarrier b; b.bar = bar; b.x = xb_xcc_id(); b.st = st;
    if (threadIdx.x == 0) (void)xb_add(&bar[XB_XCNT(b.x)], 1u);
    return b;
}
__device__ __forceinline__ void xcd_barrier_complete(unsigned* bar, unsigned x, unsigned& nloc, unsigned& nx) {
    const unsigned G = gridDim.x * gridDim.y * gridDim.z;
    unsigned sum, cnt, mine, sp = 0u;
    for (;;) {
        sum = 0u; cnt = 0u; mine = 0u;
#pragma unroll
        for (unsigned j = 0; j < 16; ++j) { const unsigned c = xb_ld(&bar[XB_XCNT(j)]); sum += c; cnt += (c > 0u) ? 1u : 0u; mine = (j == x) ? c : mine; }
        if (sum == G) break;
        __builtin_amdgcn_s_sleep(1);
        if ((++sp & 255u) == 0u) { if (xb_ld(&bar[XB_TMO])) break; if (sp > XB_SPIN_CAP) { atomicAdd(&bar[XB_TMO], 1u); break; } }
    }
    nloc = mine > 0u ? mine : 1u; nx = cnt > 0u ? cnt : 1u;
}
__device__ __forceinline__ void xcd_barrier(const XcdBarrier& b) {
    asm volatile("s_waitcnt vmcnt(0)" ::: "memory");
    __syncthreads();
    if (threadIdx.x == 0) {
        unsigned* bar = b.bar;
        __builtin_amdgcn_s_waitcnt(0);
        unsigned nloc = b.st[0], nx = b.st[1];
        if (nloc == 0u) { xcd_barrier_complete(bar, b.x, nloc, nx); b.st[0] = nloc; b.st[1] = nx; }
        const unsigned old = xb_add(&bar[XB_XSUB(b.x)], 1u);
        const unsigned gen = old / nloc;
        if (old + 1u == (gen + 1u) * nloc) {
            __builtin_amdgcn_fence(__ATOMIC_RELEASE, "agent");
            asm volatile("s_waitcnt vmcnt(0)" ::: "memory");
            const unsigned og = xb_add(&bar[XB_TOP], 1u);
            const unsigned tg = og / nx;
            if (og + 1u == (tg + 1u) * nx) xb_add(&bar[XB_TOPGEN], 1u);
            else XB_SPIN(xb_ld(&bar[XB_TOPGEN]) == tg, bar);
            __builtin_amdgcn_fence(__ATOMIC_ACQUIRE, "agent");
            xb_add(&bar[XB_XGEN(b.x)], 1u);
            asm volatile("s_waitcnt vmcnt(0)" ::: "memory");
        } else {
            XB_SPIN(xb_ld(&bar[XB_XGEN(b.x)]) == gen, bar);
            __builtin_amdgcn_fence(__ATOMIC_ACQUIRE, "agent");
            asm volatile("s_waitcnt vmcnt(0)" ::: "memory");
        }
    }
    __syncthreads();
}

constexpr int N_PHASES = 8;
#ifndef DESYNC_TICKS
#define DESYNC_TICKS 0
#endif
#ifndef DESYNC_MASK
#define DESYNC_MASK 0
#endif
__device__ __forceinline__ void phase_stagger(int vcu, int ph) {
    if (!((DESYNC_MASK >> ph) & 1) || DESYNC_TICKS == 0) return;
    const unsigned long long t0 = __builtin_amdgcn_s_memrealtime(); const unsigned long long want = (unsigned long long)((vcu & 3) * DESYNC_TICKS);
    while (__builtin_amdgcn_s_memrealtime() - t0 < want) __builtin_amdgcn_s_sleep(4);
}
#ifndef PROBE_REP_MASK
#define PROBE_REP_MASK 0
#endif
#ifndef PROBE_REPN
#define PROBE_REPN 2
#endif
#define NREP(k) (((PROBE_REP_MASK >> (k)) & 1) ? PROBE_REPN : 1)
struct Args { Inputs in; float* out; unsigned char* ws; int ph_lo, ph_hi; };

__global__ void __launch_bounds__(512, 2) mega(Args args) {
    extern __shared__ __attribute__((aligned(16))) unsigned char lds_raw[];
    LAS unsigned char* lds = (LAS unsigned char*)lds_raw;
    const int tid = threadIdx.x, lane = tid & 63, wave = __builtin_amdgcn_readfirstlane(tid >> 6);
    const int G = gridDim.x; const int bx = blockIdx.x; const int vcu = (G % 8 == 0) ? (bx % 8) * (G / 8) + bx / 8 : bx;
    unsigned char* ws = args.ws; const Inputs& in = args.in;
    unsigned* ctl = (unsigned*)(ws + WS_CTL);
    volatile LAS unsigned* MISC = (volatile LAS unsigned*)(lds + MISC_OFF);
    LAS int* moetab = (LAS int*)(lds + MOETAB_OFF);
    for (int u = tid; u < (LDS_BYTES - LDSCTL_OFF) / 4; u += 512) ((LAS unsigned*)(lds + LDSCTL_OFF))[u] = 0u;
    __syncthreads();
    const int lo = args.ph_lo, hi = args.ph_hi;
    const bool multi = (hi - lo) > 1;
    XcdBarrier bar; bar.bar = ctl + CW_BAR; bar.x = 0; bar.st = nullptr;
    if (multi) bar = xcd_barrier_post(ctl + CW_BAR, MISC + 8);
#define IN(k) (lo <= (k) && (k) < hi)
#define SEAM(k) do { if (IN(k) && IN((k) + 1)) xcd_barrier(bar); } while (0)

    if (IN(0)) { for (int rep = 0; rep < NREP(0); ++rep) { p0_prologue(in, ws, vcu * 8 + wave, G * 8, lane, (LAS float*)(lds + wave * 16384)); if (rep + 1 < NREP(0)) xcd_barrier(bar); } SEAM(0); }

    if (IN(1)) {
        pg8::DenseOrder S; S.init((const bf16_t*)(ws + WS_XN), (const bf16_t*)(ws + WS_WIN), NTOK, NPROJ, DM, G, bx);
        EpiInProj E{ws}; phase_stagger(vcu, 1);
        for (int rep = 0; rep < NREP(1); ++rep) { pg8::gemm_phase(lds, S, E); if (rep + 1 < NREP(1)) xcd_barrier(bar); } SEAM(1);
    }
    if (IN(2)) {
#ifdef HAVE_ATTN
        for (int rep = 0; rep < NREP(2); ++rep) { attn_phase<0>(lds, ws, in, G, vcu); if (rep + 1 < NREP(2)) xcd_barrier(bar); }
#endif
        SEAM(2);
    }
    if (IN(3)) {
        pg8::DenseOrder S; S.init((const bf16_t*)(ws + WS_Y), (const bf16_t*)(ws + WS_WOUT), NTOK, DM, DM, G, bx);
        EpiOutProj E{ws, in.x}; phase_stagger(vcu, 3);
        for (int rep = 0; rep < NREP(3); ++rep) { pg8::gemm_phase(lds, S, E); if (rep + 1 < NREP(3)) xcd_barrier(bar); } SEAM(3);
    }
    if (IN(4)) {
        pg8::DenseOrder S; S.init((const bf16_t*)(ws + WS_X1B), (const bf16_t*)(ws + WS_WR), NTOK, 256, DM, G, bx);
        EpiRoute E{ws, lds};
        pg8::gemm_phase<EpiRoute, pg8::DenseOrder, true>(lds, S, E); SEAM(4);
    }
    if (IN(5)) {
        moe_tables(ws, moetab);
        MoeOrder S{(const bf16_t*)(ws + WS_X1B), (const bf16_t*)(ws + WS_WGU), DM, 0, (const int*)(ws + WS_LTOK), moetab, G, vcu};
        EpiGateUp E{ws}; phase_stagger(vcu, 5);
        for (int rep = 0; rep < NREP(5); ++rep) { pg8::gemm_phase(lds, S, E); if (rep + 1 < NREP(5)) xcd_barrier(bar); } SEAM(5);
    }
    if (IN(6)) {
        if (!IN(5)) moe_tables(ws, moetab);
        MoeOrder S{(const bf16_t*)(ws + WS_HID), (const bf16_t*)(ws + WS_WD), EHID, 1, (const int*)(ws + WS_LTOK), moetab, G, vcu};
        EpiDown<0> E{ws, args.out}; phase_stagger(vcu, 6);
        for (int rep = 0; rep < NREP(6); ++rep) { pg8::gemm_phase(lds, S, E); if (rep + 1 < NREP(6)) xcd_barrier(bar); } SEAM(6);
    }
    if (IN(7)) {
        if (!IN(5) && !IN(6)) moe_tables(ws, moetab);
        MoeOrder S{(const bf16_t*)(ws + WS_HID), (const bf16_t*)(ws + WS_WD), EHID, 2, (const int*)(ws + WS_LTOK), moetab, G, vcu};
        EpiDown<1> E{ws, args.out}; phase_stagger(vcu, 7);
        for (int rep = 0; rep < NREP(7); ++rep) { pg8::gemm_phase(lds, S, E); if (rep + 1 < NREP(7)) xcd_barrier(bar); }
    }
#ifdef PROBE_EXTRA_BARRIERS
    if (multi) { for (int k = 0; k < PROBE_EXTRA_BARRIERS; ++k) xcd_barrier(bar); }
#endif
#undef IN
#undef SEAM
}

#ifdef PROBE_ATTN_ABL
__global__ void __launch_bounds__(512, 2) attn_probe(Args args) {
    extern __shared__ __attribute__((aligned(16))) unsigned char lds_raw_p[];
    LAS unsigned char* lds = (LAS unsigned char*)lds_raw_p;
    const int G = gridDim.x; const int bx = blockIdx.x; const int vcu = (G % 8 == 0) ? (bx % 8) * (G / 8) + bx / 8 : bx;
    attn_phase<PROBE_ATTN_ABL>(lds, args.ws, args.in, G, vcu);
}
#endif

#ifdef PROBE_UBENCH2
typedef float ub2_f32x16 __attribute__((ext_vector_type(16))); typedef short ub2_bf16x8 __attribute__((ext_vector_type(8))); typedef short ub2_s16x4 __attribute__((ext_vector_type(4)));
template <int V> __global__ void __launch_bounds__(512, 2) ubench2(float* sink, int iters) {
    __shared__ __attribute__((aligned(16))) unsigned char sm[57344];
    LAS unsigned char* lds = (LAS unsigned char*)sm;
    for (int i = threadIdx.x; i < 57344 / 4; i += 512) ((LAS float*)lds)[i] = -0.001f * (float)(i & 1023);
    __syncthreads();
    const int lane = threadIdx.x & 63, hi = lane >> 5, r32 = lane & 31;
    ub2_f32x16 pa0, pa1, pb0 = {}, pb1 = {}, o0 = {}, o1 = {}; ub2_bf16x8 q = {1, 2, 3, 4, 5, 6, 7, 8};
#pragma unroll
    for (int i = 0; i < 16; ++i) { pa0[i] = -0.001f * (float)(threadIdx.x + i); pa1[i] = -0.002f * (float)(threadIdx.x + i); }
    asm volatile("" : "+v"(q));
    const LAS unsigned char* kp = lds + hi * 1024 + r32 * 16;
    const LAS unsigned char* vp = lds + 8192 + ((lane >> 4) & 1) * 32 + (lane & 3) * 8 + (4 * hi + ((lane & 15) >> 2)) * 64;
    const LAS unsigned char* tp = lds + 16384 + ((lane & 3) * 2384 + ((2047 - lane) & ~3)) * 4 % 36864;
    float ls0 = 0.f, ls1 = 0.f;
#define UB_MFMA(a, b, c) ((V & 128) ? (c) : __builtin_amdgcn_mfma_f32_32x32x16_bf16(a, b, c, 0, 0, 0))
#define UB_VLOAD(g) do { if ((g) < 8) { if (V & 2) { vl[(g) % 3] = __builtin_bit_cast(ub2_s16x4, __builtin_amdgcn_ds_read_tr16_b64_v4i16((LAS ub2_s16x4*)(vp + ((g) & 1) * 4096 + ((g) >> 1) * 1024))); vh[(g) % 3] = __builtin_bit_cast(ub2_s16x4, __builtin_amdgcn_ds_read_tr16_b64_v4i16((LAS ub2_s16x4*)(vp + ((g) & 1) * 4096 + ((g) >> 1) * 1024 + 512))); } else { vl[(g) % 3] = ub2_s16x4{1, 2, 3, 4}; vh[(g) % 3] = ub2_s16x4{4, 3, 2, 1}; asm volatile("" : "+v"(vl[(g) % 3]), "+v"(vh[(g) % 3])); } } } while (0)
#define UB_SUMPACK(PC0, PC1, ks) do { _Pragma("unroll") for (int i = 0; i < 4; ++i) { const float a_ = (ks) == 0 ? PC0[2 * i] : (ks) == 1 ? PC0[8 + 2 * i] : (ks) == 2 ? PC1[2 * i] : PC1[8 + 2 * i]; const float b_ = (ks) == 0 ? PC0[2 * i + 1] : (ks) == 1 ? PC0[9 + 2 * i] : (ks) == 2 ? PC1[2 * i + 1] : PC1[9 + 2 * i]; \
            if (V & 32) { ls0 += a_; ls1 += b_; pw[(ks) & 1][i] = att::cvtpk(a_, b_); } else pw[(ks) & 1][i] = __builtin_bit_cast(unsigned, a_); } asm volatile("" : "+v"(ls0), "+v"(ls1), "+v"(pw[(ks) & 1])); } while (0)
#define UB_STEP(PC0, PC1, PN0, PN1) do { \
        ub2_bf16x8 kf[8]; \
        _Pragma("unroll") for (int i = 0; i < 8; ++i) { if (V & 1) kf[i] = *(const LAS ub2_bf16x8*)(kp + (i >> 1) * 2048 + (i & 1) * 512); else kf[i] = q; } \
        __builtin_amdgcn_sched_barrier(0); \
        _Pragma("unroll") for (int i = 0; i < 8; ++i) { \
            if (i & 1) PN1 = UB_MFMA(kf[i], q, PN1); else PN0 = UB_MFMA(kf[i], q, PN0); \
            if (V & 16) { _Pragma("unroll") for (int k = 0; k < 4; ++k) { const int e = 4 * i + k; if (e < 16) PC0[e] = __builtin_amdgcn_exp2f(PC0[e]); else PC1[e - 16] = __builtin_amdgcn_exp2f(PC1[e - 16]); } } \
            if (i < 4) asm volatile("" : "+v"(PC0)); else asm volatile("" : "+v"(PC1)); \
            __builtin_amdgcn_sched_barrier(0); } \
        if (V & 64) { asm volatile("s_waitcnt lgkmcnt(0)" ::: "memory"); __builtin_amdgcn_s_barrier(); __builtin_amdgcn_sched_barrier(0); } \
        v4u pw[2]; ub2_s16x4 vl[3], vh[3]; \
        UB_VLOAD(0); UB_VLOAD(1); UB_SUMPACK(PC0, PC1, 0); __builtin_amdgcn_sched_barrier(0); \
        _Pragma("unroll") for (int g = 0; g < 8; ++g) { const int ks = g / 2, d0 = g % 2; \
            UB_VLOAD(g + 2); \
            { const ub2_s16x4 a_ = vl[g % 3], b_ = vh[g % 3]; const ub2_bf16x8 vf = {a_[0], a_[1], a_[2], a_[3], b_[0], b_[1], b_[2], b_[3]}; \
              if (d0) o1 = UB_MFMA(__builtin_bit_cast(ub2_bf16x8, pw[ks & 1]), vf, o1); else o0 = UB_MFMA(__builtin_bit_cast(ub2_bf16x8, pw[ks & 1]), vf, o0); } \
            if (d0 == 0 && ks < 3) UB_SUMPACK(PC0, PC1, ks + 1); \
            if (g == 5) { if (V & 4) { _Pragma("unroll") for (int c = 0; c < 4; ++c) { const f32x4 c0 = *(const LAS f32x4*)(tp + c * 32), c1 = *(const LAS f32x4*)(tp + 128 + c * 32); \
                        PC0[4 * c] = c0[0]; PC0[4 * c + 1] = c0[1]; PC0[4 * c + 2] = c0[2]; PC0[4 * c + 3] = c0[3]; PC1[4 * c] = c1[0]; PC1[4 * c + 1] = c1[1]; PC1[4 * c + 2] = c1[2]; PC1[4 * c + 3] = c1[3]; } } \
                else { asm volatile("" : "+v"(PC0), "+v"(PC1)); } } \
            __builtin_amdgcn_sched_barrier(0); } \
        if (V & 8) { asm volatile("s_waitcnt lgkmcnt(0)" ::: "memory"); __builtin_amdgcn_s_barrier(); __builtin_amdgcn_sched_barrier(0); } } while (0)
    for (int it = 0; it < iters; it += 2) { UB_STEP(pa0, pa1, pb0, pb1); UB_STEP(pb0, pb1, pa0, pa1); }
    float s = ls0 + ls1;
#pragma unroll
    for (int i = 0; i < 16; ++i) s += o0[i] + o1[i] + pa0[i] + pa1[i] + pb0[i] + pb1[i];
    if (s == 123.456f) sink[threadIdx.x] = s;
#undef UB_VLOAD
#undef UB_SUMPACK
#undef UB_STEP
#undef UB_MFMA
}
#endif

#ifdef PROBE_UBENCH
typedef float ub_f32x16 __attribute__((ext_vector_type(16))); typedef short ub_bf16x8 __attribute__((ext_vector_type(8)));
template <int V> __global__ void __launch_bounds__(512, 2) ubench(float* sink, int iters) {
    ub_f32x16 a0 = {}, a1 = {}; ub_bf16x8 x = {1, 2, 3, 4, 5, 6, 7, 8}, y = {8, 7, 6, 5, 4, 3, 2, 1};
    float e[32];
#pragma unroll
    for (int i = 0; i < 32; ++i) e[i] = -0.001f * (float)(threadIdx.x + i);
    asm volatile("" : "+v"(x), "+v"(y));
    for (int it = 0; it < iters; ++it) {
#pragma unroll
        for (int g = 0; g < 16; ++g) {
            if (V & 1) { if (g & 1) a1 = __builtin_amdgcn_mfma_f32_32x32x16_bf16(x, y, a1, 0, 0, 0); else a0 = __builtin_amdgcn_mfma_f32_32x32x16_bf16(x, y, a0, 0, 0, 0); }
            if (V & 2) {
#pragma unroll
                for (int k = 0; k < 4; ++k) { const int i = (4 * g + k) & 31; e[i] = __builtin_amdgcn_exp2f(e[i]) - 1.0f; } }
            if (V & 4) {
#pragma unroll
                for (int k = 0; k < 2; ++k) { const int i = (2 * g + k) & 31; e[i] = __builtin_amdgcn_exp2f(e[i]) - 1.0f; } }
            __builtin_amdgcn_sched_barrier(0);
        }
    }
    float s = 0.f;
#pragma unroll
    for (int i = 0; i < 32; ++i) s += e[i];
#pragma unroll
    for (int i = 0; i < 16; ++i) s += a0[i] + a1[i];
    if (s == 123.456f) sink[threadIdx.x] = s;
}
#endif

extern "C" void kernel_launch(void* const* d_in, const int* in_sizes, int n_in, void* d_out, int out_size, void* d_ws, size_t ws_size, hipStream_t stream) {
    static int grid = 0;
    if (grid == 0) {
        if (n_in != 20 || in_sizes[0] != NTOK * DM || out_size != NTOK * DM || ws_size < WS_END) { fprintf(stderr, "kernel_launch: unexpected shapes (n_in %d, ws %zu)\n", n_in, ws_size); grid = -1; return; }
        int dev = 0, cus = 0, per_cu = 0;
        if (hipGetDevice(&dev) != hipSuccess || hipDeviceGetAttribute(&cus, hipDeviceAttributeMultiprocessorCount, dev) != hipSuccess) { grid = -1; return; }
        if (hipFuncSetAttribute((const void*)mega, hipFuncAttributeMaxDynamicSharedMemorySize, LDS_BYTES) != hipSuccess) { fprintf(stderr, "kernel_launch: hipFuncSetAttribute failed\n"); grid = -1; return; }
        if (hipOccupancyMaxActiveBlocksPerMultiprocessor(&per_cu, (const void*)mega, 512, LDS_BYTES) != hipSuccess || per_cu < 1) { fprintf(stderr, "kernel_launch: occupancy query says %d blocks per CU\n", per_cu); (void)hipGetLastError(); grid = -1; return; }
        grid = cus;
    }
    if (grid < 0) return;
    Args a{};
    const float** ip = (const float**)&a.in;
    for (int i = 0; i < 20; ++i) ip[i] = (const float*)d_in[i];
    a.out = (float*)d_out; a.ws = (unsigned char*)d_ws; a.ph_lo = 0; a.ph_hi = N_PHASES;
    (void)hipMemsetAsync((unsigned char*)d_ws + WS_CTL, 0, CTL_ZERO_BYTES, stream);
    hipLaunchKernelGGL(mega, dim3(grid), dim3(512), LDS_BYTES, stream, a);
#ifdef PROBE_ATTN_ABL
    { static bool ad = false; if (!ad) { (void)hipFuncSetAttribute((const void*)attn_probe, hipFuncAttributeMaxDynamicSharedMemorySize, LDS_BYTES); ad = true; }
      hipLaunchKernelGGL(attn_probe, dim3(grid), dim3(512), LDS_BYTES, stream, a); }
#endif
#ifdef PROBE_UBENCH2
    hipLaunchKernelGGL(ubench2<PROBE_UBENCH2>, dim3(grid), dim3(512), 0, stream, (float*)((unsigned char*)d_ws + WS_SS), 1000);
#endif
#ifdef PROBE_UBENCH
    hipLaunchKernelGGL(ubench<PROBE_UBENCH>, dim3(grid), dim3(PROBE_UB_THREADS), 0, stream, (float*)((unsigned char*)d_ws + WS_SS), 1000);
#endif
#ifdef PROBE_EXTRA_LO
    for (int k = PROBE_EXTRA_LO; k < PROBE_EXTRA_HI; ++k) { a.ph_lo = k; a.ph_hi = k + 1; hipLaunchKernelGGL(mega, dim3(grid), dim3(512), LDS_BYTES, stream, a); }
#endif
}
```

```cpp
#include <hip/hip_runtime.h>
#include <cstdint>
#include <cstdio>

typedef unsigned short bf16_t;
typedef unsigned v4u __attribute__((ext_vector_type(4)));
typedef unsigned v2u __attribute__((ext_vector_type(2)));
typedef float f32x4 __attribute__((ext_vector_type(4)));
#define LAS __attribute__((address_space(3)))

constexpr int BATCH = 32, SEQ = 2048, DM = 1024, NTOK = BATCH * SEQ;
constexpr int HD = 64, HDIFF = 4, HMOBA = 8, NPROJ = 3072;
constexpr int NEXP = 32, EHID = 256, NLIST = 64;
constexpr int LIST_CAP = NTOK;
constexpr float RMS_EPS = 1e-6f;
constexpr float LOG2E = 1.4426950408889634f;
constexpr float C2 = 0.125f * LOG2E;
constexpr float LAMBDA_INIT = 0.2f;

constexpr size_t MiB = 1u << 20;
constexpr size_t WS_CTL = 0, CTL_ZERO_BYTES = 1 * MiB;
constexpr size_t WS_CONST = 1 * MiB;
constexpr size_t WS_WIN = 2 * MiB, WS_WOUT = 8 * MiB, WS_WR = 10 * MiB, WS_WGU = 12 * MiB, WS_WD = 44 * MiB;
constexpr size_t WS_QD = 64 * MiB, WS_KD = 128 * MiB, WS_VD = 192 * MiB, WS_QM = 256 * MiB, WS_KM = 320 * MiB, WS_VM = 384 * MiB;
constexpr size_t WS_XN = 448 * MiB, WS_Y = 448 * MiB;
constexpr size_t WS_X1B = 576 * MiB, WS_SS = 704 * MiB  , WS_R2 = 708 * MiB, WS_KMEAN = 709 * MiB;
constexpr size_t WS_PA = 64 * MiB, WS_HID = 192 * MiB, WS_LTOK = 272 * MiB, WS_LW = 288 * MiB;
constexpr size_t WS_END = 711 * MiB;
constexpr size_t WS_HID2 = 64 * MiB  , WS_LP = 320 * MiB  , WS_PTOK = 336 * MiB  ;
constexpr int NPAIR = 112;
constexpr int CW_PCNT = 16384;
constexpr int CW_CNT = 1024;
#ifndef DBG_MEASURE
#define DBG_MEASURE 0
#endif
constexpr int CF_DBG = 8;
constexpr int CF_LAMBDA = 0, CF_OFF = 16, CF_GAIN = 64  , CF_BT = 1024;

__device__ __forceinline__ float bf2f(bf16_t v) { return __uint_as_float(((unsigned)v) << 16); }
__device__ __forceinline__ unsigned f2bf(float f) { unsigned u = __float_as_uint(f); return (u + 0x7fffu + ((u >> 16) & 1u)) >> 16; }
__device__ __forceinline__ unsigned pk2(float lo, float hi) { return f2bf(lo) | (f2bf(hi) << 16); }
__device__ __forceinline__ float wave_sum(float v) {
#pragma unroll
    for (int o = 1; o < 64; o <<= 1) v += __shfl_xor(v, o);
    return v;
}
__device__ __forceinline__ float wave_max(float v) {
#pragma unroll
    for (int o = 1; o < 64; o <<= 1) v = fmaxf(v, __shfl_xor(v, o));
    return v;
}
__host__ __device__ __forceinline__ int phys_in(int c) { const int pn = c >> 8, cc = c & 255; return 256 * pn + 128 * ((cc >> 5) & 1) + 32 * (cc >> 6) + (cc & 31); }
__device__ __forceinline__ int t5_bucket(int d) {
    if (d < 16) return d;
    const float nf = (float)d;
    int large = 16 + (int)(logf(nf / 16.0f) / 4.852030263919617f * 16.0f);
    return large < 31 ? large : 31;
}

struct Inputs {
    const float *x, *norm1_g, *w_in, *diff_q_g, *diff_k_g, *lq1, *lk1, *lq2, *lk2, *diff_sub_g, *moba_q_g, *moba_k_g, *rel_bias, *w_out, *norm2_g,
        *router_group, *router_expert, *w_gate, *w_up, *w_down;
};

__device__ __forceinline__ void p0_tr_item(const float* W, int ldw, int k0, int n_src, const float* gk, bf16_t* dst, int drow0, int dpitch, LAS float* scr, int lane) {
    float wv[32];
#pragma unroll
    for (int i = 0; i < 32; ++i) wv[i] = W[(size_t)(k0 + 2 * i + (lane >> 5)) * ldw + n_src + (lane & 31)];
#pragma unroll
    for (int i = 0; i < 32; ++i) { const int kk = 2 * i + (lane >> 5); float v = wv[i]; if (gk) v *= gk[k0 + kk]; scr[kk * 33 + (lane & 31)] = v; }
    asm volatile("s_waitcnt lgkmcnt(0)" ::: "memory");
    const int c = lane & 7;
#pragma unroll
    for (int j = 0; j < 4; ++j) {
        const int n = (lane >> 3) + 8 * j; const LAS float* s = scr + (8 * c) * 33 + n;
        v4u o; o.x = pk2(s[0 * 33], s[1 * 33]); o.y = pk2(s[2 * 33], s[3 * 33]); o.z = pk2(s[4 * 33], s[5 * 33]); o.w = pk2(s[6 * 33], s[7 * 33]);
        *(v4u*)(dst + (size_t)(drow0 + n) * dpitch + k0 + 8 * c) = o;
    }
    asm volatile("s_waitcnt lgkmcnt(0)" ::: "memory");
}

__device__ __forceinline__ void p0_prologue(const Inputs& in, unsigned char* ws, int gw, int NGW, int lane, LAS float* scr) {
    bf16_t* WIN_T = (bf16_t*)(ws + WS_WIN); bf16_t* WOUT_T = (bf16_t*)(ws + WS_WOUT); bf16_t* WR_T = (bf16_t*)(ws + WS_WR);
    bf16_t* WGU_T = (bf16_t*)(ws + WS_WGU); bf16_t* WD_T = (bf16_t*)(ws + WS_WD); bf16_t* XN = (bf16_t*)(ws + WS_XN);
    float* CF = (float*)(ws + WS_CONST);
    constexpr int I_IN = 16 * 96, I_OUT = 16 * 32, I_GU = 32 * 16 * 16, I_D = 32 * 4 * 32, NITEMS = I_IN + I_OUT + I_GU + I_D;
    for (int it = gw; it < NITEMS; it += NGW) {
        int r = it;
        if (r < I_IN) {
            const int kb = r / 96, nb = r % 96, p0 = 32 * nb, pn = p0 >> 8, pp = p0 & 255, bj = pp >> 7, wc = (pp >> 5) & 3;
            p0_tr_item(in.w_in, NPROJ, 64 * kb, 256 * pn + 64 * wc + 32 * bj, in.norm1_g, WIN_T, p0, DM, scr, lane); continue; }
        r -= I_IN;
        if (r < I_OUT) { const int kb = r / 32, nb = r % 32; p0_tr_item(in.w_out, DM, 64 * kb, 32 * nb, nullptr, WOUT_T, 32 * nb, DM, scr, lane); continue; }
        r -= I_OUT;
        if (r < I_GU) {
            const int e = r / 256, rr = r % 256, kb = rr / 16, nb = rr % 16, p0 = 32 * nb, pn = p0 >> 8, bj = (p0 >> 7) & 1, j0 = p0 & 127;
            const float* src = (bj ? in.w_up : in.w_gate) + (size_t)e * DM * EHID;
            p0_tr_item(src, EHID, 64 * kb, 128 * pn + j0, in.norm2_g, WGU_T + (size_t)e * 512 * DM, p0, DM, scr, lane); continue; }
        r -= I_GU;
        { const int e = r / 128, rr = r % 128, kb = rr / 32, nb = rr % 32;
          p0_tr_item(in.w_down + (size_t)e * EHID * DM, DM, 64 * kb, 32 * nb, nullptr, WD_T + (size_t)e * DM * EHID, 32 * nb, EHID, scr, lane); }
    }
    for (int idx = gw * 64 + lane; idx < 256 * DM; idx += NGW * 64) {
        const int p = idx >> 10, k = idx & 1023, g = (p >> 5) & 3, i = p & 31; float v = 0.f;
        if (p < 128) { if (i < 8) v = in.norm2_g[k] * in.router_expert[((size_t)g * DM + k) * 8 + i]; else if (i < 12) v = in.norm2_g[k] * in.router_group[k * 4 + (i - 8)]; }
        WR_T[idx] = (bf16_t)f2bf(v);
    }
    for (int idx = gw * 64 + lane; idx < 12 * 2048; idx += NGW * 64) {
        const int h = idx >> 11, d = idx & 2047; CF[CF_BT + idx] = in.rel_bias[t5_bucket(d) * 12 + h] * LOG2E;
    }
    if (gw == 0) {
        float a = in.lq1[lane] * in.lk1[lane], b = in.lq2[lane] * in.lk2[lane];
        a = wave_sum(a); b = wave_sum(b);
        const float mqd = wave_max(fabsf(in.diff_q_g[lane])), mkd = wave_max(fabsf(in.diff_k_g[lane]));
        const float mqm = wave_max(fabsf(in.moba_q_g[lane])), mkm = wave_max(fabsf(in.moba_k_g[lane]));
        if (lane == 0) CF[CF_LAMBDA] = expf(a) - expf(b) + LAMBDA_INIT;
        CF[CF_GAIN + lane] = in.diff_q_g[lane]; CF[CF_GAIN + 64 + lane] = in.diff_k_g[lane]; CF[CF_GAIN + 128 + lane] = in.moba_q_g[lane]; CF[CF_GAIN + 192 + lane] = in.moba_k_g[lane];
        if (lane < 12) {
            float mb = -1e30f; for (int bk = 0; bk < 32; ++bk) mb = fmaxf(mb, in.rel_bias[bk * 12 + lane]);
            const float qk = lane < 4 ? mqd * mkd : mqm * mkm;
            CF[CF_OFF + lane] = (8.0f * qk + mb) * LOG2E;
        }
    }
    for (int m0 = gw * 4; m0 < NTOK; m0 += NGW * 4) {
        f32x4 v[4][4];
#pragma unroll
        for (int rr = 0; rr < 4; ++rr) { const f32x4* xr = (const f32x4*)(in.x + (size_t)(m0 + rr) * DM) + lane;
#pragma unroll
            for (int j = 0; j < 4; ++j) v[rr][j] = __builtin_nontemporal_load(xr + 64 * j); }
#pragma unroll
        for (int rr = 0; rr < 4; ++rr) { float s = 0.f;
#pragma unroll
            for (int j = 0; j < 4; ++j) s += (v[rr][j].x * v[rr][j].x + v[rr][j].y * v[rr][j].y) + (v[rr][j].z * v[rr][j].z + v[rr][j].w * v[rr][j].w);
            const float r = rsqrtf(wave_sum(s) * (1.f / DM) + RMS_EPS);
            unsigned long long* o8 = (unsigned long long*)(XN + (size_t)(m0 + rr) * DM) + lane;
#pragma unroll
            for (int j = 0; j < 4; ++j) o8[64 * j] = (unsigned long long)pk2(v[rr][j].x * r, v[rr][j].y * r) | ((unsigned long long)pk2(v[rr][j].z * r, v[rr][j].w * r) << 32); }
    }
}

namespace pg8 {
typedef short bf16x8 __attribute__((ext_vector_type(8)));
constexpr int BM = 256, BK = 64, HALF = 128, HTB = HALF * BK * 2, STAGE_BYTES = 8 * HTB, NXCD = 8, WGM = 8;

__host__ __device__ __forceinline__ int lds_byte(int r, int c) { const int st = (r >> 4) * 2 + (c >> 5), rr = r & 15, cc = c & 31, ob = rr * 64 + cc * 2; return st * 1024 + (ob ^ (((ob >> 9) & 1) << 5)); }
__host__ __device__ __forceinline__ void stage_rc(int b, int& R, int& C) { const int st = b / 1024, sb = b % 1024, swz = sb ^ (((sb >> 9) & 1) << 5); R = (st >> 1) * 16 + swz / 64; C = (st & 1) * 32 + (swz % 64) / 2; }
__host__ __device__ __forceinline__ int perm32(int rho) { const int n = rho >> 4, i = rho & 15; return 8 * (i >> 2) + 4 * n + (i & 3); }

struct Unit { int pm, pn, a0, a1; };

struct DenseOrder {
    const bf16_t* A; const bf16_t* Bt; int K; int nM, nN, nwg, G, c;
    __device__ void init(const bf16_t* A_, const bf16_t* Bt_, int M, int N, int K_, int G_, int c_) { A = A_; Bt = Bt_; K = K_; nM = M / BM; nN = N / BM; nwg = nM * nN; G = G_; c = c_; }
    __device__ __forceinline__ bool next(int i, Unit& u) const {
        const long L = (long)i * G + c; if (L >= nwg) return false;
        int wgid = (int)L; { const int q = nwg / NXCD, r = nwg % NXCD, xcd = wgid % NXCD, off = wgid / NXCD; wgid = (xcd < r ? xcd * (q + 1) : r * (q + 1) + (xcd - r) * q) + off; }
        const int nig = WGM * nN, gid = wgid / nig, fm = gid * WGM, gsz = (nM - fm) < WGM ? (nM - fm) : WGM;
        u.pm = fm + ((wgid % nig) % gsz); u.pn = (wgid % nig) / gsz; u.a0 = 0; u.a1 = 256; return true;
    }
    __device__ __forceinline__ const char* abase() const { return (const char*)A; }
    __device__ __forceinline__ unsigned arow(const Unit& u, int r) const { return (unsigned)(u.pm * BM + r) * (unsigned)K * 2u; }
    __device__ __forceinline__ const char* bbase(const Unit& u) const { return (const char*)Bt + (size_t)u.pn * BM * K * 2; }
};

typedef float f32x2 __attribute__((ext_vector_type(2)));
__device__ __forceinline__ unsigned cvt_pk_bf16(float lo, float hi) { unsigned r; asm volatile("v_cvt_pk_bf16_f32 %0, %1, %2" : "=v"(r) : "v"(lo), "v"(hi)); return r; }

template <class Epi, class Sched, bool HALFN = false, bool SPLITB = false>
__device__ __forceinline__ void gemm_phase(LAS unsigned char* lds, const Sched& S, const Epi& E) {
    int tid_ = threadIdx.x; asm volatile("" : "+v"(tid_));
    const int tid = tid_, wid = __builtin_amdgcn_readfirstlane(tid >> 6), lane = tid & 63, wr = wid >> 2, wc = wid & 3, fr = lane & 15, fq = lane >> 4;
    const int K = S.K, nt = K / BK; int LDB = K; if constexpr (SPLITB) LDB = S.ldb();
    int RA[2]; unsigned cA2[2], voffB[2];
#pragma unroll
    for (int i = 0; i < 2; ++i) { int R, C; stage_rc(tid * 16 + i * 8192, R, C); const int Rb = (R & ~31) + perm32(R & 31);
        RA[i] = R; cA2[i] = (unsigned)C * 2u; voffB[i] = (unsigned)(Rb * LDB + C) * 2u; }
    const size_t kstep = (size_t)(BK * 2);
    const size_t hstep = (size_t)HALF * LDB * 2;
    const unsigned ldsw = (unsigned)wid * 1024u;
    const int aoff = lds_byte(wr * 64 + fr, fq * 8), boff = lds_byte(wc * 32 + fr, fq * 8);
#define PG8_SA(b, h) (((b) * 2 + (h)) * HTB)
#define PG8_SB(b, h) ((4 + (b) * 2 + (h)) * HTB)
#define PG8_STAGE(bufoff, gbase, voff) do { _Pragma("unroll") for (int _i = 0; _i < 2; ++_i) \
        __builtin_amdgcn_global_load_lds((const unsigned*)((const char*)(gbase) + (voff)[_i]), (LAS unsigned*)(lds + (bufoff) + ldsw + _i * 8192), 16, 0, 0); } while (0)
#define PG8_LDA(dst, b, h) do { _Pragma("unroll") for (int m = 0; m < 4; ++m) _Pragma("unroll") for (int k = 0; k < 2; ++k) dst[m][k] = *(const LAS bf16x8*)(lds + PG8_SA(b, h) + aoff + m * 2048 + k * 1024); } while (0)
#define PG8_LDB(dst, b, h) do { _Pragma("unroll") for (int n = 0; n < 2; ++n) _Pragma("unroll") for (int k = 0; k < 2; ++k) dst[n][k] = *(const LAS bf16x8*)(lds + PG8_SB(b, h) + boff + n * 2048 + k * 1024); } while (0)
#define PG8_MMA(ai, bj, At, Bt) do { __builtin_amdgcn_s_setprio(1); _Pragma("unroll") for (int m = 0; m < 4; ++m) _Pragma("unroll") for (int n = 0; n < 2; ++n) _Pragma("unroll") for (int k = 0; k < 2; ++k) \
        acc[ai][bj][m][n] = __builtin_amdgcn_mfma_f32_16x16x32_bf16(Bt[n][k], At[m][k], acc[ai][bj][m][n], 0, 0, 0); __builtin_amdgcn_s_setprio(0); } while (0)
#define PG8_WAIT_V(n) asm volatile("s_waitcnt vmcnt(" #n ")" ::: "memory")
#define PG8_WAIT_L(n) asm volatile("s_waitcnt lgkmcnt(" #n ")" ::: "memory")
#define PG8_BAR __builtin_amdgcn_s_barrier()
#define PG8_SCHED __builtin_amdgcn_sched_barrier(0)
    Unit cur, nxt; int ui = 0;
    if (!S.next(0, cur)) return;
    f32x4 acc[2][2][4][2];
#pragma unroll
    for (int a = 0; a < 2; ++a)
#pragma unroll
        for (int b = 0; b < 2; ++b)
#pragma unroll
            for (int m = 0; m < 4; ++m)
#pragma unroll
                for (int n = 0; n < 2; ++n) acc[a][b][m][n] = (f32x4){0.f, 0.f, 0.f, 0.f};
    bf16x8 At[4][2], B0[2][2], B1[2][2];
    const char* const Ab = S.abase();
    unsigned oC[2][2], oN[2][2];
#pragma unroll
    for (int h = 0; h < 2; ++h)
#pragma unroll
        for (int i = 0; i < 2; ++i) { oC[h][i] = S.arow(cur, h * HALF + RA[i]) + cA2[i]; oN[h][i] = oC[h][i]; }
    const char* cB = S.bbase(cur); const char* cBh = cB; if constexpr (SPLITB) cBh = S.bbase2(cur);
    PG8_STAGE(PG8_SB(0, 0), cB, voffB); PG8_STAGE(PG8_SB(0, 1), cB + hstep, voffB); PG8_STAGE(PG8_SA(0, 0), Ab, oC[0]); PG8_STAGE(PG8_SA(0, 1), Ab, oC[1]);
    if (wr == 1) PG8_BAR;
    PG8_WAIT_V(2); PG8_BAR;
    PG8_STAGE(PG8_SB(1, 0), cB + kstep, voffB); PG8_STAGE(PG8_SA(1, 0), Ab + kstep, oC[0]); PG8_STAGE(PG8_SB(1, 1), cB + hstep + kstep, voffB);
    PG8_WAIT_V(6); PG8_BAR;
    for (;;) {
        const bool has_next = S.next(ui + 1, nxt);
        const char* nB = has_next ? S.bbase(nxt) : cB; const char* nBh = nB; if constexpr (SPLITB) { if (has_next) nBh = S.bbase2(nxt); }
        if (has_next) {
#pragma unroll
            for (int h = 0; h < 2; ++h)
#pragma unroll
                for (int i = 0; i < 2; ++i) oN[h][i] = S.arow(nxt, h * HALF + RA[i]) + cA2[i];
        }
        for (int t = 0; t < nt; t += 2) {
            const bool last = (t == nt - 2);
            const char* a1 = Ab + (size_t)(t + 1) * kstep;
            const char* a2 = last ? Ab : Ab + (size_t)(t + 2) * kstep; const char* b2 = last ? nB : ((SPLITB && t + 2 >= (nt >> 1)) ? cBh : cB) + (size_t)(t + 2) * kstep;
            const char* a3 = a2 + kstep; const char* b3 = b2 + kstep;
            unsigned o2[2][2];
#pragma unroll
            for (int h = 0; h < 2; ++h)
#pragma unroll
                for (int i = 0; i < 2; ++i) o2[h][i] = last ? oN[h][i] : oC[h][i];
            PG8_LDB(B0, 0, 0); PG8_LDB(B1, 0, 1); PG8_SCHED; PG8_LDA(At, 0, 0); PG8_STAGE(PG8_SA(1, 1), a1, oC[1]);
            PG8_WAIT_V(8); PG8_WAIT_L(0); PG8_BAR; PG8_MMA(0, 0, At, B0); if (!HALFN) PG8_MMA(0, 1, At, B1); PG8_BAR; PG8_SCHED;
            PG8_LDA(At, 0, 1); PG8_STAGE(PG8_SB(0, 0), b2, voffB); PG8_STAGE(PG8_SB(0, 1), b2 + hstep, voffB); PG8_STAGE(PG8_SA(0, 0), a2, o2[0]);
            PG8_WAIT_V(8); PG8_WAIT_L(0); PG8_BAR; PG8_MMA(1, 0, At, B0); if (!HALFN) PG8_MMA(1, 1, At, B1); PG8_BAR; PG8_SCHED;
            PG8_LDB(B0, 1, 0); PG8_LDB(B1, 1, 1); PG8_SCHED; PG8_LDA(At, 1, 0); PG8_STAGE(PG8_SA(0, 1), a2, o2[1]);
            PG8_WAIT_V(8); PG8_WAIT_L(0); PG8_BAR; PG8_MMA(0, 0, At, B0); if (!HALFN) PG8_MMA(0, 1, At, B1); PG8_BAR; PG8_SCHED;
            PG8_LDA(At, 1, 1); PG8_STAGE(PG8_SB(1, 0), b3, voffB); PG8_STAGE(PG8_SB(1, 1), b3 + hstep, voffB); PG8_STAGE(PG8_SA(1, 0), a3, o2[0]);
            PG8_WAIT_V(8); PG8_WAIT_L(0); PG8_BAR; PG8_MMA(1, 0, At, B0); if (!HALFN) PG8_MMA(1, 1, At, B1); PG8_BAR; PG8_SCHED;
        }
        if (wr == 0) PG8_BAR;
        { int frE = fr, fqE = fq; asm volatile("" : "+v"(frE), "+v"(fqE));
          E(acc, cur, wr, wc, frE, fqE); }
        if (!has_next) break;
#pragma unroll
        for (int a = 0; a < 2; ++a)
#pragma unroll
            for (int b = 0; b < 2; ++b)
#pragma unroll
                for (int m = 0; m < 4; ++m)
#pragma unroll
                    for (int n = 0; n < 2; ++n) acc[a][b][m][n] = (f32x4){0.f, 0.f, 0.f, 0.f};
        cur = nxt; cB = nB; cBh = nBh; ++ui;
#pragma unroll
        for (int h = 0; h < 2; ++h)
#pragma unroll
            for (int i = 0; i < 2; ++i) oC[h][i] = oN[h][i];
        if (wr == 1) PG8_BAR;
    }
    PG8_WAIT_V(0);
    PG8_BAR;
#undef PG8_SA
#undef PG8_SB
#undef PG8_STAGE
#undef PG8_LDA
#undef PG8_LDB
#undef PG8_MMA
#undef PG8_WAIT_V
#undef PG8_WAIT_L
#undef PG8_BAR
#undef PG8_SCHED
}
}

constexpr size_t WS_LR = 304 * MiB;
constexpr int SS_PARTS = 16;
constexpr int RING_BYTES = 131072  , LDSCTL_OFF = 139264  , MISC_OFF = LDSCTL_OFF + 320, MOETAB_OFF = LDSCTL_OFF + 1024;
constexpr int LDS_BYTES = 147456;
constexpr int MT_CNT = 0, MT_ALL = 64, MT_R0 = 64 + 65, MT_R1 = 64 + 65 + 33;
constexpr int PAIRTAB_OFF = LDSCTL_OFF + 6656;
constexpr int PT_CNT = 0, PT_ALL = NPAIR;

__device__ __forceinline__ f32x4 ldg4(const float* p) { return *(const f32x4*)p; }

struct MoeOrder {
    const bf16_t* A; const bf16_t* Bt; int K; int mode; const int* ltok; const LAS int* tab; int G, c;
    __device__ __forceinline__ bool next(int i, pg8::Unit& u) const {
        const int L = i * G + c;
        if (mode == 3) {
            const LAS int* pt = tab + (PAIRTAB_OFF - MOETAB_OFF) / 4;
            const int T = L >> 2; if (T >= pt[PT_ALL + NPAIR]) return false;
            int lo = 0;
#pragma unroll
            for (int s = 64; s >= 1; s >>= 1) if (lo + s < NPAIR && pt[PT_ALL + lo + s] <= T) lo += s;
            const int tile = T - pt[PT_ALL + lo]; u.pm = T; u.pn = L & 3; u.a0 = lo | (tile << 8); const int v = pt[PT_CNT + lo] - tile * 256; u.a1 = v < 256 ? v : 256; return true;
        }
        if (mode == 0) {
            const int T = L >> 1; if (T >= tab[MT_ALL + 64]) return false;
            int lo = 0;
#pragma unroll
            for (int s = 32; s >= 1; s >>= 1) if (tab[MT_ALL + lo + s] <= T) lo += s;
            const int tile = T - tab[MT_ALL + lo]; u.pm = T; u.pn = L & 1; u.a0 = lo | (tile << 8); const int v = tab[MT_CNT + lo] - tile * 256; u.a1 = v < 256 ? v : 256; return true;
        } else {
            const int T = L >> 2; const int tb = mode == 1 ? MT_R0 : MT_R1; if (T >= tab[tb + 32]) return false;
            int lo = 0;
#pragma unroll
            for (int s = 16; s >= 1; s >>= 1) if (tab[tb + lo + s] <= T) lo += s;
            const int list = 2 * lo + (mode - 1), tile = T - tab[tb + lo]; u.pm = tab[MT_ALL + list] + tile; u.pn = L & 3; u.a0 = list | (tile << 8);
            const int v = tab[MT_CNT + list] - tile * 256; u.a1 = v < 256 ? v : 256; return true;
        }
    }
    __device__ __forceinline__ const char* abase() const { return (const char*)A; }
    __device__ __forceinline__ unsigned arow(const pg8::Unit& u, int r) const {
        if (mode == 0) { const int list = u.a0 & 255, tile = u.a0 >> 8; const int tok = r < u.a1 ? ltok[(size_t)list * LIST_CAP + tile * 256 + r] : 0; return (unsigned)tok * (unsigned)(DM * 2); }
        if (mode == 3) return (unsigned)(u.pm * 256 + r) * (unsigned)(2 * EHID * 2);
        return (unsigned)(u.pm * 256 + r) * (unsigned)(EHID * 2);
    }
    __device__ __forceinline__ static void pair_experts(int p, int& elo, int& ehi) { const int g = p / 28; int q = p - g * 28, lo = 0;
#pragma unroll
        for (int k = 0; k < 7; ++k) if (q >= 7 - lo) { q -= 7 - lo; ++lo; }
        elo = g * 8 + lo; ehi = g * 8 + lo + 1 + q; }
    __device__ __forceinline__ int ldb() const { return EHID; }
    __device__ __forceinline__ const char* bbase2(const pg8::Unit& u) const { int elo, ehi; pair_experts(u.a0 & 255, elo, ehi); return (const char*)Bt + ((size_t)ehi * DM + u.pn * 256) * EHID * 2 - (size_t)EHID * 2; }
    __device__ __forceinline__ const char* bbase(const pg8::Unit& u) const {
        if (mode == 3) { int elo, ehi; pair_experts(u.a0 & 255, elo, ehi); return (const char*)Bt + ((size_t)elo * DM + u.pn * 256) * EHID * 2; }
        const int e = (u.a0 & 255) >> 1;
        if (mode == 0) return (const char*)Bt + ((size_t)e * 512 + u.pn * 256) * DM * 2;
        return (const char*)Bt + ((size_t)e * DM + u.pn * 256) * EHID * 2;
    }
};
__device__ __forceinline__ void moe_tables(unsigned char* ws, LAS int* tab) {
    LAS int* pt = tab + (PAIRTAB_OFF - MOETAB_OFF) / 4;
    if (threadIdx.x < 64) tab[MT_CNT + threadIdx.x] = (int)__hip_atomic_load((unsigned*)(ws + WS_CTL) + CW_CNT + 64 * threadIdx.x, __ATOMIC_RELAXED, __HIP_MEMORY_SCOPE_AGENT);
#ifndef DEBUG_NOPT
    else if (threadIdx.x < 64 + NPAIR) pt[PT_CNT + threadIdx.x - 64] = (int)__hip_atomic_load((unsigned*)(ws + WS_CTL) + CW_PCNT + 64 * (threadIdx.x - 64), __ATOMIC_RELAXED, __HIP_MEMORY_SCOPE_AGENT);
#endif
    __syncthreads();
#ifndef DEBUG_NOPT
    if (threadIdx.x == 64) { int a = 0; for (int l = 0; l < NPAIR; ++l) { pt[PT_ALL + l] = a; a += (pt[PT_CNT + l] + 255) >> 8; } pt[PT_ALL + NPAIR] = a; }
#endif
    if (threadIdx.x == 0) { int a = 0, r0 = 0, r1 = 0;
        for (int l = 0; l < 64; ++l) { const int t = (tab[MT_CNT + l] + 255) >> 8; tab[MT_ALL + l] = a; a += t; if (l & 1) { tab[MT_R1 + (l >> 1)] = r1; r1 += t; } else { tab[MT_R0 + (l >> 1)] = r0; r0 += t; } }
        tab[MT_ALL + 64] = a; tab[MT_R0 + 32] = r0; tab[MT_R1 + 32] = r1; }
    __syncthreads();
}

struct EpiInProj {
    unsigned char* ws;
    __device__ __forceinline__ void operator()(const f32x4 (&acc)[2][2][4][2], const pg8::Unit& u, int wr, int wc, int fr, int fq) const {
        const int seg = u.pn >> 1, gi = ((u.pn & 1) << 2) | wc, b = u.pm >> 3, blk = u.pm & 7;
        const bool nrm = (seg != 2 && seg != 5);
        const float* gp = (const float*)(ws + WS_CONST) + CF_GAIN + 64 * (seg == 0 ? 0 : seg == 1 ? 1 : seg == 3 ? 2 : 3);
        const float qs = (seg == 0 || seg == 3) ? C2 : 1.0f;
        f32x4 g[2][2];
#pragma unroll
        for (int bj = 0; bj < 2; ++bj)
#pragma unroll
            for (int n = 0; n < 2; ++n) g[bj][n] = nrm ? ldg4(gp + 32 * bj + 8 * fq + 4 * n) * qs : (f32x4){1.f, 1.f, 1.f, 1.f};
        bf16_t* base; size_t rstride;
        if (seg < 2) { base = (bf16_t*)(ws + (seg == 0 ? WS_QD : WS_KD)) + ((size_t)((b * 4 + (gi >> 1)) * 2 + (gi & 1)) * SEQ + blk * 256) * 64; rstride = 64; }
        else if (seg == 2) { base = (bf16_t*)(ws + WS_VD) + ((size_t)(b * 4 + (gi >> 1)) * SEQ + blk * 256) * 128 + (gi & 1) * 64; rstride = 128; }
        else { base = (bf16_t*)(ws + (seg == 3 ? WS_QM : seg == 4 ? WS_KM : WS_VM)) + ((size_t)(b * 8 + gi) * SEQ + blk * 256) * 64; rstride = 64; }
        f32x4 ks[2][2];
#pragma unroll
        for (int bj = 0; bj < 2; ++bj)
#pragma unroll
            for (int n = 0; n < 2; ++n) ks[bj][n] = (f32x4){0.f, 0.f, 0.f, 0.f};
#pragma unroll
        for (int ai = 0; ai < 2; ++ai)
#pragma unroll
            for (int m = 0; m < 4; ++m) {
                const int r = 128 * ai + 64 * wr + 16 * m + fr;
                f32x4 v[2][2]; float ss = 0.f;
#pragma unroll
                for (int bj = 0; bj < 2; ++bj)
#pragma unroll
                    for (int n = 0; n < 2; ++n) { v[bj][n] = acc[ai][bj][m][n]; ss += (v[bj][n][0] * v[bj][n][0] + v[bj][n][1] * v[bj][n][1]) + (v[bj][n][2] * v[bj][n][2] + v[bj][n][3] * v[bj][n][3]); }
                float rs = 1.f;
                if (nrm) { ss += __shfl_xor(ss, 16); ss += __shfl_xor(ss, 32); rs = rsqrtf(ss * (1.f / 64.f) + RMS_EPS); }
                bf16_t* rowp = base + (size_t)r * rstride + 8 * fq;
                const int rt = r >> 6, rk = r & 63;
#pragma unroll
                for (int bj = 0; bj < 2; ++bj) {
                    const f32x4 a = v[bj][0] * rs * g[bj][0], c = v[bj][1] * rs * g[bj][1];
                    if (seg == 4) { ks[bj][0] += a; ks[bj][1] += c; }
                    v4u w; w.x = pg8::cvt_pk_bf16(a[0], a[1]); w.y = pg8::cvt_pk_bf16(a[2], a[3]); w.z = pg8::cvt_pk_bf16(c[0], c[1]); w.w = pg8::cvt_pk_bf16(c[2], c[3]);
                    bf16_t* dst = rowp + 32 * bj;
                    if (seg == 1 || seg == 4) dst = base + (size_t)((rt * 8 + 4 * bj + fq) * 512 + rk * 8);
                    else if (seg == 5) dst = base + (size_t)((rt * 2 + bj) * 2048 + rk * 32 + 8 * fq);
                    else if (seg == 2) dst = base - (gi & 1) * 64 + (size_t)((rt * 4 + 2 * (gi & 1) + bj) * 2048 + rk * 32 + 8 * fq);
                    *(v4u*)dst = w;
                }
            }
        if (seg == 4) {
            float* km = (float*)(ws + WS_KMEAN) + (((size_t)(b * 8 + blk) * 2 + wr) * 8 + gi) * 64;
#pragma unroll
            for (int bj = 0; bj < 2; ++bj)
#pragma unroll
                for (int n = 0; n < 2; ++n) { f32x4 s = ks[bj][n];
#pragma unroll
                    for (int j = 0; j < 4; ++j) { float t = s[j]; t += __shfl_xor(t, 1); t += __shfl_xor(t, 2); t += __shfl_xor(t, 4); t += __shfl_xor(t, 8); s[j] = t; }
                    if (fr == 0) *(f32x4*)(km + 32 * bj + 8 * fq + 4 * n) = s; }
        }
    }
};

struct EpiOutProj {
    unsigned char* ws; const float* x;
    __device__ __forceinline__ void operator()(const f32x4 (&acc)[2][2][4][2], const pg8::Unit& u, int wr, int wc, int fr, int fq) const {
        bf16_t* X1B = (bf16_t*)(ws + WS_X1B); float* SS = (float*)(ws + WS_SS);
#pragma unroll
        for (int ai = 0; ai < 2; ++ai) {
            f32x4 xv[4][2][2];
#pragma unroll
            for (int m = 0; m < 4; ++m)
#pragma unroll
                for (int bj = 0; bj < 2; ++bj) { const size_t off = ((size_t)u.pm * 256 + 128 * ai + 64 * wr + 16 * m + fr) * DM + u.pn * 256 + 128 * bj + 32 * wc + 8 * fq;
                    xv[m][bj][0] = ldg4(x + off); xv[m][bj][1] = ldg4(x + off + 4); }
#pragma unroll
            for (int m = 0; m < 4; ++m) {
                const size_t row = (size_t)u.pm * 256 + 128 * ai + 64 * wr + 16 * m + fr; float ss = 0.f;
#pragma unroll
                for (int bj = 0; bj < 2; ++bj) {
                    const size_t off = row * DM + u.pn * 256 + 128 * bj + 32 * wc + 8 * fq;
                    const f32x4 a = acc[ai][bj][m][0] + xv[m][bj][0], c = acc[ai][bj][m][1] + xv[m][bj][1];
                    ss += (a[0] * a[0] + a[1] * a[1]) + (a[2] * a[2] + a[3] * a[3]) + (c[0] * c[0] + c[1] * c[1]) + (c[2] * c[2] + c[3] * c[3]);
                    v4u w; w.x = pg8::cvt_pk_bf16(a[0], a[1]); w.y = pg8::cvt_pk_bf16(a[2], a[3]); w.z = pg8::cvt_pk_bf16(c[0], c[1]); w.w = pg8::cvt_pk_bf16(c[2], c[3]);
                    *(v4u*)(X1B + off) = w;
                }
                ss += __shfl_xor(ss, 16); ss += __shfl_xor(ss, 32);
                if (fq == 0) SS[row * SS_PARTS + u.pn * 4 + wc] = ss;
            }
        }
    }
};

constexpr int ROUTE_OFF = LDSCTL_OFF + 2048;
struct EpiRoute {
    unsigned char* ws; LAS unsigned char* lds;
    __device__ __forceinline__ void operator()(const f32x4 (&acc)[2][2][4][2], const pg8::Unit& u, int wr, int wc, int fr, int fq) const {
        const float* SS = (const float*)(ws + WS_SS);
        LAS int* lcount = (LAS int*)(lds + ROUTE_OFF); LAS int* lbase = lcount + 64; LAS int* pcount = lcount + 128; LAS int* pbase = pcount + NPAIR;
        unsigned* CTL = (unsigned*)(ws + WS_CTL); int* LTOK = (int*)(ws + WS_LTOK); float* LW = (float*)(ws + WS_LW); float* LR = (float*)(ws + WS_LR); int* LP = (int*)(ws + WS_LP); int* PTOK = (int*)(ws + WS_PTOK);
        if (threadIdx.x < 64) lcount[threadIdx.x] = 0; else if (threadIdx.x < 64 + NPAIR) pcount[threadIdx.x - 64] = 0;
        asm volatile("s_waitcnt lgkmcnt(0)" ::: "memory"); __builtin_amdgcn_s_barrier(); asm volatile("" ::: "memory");
        int l0v[2][4], p0v[2][4], l1v[2][4], p1v[2][4], prv[2][4], ppv[2][4]; float w0v[2][4], w1v[2][4], r2v[2][4];
#pragma unroll
        for (int ai = 0; ai < 2; ++ai)
#pragma unroll
            for (int m = 0; m < 4; ++m) {
                const int row = u.pm * 256 + 128 * ai + 64 * wr + 16 * m + fr;
                const f32x4 e0 = acc[ai][0][m][0], e1 = acc[ai][0][m][1];
                float gl[4];
#pragma unroll
                for (int j = 0; j < 4; ++j) gl[j] = __shfl_down(e0[j], 16);
                int g = 0; float gv = gl[0];
#pragma unroll
                for (int i = 1; i < 4; ++i) if (gl[i] > gv) { gv = gl[i]; g = i; }
                l0v[ai][m] = -1; p0v[ai][m] = 0; l1v[ai][m] = 0; p1v[ai][m] = 0; prv[ai][m] = 0; ppv[ai][m] = 0; w0v[ai][m] = 0.f; w1v[ai][m] = 0.f; r2v[ai][m] = 0.f;
                if (fq == 0 && g == wc) {
                    const float* sp = SS + (size_t)row * SS_PARTS; const f32x4 s0 = ldg4(sp), s1 = ldg4(sp + 4), s2 = ldg4(sp + 8), s3 = ldg4(sp + 12);
                    const float tot = ((s0[0] + s0[1]) + (s0[2] + s0[3])) + ((s1[0] + s1[1]) + (s1[2] + s1[3])) + ((s2[0] + s2[1]) + (s2[2] + s2[3])) + ((s3[0] + s3[1]) + (s3[2] + s3[3]));
                    const float r2 = rsqrtf(tot * (1.f / DM) + RMS_EPS);
                    const float el[8] = {e0[0], e0[1], e0[2], e0[3], e1[0], e1[1], e1[2], e1[3]};
                    const float mx = fmaxf(fmaxf(gl[0], gl[1]), fmaxf(gl[2], gl[3])) * r2;
                    const float den = (__expf(gl[0] * r2 - mx) + __expf(gl[1] * r2 - mx)) + (__expf(gl[2] * r2 - mx) + __expf(gl[3] * r2 - mx));
                    const float pg = __expf(gv * r2 - mx) / den;
                    float v0 = el[0]; int x0 = 0;
#pragma unroll
                    for (int i = 1; i < 8; ++i) if (el[i] > v0) { v0 = el[i]; x0 = i; }
                    float v1 = -3.0e38f; int x1 = 0;
#pragma unroll
                    for (int i = 0; i < 8; ++i) if (i != x0 && el[i] > v1) { v1 = el[i]; x1 = i; }
                    const float w0 = 1.f / (1.f + __expf((v1 - v0) * r2));
                    const int l0 = (g * 8 + x0) * 2, l1 = (g * 8 + x1) * 2 + 1;
                    l0v[ai][m] = l0; l1v[ai][m] = l1; w0v[ai][m] = pg * w0; w1v[ai][m] = pg * (1.f - w0); r2v[ai][m] = r2;
                    p0v[ai][m] = atomicAdd((int*)(lcount + l0), 1); p1v[ai][m] = atomicAdd((int*)(lcount + l1), 1);
                    { const int lo = x0 < x1 ? x0 : x1, hi = x0 < x1 ? x1 : x0, pr = g * 28 + ((lo * (15 - lo)) >> 1) + (hi - lo - 1);
                      prv[ai][m] = pr | ((x0 > x1 ? 1 : 0) << 7); ppv[ai][m] = atomicAdd((int*)(pcount + pr), 1); }
                }
            }
        asm volatile("s_waitcnt lgkmcnt(0)" ::: "memory"); __builtin_amdgcn_s_barrier(); asm volatile("" ::: "memory");
        if (threadIdx.x < 64) lbase[threadIdx.x] = (int)atomicAdd(CTL + CW_CNT + 64 * threadIdx.x, (unsigned)lcount[threadIdx.x]);
        else if (threadIdx.x < 64 + NPAIR) { const int pq = threadIdx.x - 64; pbase[pq] = (int)atomicAdd(CTL + CW_PCNT + 64 * pq, (unsigned)pcount[pq]); }
        asm volatile("s_waitcnt vmcnt(0) lgkmcnt(0)" ::: "memory"); __builtin_amdgcn_s_barrier(); asm volatile("" ::: "memory");
#pragma unroll
        for (int ai = 0; ai < 2; ++ai)
#pragma unroll
            for (int m = 0; m < 4; ++m) if (l0v[ai][m] >= 0) {
                const int row = u.pm * 256 + 128 * ai + 64 * wr + 16 * m + fr;
                const size_t a0 = (size_t)l0v[ai][m] * LIST_CAP + lbase[l0v[ai][m]] + p0v[ai][m], a1 = (size_t)l1v[ai][m] * LIST_CAP + lbase[l1v[ai][m]] + p1v[ai][m];
                LTOK[a0] = row; LW[a0] = w0v[ai][m]; LR[a0] = r2v[ai][m]; LTOK[a1] = row; LW[a1] = w1v[ai][m]; LR[a1] = r2v[ai][m];
                { const int pr = prv[ai][m] & 127, h0 = (prv[ai][m] >> 7) & 1, ps = pbase[pr] + ppv[ai][m];
                  PTOK[(size_t)pr * LIST_CAP + ps] = row; LP[a0] = pr | (h0 << 7) | (ps << 8); LP[a1] = pr | ((h0 ^ 1) << 7) | (ps << 8); }
            }
    }
};

struct EpiGateUp {
    unsigned char* ws; const LAS int* tab;
    __device__ __forceinline__ void operator()(const f32x4 (&acc)[2][2][4][2], const pg8::Unit& u, int wr, int wc, int fr, int fq) const {
#ifdef DEBUG_NOEPI5
        return;
#endif
        const int list = u.a0 & 255, tile = u.a0 >> 8; const size_t eb = (size_t)list * LIST_CAP + tile * 256;
        const float* LR = (const float*)(ws + WS_LR) + eb; const float* LW = (const float*)(ws + WS_LW) + eb; const int* LP = (const int*)(ws + WS_LP) + eb;
        const LAS int* pt = tab + (PAIRTAB_OFF - MOETAB_OFF) / 4;
        bf16_t* HID = (bf16_t*)(ws + WS_HID2);
        float r2v[2][4], wv[2][4]; int lpv[2][4];
#pragma unroll
        for (int ai = 0; ai < 2; ++ai)
#pragma unroll
            for (int m = 0; m < 4; ++m) { const int r = 128 * ai + 64 * wr + 16 * m + fr, rc = r < u.a1 ? r : u.a1 - 1; r2v[ai][m] = LR[rc]; wv[ai][m] = LW[rc]; lpv[ai][m] = LP[rc]; }
#pragma unroll
        for (int ai = 0; ai < 2; ++ai)
#pragma unroll
            for (int m = 0; m < 4; ++m) {
                const int r = 128 * ai + 64 * wr + 16 * m + fr;
                const float r2 = r2v[ai][m], wt = wv[ai][m]; float h[8];
                const int lp = lpv[ai][m]; const size_t drow = (size_t)pt[PT_ALL + (lp & 127)] * 256 + (size_t)(lp >> 8);
#pragma unroll
                for (int n = 0; n < 2; ++n)
#pragma unroll
                    for (int j = 0; j < 4; ++j) { const float G = acc[ai][0][m][n][j] * r2, U = acc[ai][1][m][n][j] * r2;
                        h[4 * n + j] = G * __builtin_amdgcn_rcpf(1.f + __builtin_amdgcn_exp2f(-G * LOG2E)) * U * wt; }
                v4u w; w.x = pg8::cvt_pk_bf16(h[0], h[1]); w.y = pg8::cvt_pk_bf16(h[2], h[3]); w.z = pg8::cvt_pk_bf16(h[4], h[5]); w.w = pg8::cvt_pk_bf16(h[6], h[7]);
#ifdef DEBUG_NOHIDW
                if (r < u.a1 && drow < 95000) *(v4u*)(HID + drow * (2 * EHID) + ((lp >> 7) & 1) * EHID + u.pn * 128 + 32 * wc + 8 * fq) = w;
#else
                if (r < u.a1) *(v4u*)(HID + drow * (2 * EHID) + ((lp >> 7) & 1) * EHID + u.pn * 128 + 32 * wc + 8 * fq) = w;
#endif
            }
    }
};

struct EpiDownPair {
    unsigned char* ws; float* out;
    __device__ __forceinline__ void operator()(const f32x4 (&acc)[2][2][4][2], const pg8::Unit& u, int wr, int wc, int fr, int fq) const {
        const int pr = u.a0 & 255, tile = u.a0 >> 8; const int* PTOK = (const int*)(ws + WS_PTOK) + (size_t)pr * LIST_CAP + tile * 256;
        const bf16_t* SRC = (const bf16_t*)(ws + WS_X1B);
        int tokv[2][4];
#pragma unroll
        for (int ai = 0; ai < 2; ++ai)
#pragma unroll
            for (int m = 0; m < 4; ++m) { const int r = 128 * ai + 64 * wr + 16 * m + fr, rc = r < u.a1 ? r : u.a1 - 1; tokv[ai][m] = PTOK[rc]; }
#pragma unroll
        for (int ai = 0; ai < 2; ++ai) {
            v4u bs[4][2];
#pragma unroll
            for (int m = 0; m < 4; ++m)
#pragma unroll
                for (int bj = 0; bj < 2; ++bj) bs[m][bj] = *(const v4u*)(SRC + (size_t)tokv[ai][m] * DM + u.pn * 256 + 128 * bj + 32 * wc + 8 * fq);
#pragma unroll
            for (int m = 0; m < 4; ++m) {
                const int r = 128 * ai + 64 * wr + 16 * m + fr; const bool ok = r < u.a1;
#pragma unroll
                for (int bj = 0; bj < 2; ++bj) {
                    const size_t off = (size_t)tokv[ai][m] * DM + u.pn * 256 + 128 * bj + 32 * wc + 8 * fq; const v4u b4 = bs[m][bj];
                    f32x4 a, c;
                    a[0] = __uint_as_float(b4.x << 16); a[1] = __uint_as_float(b4.x & 0xffff0000u); a[2] = __uint_as_float(b4.y << 16); a[3] = __uint_as_float(b4.y & 0xffff0000u);
                    c[0] = __uint_as_float(b4.z << 16); c[1] = __uint_as_float(b4.z & 0xffff0000u); c[2] = __uint_as_float(b4.w << 16); c[3] = __uint_as_float(b4.w & 0xffff0000u);
                    a += acc[ai][bj][m][0]; c += acc[ai][bj][m][1];
                    if (ok) { if (DBG_MEASURE) { const float sc_ = 1.0f + ((const float*)(ws + WS_CONST))[CF_DBG]; a *= sc_; c *= sc_; } *(f32x4*)(out + off) = a; *(f32x4*)(out + off + 4) = c; }
                }
            }
        }
    }
};

template <int RK> struct EpiDown {
    unsigned char* ws; float* out;
    __device__ __forceinline__ void operator()(const f32x4 (&acc)[2][2][4][2], const pg8::Unit& u, int wr, int wc, int fr, int fq) const {
        const int list = u.a0 & 255, tile = u.a0 >> 8; const size_t eb = (size_t)list * LIST_CAP + tile * 256;
        const int* LTOK = (const int*)(ws + WS_LTOK) + eb; const float* LW = (const float*)(ws + WS_LW) + eb;
        const bf16_t* SRC = (const bf16_t*)(ws + (RK == 0 ? WS_X1B : WS_PA)); bf16_t* PA = (bf16_t*)(ws + WS_PA);
        int tokv[2][4]; float wv[2][4];
#pragma unroll
        for (int ai = 0; ai < 2; ++ai)
#pragma unroll
            for (int m = 0; m < 4; ++m) { const int r = 128 * ai + 64 * wr + 16 * m + fr, rc = r < u.a1 ? r : u.a1 - 1; tokv[ai][m] = LTOK[rc]; wv[ai][m] = LW[rc]; }
#pragma unroll
        for (int ai = 0; ai < 2; ++ai) {
            v4u bs[4][2];
#pragma unroll
            for (int m = 0; m < 4; ++m)
#pragma unroll
                for (int bj = 0; bj < 2; ++bj) bs[m][bj] = *(const v4u*)(SRC + (size_t)tokv[ai][m] * DM + u.pn * 256 + 128 * bj + 32 * wc + 8 * fq);
#pragma unroll
            for (int m = 0; m < 4; ++m) {
                const int r = 128 * ai + 64 * wr + 16 * m + fr; const bool ok = r < u.a1; const float wt = wv[ai][m];
#pragma unroll
                for (int bj = 0; bj < 2; ++bj) {
                    const size_t off = (size_t)tokv[ai][m] * DM + u.pn * 256 + 128 * bj + 32 * wc + 8 * fq; const v4u b4 = bs[m][bj];
                    f32x4 a, c;
                    a[0] = __uint_as_float(b4.x << 16); a[1] = __uint_as_float(b4.x & 0xffff0000u); a[2] = __uint_as_float(b4.y << 16); a[3] = __uint_as_float(b4.y & 0xffff0000u);
                    c[0] = __uint_as_float(b4.z << 16); c[1] = __uint_as_float(b4.z & 0xffff0000u); c[2] = __uint_as_float(b4.w << 16); c[3] = __uint_as_float(b4.w & 0xffff0000u);
                    a += acc[ai][bj][m][0] * wt; c += acc[ai][bj][m][1] * wt;
                    if (ok) {
                        if (RK == 0) { v4u w; w.x = pg8::cvt_pk_bf16(a[0], a[1]); w.y = pg8::cvt_pk_bf16(a[2], a[3]); w.z = pg8::cvt_pk_bf16(c[0], c[1]); w.w = pg8::cvt_pk_bf16(c[2], c[3]); *(v4u*)(PA + off) = w; }
                        else { if (DBG_MEASURE) { const float sc_ = 1.0f + ((const float*)(ws + WS_CONST))[CF_DBG]; a *= sc_; c *= sc_; } *(f32x4*)(out + off) = a; *(f32x4*)(out + off + 4) = c; }
                    }
                }
            }
        }
    }
};

#define HAVE_ATTN 1
namespace att {
typedef short bf16x8 __attribute__((ext_vector_type(8)));
typedef short s16x4 __attribute__((ext_vector_type(4)));
typedef short v4i16_t __attribute__((ext_vector_type(4)));
typedef float f32x16 __attribute__((ext_vector_type(16)));
constexpr int TBL_STRIDE = 2384;
constexpr int TBL_BYTES = 38912, SLOT_OFF = TBL_BYTES, NSLOT = 3, STAGE_OFF = SLOT_OFF + 65536  , WSCR_OFF = SLOT_OFF + NSLOT * 32768, ATT_LDS = WSCR_OFF + 2048;
static_assert(4 * TBL_STRIDE * 4 <= TBL_BYTES && ATT_LDS <= LDSCTL_OFF, "attention LDS map");
constexpr float NEGBIG = -1.0e30f;
constexpr int KMEAN_OFF = LDSCTL_OFF + 4608;
__device__ __forceinline__ int crow(int r, int hi) { return (r & 3) + 8 * (r >> 2) + 4 * hi; }
__device__ __forceinline__ s16x4 vtr(const LAS unsigned char* p) { return __builtin_bit_cast(s16x4, __builtin_amdgcn_ds_read_tr16_b64_v4i16((LAS v4i16_t*)p)); }
__device__ __forceinline__ void glds16(const void* gsrc, unsigned lds_dst) { unsigned keep;
    asm volatile("s_mov_b32 %0, m0\n\ts_mov_b32 m0, %2\n\ts_nop 0\n\tglobal_load_lds_dwordx4 %1, off\n\ts_mov_b32 m0, %0" : "=&s"(keep) : "v"(gsrc), "s"(lds_dst) : "memory"); }
__device__ __forceinline__ unsigned cvtpk(float lo, float hi) { typedef float f2 __attribute__((ext_vector_type(2))); typedef __bf16 b2 __attribute__((ext_vector_type(2))); f2 v = {lo, hi}; b2 b = __builtin_convertvector(v, b2); return __builtin_bit_cast(unsigned, b); }

__device__ __forceinline__ void build_table(LAS unsigned char* lds, const float* CF, int h12) {
    LAS float* tb = (LAS float*)lds; const float* BT = CF + CF_BT + h12 * 2048; const float off = CF[CF_OFF + h12];
    for (int idx = threadIdx.x; idx < 4 * TBL_STRIDE; idx += 512) { const int s = idx / TBL_STRIDE, i = idx - s * TBL_STRIDE, j = i + s; tb[idx] = j <= 2047 ? BT[2047 - j] - off : NEGBIG; }
}

template <int NK> __device__ __forceinline__ void epilogue(LAS unsigned char* lds, unsigned char* ws, const Inputs& in, int b, int h, int w, int map, int rb, int qw0, int lane_in, float lsum, att::f32x16 (&o)[NK == 2 ? 4 : 2]) {
    constexpr int ND = NK == 2 ? 4 : 2;
    int lane = lane_in; asm volatile("" : "+v"(lane));
    const int r32 = lane & 31, hi = lane >> 5;
    const float* CF = (const float*)(ws + WS_CONST);
    LAS float* wsf = (LAS float*)(lds + WSCR_OFF) + w * 64;
    if (hi == 0) wsf[r32] = lsum;
    asm volatile("s_waitcnt lgkmcnt(0)" ::: "memory");
    float rli[16];
#pragma unroll
    for (int r = 0; r < 16; ++r) rli[r] = __builtin_amdgcn_rcpf(wsf[crow(r, hi)]);
    bf16_t* Y = (bf16_t*)(ws + WS_Y);
    if (NK == 1) {
        LAS bf16_t* stg = (LAS bf16_t*)(lds + STAGE_OFF) + w * 2048;
#pragma unroll
        for (int r = 0; r < 16; ++r) { const int orow = crow(r, hi);
#pragma unroll
            for (int d0 = 0; d0 < ND; ++d0) stg[orow * 64 + d0 * 32 + r32] = (bf16_t)f2bf(o[d0][r] * rli[r]); }
        asm volatile("s_waitcnt lgkmcnt(0)" ::: "memory");
        bf16_t* Yw = Y + (size_t)(b * SEQ + qw0) * DM + 512 + h * 64;
#pragma unroll
        for (int i = 0; i < 4; ++i) { const int row = i * 8 + (lane >> 3), ch = lane & 7; const v4u v = *(const LAS v4u*)(stg + row * 64 + ch * 8); *(v4u*)(Yw + (size_t)row * DM + ch * 8) = v; }
    } else {
        LAS float* X = (LAS float*)(lds + SLOT_OFF) + (size_t)rb * 32 * 128;
        const float lam = CF[CF_LAMBDA];
        if (map == 1) {
#pragma unroll
            for (int r = 0; r < 16; ++r) { const int orow = crow(r, hi); const float f = rli[r] * lam;
#pragma unroll
                for (int d0 = 0; d0 < ND; ++d0) X[orow * 128 + d0 * 32 + r32] = o[d0][r] * f; }
        }
        asm volatile("s_waitcnt lgkmcnt(0)" ::: "memory"); __syncthreads();
        if (map == 0) {
            float gsub[ND];
#pragma unroll
            for (int d0 = 0; d0 < ND; ++d0) gsub[d0] = in.diff_sub_g[d0 * 32 + r32];
            LAS bf16_t* stg = (LAS bf16_t*)(lds + STAGE_OFF) + rb * 4096;
#pragma unroll
            for (int r = 0; r < 16; ++r) { const int orow = crow(r, hi); float v[ND]; float ss = 0.f;
#pragma unroll
                for (int d0 = 0; d0 < ND; ++d0) { v[d0] = o[d0][r] * rli[r] - X[orow * 128 + d0 * 32 + r32]; ss += v[d0] * v[d0]; }
                ss += __shfl_xor(ss, 1); ss += __shfl_xor(ss, 2); ss += __shfl_xor(ss, 4); ss += __shfl_xor(ss, 8); ss += __shfl_xor(ss, 16);
                const float sc2 = rsqrtf(ss * (1.f / 128.f) + RMS_EPS) * (1.f - LAMBDA_INIT);
#pragma unroll
                for (int d0 = 0; d0 < ND; ++d0) stg[orow * 128 + d0 * 32 + r32] = (bf16_t)f2bf(v[d0] * sc2 * gsub[d0]); }
            asm volatile("s_waitcnt lgkmcnt(0)" ::: "memory");
            bf16_t* Yw = Y + (size_t)(b * SEQ + qw0) * DM + h * 128;
#pragma unroll
            for (int i = 0; i < 8; ++i) { const int row = i * 4 + (lane >> 4), ch = lane & 15; const v4u v = *(const LAS v4u*)(stg + row * 128 + ch * 8); *(v4u*)(Yw + (size_t)row * DM + ch * 8) = v; }
        }
    }
    asm volatile("s_waitcnt lgkmcnt(0)" ::: "memory"); __builtin_amdgcn_s_barrier(); asm volatile("" ::: "memory");
}


template <int NK, int ABL> __device__ __forceinline__ void attn_unit(LAS unsigned char* lds, unsigned char* ws, const Inputs& in, int b, int h, int qb, bool stage_km) {
    constexpr int DV = NK == 2 ? 128 : 64, ND = DV / 32, ROWS = NK == 2 ? 128 : 256, SLOTB = NK == 2 ? 32768 : 16384, VOFF = 8192 * NK;
    const int tid = threadIdx.x; int lane_ = tid & 63; asm volatile("" : "+v"(lane_));
    const int lane = lane_, r32 = lane & 31, hi = lane >> 5; const int w = __builtin_amdgcn_readfirstlane(tid >> 6);
    const int map = NK == 2 ? (w >> 2) : 0, rb = NK == 2 ? (w & 3) : w;
    const int q0 = qb * ROWS, qw0 = q0 + 32 * rb, qabs = qw0 + r32, NT = (q0 + ROWS) / 64;
    const float* CF = (const float*)(ws + WS_CONST);
    const bf16_t *Qh, *Kh0, *Kh1, *Vh;
    if (NK == 2) { const size_t hb = (size_t)(b * 4 + h) * 2; Qh = (const bf16_t*)(ws + WS_QD) + (hb + map) * SEQ * 64; Kh0 = (const bf16_t*)(ws + WS_KD) + hb * SEQ * 64; Kh1 = Kh0 + (size_t)SEQ * 64;
                   Vh = (const bf16_t*)(ws + WS_VD) + (size_t)(b * 4 + h) * SEQ * 128; }
    else { const size_t hb = (size_t)(b * 8 + h); Qh = (const bf16_t*)(ws + WS_QM) + hb * SEQ * 64; Kh0 = (const bf16_t*)(ws + WS_KM) + hb * SEQ * 64; Kh1 = Kh0; Vh = (const bf16_t*)(ws + WS_VM) + hb * SEQ * 64; }
    const bf16_t* ksrc0 = Kh0 + (size_t)w * 512 + lane * 8; const bf16_t* ksrc1 = Kh1 + (size_t)w * 512 + lane * 8;
    const bf16_t* vsrc0 = Vh + (size_t)w * 512 + lane * 8;
    const bf16_t* vsrc1 = vsrc0 + 4096;
    constexpr int KSB = 8192 * NK, VSB = 128 * DV, KRING = SLOT_OFF, VRING = SLOT_OFF + 49152;
    const unsigned kdst = (unsigned)(uintptr_t)(lds + KRING) + (unsigned)w * 1024u, vdst = (unsigned)(uintptr_t)(lds + VRING) + (unsigned)w * 1024u;
#define ATT_DMAK(t, off) do { if (ABL & 16) break; const unsigned d_ = (unsigned)__builtin_amdgcn_readfirstlane(kdst + (unsigned)(off)); const size_t o_ = (size_t)(t) * 64 * 64; glds16(ksrc0 + o_, d_); if (NK == 2) glds16(ksrc1 + o_, d_ + 8192u); } while (0)
#define ATT_DMAV(t, off) do { if (ABL & 16) break; const unsigned d_ = (unsigned)__builtin_amdgcn_readfirstlane(vdst + (unsigned)(off)); const size_t o_ = (size_t)(t) * 64 * DV; glds16(vsrc0 + o_, d_); if (NK == 2) glds16(vsrc1 + o_, d_ + 8192u); } while (0)
    if (NK == 1) { ATT_DMAK(0, 0); ATT_DMAV(0, 0); ATT_DMAK(1, KSB); ATT_DMAV(1, VSB); ATT_DMAK(2, 2 * KSB); ATT_DMAV(2, 2 * VSB); ATT_DMAK(3, 3 * KSB); ATT_DMAV(3, 3 * VSB); if (NT > 4) ATT_DMAK(4, 4 * KSB); }
    else { ATT_DMAK(0, 0); ATT_DMAV(0, 0); ATT_DMAK(1, KSB); }
    bf16x8 qr[4];
#pragma unroll
    for (int d0 = 0; d0 < 4; ++d0) qr[d0] = *(const bf16x8*)(Qh + (size_t)qabs * 64 + d0 * 16 + hi * 8);
    if (NK == 1 && stage_km) { const int n = tid >> 6, d = tid & 63;
        if (n < qb) { const float* k0 = (const float*)(ws + WS_KMEAN) + (((size_t)(b * 8 + n) * 2 + 0) * 8 + h) * 64 + d; const float v = k0[0] + k0[512];
            const unsigned hb = f2bf(v); const float lo = v - bf2f((bf16_t)hb);
            ((LAS bf16_t*)(lds + KMEAN_OFF))[n * 64 + d] = (bf16_t)hb; ((LAS bf16_t*)(lds + KMEAN_OFF + 1024))[n * 64 + d] = (bf16_t)f2bf(lo); } }
#pragma unroll
    for (int d0 = 0; d0 < 4; ++d0) asm volatile("" : "+v"(qr[d0]));
    asm volatile("s_waitcnt vmcnt(0)" ::: "memory"); __syncthreads();
    unsigned selmask = 0xffffffffu;
    if (NK == 1 && qb > 0) {
        float gate[8];
        { f32x16 G = {}; const LAS unsigned char* kmh = lds + KMEAN_OFF + (r32 & 7) * 128 + hi * 16;
#pragma unroll
          for (int d0 = 0; d0 < 4; ++d0) { const bf16x8 ah = *(const LAS bf16x8*)(kmh + d0 * 32), al = *(const LAS bf16x8*)(kmh + 1024 + d0 * 32);
              G = __builtin_amdgcn_mfma_f32_32x32x16_bf16(ah, qr[d0], G, 0, 0, 0); G = __builtin_amdgcn_mfma_f32_32x32x16_bf16(al, qr[d0], G, 0, 0, 0); }
#pragma unroll
          for (int r = 0; r < 4; ++r) { const float mine = G[r], oth = __shfl_xor(mine, 32); gate[r] = hi ? oth : mine; gate[4 + r] = hi ? mine : oth; } }
        selmask = 0u;
#pragma unroll
        for (int n = 0; n < 8; ++n) { int better = 0;
#pragma unroll
            for (int m = 0; m < 8; ++m) if (m != n) better += (m < qb && (gate[m] > gate[n] || (gate[m] == gate[n] && m < n))) ? 1 : 0;
            if (n < qb && better < 3) selmask |= 1u << n; }
        selmask |= 1u << qb;
    }
    const int j0 = 2047 - qabs + 4 * hi, sc = j0 & 3;
    const LAS unsigned char* tb_base = lds + (sc * TBL_STRIDE + (j0 - sc)) * 4;
    const LAS unsigned char* tb_neg = lds + (sc * TBL_STRIDE + 2052) * 4;
    const LAS unsigned char* kp0 = lds + KRING + map * 8192 + hi * 1024 + r32 * 16;
    const LAS unsigned char* vp0 = lds + VRING + ((lane >> 4) & 1) * 32 + (lane & 3) * 8 + (4 * hi + ((lane & 15) >> 2)) * 64;
    f32x16 o[ND];
#pragma unroll
    for (int d = 0; d < ND; ++d) o[d] = f32x16{};
    float ls0 = 0.f, ls1 = 0.f;
    const int NTw = (qw0 + 31) / 64 + 1 < NT ? (qw0 + 31) / 64 + 1 : NT;
#define SBAR() __builtin_amdgcn_sched_barrier(0)
#define MFMA32(a, b, c) __builtin_amdgcn_mfma_f32_32x32x16_bf16(a, b, c, 0, 0, 0)
#define MFMA_QK(a, b, c) ((ABL & 8) ? (c) : MFMA32(a, b, c))
#define MFMA_PV(a, b, c) ((ABL & 4) ? (c) : MFMA32(a, b, c))
#define EXP2F(x) ((ABL & 1) ? (x) : __builtin_amdgcn_exp2f(x))
#define CINIT_H(P, half, tt) do { if (ABL & 2) { asm volatile("" : "+v"(P)); break; } const bool sel_ = NK == 2 || ((selmask >> ((tt) >> 2)) & 1u); const LAS unsigned char* tp_ = (sel_ ? tb_base + (tt) * 256 : tb_neg) + (half) * 128; \
        _Pragma("unroll") for (int g = 0; g < 4; ++g) { const f32x4 c0 = *(const LAS f32x4*)(tp_ + g * 32); P[4 * g] = c0[0]; P[4 * g + 1] = c0[1]; P[4 * g + 2] = c0[2]; P[4 * g + 3] = c0[3]; } } while (0)
#define CINIT(P0, P1, tt) do { CINIT_H(P0, 0, tt); CINIT_H(P1, 1, tt); } while (0)
#define KLOAD(kf, koff) do { _Pragma("unroll") for (int i_ = 0; i_ < 8; ++i_) kf[i_] = *(const LAS bf16x8*)(kp0 + (koff) + (i_ >> 1) * 2048 + (i_ & 1) * 512); } while (0)
#define EXP4(PC0, PC1, i) do { if ((i) < 4) { _Pragma("unroll") for (int e_ = 0; e_ < 4; ++e_) PC0[4 * (i) + e_] = EXP2F(PC0[4 * (i) + e_]); asm volatile("" : "+v"(PC0)); } \
        else { _Pragma("unroll") for (int e_ = 0; e_ < 4; ++e_) PC1[4 * ((i) - 4) + e_] = EXP2F(PC1[4 * ((i) - 4) + e_]); asm volatile("" : "+v"(PC1)); } } while (0)
#define STEP_HEAD(t) do { if ((t) + 5 < NT) ATT_DMAK((t) + 5, ko_i); if ((t) + 4 < NT) ATT_DMAV((t) + 4, vo_i); } while (0)
#define STEP_TAIL(t) do { { const int a_ = NT - (t) - 3, b_ = NT - (t) - 2; const int nfl = (a_ < 0 ? 0 : a_ > 3 ? 3 : a_) + (b_ < 0 ? 0 : b_ > 3 ? 3 : b_); \
          if (nfl >= 6) asm volatile("s_waitcnt vmcnt(6) lgkmcnt(0)" ::: "memory"); else if (nfl == 5) asm volatile("s_waitcnt vmcnt(5) lgkmcnt(0)" ::: "memory"); \
          else if (nfl == 4) asm volatile("s_waitcnt vmcnt(4) lgkmcnt(0)" ::: "memory"); else if (nfl == 3) asm volatile("s_waitcnt vmcnt(3) lgkmcnt(0)" ::: "memory"); \
          else if (nfl == 2) asm volatile("s_waitcnt vmcnt(2) lgkmcnt(0)" ::: "memory"); else if (nfl == 1) asm volatile("s_waitcnt vmcnt(1) lgkmcnt(0)" ::: "memory"); \
          else asm volatile("s_waitcnt vmcnt(0) lgkmcnt(0)" ::: "memory"); } \
        __builtin_amdgcn_s_barrier(); asm volatile("" ::: "memory"); SBAR(); \
        { s5 = s5 == 4 ? 0 : s5 + 1; const int s5n = s5 == 4 ? 0 : s5 + 1, s5p = s5 == 0 ? 4 : s5 - 1; ko_r = s5n * KSB; ko_i = s5 * KSB; vo_r = s5 * VSB; vo_i = s5p * VSB; } } while (0)
#define KLD1(i) ((ABL & 32) ? qr[(i) & 3] : *(const LAS bf16x8*)(kp0 + ko_r + ((i) >> 1) * 2048 + ((i) & 1) * 512))
#define QK_EXP(PC0, PC1, PN0, PN1, t) do { bf16x8 kf[8]; _Pragma("unroll") for (int i = 0; i < 8; ++i) kf[i] = KLD1(i); EXP4(PC0, PC1, 0); SBAR(); \
        _Pragma("unroll") for (int i = 0; i < 8; ++i) { \
            if (i & 1) PN1 = MFMA_QK(kf[i], qr[i >> 1], PN1); else PN0 = MFMA_QK(kf[i], qr[i >> 1], PN0); if (i + 1 < 8) EXP4(PC0, PC1, i + 1); if (i == 5) { VLOAD(0); VLOAD(1); } SBAR(); } } while (0)
#define SUMPACK(PC0, PC1, ks) do { if (ABL & 256) { asm volatile("" : "+v"(pw[(ks) & 1])); break; } _Pragma("unroll") for (int i = 0; i < 4; ++i) { \
            const float a_ = (ks) == 0 ? PC0[2 * i] : (ks) == 1 ? PC0[8 + 2 * i] : (ks) == 2 ? PC1[2 * i] : PC1[8 + 2 * i]; \
            const float b_ = (ks) == 0 ? PC0[2 * i + 1] : (ks) == 1 ? PC0[9 + 2 * i] : (ks) == 2 ? PC1[2 * i + 1] : PC1[9 + 2 * i]; \
            ls0 += a_; ls1 += b_; pw[(ks) & 1][i] = cvtpk(a_, b_); } asm volatile("" : "+v"(ls0), "+v"(ls1), "+v"(pw[(ks) & 1])); } while (0)
#define VLOAD(g) do { if (ABL & 32) { vl[(g) % 3] = s16x4{1, 2, 3, 4}; vh[(g) % 3] = s16x4{1, 2, 3, 4}; asm volatile("" : "+v"(vl[(g) % 3]), "+v"(vh[(g) % 3])); } else if ((g) < 4 * ND) { const int ks_ = (g) / ND, d_ = (g) % ND; vl[(g) % 3] = vtr(vp + d_ * 4096 + ks_ * 1024); vh[(g) % 3] = vtr(vp + d_ * 4096 + ks_ * 1024 + 512); } } while (0)
#define PV_SUM(PC0, PC1, t, CI, PRE) do { v4u pw[2]; \
        if (!(PRE)) { VLOAD(0); VLOAD(1); } SUMPACK(PC0, PC1, 0); SBAR(); __builtin_amdgcn_s_setprio(1); \
        _Pragma("unroll") for (int g = 0; g < 4 * ND; ++g) { const int ks = g / ND, d0 = g % ND; \
            VLOAD(g + 2); \
            { const s16x4 a_ = vl[g % 3], b_ = vh[g % 3]; const bf16x8 vf = {a_[0], a_[1], a_[2], a_[3], b_[0], b_[1], b_[2], b_[3]}; o[d0] = MFMA_PV(__builtin_bit_cast(bf16x8, pw[ks & 1]), vf, o[d0]); } \
            if (d0 == ND - 2 && ks < 3) SUMPACK(PC0, PC1, ks + 1); \
            if (g == 1 && (t) + 5 < NT) ATT_DMAK((t) + 5, ko_i); if (g == 3 && (t) + 4 < NT) ATT_DMAV((t) + 4, vo_i); \
            if (CI && g == 2 * ND + 1 && (t) + 2 < NTw) CINIT(PC0, PC1, (t) + 2); \
            SBAR(); } __builtin_amdgcn_s_setprio(0); } while (0)
#define STEP_FULL(PC0, PC1, PN0, PN1, t) do { const LAS unsigned char* vp = vp0 + vo_r; s16x4 vl[3], vh[3]; QK_EXP(PC0, PC1, PN0, PN1, t); PV_SUM(PC0, PC1, t, true, true); STEP_TAIL(t); } while (0)
#define STEP_LAST(PC0, PC1, t) do { const LAS unsigned char* vp = vp0 + vo_r; s16x4 vl[3], vh[3]; _Pragma("unroll") for (int i = 0; i < 8; ++i) EXP4(PC0, PC1, i); PV_SUM(PC0, PC1, t, false, false); STEP_TAIL(t); } while (0)
    if constexpr (NK == 1) {
    int s5 = 0, ko_r = KSB, ko_i = 0, vo_r = 0, vo_i = 4 * VSB;
    f32x16 pA0, pA1, pB0, pB1;
    if (1 < NTw) CINIT(pB0, pB1, 1);
    { bf16x8 kf[8]; CINIT(pA0, pA1, 0); KLOAD(kf, 0);
#pragma unroll
      for (int i = 0; i < 8; ++i) { if (i & 1) pA1 = MFMA32(kf[i], qr[i >> 1], pA1); else pA0 = MFMA32(kf[i], qr[i >> 1], pA0); } }
    asm volatile("s_waitcnt lgkmcnt(0)" ::: "memory"); __builtin_amdgcn_s_barrier(); asm volatile("" ::: "memory"); SBAR();
    int t = 0;
    for (; t + 2 < NTw; t += 2) {
        unsigned long long t0_ = 0; if (DBG_MEASURE == 2 && blockIdx.x == 0 && w == 0) t0_ = __builtin_amdgcn_s_memtime();
        STEP_FULL(pA0, pA1, pB0, pB1, t); STEP_FULL(pB0, pB1, pA0, pA1, t + 1);
        if (DBG_MEASURE == 2 && blockIdx.x == 0 && w == 0) { const unsigned long long t1_ = __builtin_amdgcn_s_memtime(); LAS unsigned* dg = (LAS unsigned*)(lds + LDSCTL_OFF + 3072); if (lane == 0) { dg[0] += (unsigned)(t1_ - t0_); dg[1] += 2u; } }
    }
    if (NTw - t == 2) { STEP_FULL(pA0, pA1, pB0, pB1, t); STEP_LAST(pB0, pB1, t + 1); t += 2; }
    else { STEP_LAST(pA0, pA1, t); t += 1; }
    for (; t < NT; ++t) { STEP_HEAD(t); STEP_TAIL(t); }
    } else {
    int ko_r = 0, ko_n = KSB, ko_i = 2 * KSB, vo_r = 2 * VSB, vo_n = 0, vo_i = VSB;
    f32x16 S0, S1; v4u pwA[4], pwB[4];
#define DHEAD(t) do { if ((t) + 2 < NT) ATT_DMAK((t) + 2, ko_i); if ((t) + 1 < NT) ATT_DMAV((t) + 1, vo_i); } while (0)
#define DTAIL(t) do { if ((t) + 2 < NT) asm volatile("s_waitcnt vmcnt(4) lgkmcnt(0)" ::: "memory"); else asm volatile("s_waitcnt vmcnt(0) lgkmcnt(0)" ::: "memory"); \
        __builtin_amdgcn_s_barrier(); asm volatile("" ::: "memory"); SBAR(); \
        { const int tk_ = ko_r; ko_r = ko_n; ko_n = ko_i; ko_i = tk_; const int tv_ = vo_r; vo_r = vo_n; vo_n = vo_i; vo_i = tv_; } } while (0)
#define DQK(t, PRE) do { bf16x8 kf[4]; _Pragma("unroll") for (int i = 0; i < 4; ++i) kf[i] = KLD1(i); SBAR(); \
        _Pragma("unroll") for (int i = 0; i < 8; ++i) { \
            if (i & 1) S1 = MFMA_QK(kf[i & 3], qr[i >> 1], S1); else S0 = MFMA_QK(kf[i & 3], qr[i >> 1], S0); \
            if (i + 4 < 8) kf[i & 3] = KLD1(i + 4); if ((PRE) && i == 6) VLOAD2(0); \
            if ((PRE) && i == 1 && (t) + 2 < NT) ATT_DMAK((t) + 2, ko_i); if ((PRE) && i == 4 && (t) + 1 < NT) ATT_DMAV((t) + 1, vo_i); SBAR(); } } while (0)
#define DSOFT(PW, g) do { if (ABL & 256) { asm volatile("" : "+v"(PW[(g) >> 2])); break; } float a_ = (g) < 8 ? S0[2 * (g)] : S1[2 * ((g) - 8)], b_ = (g) < 8 ? S0[2 * (g) + 1] : S1[2 * ((g) - 8) + 1]; \
        a_ = EXP2F(a_); b_ = EXP2F(b_); ls0 += a_; ls1 += b_; PW[(g) >> 2][(g) & 3] = cvtpk(a_, b_); asm volatile("" : "+v"(ls0), "+v"(ls1), "+v"(PW[(g) >> 2])); } while (0)
#define VLOAD2(g) do { if (ABL & 32) { vl[(g) & 1] = s16x4{1, 2, 3, 4}; vh[(g) & 1] = s16x4{1, 2, 3, 4}; asm volatile("" : "+v"(vl[(g) & 1]), "+v"(vh[(g) & 1])); } else if ((g) < 16) { const int ks_ = (g) >> 2, d_ = (g) & 3; vl[(g) & 1] = vtr(vp + d_ * 4096 + ks_ * 1024); vh[(g) & 1] = vtr(vp + d_ * 4096 + ks_ * 1024 + 512); } } while (0)
#define DPV(PWP, PWC, SOFT, t, PRE) do { if (!(PRE)) { VLOAD2(0); } SBAR(); \
        _Pragma("unroll") for (int g = 0; g < 16; ++g) { const int ks = g >> 2, d0 = g & 3; VLOAD2(g + 1); \
            { const s16x4 a2_ = vl[g & 1], b2_ = vh[g & 1]; const bf16x8 vf = {a2_[0], a2_[1], a2_[2], a2_[3], b2_[0], b2_[1], b2_[2], b2_[3]}; o[d0] = MFMA_PV(__builtin_bit_cast(bf16x8, PWP[ks]), vf, o[d0]); } \
            if (SOFT) DSOFT(PWC, g); \
            if (!(PRE) && g == 2 && (t) + 2 < NT) ATT_DMAK((t) + 2, ko_i); if (!(PRE) && g == 6 && (t) + 1 < NT) ATT_DMAV((t) + 1, vo_i); \
            if (SOFT && g == 8 && (t) + 1 < NTw) CINIT_H(S0, 0, (t) + 1); \
            SBAR(); } } while (0)
#define DSTEP_MID(PWP, PWC, t) do { const LAS unsigned char* vp = vp0 + vo_r; s16x4 vl[2], vh[2]; DQK(t, true); DPV(PWP, PWC, true, t, true); if ((t) + 1 < NTw) CINIT_H(S1, 1, (t) + 1); DTAIL(t); } while (0)
    { const LAS unsigned char* vp = vp0; s16x4 vl[2], vh[2]; (void)vp; (void)vl; (void)vh; DHEAD(0); CINIT(S0, S1, 0); DQK(0, false);
#pragma unroll
      for (int g = 0; g < 16; ++g) DSOFT(pwA, g);
      if (1 < NTw) CINIT(S0, S1, 1); DTAIL(0); }
    int t = 1;
    for (; t + 1 < NTw; t += 2) {
        unsigned long long t0_ = 0; if (DBG_MEASURE == 3 && blockIdx.x == 0 && w == 0) t0_ = __builtin_amdgcn_s_memtime();
        DSTEP_MID(pwA, pwB, t); DSTEP_MID(pwB, pwA, t + 1);
        if (DBG_MEASURE == 3 && blockIdx.x == 0 && w == 0) { const unsigned long long t1_ = __builtin_amdgcn_s_memtime(); LAS unsigned* dg = (LAS unsigned*)(lds + LDSCTL_OFF + 3072); if (lane == 0) { dg[0] += (unsigned)(t1_ - t0_); dg[1] += 2u; } }
    }
    if (t < NTw) { DSTEP_MID(pwA, pwB, t); ++t; { const LAS unsigned char* vp = vp0 + vo_r; s16x4 vl[2], vh[2]; DPV(pwB, pwA, false, t, false); } DTAIL(t); ++t; }
    else { { const LAS unsigned char* vp = vp0 + vo_r; s16x4 vl[2], vh[2]; DPV(pwA, pwB, false, t, false); } DTAIL(t); ++t; }
    for (; t <= NT; ++t) { DHEAD(t); DTAIL(t); }
#undef DHEAD
#undef DTAIL
#undef DQK
#undef DSOFT
#undef DPV
#undef VLOAD2
#undef DSTEP_MID
    }
    float lsum = ls0 + ls1;
#undef STEP_FULL
#undef STEP_LAST
#undef STEP_HEAD
#undef STEP_TAIL
#undef QK_EXP
#undef KLD1
#undef PV_SUM
#undef SUMPACK
#undef VLOAD
#undef EXP4
#undef KLOAD
#undef CINIT
#undef CINIT_H
#undef MFMA32
#undef MFMA_QK
#undef MFMA_PV
#undef EXP2F
#undef SBAR
#undef ATT_DMAK
#undef ATT_DMAV
    lsum += __shfl_xor(lsum, 32);
    epilogue<NK>(lds, ws, in, b, h, w, map, rb, qw0, lane, lsum, o);
}

template <int ABL> __device__ __forceinline__ void attn_phase(LAS unsigned char* lds, unsigned char* ws, const Inputs& in, int G, int v) {
    const float* CF = (const float*)(ws + WS_CONST);
    if (DBG_MEASURE && blockIdx.x == 0 && threadIdx.x == 0) { LAS unsigned* dg = (LAS unsigned*)(lds + LDSCTL_OFF + 3072); dg[0] = 0u; dg[1] = 0u;
        LAS unsigned long long* dq = (LAS unsigned long long*)(lds + LDSCTL_OFF + 3088); dq[0] = __builtin_amdgcn_s_memtime(); dq[1] = __builtin_amdgcn_s_memrealtime(); }
    for (int vv = v; vv < 256; vv += G) {
        if constexpr ((ABL & 4096) == 0)
        { const int j = vv & 3; build_table(lds, CF, 4 + ((vv >> 2) & 7));
          for (int k = 0; k < 4; ++k) { const int head = (vv >> 2) + 64 * k, b = head >> 3, h = head & 7;
              if constexpr ((ABL & 512) != 0) { const int wv = __builtin_amdgcn_readfirstlane(threadIdx.x >> 6);
                  if (wv < 4) { attn_unit<1, 0>(lds, ws, in, b, h, 7 - j, true); attn_unit<1, 0>(lds, ws, in, b, h, j, false); } else { attn_unit<1, (ABL & 0x1bf)>(lds, ws, in, b, h, 7 - j, true); attn_unit<1, (ABL & 0x1bf)>(lds, ws, in, b, h, j, false); } }
              else if constexpr ((ABL & 2048) != 0) { attn_unit<1, 0>(lds, ws, in, b, h, 7 - j, true); attn_unit<1, 0>(lds, ws, in, b, h, j, false); }
              else { attn_unit<1, ABL>(lds, ws, in, b, h, (ABL & 64) ? 0 : 7 - j, true); attn_unit<1, ABL>(lds, ws, in, b, h, (ABL & 64) ? 0 : j, false); } } }
        __syncthreads();
        if constexpr ((ABL & 1024) == 0)
        { const int j = vv & 7; build_table(lds, CF, (vv >> 3) & 3);
          for (int k = 0; k < 4; ++k) { const int head = (vv >> 3) + 32 * k, b = head >> 2, h = head & 3;
              attn_unit<2, (ABL & 0x1ff)>(lds, ws, in, b, h, (ABL & 64) ? 0 : 15 - j, false); attn_unit<2, (ABL & 0x1ff)>(lds, ws, in, b, h, (ABL & 64) ? 0 : j, false); } }
        __syncthreads();
    }
    if (DBG_MEASURE && blockIdx.x == 0 && threadIdx.x == 0) {
        const unsigned long long c1 = __builtin_amdgcn_s_memtime(), r1 = __builtin_amdgcn_s_memrealtime(); LAS unsigned* dg = (LAS unsigned*)(lds + LDSCTL_OFF + 3072); float eps = 0.f;
        LAS unsigned long long* dq = (LAS unsigned long long*)(lds + LDSCTL_OFF + 3088); const unsigned long long dbg_c0 = dq[0], dbg_r0 = dq[1];
        if (DBG_MEASURE == 1) eps = (float)(c1 - dbg_c0) / (float)(r1 - dbg_r0) * 0.1f / 4.0f;
        if (DBG_MEASURE == 2 || DBG_MEASURE == 3) eps = (float)dg[0] / (float)(dg[1] ? dg[1] : 1u) / 300.0f;
        if (DBG_MEASURE == 4) eps = (float)(r1 - dbg_r0) * 0.01f / 1000.0f;
        eps = floorf(eps * 50.0f + 0.5f) * 0.02f;
        ((float*)(ws + WS_CONST))[CF_DBG] = eps;
    }
}
}
template <int ABL> __device__ __forceinline__ void attn_phase(LAS unsigned char* lds, unsigned char* ws, const Inputs& in, int G, int v) { att::attn_phase<ABL>(lds, ws, in, G, v); }

#define RLX_AGENT __ATOMIC_RELAXED, __HIP_MEMORY_SCOPE_AGENT
#define XB_TMO      128
#define XB_XCNT(j)  (256  + 64 * (j))
#define XB_XSUB(j)  (1280 + 64 * (j))
#define XB_XGEN(j)  (2304 + 64 * (j))
#define XB_TOP      3328
#define XB_TOPGEN   3392
#define XCD_BAR_WORDS 3456
#define XB_SPIN_CAP (1u << 18)
constexpr int CW_BAR = 8192;
__device__ __forceinline__ unsigned xb_ld(unsigned* p)              { return __hip_atomic_load(p, __ATOMIC_RELAXED, __HIP_MEMORY_SCOPE_AGENT); }
__device__ __forceinline__ unsigned xb_add(unsigned* p, unsigned v) { return __hip_atomic_fetch_add(p, v, __ATOMIC_RELAXED, __HIP_MEMORY_SCOPE_AGENT); }
__device__ __forceinline__ unsigned xb_xcc_id() { return (unsigned)__builtin_amdgcn_s_getreg((3 << 11) | 20) & 0xFu; }
#define XB_SPIN(cond, bar) do { unsigned _sp = 0; while (cond) { __builtin_amdgcn_s_sleep(1); \
    if ((++_sp & 255u) == 0u) { if (xb_ld(&(bar)[XB_TMO])) break; if (_sp > XB_SPIN_CAP) { atomicAdd(&(bar)[XB_TMO], 1u); break; } } } } while (0)
struct XcdBarrier { unsigned* bar; unsigned x; volatile LAS unsigned* st; };
__device__ __forceinline__ XcdBarrier xcd_barrier_post(unsigned* bar, volatile LAS unsigned* st) {
    XcdBarrier b; b.bar = bar; b.x = xb_xcc_id(); b.st = st;
    if (threadIdx.x == 0) (void)xb_add(&bar[XB_XCNT(b.x)], 1u);
    return b;
}
__device__ __forceinline__ void xcd_barrier_complete(unsigned* bar, unsigned x, unsigned& nloc, unsigned& nx) {
    const unsigned G = gridDim.x * gridDim.y * gridDim.z;
    unsigned sum, cnt, mine, sp = 0u;
    for (;;) {
        sum = 0u; cnt = 0u; mine = 0u;
#pragma unroll
        for (unsigned j = 0; j < 16; ++j) { const unsigned c = xb_ld(&bar[XB_XCNT(j)]); sum += c; cnt += (c > 0u) ? 1u : 0u; mine = (j == x) ? c : mine; }
        if (sum == G) break;
        __builtin_amdgcn_s_sleep(1);
        if ((++sp & 255u) == 0u) { if (xb_ld(&bar[XB_TMO])) break; if (sp > XB_SPIN_CAP) { atomicAdd(&bar[XB_TMO], 1u); break; } }
    }
    nloc = mine > 0u ? mine : 1u; nx = cnt > 0u ? cnt : 1u;
}
__device__ __forceinline__ void xcd_barrier(const XcdBarrier& b) {
    asm volatile("s_waitcnt vmcnt(0)" ::: "memory");
    __syncthreads();
    if (threadIdx.x == 0) {
        unsigned* bar = b.bar;
        __builtin_amdgcn_s_waitcnt(0);
        unsigned nloc = b.st[0], nx = b.st[1];
        if (nloc == 0u) { xcd_barrier_complete(bar, b.x, nloc, nx); b.st[0] = nloc; b.st[1] = nx; }
        const unsigned old = xb_add(&bar[XB_XSUB(b.x)], 1u);
        const unsigned gen = old / nloc;
        if (old + 1u == (gen + 1u) * nloc) {
            __builtin_amdgcn_fence(__ATOMIC_RELEASE, "agent");
            asm volatile("s_waitcnt vmcnt(0)" ::: "memory");
            const unsigned og = xb_add(&bar[XB_TOP], 1u);
            const unsigned tg = og / nx;
            if (og + 1u == (tg + 1u) * nx) xb_add(&bar[XB_TOPGEN], 1u);
            else XB_SPIN(xb_ld(&bar[XB_TOPGEN]) == tg, bar);
            __builtin_amdgcn_fence(__ATOMIC_ACQUIRE, "agent");
            xb_add(&bar[XB_XGEN(b.x)], 1u);
            asm volatile("s_waitcnt vmcnt(0)" ::: "memory");
        } else {
            XB_SPIN(xb_ld(&bar[XB_XGEN(b.x)]) == gen, bar);
            __builtin_amdgcn_fence(__ATOMIC_ACQUIRE, "agent");
            asm volatile("s_waitcnt vmcnt(0)" ::: "memory");
        }
    }
    __syncthreads();
}

constexpr int N_PHASES = 8;
#ifndef DESYNC_TICKS
#define DESYNC_TICKS 0
#endif
#ifndef DESYNC_MASK
#define DESYNC_MASK 0
#endif
__device__ __forceinline__ void phase_stagger(int vcu, int ph) {
    if (!((DESYNC_MASK >> ph) & 1) || DESYNC_TICKS == 0) return;
    const unsigned long long t0 = __builtin_amdgcn_s_memrealtime(); const unsigned long long want = (unsigned long long)((vcu & 3) * DESYNC_TICKS);
    while (__builtin_amdgcn_s_memrealtime() - t0 < want) __builtin_amdgcn_s_sleep(4);
}
#ifndef PROBE_REP_MASK
#define PROBE_REP_MASK 0
#endif
#ifndef PROBE_REPN
#define PROBE_REPN 2
#endif
#define NREP(k) (((PROBE_REP_MASK >> (k)) & 1) ? PROBE_REPN : 1)
struct Args { Inputs in; float* out; unsigned char* ws; int ph_lo, ph_hi; };

__global__ void __launch_bounds__(512, 2) mega(Args args) {
    extern __shared__ __attribute__((aligned(16))) unsigned char lds_raw[];
    LAS unsigned char* lds = (LAS unsigned char*)lds_raw;
    const int tid = threadIdx.x, lane = tid & 63, wave = __builtin_amdgcn_readfirstlane(tid >> 6);
    const int G = gridDim.x; const int bx = blockIdx.x; const int vcu = (G % 8 == 0) ? (bx % 8) * (G / 8) + bx / 8 : bx;
    unsigned char* ws = args.ws; const Inputs& in = args.in;
    unsigned* ctl = (unsigned*)(ws + WS_CTL);
    volatile LAS unsigned* MISC = (volatile LAS unsigned*)(lds + MISC_OFF);
    LAS int* moetab = (LAS int*)(lds + MOETAB_OFF);
    for (int u = tid; u < (LDS_BYTES - LDSCTL_OFF) / 4; u += 512) ((LAS unsigned*)(lds + LDSCTL_OFF))[u] = 0u;
    __syncthreads();
    const int lo = args.ph_lo, hi = args.ph_hi;
    const bool multi = (hi - lo) > 1;
    XcdBarrier bar; bar.bar = ctl + CW_BAR; bar.x = 0; bar.st = nullptr;
    if (multi) bar = xcd_barrier_post(ctl + CW_BAR, MISC + 8);
#define IN(k) (lo <= (k) && (k) < hi)
#define SEAM(k) do { if (IN(k) && IN((k) + 1)) xcd_barrier(bar); } while (0)

    if (IN(0)) { for (int rep = 0; rep < NREP(0); ++rep) { p0_prologue(in, ws, vcu * 8 + wave, G * 8, lane, (LAS float*)(lds + wave * 16384)); if (rep + 1 < NREP(0)) xcd_barrier(bar); } SEAM(0); }

    if (IN(1)) {
        pg8::DenseOrder S; S.init((const bf16_t*)(ws + WS_XN), (const bf16_t*)(ws + WS_WIN), NTOK, NPROJ, DM, G, bx);
        EpiInProj E{ws}; phase_stagger(vcu, 1);
        for (int rep = 0; rep < NREP(1); ++rep) { pg8::gemm_phase(lds, S, E); if (rep + 1 < NREP(1)) xcd_barrier(bar); } SEAM(1);
    }
    if (IN(2)) {
#ifdef HAVE_ATTN
        for (int rep = 0; rep < NREP(2); ++rep) { attn_phase<0>(lds, ws, in, G, vcu); if (rep + 1 < NREP(2)) xcd_barrier(bar); }
#endif
        SEAM(2);
    }
    if (IN(3)) {
        pg8::DenseOrder S; S.init((const bf16_t*)(ws + WS_Y), (const bf16_t*)(ws + WS_WOUT), NTOK, DM, DM, G, bx);
        EpiOutProj E{ws, in.x}; phase_stagger(vcu, 3);
        for (int rep = 0; rep < NREP(3); ++rep) { pg8::gemm_phase(lds, S, E); if (rep + 1 < NREP(3)) xcd_barrier(bar); } SEAM(3);
    }
    if (IN(4)) {
        pg8::DenseOrder S; S.init((const bf16_t*)(ws + WS_X1B), (const bf16_t*)(ws + WS_WR), NTOK, 256, DM, G, bx);
        EpiRoute E{ws, lds};
        pg8::gemm_phase<EpiRoute, pg8::DenseOrder, true>(lds, S, E); SEAM(4);
    }
#ifndef DEBUG_SKIP5
    if (IN(5)) {
        moe_tables(ws, moetab);
        MoeOrder S{(const bf16_t*)(ws + WS_X1B), (const bf16_t*)(ws + WS_WGU), DM, 0, (const int*)(ws + WS_LTOK), moetab, G, vcu};
        EpiGateUp E{ws, moetab}; phase_stagger(vcu, 5);
        for (int rep = 0; rep < NREP(5); ++rep) { pg8::gemm_phase(lds, S, E); if (rep + 1 < NREP(5)) xcd_barrier(bar); } SEAM(5);
    }
#endif
#ifndef DEBUG_SKIP6
    if (IN(6)) {
        if (!IN(5)) moe_tables(ws, moetab);
        MoeOrder S{(const bf16_t*)(ws + WS_HID2), (const bf16_t*)(ws + WS_WD), 2 * EHID, 3, (const int*)(ws + WS_LTOK), moetab, G, vcu};
        EpiDownPair E{ws, args.out}; phase_stagger(vcu, 6);
        for (int rep = 0; rep < NREP(6); ++rep) { pg8::gemm_phase<EpiDownPair, MoeOrder, false, true>(lds, S, E); if (rep + 1 < NREP(6)) xcd_barrier(bar); }
    }
#endif
#ifdef PROBE_EXTRA_BARRIERS
    if (multi) { for (int k = 0; k < PROBE_EXTRA_BARRIERS; ++k) xcd_barrier(bar); }
#endif
#undef IN
#undef SEAM
}

#ifdef PROBE_ATTN_ABL
__global__ void __launch_bounds__(512, 2) attn_probe(Args args) {
    extern __shared__ __attribute__((aligned(16))) unsigned char lds_raw_p[];
    LAS unsigned char* lds = (LAS unsigned char*)lds_raw_p;
    const int G = gridDim.x; const int bx = blockIdx.x; const int vcu = (G % 8 == 0) ? (bx % 8) * (G / 8) + bx / 8 : bx;
    attn_phase<PROBE_ATTN_ABL>(lds, args.ws, args.in, G, vcu);
}
#endif

#ifdef PROBE_UBENCH2
typedef float ub2_f32x16 __attribute__((ext_vector_type(16))); typedef short ub2_bf16x8 __attribute__((ext_vector_type(8))); typedef short ub2_s16x4 __attribute__((ext_vector_type(4)));
template <int V> __global__ void __launch_bounds__(512, 2) ubench2(float* sink, int iters) {
    __shared__ __attribute__((aligned(16))) unsigned char sm[57344];
    LAS unsigned char* lds = (LAS unsigned char*)sm;
    for (int i = threadIdx.x; i < 57344 / 4; i += 512) ((LAS float*)lds)[i] = -0.001f * (float)(i & 1023);
    __syncthreads();
    const int lane = threadIdx.x & 63, hi = lane >> 5, r32 = lane & 31;
    ub2_f32x16 pa0, pa1, pb0 = {}, pb1 = {}, o0 = {}, o1 = {}; ub2_bf16x8 q = {1, 2, 3, 4, 5, 6, 7, 8};
#pragma unroll
    for (int i = 0; i < 16; ++i) { pa0[i] = -0.001f * (float)(threadIdx.x + i); pa1[i] = -0.002f * (float)(threadIdx.x + i); }
    asm volatile("" : "+v"(q));
    const LAS unsigned char* kp = lds + hi * 1024 + r32 * 16;
    const LAS unsigned char* vp = lds + 8192 + ((lane >> 4) & 1) * 32 + (lane & 3) * 8 + (4 * hi + ((lane & 15) >> 2)) * 64;
    const LAS unsigned char* tp = lds + 16384 + ((lane & 3) * 2384 + ((2047 - lane) & ~3)) * 4 % 36864;
    float ls0 = 0.f, ls1 = 0.f;
#define UB_MFMA(a, b, c) ((V & 128) ? (c) : __builtin_amdgcn_mfma_f32_32x32x16_bf16(a, b, c, 0, 0, 0))
#define UB_VLOAD(g) do { if ((g) < 8) { if (V & 2) { vl[(g) % 3] = __builtin_bit_cast(ub2_s16x4, __builtin_amdgcn_ds_read_tr16_b64_v4i16((LAS ub2_s16x4*)(vp + ((g) & 1) * 4096 + ((g) >> 1) * 1024))); vh[(g) % 3] = __builtin_bit_cast(ub2_s16x4, __builtin_amdgcn_ds_read_tr16_b64_v4i16((LAS ub2_s16x4*)(vp + ((g) & 1) * 4096 + ((g) >> 1) * 1024 + 512))); } else { vl[(g) % 3] = ub2_s16x4{1, 2, 3, 4}; vh[(g) % 3] = ub2_s16x4{4, 3, 2, 1}; asm volatile("" : "+v"(vl[(g) % 3]), "+v"(vh[(g) % 3])); } } } while (0)
#define UB_SUMPACK(PC0, PC1, ks) do { _Pragma("unroll") for (int i = 0; i < 4; ++i) { const float a_ = (ks) == 0 ? PC0[2 * i] : (ks) == 1 ? PC0[8 + 2 * i] : (ks) == 2 ? PC1[2 * i] : PC1[8 + 2 * i]; const float b_ = (ks) == 0 ? PC0[2 * i + 1] : (ks) == 1 ? PC0[9 + 2 * i] : (ks) == 2 ? PC1[2 * i + 1] : PC1[9 + 2 * i]; \
            if (V & 32) { ls0 += a_; ls1 += b_; pw[(ks) & 1][i] = att::cvtpk(a_, b_); } else pw[(ks) & 1][i] = __builtin_bit_cast(unsigned, a_); } asm volatile("" : "+v"(ls0), "+v"(ls1), "+v"(pw[(ks) & 1])); } while (0)
#define UB_STEP(PC0, PC1, PN0, PN1) do { \
        ub2_bf16x8 kf[8]; \
        _Pragma("unroll") for (int i = 0; i < 8; ++i) { if (V & 1) kf[i] = *(const LAS ub2_bf16x8*)(kp + (i >> 1) * 2048 + (i & 1) * 512); else kf[i] = q; } \
        __builtin_amdgcn_sched_barrier(0); \
        _Pragma("unroll") for (int i = 0; i < 8; ++i) { \
            if (i & 1) PN1 = UB_MFMA(kf[i], q, PN1); else PN0 = UB_MFMA(kf[i], q, PN0); \
            if (V & 16) { _Pragma("unroll") for (int k = 0; k < 4; ++k) { const int e = 4 * i + k; if (e < 16) PC0[e] = __builtin_amdgcn_exp2f(PC0[e]); else PC1[e - 16] = __builtin_amdgcn_exp2f(PC1[e - 16]); } } \
            if (i < 4) asm volatile("" : "+v"(PC0)); else asm volatile("" : "+v"(PC1)); \
            __builtin_amdgcn_sched_barrier(0); } \
        if (V & 64) { asm volatile("s_waitcnt lgkmcnt(0)" ::: "memory"); __builtin_amdgcn_s_barrier(); __builtin_amdgcn_sched_barrier(0); } \
        v4u pw[2]; ub2_s16x4 vl[3], vh[3]; \
        UB_VLOAD(0); UB_VLOAD(1); UB_SUMPACK(PC0, PC1, 0); __builtin_amdgcn_sched_barrier(0); \
        _Pragma("unroll") for (int g = 0; g < 8; ++g) { const int ks = g / 2, d0 = g % 2; \
            UB_VLOAD(g + 2); \
            { const ub2_s16x4 a_ = vl[g % 3], b_ = vh[g % 3]; const ub2_bf16x8 vf = {a_[0], a_[1], a_[2], a_[3], b_[0], b_[1], b_[2], b_[3]}; \
              if (d0) o1 = UB_MFMA(__builtin_bit_cast(ub2_bf16x8, pw[ks & 1]), vf, o1); else o0 = UB_MFMA(__builtin_bit_cast(ub2_bf16x8, pw[ks & 1]), vf, o0); } \
            if (d0 == 0 && ks < 3) UB_SUMPACK(PC0, PC1, ks + 1); \
            if (g == 5) { if (V & 4) { _Pragma("unroll") for (int c = 0; c < 4; ++c) { const f32x4 c0 = *(const LAS f32x4*)(tp + c * 32), c1 = *(const LAS f32x4*)(tp + 128 + c * 32); \
                        PC0[4 * c] = c0[0]; PC0[4 * c + 1] = c0[1]; PC0[4 * c + 2] = c0[2]; PC0[4 * c + 3] = c0[3]; PC1[4 * c] = c1[0]; PC1[4 * c + 1] = c1[1]; PC1[4 * c + 2] = c1[2]; PC1[4 * c + 3] = c1[3]; } } \
                else { asm volatile("" : "+v"(PC0), "+v"(PC1)); } } \
            __builtin_amdgcn_sched_barrier(0); } \
        if (V & 8) { asm volatile("s_waitcnt lgkmcnt(0)" ::: "memory"); __builtin_amdgcn_s_barrier(); __builtin_amdgcn_sched_barrier(0); } } while (0)
    for (int it = 0; it < iters; it += 2) { UB_STEP(pa0, pa1, pb0, pb1); UB_STEP(pb0, pb1, pa0, pa1); }
    float s = ls0 + ls1;
#pragma unroll
    for (int i = 0; i < 16; ++i) s += o0[i] + o1[i] + pa0[i] + pa1[i] + pb0[i] + pb1[i];
    if (s == 123.456f) sink[threadIdx.x] = s;
#undef UB_VLOAD
#undef UB_SUMPACK
#undef UB_STEP
#undef UB_MFMA
}
#endif

#ifdef PROBE_UBENCH
typedef float ub_f32x16 __attribute__((ext_vector_type(16))); typedef short ub_bf16x8 __attribute__((ext_vector_type(8)));
template <int V> __global__ void __launch_bounds__(512, 2) ubench(float* sink, int iters) {
    ub_f32x16 a0 = {}, a1 = {}; ub_bf16x8 x = {1, 2, 3, 4, 5, 6, 7, 8}, y = {8, 7, 6, 5, 4, 3, 2, 1};
    float e[32];
#pragma unroll
    for (int i = 0; i < 32; ++i) e[i] = -0.001f * (float)(threadIdx.x + i);
    asm volatile("" : "+v"(x), "+v"(y));
    for (int it = 0; it < iters; ++it) {
#pragma unroll
        for (int g = 0; g < 16; ++g) {
            if (V & 1) { if (g & 1) a1 = __builtin_amdgcn_mfma_f32_32x32x16_bf16(x, y, a1, 0, 0, 0); else a0 = __builtin_amdgcn_mfma_f32_32x32x16_bf16(x, y, a0, 0, 0, 0); }
            if (V & 2) {
#pragma unroll
                for (int k = 0; k < 4; ++k) { const int i = (4 * g + k) & 31; e[i] = __builtin_amdgcn_exp2f(e[i]) - 1.0f; } }
            if (V & 4) {
#pragma unroll
                for (int k = 0; k < 2; ++k) { const int i = (2 * g + k) & 31; e[i] = __builtin_amdgcn_exp2f(e[i]) - 1.0f; } }
            __builtin_amdgcn_sched_barrier(0);
        }
    }
    float s = 0.f;
#pragma unroll
    for (int i = 0; i < 32; ++i) s += e[i];
#pragma unroll
    for (int i = 0; i < 16; ++i) s += a0[i] + a1[i];
    if (s == 123.456f) sink[threadIdx.x] = s;
}
#endif

extern "C" void kernel_launch(void* const* d_in, const int* in_sizes, int n_in, void* d_out, int out_size, void* d_ws, size_t ws_size, hipStream_t stream) {
    static int grid = 0;
    if (grid == 0) {
        if (n_in != 20 || in_sizes[0] != NTOK * DM || out_size != NTOK * DM || ws_size < WS_END) { fprintf(stderr, "kernel_launch: unexpected shapes (n_in %d, ws %zu)\n", n_in, ws_size); grid = -1; return; }
        int dev = 0, cus = 0, per_cu = 0;
        if (hipGetDevice(&dev) != hipSuccess || hipDeviceGetAttribute(&cus, hipDeviceAttributeMultiprocessorCount, dev) != hipSuccess) { grid = -1; return; }
        if (hipFuncSetAttribute((const void*)mega, hipFuncAttributeMaxDynamicSharedMemorySize, LDS_BYTES) != hipSuccess) { fprintf(stderr, "kernel_launch: hipFuncSetAttribute failed\n"); grid = -1; return; }
        if (hipOccupancyMaxActiveBlocksPerMultiprocessor(&per_cu, (const void*)mega, 512, LDS_BYTES) != hipSuccess || per_cu < 1) { fprintf(stderr, "kernel_launch: occupancy query says %d blocks per CU\n", per_cu); (void)hipGetLastError(); grid = -1; return; }
        grid = cus;
    }
    if (grid < 0) return;
    Args a{};
    const float** ip = (const float**)&a.in;
    for (int i = 0; i < 20; ++i) ip[i] = (const float*)d_in[i];
    a.out = (float*)d_out; a.ws = (unsigned char*)d_ws; a.ph_lo = 0; a.ph_hi = N_PHASES;
    (void)hipMemsetAsync((unsigned char*)d_ws + WS_CTL, 0, CTL_ZERO_BYTES, stream);
    hipLaunchKernelGGL(mega, dim3(grid), dim3(512), LDS_BYTES, stream, a);
#ifdef PROBE_ATTN_ABL
    { static bool ad = false; if (!ad) { (void)hipFuncSetAttribute((const void*)attn_probe, hipFuncAttributeMaxDynamicSharedMemorySize, LDS_BYTES); ad = true; }
      hipLaunchKernelGGL(attn_probe, dim3(grid), dim3(512), LDS_BYTES, stream, a); }
#endif
#ifdef PROBE_UBENCH2
    hipLaunchKernelGGL(ubench2<PROBE_UBENCH2>, dim3(grid), dim3(512), 0, stream, (float*)((unsigned char*)d_ws + WS_SS), 1000);
#endif
#ifdef PROBE_UBENCH
    hipLaunchKernelGGL(ubench<PROBE_UBENCH>, dim3(grid), dim3(PROBE_UB_THREADS), 0, stream, (float*)((unsigned char*)d_ws + WS_SS), 1000);
#endif
#ifdef PROBE_EXTRA_LO
    for (int k = PROBE_EXTRA_LO; k < PROBE_EXTRA_HI; ++k) { a.ph_lo = k; a.ph_hi = k + 1; hipLaunchKernelGGL(mega, dim3(grid), dim3(512), LDS_BYTES, stream, a); }
#endif
}
```

```cpp
#include <hip/hip_runtime.h>
#include <cstdint>
#include <cstdio>

typedef unsigned short bf16_t;
typedef unsigned v4u __attribute__((ext_vector_type(4)));
typedef unsigned v2u __attribute__((ext_vector_type(2)));
typedef float f32x4 __attribute__((ext_vector_type(4)));
#define LAS __attribute__((address_space(3)))

constexpr int BATCH = 32, SEQ = 2048, DM = 1024, NTOK = BATCH * SEQ;
constexpr int HD = 64, HDIFF = 4, HMOBA = 8, NPROJ = 3072;
constexpr int NEXP = 32, EHID = 256, NLIST = 64;
constexpr int LIST_CAP = NTOK;
constexpr float RMS_EPS = 1e-6f;
constexpr float LOG2E = 1.4426950408889634f;
constexpr float C2 = 0.125f * LOG2E;
constexpr float LAMBDA_INIT = 0.2f;

constexpr size_t MiB = 1u << 20;
constexpr size_t WS_CTL = 0, CTL_ZERO_BYTES = 1 * MiB;
constexpr size_t WS_CONST = 1 * MiB;
constexpr size_t WS_WIN = 2 * MiB, WS_WOUT = 8 * MiB, WS_WR = 10 * MiB, WS_WGU = 12 * MiB, WS_WD = 44 * MiB;
constexpr size_t WS_QD = 64 * MiB, WS_KD = 128 * MiB, WS_VD = 192 * MiB, WS_QM = 256 * MiB, WS_KM = 320 * MiB, WS_VM = 384 * MiB;
constexpr size_t WS_XN = 448 * MiB, WS_Y = 448 * MiB;
constexpr size_t WS_X1B = 576 * MiB, WS_SS = 704 * MiB  , WS_R2 = 708 * MiB, WS_KMEAN = 709 * MiB;
constexpr size_t WS_PA = 64 * MiB, WS_HID = 192 * MiB, WS_LTOK = 272 * MiB, WS_LW = 288 * MiB;
constexpr size_t WS_END = 711 * MiB;
constexpr size_t WS_HID2 = 64 * MiB  , WS_LP = 320 * MiB  , WS_PTOK = 336 * MiB  ;
constexpr int NPAIR = 112;
constexpr int CW_PCNT = 16384;
constexpr int CW_CNT = 1024;
#ifndef DBG_MEASURE
#define DBG_MEASURE 0
#endif
constexpr int CF_DBG = 8;
constexpr int CF_LAMBDA = 0, CF_OFF = 16, CF_GAIN = 64  , CF_BT = 1024;

__device__ __forceinline__ float bf2f(bf16_t v) { return __uint_as_float(((unsigned)v) << 16); }
__device__ __forceinline__ unsigned f2bf(float f) { unsigned u = __float_as_uint(f); return (u + 0x7fffu + ((u >> 16) & 1u)) >> 16; }
__device__ __forceinline__ unsigned pk2(float lo, float hi) { return f2bf(lo) | (f2bf(hi) << 16); }
__device__ __forceinline__ float wave_sum(float v) {
#pragma unroll
    for (int o = 1; o < 64; o <<= 1) v += __shfl_xor(v, o);
    return v;
}
__device__ __forceinline__ float wave_max(float v) {
#pragma unroll
    for (int o = 1; o < 64; o <<= 1) v = fmaxf(v, __shfl_xor(v, o));
    return v;
}
__host__ __device__ __forceinline__ int phys_in(int c) { const int pn = c >> 8, cc = c & 255; return 256 * pn + 128 * ((cc >> 5) & 1) + 32 * (cc >> 6) + (cc & 31); }
__device__ __forceinline__ int t5_bucket(int d) {
    if (d < 16) return d;
    const float nf = (float)d;
    int large = 16 + (int)(logf(nf / 16.0f) / 4.852030263919617f * 16.0f);
    return large < 31 ? large : 31;
}

struct Inputs {
    const float *x, *norm1_g, *w_in, *diff_q_g, *diff_k_g, *lq1, *lk1, *lq2, *lk2, *diff_sub_g, *moba_q_g, *moba_k_g, *rel_bias, *w_out, *norm2_g,
        *router_group, *router_expert, *w_gate, *w_up, *w_down;
};

__device__ __forceinline__ void p0_tr_item(const float* W, int ldw, int k0, int n_src, const float* gk, bf16_t* dst, int drow0, int dpitch, LAS float* scr, int lane) {
    float wv[32];
#pragma unroll
    for (int i = 0; i < 32; ++i) wv[i] = W[(size_t)(k0 + 2 * i + (lane >> 5)) * ldw + n_src + (lane & 31)];
#pragma unroll
    for (int i = 0; i < 32; ++i) { const int kk = 2 * i + (lane >> 5); float v = wv[i]; if (gk) v *= gk[k0 + kk]; scr[kk * 33 + (lane & 31)] = v; }
    asm volatile("s_waitcnt lgkmcnt(0)" ::: "memory");
    const int c = lane & 7;
#pragma unroll
    for (int j = 0; j < 4; ++j) {
        const int n = (lane >> 3) + 8 * j; const LAS float* s = scr + (8 * c) * 33 + n;
        v4u o; o.x = pk2(s[0 * 33], s[1 * 33]); o.y = pk2(s[2 * 33], s[3 * 33]); o.z = pk2(s[4 * 33], s[5 * 33]); o.w = pk2(s[6 * 33], s[7 * 33]);
        *(v4u*)(dst + (size_t)(drow0 + n) * dpitch + k0 + 8 * c) = o;
    }
    asm volatile("s_waitcnt lgkmcnt(0)" ::: "memory");
}

__device__ __forceinline__ void p0_prologue(const Inputs& in, unsigned char* ws, int gw, int NGW, int lane, LAS float* scr) {
    bf16_t* WIN_T = (bf16_t*)(ws + WS_WIN); bf16_t* WOUT_T = (bf16_t*)(ws + WS_WOUT); bf16_t* WR_T = (bf16_t*)(ws + WS_WR);
    bf16_t* WGU_T = (bf16_t*)(ws + WS_WGU); bf16_t* WD_T = (bf16_t*)(ws + WS_WD); bf16_t* XN = (bf16_t*)(ws + WS_XN);
    float* CF = (float*)(ws + WS_CONST);
    constexpr int I_IN = 16 * 96, I_OUT = 16 * 32, I_GU = 32 * 16 * 16, I_D = 32 * 4 * 32, NITEMS = I_IN + I_OUT + I_GU + I_D;
    for (int it = gw; it < NITEMS; it += NGW) {
        int r = it;
        if (r < I_IN) {
            const int kb = r / 96, nb = r % 96, p0 = 32 * nb, pn = p0 >> 8, pp = p0 & 255, bj = pp >> 7, wc = (pp >> 5) & 3;
            p0_tr_item(in.w_in, NPROJ, 64 * kb, 256 * pn + 64 * wc + 32 * bj, in.norm1_g, WIN_T, p0, DM, scr, lane); continue; }
        r -= I_IN;
        if (r < I_OUT) { const int kb = r / 32, nb = r % 32; p0_tr_item(in.w_out, DM, 64 * kb, 32 * nb, nullptr, WOUT_T, 32 * nb, DM, scr, lane); continue; }
        r -= I_OUT;
        if (r < I_GU) {
            const int e = r / 256, rr = r % 256, kb = rr / 16, nb = rr % 16, p0 = 32 * nb, pn = p0 >> 8, bj = (p0 >> 7) & 1, j0 = p0 & 127;
            const float* src = (bj ? in.w_up : in.w_gate) + (size_t)e * DM * EHID;
            p0_tr_item(src, EHID, 64 * kb, 128 * pn + j0, in.norm2_g, WGU_T + (size_t)e * 512 * DM, p0, DM, scr, lane); continue; }
        r -= I_GU;
        { const int e = r / 128, rr = r % 128, kb = rr / 32, nb = rr % 32;
          p0_tr_item(in.w_down + (size_t)e * EHID * DM, DM, 64 * kb, 32 * nb, nullptr, WD_T + (size_t)e * DM * EHID, 32 * nb, EHID, scr, lane); }
    }
    for (int idx = gw * 64 + lane; idx < 256 * DM; idx += NGW * 64) {
        const int p = idx >> 10, k = idx & 1023, g = (p >> 5) & 3, i = p & 31; float v = 0.f;
        if (p < 128) { if (i < 8) v = in.norm2_g[k] * in.router_expert[((size_t)g * DM + k) * 8 + i]; else if (i < 12) v = in.norm2_g[k] * in.router_group[k * 4 + (i - 8)]; }
        WR_T[idx] = (bf16_t)f2bf(v);
    }
    for (int idx = gw * 64 + lane; idx < 12 * 2048; idx += NGW * 64) {
        const int h = idx >> 11, d = idx & 2047; CF[CF_BT + idx] = in.rel_bias[t5_bucket(d) * 12 + h] * LOG2E;
    }
    if (gw == 0) {
        float a = in.lq1[lane] * in.lk1[lane], b = in.lq2[lane] * in.lk2[lane];
        a = wave_sum(a); b = wave_sum(b);
        const float mqd = wave_max(fabsf(in.diff_q_g[lane])), mkd = wave_max(fabsf(in.diff_k_g[lane]));
        const float mqm = wave_max(fabsf(in.moba_q_g[lane])), mkm = wave_max(fabsf(in.moba_k_g[lane]));
        if (lane == 0) CF[CF_LAMBDA] = expf(a) - expf(b) + LAMBDA_INIT;
        CF[CF_GAIN + lane] = in.diff_q_g[lane]; CF[CF_GAIN + 64 + lane] = in.diff_k_g[lane]; CF[CF_GAIN + 128 + lane] = in.moba_q_g[lane]; CF[CF_GAIN + 192 + lane] = in.moba_k_g[lane];
        if (lane < 12) {
            float mb = -1e30f; for (int bk = 0; bk < 32; ++bk) mb = fmaxf(mb, in.rel_bias[bk * 12 + lane]);
            const float qk = lane < 4 ? mqd * mkd : mqm * mkm;
            CF[CF_OFF + lane] = (8.0f * qk + mb) * LOG2E;
        }
    }
    for (int m0 = gw * 4; m0 < NTOK; m0 += NGW * 4) {
        f32x4 v[4][4];
#pragma unroll
        for (int rr = 0; rr < 4; ++rr) { const f32x4* xr = (const f32x4*)(in.x + (size_t)(m0 + rr) * DM) + lane;
#pragma unroll
            for (int j = 0; j < 4; ++j) v[rr][j] = __builtin_nontemporal_load(xr + 64 * j); }
#pragma unroll
        for (int rr = 0; rr < 4; ++rr) { float s = 0.f;
#pragma unroll
            for (int j = 0; j < 4; ++j) s += (v[rr][j].x * v[rr][j].x + v[rr][j].y * v[rr][j].y) + (v[rr][j].z * v[rr][j].z + v[rr][j].w * v[rr][j].w);
            const float r = rsqrtf(wave_sum(s) * (1.f / DM) + RMS_EPS);
            unsigned long long* o8 = (unsigned long long*)(XN + (size_t)(m0 + rr) * DM) + lane;
#pragma unroll
            for (int j = 0; j < 4; ++j) o8[64 * j] = (unsigned long long)pk2(v[rr][j].x * r, v[rr][j].y * r) | ((unsigned long long)pk2(v[rr][j].z * r, v[rr][j].w * r) << 32); }
    }
}

namespace pg8 {
typedef short bf16x8 __attribute__((ext_vector_type(8)));
constexpr int BM = 256, BK = 64, HALF = 128, HTB = HALF * BK * 2, STAGE_BYTES = 8 * HTB, NXCD = 8, WGM = 8;

__host__ __device__ __forceinline__ int lds_byte(int r, int c) { const int st = (r >> 4) * 2 + (c >> 5), rr = r & 15, cc = c & 31, ob = rr * 64 + cc * 2; return st * 1024 + (ob ^ (((ob >> 9) & 1) << 5)); }
__host__ __device__ __forceinline__ void stage_rc(int b, int& R, int& C) { const int st = b / 1024, sb = b % 1024, swz = sb ^ (((sb >> 9) & 1) << 5); R = (st >> 1) * 16 + swz / 64; C = (st & 1) * 32 + (swz % 64) / 2; }
__host__ __device__ __forceinline__ int perm32(int rho) { const int n = rho >> 4, i = rho & 15; return 8 * (i >> 2) + 4 * n + (i & 3); }

struct Unit { int pm, pn, a0, a1; };

struct DenseOrder {
    const bf16_t* A; const bf16_t* Bt; int K; int nM, nN, nwg, G, c;
    __device__ void init(const bf16_t* A_, const bf16_t* Bt_, int M, int N, int K_, int G_, int c_) { A = A_; Bt = Bt_; K = K_; nM = M / BM; nN = N / BM; nwg = nM * nN; G = G_; c = c_; }
    __device__ __forceinline__ bool next(int i, Unit& u) const {
        const long L = (long)i * G + c; if (L >= nwg) return false;
        int wgid = (int)L; { const int q = nwg / NXCD, r = nwg % NXCD, xcd = wgid % NXCD, off = wgid / NXCD; wgid = (xcd < r ? xcd * (q + 1) : r * (q + 1) + (xcd - r) * q) + off; }
        const int nig = WGM * nN, gid = wgid / nig, fm = gid * WGM, gsz = (nM - fm) < WGM ? (nM - fm) : WGM;
        u.pm = fm + ((wgid % nig) % gsz); u.pn = (wgid % nig) / gsz; u.a0 = 0; u.a1 = 256; return true;
    }
    __device__ __forceinline__ const char* abase() const { return (const char*)A; }
    __device__ __forceinline__ unsigned arow(const Unit& u, int r) const { return (unsigned)(u.pm * BM + r) * (unsigned)K * 2u; }
    __device__ __forceinline__ const char* bbase(const Unit& u) const { return (const char*)Bt + (size_t)u.pn * BM * K * 2; }
};

typedef float f32x2 __attribute__((ext_vector_type(2)));
__device__ __forceinline__ unsigned cvt_pk_bf16(float lo, float hi) { unsigned r; asm volatile("v_cvt_pk_bf16_f32 %0, %1, %2" : "=v"(r) : "v"(lo), "v"(hi)); return r; }

template <class Epi, class Sched, bool HALFN = false, bool SPLITB = false>
__device__ __forceinline__ void gemm_phase(LAS unsigned char* lds, const Sched& S, const Epi& E) {
    int tid_ = threadIdx.x; asm volatile("" : "+v"(tid_));
    const int tid = tid_, wid = __builtin_amdgcn_readfirstlane(tid >> 6), lane = tid & 63, wr = wid >> 2, wc = wid & 3, fr = lane & 15, fq = lane >> 4;
    const int K = S.K, nt = K / BK; int LDB = K; if constexpr (SPLITB) LDB = S.ldb();
    int RA[2]; unsigned cA2[2], voffB[2];
#pragma unroll
    for (int i = 0; i < 2; ++i) { int R, C; stage_rc(tid * 16 + i * 8192, R, C); const int Rb = (R & ~31) + perm32(R & 31);
        RA[i] = R; cA2[i] = (unsigned)C * 2u; voffB[i] = (unsigned)(Rb * LDB + C) * 2u; }
    const size_t kstep = (size_t)(BK * 2);
    const size_t hstep = (size_t)HALF * LDB * 2;
    const unsigned ldsw = (unsigned)wid * 1024u;
    const int aoff = lds_byte(wr * 64 + fr, fq * 8), boff = lds_byte(wc * 32 + fr, fq * 8);
#define PG8_SA(b, h) (((b) * 2 + (h)) * HTB)
#define PG8_SB(b, h) ((4 + (b) * 2 + (h)) * HTB)
#define PG8_STAGE(bufoff, gbase, voff) do { _Pragma("unroll") for (int _i = 0; _i < 2; ++_i) \
        __builtin_amdgcn_global_load_lds((const unsigned*)((const char*)(gbase) + (voff)[_i]), (LAS unsigned*)(lds + (bufoff) + ldsw + _i * 8192), 16, 0, 0); } while (0)
#define PG8_LDA(dst, b, h) do { _Pragma("unroll") for (int m = 0; m < 4; ++m) _Pragma("unroll") for (int k = 0; k < 2; ++k) dst[m][k] = *(const LAS bf16x8*)(lds + PG8_SA(b, h) + aoff + m * 2048 + k * 1024); } while (0)
#define PG8_LDB(dst, b, h) do { _Pragma("unroll") for (int n = 0; n < 2; ++n) _Pragma("unroll") for (int k = 0; k < 2; ++k) dst[n][k] = *(const LAS bf16x8*)(lds + PG8_SB(b, h) + boff + n * 2048 + k * 1024); } while (0)
#define PG8_MMA(ai, bj, At, Bt) do { __builtin_amdgcn_s_setprio(1); _Pragma("unroll") for (int m = 0; m < 4; ++m) _Pragma("unroll") for (int n = 0; n < 2; ++n) _Pragma("unroll") for (int k = 0; k < 2; ++k) \
        acc[ai][bj][m][n] = __builtin_amdgcn_mfma_f32_16x16x32_bf16(Bt[n][k], At[m][k], acc[ai][bj][m][n], 0, 0, 0); __builtin_amdgcn_s_setprio(0); } while (0)
#define PG8_WAIT_V(n) asm volatile("s_waitcnt vmcnt(" #n ")" ::: "memory")
#define PG8_WAIT_L(n) asm volatile("s_waitcnt lgkmcnt(" #n ")" ::: "memory")
#define PG8_BAR __builtin_amdgcn_s_barrier()
#define PG8_SCHED __builtin_amdgcn_sched_barrier(0)
    Unit cur, nxt; int ui = 0;
    if (!S.next(0, cur)) return;
    f32x4 acc[2][2][4][2];
#pragma unroll
    for (int a = 0; a < 2; ++a)
#pragma unroll
        for (int b = 0; b < 2; ++b)
#pragma unroll
            for (int m = 0; m < 4; ++m)
#pragma unroll
                for (int n = 0; n < 2; ++n) acc[a][b][m][n] = (f32x4){0.f, 0.f, 0.f, 0.f};
    bf16x8 At[4][2], B0[2][2], B1[2][2];
    const char* const Ab = S.abase();
    unsigned oC[2][2], oN[2][2];
#pragma unroll
    for (int h = 0; h < 2; ++h)
#pragma unroll
        for (int i = 0; i < 2; ++i) { oC[h][i] = S.arow(cur, h * HALF + RA[i]) + cA2[i]; oN[h][i] = oC[h][i]; }
    const char* cB = S.bbase(cur); const char* cBh = cB; if constexpr (SPLITB) cBh = S.bbase2(cur);
    PG8_STAGE(PG8_SB(0, 0), cB, voffB); PG8_STAGE(PG8_SB(0, 1), cB + hstep, voffB); PG8_STAGE(PG8_SA(0, 0), Ab, oC[0]); PG8_STAGE(PG8_SA(0, 1), Ab, oC[1]);
    if (wr == 1) PG8_BAR;
    PG8_WAIT_V(2); PG8_BAR;
    PG8_STAGE(PG8_SB(1, 0), cB + kstep, voffB); PG8_STAGE(PG8_SA(1, 0), Ab + kstep, oC[0]); PG8_STAGE(PG8_SB(1, 1), cB + hstep + kstep, voffB);
    PG8_WAIT_V(6); PG8_BAR;
    for (;;) {
        const bool has_next = S.next(ui + 1, nxt);
        const char* nB = has_next ? S.bbase(nxt) : cB; const char* nBh = nB; if constexpr (SPLITB) { if (has_next) nBh = S.bbase2(nxt); }
        if (has_next) {
#pragma unroll
            for (int h = 0; h < 2; ++h)
#pragma unroll
                for (int i = 0; i < 2; ++i) oN[h][i] = S.arow(nxt, h * HALF + RA[i]) + cA2[i];
        }
        for (int t = 0; t < nt; t += 2) {
            const bool last = (t == nt - 2);
            const char* a1 = Ab + (size_t)(t + 1) * kstep;
            const char* a2 = last ? Ab : Ab + (size_t)(t + 2) * kstep; const char* b2 = last ? nB : ((SPLITB && t + 2 >= (nt >> 1)) ? cBh : cB) + (size_t)(t + 2) * kstep;
            const char* a3 = a2 + kstep; const char* b3 = b2 + kstep;
            unsigned o2[2][2];
#pragma unroll
            for (int h = 0; h < 2; ++h)
#pragma unroll
                for (int i = 0; i < 2; ++i) o2[h][i] = last ? oN[h][i] : oC[h][i];
            PG8_LDB(B0, 0, 0); PG8_LDB(B1, 0, 1); PG8_SCHED; PG8_LDA(At, 0, 0); PG8_STAGE(PG8_SA(1, 1), a1, oC[1]);
            PG8_WAIT_V(8); PG8_WAIT_L(0); PG8_BAR; PG8_MMA(0, 0, At, B0); if (!HALFN) PG8_MMA(0, 1, At, B1); PG8_BAR; PG8_SCHED;
            PG8_LDA(At, 0, 1); PG8_STAGE(PG8_SB(0, 0), b2, voffB); PG8_STAGE(PG8_SB(0, 1), b2 + hstep, voffB); PG8_STAGE(PG8_SA(0, 0), a2, o2[0]);
            PG8_WAIT_V(8); PG8_WAIT_L(0); PG8_BAR; PG8_MMA(1, 0, At, B0); if (!HALFN) PG8_MMA(1, 1, At, B1); PG8_BAR; PG8_SCHED;
            PG8_LDB(B0, 1, 0); PG8_LDB(B1, 1, 1); PG8_SCHED; PG8_LDA(At, 1, 0); PG8_STAGE(PG8_SA(0, 1), a2, o2[1]);
            PG8_WAIT_V(8); PG8_WAIT_L(0); PG8_BAR; PG8_MMA(0, 0, At, B0); if (!HALFN) PG8_MMA(0, 1, At, B1); PG8_BAR; PG8_SCHED;
            PG8_LDA(At, 1, 1); PG8_STAGE(PG8_SB(1, 0), b3, voffB); PG8_STAGE(PG8_SB(1, 1), b3 + hstep, voffB); PG8_STAGE(PG8_SA(1, 0), a3, o2[0]);
            PG8_WAIT_V(8); PG8_WAIT_L(0); PG8_BAR; PG8_MMA(1, 0, At, B0); if (!HALFN) PG8_MMA(1, 1, At, B1); PG8_BAR; PG8_SCHED;
        }
        if (wr == 0) PG8_BAR;
        { int frE = fr, fqE = fq; asm volatile("" : "+v"(frE), "+v"(fqE));
          E(acc, cur, wr, wc, frE, fqE); }
        if (!has_next) break;
#pragma unroll
        for (int a = 0; a < 2; ++a)
#pragma unroll
            for (int b = 0; b < 2; ++b)
#pragma unroll
                for (int m = 0; m < 4; ++m)
#pragma unroll
                    for (int n = 0; n < 2; ++n) acc[a][b][m][n] = (f32x4){0.f, 0.f, 0.f, 0.f};
        cur = nxt; cB = nB; cBh = nBh; ++ui;
#pragma unroll
        for (int h = 0; h < 2; ++h)
#pragma unroll
            for (int i = 0; i < 2; ++i) oC[h][i] = oN[h][i];
        if (wr == 1) PG8_BAR;
    }
    PG8_WAIT_V(0);
    PG8_BAR;
#undef PG8_SA
#undef PG8_SB
#undef PG8_STAGE
#undef PG8_LDA
#undef PG8_LDB
#undef PG8_MMA
#undef PG8_WAIT_V
#undef PG8_WAIT_L
#undef PG8_BAR
#undef PG8_SCHED
}
}

constexpr size_t WS_LR = 304 * MiB;
constexpr int SS_PARTS = 16;
constexpr int RING_BYTES = 131072  , LDSCTL_OFF = 139264  , MISC_OFF = LDSCTL_OFF + 320, MOETAB_OFF = LDSCTL_OFF + 1024;
constexpr int LDS_BYTES = 147456;
constexpr int MT_CNT = 0, MT_ALL = 64, MT_R0 = 64 + 65, MT_R1 = 64 + 65 + 33;
constexpr int PAIRTAB_OFF = LDSCTL_OFF + 6656;
constexpr int PT_CNT = 0, PT_ALL = NPAIR;

__device__ __forceinline__ f32x4 ldg4(const float* p) { return *(const f32x4*)p; }

struct MoeOrder {
    const bf16_t* A; const bf16_t* Bt; int K; int mode; const int* ltok; const LAS int* tab; int G, c;
    __device__ __forceinline__ bool next(int i, pg8::Unit& u) const {
        const int L = i * G + c;
        if (mode == 3) {
            const LAS int* pt = tab + (PAIRTAB_OFF - MOETAB_OFF) / 4;
            const int T = L >> 2; if (T >= pt[PT_ALL + NPAIR]) return false;
            int lo = 0;
#pragma unroll
            for (int s = 64; s >= 1; s >>= 1) if (lo + s < NPAIR && pt[PT_ALL + lo + s] <= T) lo += s;
            const int tile = T - pt[PT_ALL + lo]; u.pm = T; u.pn = L & 3; u.a0 = lo | (tile << 8); const int v = pt[PT_CNT + lo] - tile * 256; u.a1 = v < 256 ? v : 256; return true;
        }
        if (mode == 0) {
            const int T = L >> 1; if (T >= tab[MT_ALL + 64]) return false;
            int lo = 0;
#pragma unroll
            for (int s = 32; s >= 1; s >>= 1) if (tab[MT_ALL + lo + s] <= T) lo += s;
            const int tile = T - tab[MT_ALL + lo]; u.pm = T; u.pn = L & 1; u.a0 = lo | (tile << 8); const int v = tab[MT_CNT + lo] - tile * 256; u.a1 = v < 256 ? v : 256; return true;
        } else {
            const int T = L >> 2; const int tb = mode == 1 ? MT_R0 : MT_R1; if (T >= tab[tb + 32]) return false;
            int lo = 0;
#pragma unroll
            for (int s = 16; s >= 1; s >>= 1) if (tab[tb + lo + s] <= T) lo += s;
            const int list = 2 * lo + (mode - 1), tile = T - tab[tb + lo]; u.pm = tab[MT_ALL + list] + tile; u.pn = L & 3; u.a0 = list | (tile << 8);
            const int v = tab[MT_CNT + list] - tile * 256; u.a1 = v < 256 ? v : 256; return true;
        }
    }
    __device__ __forceinline__ const char* abase() const { return (const char*)A; }
    __device__ __forceinline__ unsigned arow(const pg8::Unit& u, int r) const {
        if (mode == 0) { const int list = u.a0 & 255, tile = u.a0 >> 8; const int tok = r < u.a1 ? ltok[(size_t)list * LIST_CAP + tile * 256 + r] : 0; return (unsigned)tok * (unsigned)(DM * 2); }
        if (mode == 3) return (unsigned)(u.pm * 256 + r) * (unsigned)(2 * EHID * 2);
        return (unsigned)(u.pm * 256 + r) * (unsigned)(EHID * 2);
    }
    __device__ __forceinline__ static void pair_experts(int p, int& elo, int& ehi) { const int g = p / 28; int q = p - g * 28, lo = 0;
#pragma unroll
        for (int k = 0; k < 7; ++k) if (q >= 7 - lo) { q -= 7 - lo; ++lo; }
        elo = g * 8 + lo; ehi = g * 8 + lo + 1 + q; }
    __device__ __forceinline__ int ldb() const { return EHID; }
    __device__ __forceinline__ const char* bbase2(const pg8::Unit& u) const { int elo, ehi; pair_experts(u.a0 & 255, elo, ehi); return (const char*)Bt + ((size_t)ehi * DM + u.pn * 256) * EHID * 2 - (size_t)EHID * 2; }
    __device__ __forceinline__ const char* bbase(const pg8::Unit& u) const {
        if (mode == 3) { int elo, ehi; pair_experts(u.a0 & 255, elo, ehi); return (const char*)Bt + ((size_t)elo * DM + u.pn * 256) * EHID * 2; }
        const int e = (u.a0 & 255) >> 1;
        if (mode == 0) return (const char*)Bt + ((size_t)e * 512 + u.pn * 256) * DM * 2;
        return (const char*)Bt + ((size_t)e * DM + u.pn * 256) * EHID * 2;
    }
};
__device__ __forceinline__ void moe_tables(unsigned char* ws, LAS int* tab) {
    LAS int* pt = tab + (PAIRTAB_OFF - MOETAB_OFF) / 4;
    if (threadIdx.x < 64) tab[MT_CNT + threadIdx.x] = (int)__hip_atomic_load((unsigned*)(ws + WS_CTL) + CW_CNT + 64 * threadIdx.x, __ATOMIC_RELAXED, __HIP_MEMORY_SCOPE_AGENT);
#ifndef DEBUG_NOPT
    else if (threadIdx.x < 64 + NPAIR) pt[PT_CNT + threadIdx.x - 64] = (int)__hip_atomic_load((unsigned*)(ws + WS_CTL) + CW_PCNT + 64 * (threadIdx.x - 64), __ATOMIC_RELAXED, __HIP_MEMORY_SCOPE_AGENT);
#endif
    __syncthreads();
#ifndef DEBUG_NOPT
    if (threadIdx.x == 64) { int a = 0; for (int l = 0; l < NPAIR; ++l) { pt[PT_ALL + l] = a; a += (pt[PT_CNT + l] + 255) >> 8; } pt[PT_ALL + NPAIR] = a; }
#endif
    if (threadIdx.x == 0) { int a = 0, r0 = 0, r1 = 0;
        for (int l = 0; l < 64; ++l) { const int t = (tab[MT_CNT + l] + 255) >> 8; tab[MT_ALL + l] = a; a += t; if (l & 1) { tab[MT_R1 + (l >> 1)] = r1; r1 += t; } else { tab[MT_R0 + (l >> 1)] = r0; r0 += t; } }
        tab[MT_ALL + 64] = a; tab[MT_R0 + 32] = r0; tab[MT_R1 + 32] = r1; }
    __syncthreads();
}

constexpr int GAINS_OFF = LDSCTL_OFF + 4096;
struct EpiInProj {
    unsigned char* ws; const LAS float* gl;
    __device__ __forceinline__ void operator()(const f32x4 (&acc)[2][2][4][2], const pg8::Unit& u, int wr, int wc, int fr, int fq) const {
        const int seg = u.pn >> 1, gi = ((u.pn & 1) << 2) | wc, b = u.pm >> 3, blk = u.pm & 7;
        const bool nrm = (seg != 2 && seg != 5);
        const LAS float* gp = gl + 64 * (seg == 0 ? 0 : seg == 1 ? 1 : seg == 3 ? 2 : 3);
        const float qs = (seg == 0 || seg == 3) ? C2 : 1.0f;
        f32x4 g[2][2];
#pragma unroll
        for (int bj = 0; bj < 2; ++bj)
#pragma unroll
            for (int n = 0; n < 2; ++n) g[bj][n] = nrm ? *(const LAS f32x4*)(gp + 32 * bj + 8 * fq + 4 * n) * qs : (f32x4){1.f, 1.f, 1.f, 1.f};
        bf16_t* base; size_t rstride;
        if (seg < 2) { base = (bf16_t*)(ws + (seg == 0 ? WS_QD : WS_KD)) + ((size_t)((b * 4 + (gi >> 1)) * 2 + (gi & 1)) * SEQ + blk * 256) * 64; rstride = 64; }
        else if (seg == 2) { base = (bf16_t*)(ws + WS_VD) + ((size_t)(b * 4 + (gi >> 1)) * SEQ + blk * 256) * 128 + (gi & 1) * 64; rstride = 128; }
        else { base = (bf16_t*)(ws + (seg == 3 ? WS_QM : seg == 4 ? WS_KM : WS_VM)) + ((size_t)(b * 8 + gi) * SEQ + blk * 256) * 64; rstride = 64; }
        f32x4 ks[2][2];
#pragma unroll
        for (int bj = 0; bj < 2; ++bj)
#pragma unroll
            for (int n = 0; n < 2; ++n) ks[bj][n] = (f32x4){0.f, 0.f, 0.f, 0.f};
#pragma unroll
        for (int ai = 0; ai < 2; ++ai)
#pragma unroll
            for (int m = 0; m < 4; ++m) {
                const int r = 128 * ai + 64 * wr + 16 * m + fr;
                f32x4 v[2][2]; float ss = 0.f;
#pragma unroll
                for (int bj = 0; bj < 2; ++bj)
#pragma unroll
                    for (int n = 0; n < 2; ++n) { v[bj][n] = acc[ai][bj][m][n]; ss += (v[bj][n][0] * v[bj][n][0] + v[bj][n][1] * v[bj][n][1]) + (v[bj][n][2] * v[bj][n][2] + v[bj][n][3] * v[bj][n][3]); }
                float rs = 1.f;
                if (nrm) { ss += __shfl_xor(ss, 16); ss += __shfl_xor(ss, 32); rs = rsqrtf(ss * (1.f / 64.f) + RMS_EPS); }
                bf16_t* rowp = base + (size_t)r * rstride + 8 * fq;
                const int rt = r >> 6, rk = r & 63;
#pragma unroll
                for (int bj = 0; bj < 2; ++bj) {
                    const f32x4 a = v[bj][0] * rs * g[bj][0], c = v[bj][1] * rs * g[bj][1];
                    if (seg == 4) { ks[bj][0] += a; ks[bj][1] += c; }
                    v4u w; w.x = pg8::cvt_pk_bf16(a[0], a[1]); w.y = pg8::cvt_pk_bf16(a[2], a[3]); w.z = pg8::cvt_pk_bf16(c[0], c[1]); w.w = pg8::cvt_pk_bf16(c[2], c[3]);
                    bf16_t* dst = rowp + 32 * bj;
                    if (seg == 1 || seg == 4) dst = base + (size_t)((rt * 8 + 4 * bj + fq) * 512 + rk * 8);
                    else if (seg == 5) dst = base + (size_t)((rt * 2 + bj) * 2048 + rk * 32 + 8 * fq);
                    else if (seg == 2) dst = base - (gi & 1) * 64 + (size_t)((rt * 4 + 2 * (gi & 1) + bj) * 2048 + rk * 32 + 8 * fq);
                    *(v4u*)dst = w;
                }
            }
        if (seg == 4) {
            float* km = (float*)(ws + WS_KMEAN) + (((size_t)(b * 8 + blk) * 2 + wr) * 8 + gi) * 64;
#pragma unroll
            for (int bj = 0; bj < 2; ++bj)
#pragma unroll
                for (int n = 0; n < 2; ++n) { f32x4 s = ks[bj][n];
#pragma unroll
                    for (int j = 0; j < 4; ++j) { float t = s[j]; t += __shfl_xor(t, 1); t += __shfl_xor(t, 2); t += __shfl_xor(t, 4); t += __shfl_xor(t, 8); s[j] = t; }
                    if (fr == 0) *(f32x4*)(km + 32 * bj + 8 * fq + 4 * n) = s; }
        }
    }
};

struct EpiOutProj {
    unsigned char* ws; const float* x;
    __device__ __forceinline__ void operator()(const f32x4 (&acc)[2][2][4][2], const pg8::Unit& u, int wr, int wc, int fr, int fq) const {
        bf16_t* X1B = (bf16_t*)(ws + WS_X1B); float* SS = (float*)(ws + WS_SS);
#pragma unroll
        for (int ai = 0; ai < 2; ++ai) {
            f32x4 xv[4][2][2];
#pragma unroll
            for (int m = 0; m < 4; ++m)
#pragma unroll
                for (int bj = 0; bj < 2; ++bj) { const size_t off = ((size_t)u.pm * 256 + 128 * ai + 64 * wr + 16 * m + fr) * DM + u.pn * 256 + 128 * bj + 32 * wc + 8 * fq;
                    xv[m][bj][0] = ldg4(x + off); xv[m][bj][1] = ldg4(x + off + 4); }
#pragma unroll
            for (int m = 0; m < 4; ++m) {
                const size_t row = (size_t)u.pm * 256 + 128 * ai + 64 * wr + 16 * m + fr; float ss = 0.f;
#pragma unroll
                for (int bj = 0; bj < 2; ++bj) {
                    const size_t off = row * DM + u.pn * 256 + 128 * bj + 32 * wc + 8 * fq;
                    const f32x4 a = acc[ai][bj][m][0] + xv[m][bj][0], c = acc[ai][bj][m][1] + xv[m][bj][1];
                    ss += (a[0] * a[0] + a[1] * a[1]) + (a[2] * a[2] + a[3] * a[3]) + (c[0] * c[0] + c[1] * c[1]) + (c[2] * c[2] + c[3] * c[3]);
                    v4u w; w.x = pg8::cvt_pk_bf16(a[0], a[1]); w.y = pg8::cvt_pk_bf16(a[2], a[3]); w.z = pg8::cvt_pk_bf16(c[0], c[1]); w.w = pg8::cvt_pk_bf16(c[2], c[3]);
                    *(v4u*)(X1B + off) = w;
                }
                ss += __shfl_xor(ss, 16); ss += __shfl_xor(ss, 32);
                if (fq == 0) SS[row * SS_PARTS + u.pn * 4 + wc] = ss;
            }
        }
    }
};

constexpr int ROUTE_OFF = LDSCTL_OFF + 2048;
struct EpiRoute {
    unsigned char* ws; LAS unsigned char* lds;
    __device__ __forceinline__ void operator()(const f32x4 (&acc)[2][2][4][2], const pg8::Unit& u, int wr, int wc, int fr, int fq) const {
        const float* SS = (const float*)(ws + WS_SS);
        LAS int* lcount = (LAS int*)(lds + ROUTE_OFF); LAS int* lbase = lcount + 64; LAS int* pcount = lcount + 128; LAS int* pbase = pcount + NPAIR;
        unsigned* CTL = (unsigned*)(ws + WS_CTL); int* LTOK = (int*)(ws + WS_LTOK); float* LW = (float*)(ws + WS_LW); float* LR = (float*)(ws + WS_LR); int* LP = (int*)(ws + WS_LP); int* PTOK = (int*)(ws + WS_PTOK);
        if (threadIdx.x < 64) lcount[threadIdx.x] = 0; else if (threadIdx.x < 64 + NPAIR) pcount[threadIdx.x - 64] = 0;
        asm volatile("s_waitcnt lgkmcnt(0)" ::: "memory"); __builtin_amdgcn_s_barrier(); asm volatile("" ::: "memory");
        int l0v[2][4], p0v[2][4], l1v[2][4], p1v[2][4], prv[2][4], ppv[2][4]; float w0v[2][4], w1v[2][4], r2v[2][4];
#pragma unroll
        for (int ai = 0; ai < 2; ++ai)
#pragma unroll
            for (int m = 0; m < 4; ++m) {
                const int row = u.pm * 256 + 128 * ai + 64 * wr + 16 * m + fr;
                const f32x4 e0 = acc[ai][0][m][0], e1 = acc[ai][0][m][1];
                float gl[4];
#pragma unroll
                for (int j = 0; j < 4; ++j) gl[j] = __shfl_down(e0[j], 16);
                int g = 0; float gv = gl[0];
#pragma unroll
                for (int i = 1; i < 4; ++i) if (gl[i] > gv) { gv = gl[i]; g = i; }
                l0v[ai][m] = -1; p0v[ai][m] = 0; l1v[ai][m] = 0; p1v[ai][m] = 0; prv[ai][m] = 0; ppv[ai][m] = 0; w0v[ai][m] = 0.f; w1v[ai][m] = 0.f; r2v[ai][m] = 0.f;
                if (fq == 0 && g == wc) {
                    const float* sp = SS + (size_t)row * SS_PARTS; const f32x4 s0 = ldg4(sp), s1 = ldg4(sp + 4), s2 = ldg4(sp + 8), s3 = ldg4(sp + 12);
                    const float tot = ((s0[0] + s0[1]) + (s0[2] + s0[3])) + ((s1[0] + s1[1]) + (s1[2] + s1[3])) + ((s2[0] + s2[1]) + (s2[2] + s2[3])) + ((s3[0] + s3[1]) + (s3[2] + s3[3]));
                    const float r2 = rsqrtf(tot * (1.f / DM) + RMS_EPS);
                    const float el[8] = {e0[0], e0[1], e0[2], e0[3], e1[0], e1[1], e1[2], e1[3]};
                    const float mx = fmaxf(fmaxf(gl[0], gl[1]), fmaxf(gl[2], gl[3])) * r2;
                    const float den = (__expf(gl[0] * r2 - mx) + __expf(gl[1] * r2 - mx)) + (__expf(gl[2] * r2 - mx) + __expf(gl[3] * r2 - mx));
                    const float pg = __expf(gv * r2 - mx) / den;
                    float v0 = el[0]; int x0 = 0;
#pragma unroll
                    for (int i = 1; i < 8; ++i) if (el[i] > v0) { v0 = el[i]; x0 = i; }
                    float v1 = -3.0e38f; int x1 = 0;
#pragma unroll
                    for (int i = 0; i < 8; ++i) if (i != x0 && el[i] > v1) { v1 = el[i]; x1 = i; }
                    const float w0 = 1.f / (1.f + __expf((v1 - v0) * r2));
                    const int l0 = (g * 8 + x0) * 2, l1 = (g * 8 + x1) * 2 + 1;
                    l0v[ai][m] = l0; l1v[ai][m] = l1; w0v[ai][m] = pg * w0; w1v[ai][m] = pg * (1.f - w0); r2v[ai][m] = r2;
                    p0v[ai][m] = atomicAdd((int*)(lcount + l0), 1); p1v[ai][m] = atomicAdd((int*)(lcount + l1), 1);
                    { const int lo = x0 < x1 ? x0 : x1, hi = x0 < x1 ? x1 : x0, pr = g * 28 + ((lo * (15 - lo)) >> 1) + (hi - lo - 1);
                      prv[ai][m] = pr | ((x0 > x1 ? 1 : 0) << 7); ppv[ai][m] = atomicAdd((int*)(pcount + pr), 1); }
                }
            }
        asm volatile("s_waitcnt lgkmcnt(0)" ::: "memory"); __builtin_amdgcn_s_barrier(); asm volatile("" ::: "memory");
        if (threadIdx.x < 64) lbase[threadIdx.x] = (int)atomicAdd(CTL + CW_CNT + 64 * threadIdx.x, (unsigned)lcount[threadIdx.x]);
        else if (threadIdx.x < 64 + NPAIR) { const int pq = threadIdx.x - 64; pbase[pq] = (int)atomicAdd(CTL + CW_PCNT + 64 * pq, (unsigned)pcount[pq]); }
        asm volatile("s_waitcnt vmcnt(0) lgkmcnt(0)" ::: "memory"); __builtin_amdgcn_s_barrier(); asm volatile("" ::: "memory");
#pragma unroll
        for (int ai = 0; ai < 2; ++ai)
#pragma unroll
            for (int m = 0; m < 4; ++m) if (l0v[ai][m] >= 0) {
                const int row = u.pm * 256 + 128 * ai + 64 * wr + 16 * m + fr;
                const size_t a0 = (size_t)l0v[ai][m] * LIST_CAP + lbase[l0v[ai][m]] + p0v[ai][m], a1 = (size_t)l1v[ai][m] * LIST_CAP + lbase[l1v[ai][m]] + p1v[ai][m];
                LTOK[a0] = row; LW[a0] = w0v[ai][m]; LR[a0] = r2v[ai][m]; LTOK[a1] = row; LW[a1] = w1v[ai][m]; LR[a1] = r2v[ai][m];
                { const int pr = prv[ai][m] & 127, h0 = (prv[ai][m] >> 7) & 1, ps = pbase[pr] + ppv[ai][m];
                  PTOK[(size_t)pr * LIST_CAP + ps] = row; LP[a0] = pr | (h0 << 7) | (ps << 8); LP[a1] = pr | ((h0 ^ 1) << 7) | (ps << 8); }
            }
    }
};

struct EpiGateUp {
    unsigned char* ws; const LAS int* tab;
    __device__ __forceinline__ void operator()(const f32x4 (&acc)[2][2][4][2], const pg8::Unit& u, int wr, int wc, int fr, int fq) const {
#ifdef DEBUG_NOEPI5
        return;
#endif
        const int list = u.a0 & 255, tile = u.a0 >> 8; const size_t eb = (size_t)list * LIST_CAP + tile * 256;
        const float* LR = (const float*)(ws + WS_LR) + eb; const float* LW = (const float*)(ws + WS_LW) + eb; const int* LP = (const int*)(ws + WS_LP) + eb;
        const LAS int* pt = tab + (PAIRTAB_OFF - MOETAB_OFF) / 4;
        bf16_t* HID = (bf16_t*)(ws + WS_HID2);
        float r2v[2][4], wv[2][4]; int lpv[2][4];
#pragma unroll
        for (int ai = 0; ai < 2; ++ai)
#pragma unroll
            for (int m = 0; m < 4; ++m) { const int r = 128 * ai + 64 * wr + 16 * m + fr, rc = r < u.a1 ? r : u.a1 - 1; r2v[ai][m] = LR[rc]; wv[ai][m] = LW[rc]; lpv[ai][m] = LP[rc]; }
#pragma unroll
        for (int ai = 0; ai < 2; ++ai)
#pragma unroll
            for (int m = 0; m < 4; ++m) {
                const int r = 128 * ai + 64 * wr + 16 * m + fr;
                const float r2 = r2v[ai][m], wt = wv[ai][m]; float h[8];
                const int lp = lpv[ai][m]; const size_t drow = (size_t)pt[PT_ALL + (lp & 127)] * 256 + (size_t)(lp >> 8);
#pragma unroll
                for (int n = 0; n < 2; ++n)
#pragma unroll
                    for (int j = 0; j < 4; ++j) { const float G = acc[ai][0][m][n][j] * r2, U = acc[ai][1][m][n][j] * r2;
                        h[4 * n + j] = G * __builtin_amdgcn_rcpf(1.f + __builtin_amdgcn_exp2f(-G * LOG2E)) * U * wt; }
                v4u w; w.x = pg8::cvt_pk_bf16(h[0], h[1]); w.y = pg8::cvt_pk_bf16(h[2], h[3]); w.z = pg8::cvt_pk_bf16(h[4], h[5]); w.w = pg8::cvt_pk_bf16(h[6], h[7]);
#ifdef DEBUG_NOHIDW
                if (r < u.a1 && drow < 95000) *(v4u*)(HID + drow * (2 * EHID) + ((lp >> 7) & 1) * EHID + u.pn * 128 + 32 * wc + 8 * fq) = w;
#else
                if (r < u.a1) *(v4u*)(HID + drow * (2 * EHID) + ((lp >> 7) & 1) * EHID + u.pn * 128 + 32 * wc + 8 * fq) = w;
#endif
            }
    }
};

struct EpiDownPair {
    unsigned char* ws; float* out;
    __device__ __forceinline__ void operator()(const f32x4 (&acc)[2][2][4][2], const pg8::Unit& u, int wr, int wc, int fr, int fq) const {
        const int pr = u.a0 & 255, tile = u.a0 >> 8; const int* PTOK = (const int*)(ws + WS_PTOK) + (size_t)pr * LIST_CAP + tile * 256;
        const bf16_t* SRC = (const bf16_t*)(ws + WS_X1B);
        int tokv[2][4];
#pragma unroll
        for (int ai = 0; ai < 2; ++ai)
#pragma unroll
            for (int m = 0; m < 4; ++m) { const int r = 128 * ai + 64 * wr + 16 * m + fr, rc = r < u.a1 ? r : u.a1 - 1; tokv[ai][m] = PTOK[rc]; }
#pragma unroll
        for (int ai = 0; ai < 2; ++ai) {
            v4u bs[4][2];
#pragma unroll
            for (int m = 0; m < 4; ++m)
#pragma unroll
                for (int bj = 0; bj < 2; ++bj) bs[m][bj] = *(const v4u*)(SRC + (size_t)tokv[ai][m] * DM + u.pn * 256 + 128 * bj + 32 * wc + 8 * fq);
#pragma unroll
            for (int m = 0; m < 4; ++m) {
                const int r = 128 * ai + 64 * wr + 16 * m + fr; const bool ok = r < u.a1;
#pragma unroll
                for (int bj = 0; bj < 2; ++bj) {
                    const size_t off = (size_t)tokv[ai][m] * DM + u.pn * 256 + 128 * bj + 32 * wc + 8 * fq; const v4u b4 = bs[m][bj];
                    f32x4 a, c;
                    a[0] = __uint_as_float(b4.x << 16); a[1] = __uint_as_float(b4.x & 0xffff0000u); a[2] = __uint_as_float(b4.y << 16); a[3] = __uint_as_float(b4.y & 0xffff0000u);
                    c[0] = __uint_as_float(b4.z << 16); c[1] = __uint_as_float(b4.z & 0xffff0000u); c[2] = __uint_as_float(b4.w << 16); c[3] = __uint_as_float(b4.w & 0xffff0000u);
                    a += acc[ai][bj][m][0]; c += acc[ai][bj][m][1];
                    if (ok) { if (DBG_MEASURE) { const float sc_ = 1.0f + ((const float*)(ws + WS_CONST))[CF_DBG]; a *= sc_; c *= sc_; } *(f32x4*)(out + off) = a; *(f32x4*)(out + off + 4) = c; }
                }
            }
        }
    }
};

template <int RK> struct EpiDown {
    unsigned char* ws; float* out;
    __device__ __forceinline__ void operator()(const f32x4 (&acc)[2][2][4][2], const pg8::Unit& u, int wr, int wc, int fr, int fq) const {
        const int list = u.a0 & 255, tile = u.a0 >> 8; const size_t eb = (size_t)list * LIST_CAP + tile * 256;
        const int* LTOK = (const int*)(ws + WS_LTOK) + eb; const float* LW = (const float*)(ws + WS_LW) + eb;
        const bf16_t* SRC = (const bf16_t*)(ws + (RK == 0 ? WS_X1B : WS_PA)); bf16_t* PA = (bf16_t*)(ws + WS_PA);
        int tokv[2][4]; float wv[2][4];
#pragma unroll
        for (int ai = 0; ai < 2; ++ai)
#pragma unroll
            for (int m = 0; m < 4; ++m) { const int r = 128 * ai + 64 * wr + 16 * m + fr, rc = r < u.a1 ? r : u.a1 - 1; tokv[ai][m] = LTOK[rc]; wv[ai][m] = LW[rc]; }
#pragma unroll
        for (int ai = 0; ai < 2; ++ai) {
            v4u bs[4][2];
#pragma unroll
            for (int m = 0; m < 4; ++m)
#pragma unroll
                for (int bj = 0; bj < 2; ++bj) bs[m][bj] = *(const v4u*)(SRC + (size_t)tokv[ai][m] * DM + u.pn * 256 + 128 * bj + 32 * wc + 8 * fq);
#pragma unroll
            for (int m = 0; m < 4; ++m) {
                const int r = 128 * ai + 64 * wr + 16 * m + fr; const bool ok = r < u.a1; const float wt = wv[ai][m];
#pragma unroll
                for (int bj = 0; bj < 2; ++bj) {
                    const size_t off = (size_t)tokv[ai][m] * DM + u.pn * 256 + 128 * bj + 32 * wc + 8 * fq; const v4u b4 = bs[m][bj];
                    f32x4 a, c;
                    a[0] = __uint_as_float(b4.x << 16); a[1] = __uint_as_float(b4.x & 0xffff0000u); a[2] = __uint_as_float(b4.y << 16); a[3] = __uint_as_float(b4.y & 0xffff0000u);
                    c[0] = __uint_as_float(b4.z << 16); c[1] = __uint_as_float(b4.z & 0xffff0000u); c[2] = __uint_as_float(b4.w << 16); c[3] = __uint_as_float(b4.w & 0xffff0000u);
                    a += acc[ai][bj][m][0] * wt; c += acc[ai][bj][m][1] * wt;
                    if (ok) {
                        if (RK == 0) { v4u w; w.x = pg8::cvt_pk_bf16(a[0], a[1]); w.y = pg8::cvt_pk_bf16(a[2], a[3]); w.z = pg8::cvt_pk_bf16(c[0], c[1]); w.w = pg8::cvt_pk_bf16(c[2], c[3]); *(v4u*)(PA + off) = w; }
                        else { if (DBG_MEASURE) { const float sc_ = 1.0f + ((const float*)(ws + WS_CONST))[CF_DBG]; a *= sc_; c *= sc_; } *(f32x4*)(out + off) = a; *(f32x4*)(out + off + 4) = c; }
                    }
                }
            }
        }
    }
};

#define HAVE_ATTN 1
namespace att {
typedef short bf16x8 __attribute__((ext_vector_type(8)));
typedef short s16x4 __attribute__((ext_vector_type(4)));
typedef short v4i16_t __attribute__((ext_vector_type(4)));
typedef float f32x16 __attribute__((ext_vector_type(16)));
constexpr int TBL_STRIDE = 2384;
constexpr int TBL_BYTES = 38912, SLOT_OFF = TBL_BYTES, NSLOT = 3, STAGE_OFF = SLOT_OFF + 65536  , WSCR_OFF = SLOT_OFF + NSLOT * 32768, ATT_LDS = WSCR_OFF + 2048;
static_assert(4 * TBL_STRIDE * 4 <= TBL_BYTES && ATT_LDS <= LDSCTL_OFF, "attention LDS map");
constexpr float NEGBIG = -1.0e30f;
constexpr int KMEAN_OFF = LDSCTL_OFF + 4608;
__device__ __forceinline__ int crow(int r, int hi) { return (r & 3) + 8 * (r >> 2) + 4 * hi; }
__device__ __forceinline__ s16x4 vtr(const LAS unsigned char* p) { return __builtin_bit_cast(s16x4, __builtin_amdgcn_ds_read_tr16_b64_v4i16((LAS v4i16_t*)p)); }
__device__ __forceinline__ void glds16(const void* gsrc, unsigned lds_dst) { unsigned keep;
    asm volatile("s_mov_b32 %0, m0\n\ts_mov_b32 m0, %2\n\ts_nop 0\n\tglobal_load_lds_dwordx4 %1, off\n\ts_mov_b32 m0, %0" : "=&s"(keep) : "v"(gsrc), "s"(lds_dst) : "memory"); }
__device__ __forceinline__ unsigned cvtpk(float lo, float hi) { typedef float f2 __attribute__((ext_vector_type(2))); typedef __bf16 b2 __attribute__((ext_vector_type(2))); f2 v = {lo, hi}; b2 b = __builtin_convertvector(v, b2); return __builtin_bit_cast(unsigned, b); }

__device__ __forceinline__ void build_table(LAS unsigned char* lds, const float* CF, int h12) {
    LAS float* tb = (LAS float*)lds; const float* BT = CF + CF_BT + h12 * 2048; const float off = CF[CF_OFF + h12];
    for (int idx = threadIdx.x; idx < 4 * TBL_STRIDE; idx += 512) { const int s = idx / TBL_STRIDE, i = idx - s * TBL_STRIDE, j = i + s; tb[idx] = j <= 2047 ? BT[2047 - j] - off : NEGBIG; }
}

template <int NK> __device__ __forceinline__ void epilogue(LAS unsigned char* lds, unsigned char* ws, const Inputs& in, int b, int h, int w, int map, int rb, int qw0, int lane_in, float lsum, att::f32x16 (&o)[NK == 2 ? 4 : 2]) {
    constexpr int ND = NK == 2 ? 4 : 2;
    int lane = lane_in; asm volatile("" : "+v"(lane));
    const int r32 = lane & 31, hi = lane >> 5;
    const float* CF = (const float*)(ws + WS_CONST);
    LAS float* wsf = (LAS float*)(lds + WSCR_OFF) + w * 64;
    if (hi == 0) wsf[r32] = lsum;
    asm volatile("s_waitcnt lgkmcnt(0)" ::: "memory");
    float rli[16];
#pragma unroll
    for (int r = 0; r < 16; ++r) rli[r] = __builtin_amdgcn_rcpf(wsf[crow(r, hi)]);
    bf16_t* Y = (bf16_t*)(ws + WS_Y);
    if (NK == 1) {
        LAS bf16_t* stg = (LAS bf16_t*)(lds + STAGE_OFF) + w * 2048;
#pragma unroll
        for (int r = 0; r < 16; ++r) { const int orow = crow(r, hi);
#pragma unroll
            for (int d0 = 0; d0 < ND; ++d0) stg[orow * 64 + d0 * 32 + r32] = (bf16_t)f2bf(o[d0][r] * rli[r]); }
        asm volatile("s_waitcnt lgkmcnt(0)" ::: "memory");
        bf16_t* Yw = Y + (size_t)(b * SEQ + qw0) * DM + 512 + h * 64;
#pragma unroll
        for (int i = 0; i < 4; ++i) { const int row = i * 8 + (lane >> 3), ch = lane & 7; const v4u v = *(const LAS v4u*)(stg + row * 64 + ch * 8); *(v4u*)(Yw + (size_t)row * DM + ch * 8) = v; }
    } else {
        LAS float* X = (LAS float*)(lds + SLOT_OFF) + (size_t)rb * 32 * 128;
        const float lam = CF[CF_LAMBDA];
        if (map == 1) {
#pragma unroll
            for (int r = 0; r < 16; ++r) { const int orow = crow(r, hi); const float f = rli[r] * lam;
#pragma unroll
                for (int d0 = 0; d0 < ND; ++d0) X[orow * 128 + d0 * 32 + r32] = o[d0][r] * f; }
        }
        asm volatile("s_waitcnt lgkmcnt(0)" ::: "memory"); __syncthreads();
        if (map == 0) {
            float gsub[ND];
#pragma unroll
            for (int d0 = 0; d0 < ND; ++d0) gsub[d0] = in.diff_sub_g[d0 * 32 + r32];
            LAS bf16_t* stg = (LAS bf16_t*)(lds + STAGE_OFF) + rb * 4096;
#pragma unroll
            for (int r = 0; r < 16; ++r) { const int orow = crow(r, hi); float v[ND]; float ss = 0.f;
#pragma unroll
                for (int d0 = 0; d0 < ND; ++d0) { v[d0] = o[d0][r] * rli[r] - X[orow * 128 + d0 * 32 + r32]; ss += v[d0] * v[d0]; }
                ss += __shfl_xor(ss, 1); ss += __shfl_xor(ss, 2); ss += __shfl_xor(ss, 4); ss += __shfl_xor(ss, 8); ss += __shfl_xor(ss, 16);
                const float sc2 = rsqrtf(ss * (1.f / 128.f) + RMS_EPS) * (1.f - LAMBDA_INIT);
#pragma unroll
                for (int d0 = 0; d0 < ND; ++d0) stg[orow * 128 + d0 * 32 + r32] = (bf16_t)f2bf(v[d0] * sc2 * gsub[d0]); }
            asm volatile("s_waitcnt lgkmcnt(0)" ::: "memory");
            bf16_t* Yw = Y + (size_t)(b * SEQ + qw0) * DM + h * 128;
#pragma unroll
            for (int i = 0; i < 8; ++i) { const int row = i * 4 + (lane >> 4), ch = lane & 15; const v4u v = *(const LAS v4u*)(stg + row * 128 + ch * 8); *(v4u*)(Yw + (size_t)row * DM + ch * 8) = v; }
        }
    }
    asm volatile("s_waitcnt lgkmcnt(0)" ::: "memory"); __builtin_amdgcn_s_barrier(); asm volatile("" ::: "memory");
}


template <int NK, int ABL> __device__ __forceinline__ void attn_unit(LAS unsigned char* lds, unsigned char* ws, const Inputs& in, int b, int h, int qb, bool stage_km) {
    constexpr int DV = NK == 2 ? 128 : 64, ND = DV / 32, ROWS = NK == 2 ? 128 : 256, SLOTB = NK == 2 ? 32768 : 16384, VOFF = 8192 * NK;
    const int tid = threadIdx.x; int lane_ = tid & 63; asm volatile("" : "+v"(lane_));
    const int lane = lane_, r32 = lane & 31, hi = lane >> 5; const int w = __builtin_amdgcn_readfirstlane(tid >> 6);
    const int map = NK == 2 ? (w >> 2) : 0, rb = NK == 2 ? (w & 3) : w;
    const int q0 = qb * ROWS, qw0 = q0 + 32 * rb, qabs = qw0 + r32, NT = (q0 + ROWS) / 64;
    const float* CF = (const float*)(ws + WS_CONST);
    const bf16_t *Qh, *Kh0, *Kh1, *Vh;
    if (NK == 2) { const size_t hb = (size_t)(b * 4 + h) * 2; Qh = (const bf16_t*)(ws + WS_QD) + (hb + map) * SEQ * 64; Kh0 = (const bf16_t*)(ws + WS_KD) + hb * SEQ * 64; Kh1 = Kh0 + (size_t)SEQ * 64;
                   Vh = (const bf16_t*)(ws + WS_VD) + (size_t)(b * 4 + h) * SEQ * 128; }
    else { const size_t hb = (size_t)(b * 8 + h); Qh = (const bf16_t*)(ws + WS_QM) + hb * SEQ * 64; Kh0 = (const bf16_t*)(ws + WS_KM) + hb * SEQ * 64; Kh1 = Kh0; Vh = (const bf16_t*)(ws + WS_VM) + hb * SEQ * 64; }
    const bf16_t* ksrc0 = Kh0 + (size_t)w * 512 + lane * 8; const bf16_t* ksrc1 = Kh1 + (size_t)w * 512 + lane * 8;
    const bf16_t* vsrc0 = Vh + (size_t)w * 512 + lane * 8;
    const bf16_t* vsrc1 = vsrc0 + 4096;
    constexpr int KSB = 8192 * NK, VSB = 128 * DV, KRING = SLOT_OFF, VRING = SLOT_OFF + 49152;
    const unsigned kdst = (unsigned)(uintptr_t)(lds + KRING) + (unsigned)w * 1024u, vdst = (unsigned)(uintptr_t)(lds + VRING) + (unsigned)w * 1024u;
#define ATT_DMAK(t, off) do { if (ABL & 16) break; const unsigned d_ = (unsigned)__builtin_amdgcn_readfirstlane(kdst + (unsigned)(off)); const size_t o_ = (size_t)(t) * 64 * 64; glds16(ksrc0 + o_, d_); if (NK == 2) glds16(ksrc1 + o_, d_ + 8192u); } while (0)
#define ATT_DMAV(t, off) do { if (ABL & 16) break; const unsigned d_ = (unsigned)__builtin_amdgcn_readfirstlane(vdst + (unsigned)(off)); const size_t o_ = (size_t)(t) * 64 * DV; glds16(vsrc0 + o_, d_); if (NK == 2) glds16(vsrc1 + o_, d_ + 8192u); } while (0)
    if (NK == 1) { ATT_DMAK(0, 0); ATT_DMAV(0, 0); ATT_DMAK(1, KSB); ATT_DMAV(1, VSB); ATT_DMAK(2, 2 * KSB); ATT_DMAV(2, 2 * VSB); ATT_DMAK(3, 3 * KSB); ATT_DMAV(3, 3 * VSB); if (NT > 4) ATT_DMAK(4, 4 * KSB); }
    else { ATT_DMAK(0, 0); ATT_DMAV(0, 0); ATT_DMAK(1, KSB); }
    bf16x8 qr[4];
#pragma unroll
    for (int d0 = 0; d0 < 4; ++d0) qr[d0] = *(const bf16x8*)(Qh + (size_t)qabs * 64 + d0 * 16 + hi * 8);
    if (NK == 1 && stage_km) { const int n = tid >> 6, d = tid & 63;
        if (n < qb) { const float* k0 = (const float*)(ws + WS_KMEAN) + (((size_t)(b * 8 + n) * 2 + 0) * 8 + h) * 64 + d; const float v = k0[0] + k0[512];
            const unsigned hb = f2bf(v); const float lo = v - bf2f((bf16_t)hb);
            ((LAS bf16_t*)(lds + KMEAN_OFF))[n * 64 + d] = (bf16_t)hb; ((LAS bf16_t*)(lds + KMEAN_OFF + 1024))[n * 64 + d] = (bf16_t)f2bf(lo); } }
#pragma unroll
    for (int d0 = 0; d0 < 4; ++d0) asm volatile("" : "+v"(qr[d0]));
    asm volatile("s_waitcnt vmcnt(0)" ::: "memory"); __syncthreads();
    unsigned selmask = 0xffffffffu;
    if (NK == 1 && qb > 0) {
        float gate[8];
        { f32x16 G = {}; const LAS unsigned char* kmh = lds + KMEAN_OFF + (r32 & 7) * 128 + hi * 16;
#pragma unroll
          for (int d0 = 0; d0 < 4; ++d0) { const bf16x8 ah = *(const LAS bf16x8*)(kmh + d0 * 32), al = *(const LAS bf16x8*)(kmh + 1024 + d0 * 32);
              G = __builtin_amdgcn_mfma_f32_32x32x16_bf16(ah, qr[d0], G, 0, 0, 0); G = __builtin_amdgcn_mfma_f32_32x32x16_bf16(al, qr[d0], G, 0, 0, 0); }
#pragma unroll
          for (int r = 0; r < 4; ++r) { const float mine = G[r], oth = __shfl_xor(mine, 32); gate[r] = hi ? oth : mine; gate[4 + r] = hi ? mine : oth; } }
        selmask = 0u;
#pragma unroll
        for (int n = 0; n < 8; ++n) { int better = 0;
#pragma unroll
            for (int m = 0; m < 8; ++m) if (m != n) better += (m < qb && (gate[m] > gate[n] || (gate[m] == gate[n] && m < n))) ? 1 : 0;
            if (n < qb && better < 3) selmask |= 1u << n; }
        selmask |= 1u << qb;
    }
    const int j0 = 2047 - qabs + 4 * hi, sc = j0 & 3;
    const LAS unsigned char* tb_base = lds + (sc * TBL_STRIDE + (j0 - sc)) * 4;
    const LAS unsigned char* tb_neg = lds + (sc * TBL_STRIDE + 2052) * 4;
    const LAS unsigned char* kp0 = lds + KRING + map * 8192 + hi * 1024 + r32 * 16;
    const LAS unsigned char* vp0 = lds + VRING + ((lane >> 4) & 1) * 32 + (lane & 3) * 8 + (4 * hi + ((lane & 15) >> 2)) * 64;
    f32x16 o[ND];
#pragma unroll
    for (int d = 0; d < ND; ++d) o[d] = f32x16{};
    float ls0 = 0.f, ls1 = 0.f;
    const int NTw = (qw0 + 31) / 64 + 1 < NT ? (qw0 + 31) / 64 + 1 : NT;
#define SBAR() __builtin_amdgcn_sched_barrier(0)
#define MFMA32(a, b, c) __builtin_amdgcn_mfma_f32_32x32x16_bf16(a, b, c, 0, 0, 0)
#define MFMA_QK(a, b, c) ((ABL & 8) ? (c) : MFMA32(a, b, c))
#define MFMA_PV(a, b, c) ((ABL & 4) ? (c) : MFMA32(a, b, c))
#define EXP2F(x) ((ABL & 1) ? (x) : __builtin_amdgcn_exp2f(x))
#define CINIT_H(P, half, tt) do { if (ABL & 2) { asm volatile("" : "+v"(P)); break; } const bool sel_ = NK == 2 || ((selmask >> ((tt) >> 2)) & 1u); const LAS unsigned char* tp_ = (sel_ ? tb_base + (tt) * 256 : tb_neg) + (half) * 128; \
        _Pragma("unroll") for (int g = 0; g < 4; ++g) { const f32x4 c0 = *(const LAS f32x4*)(tp_ + g * 32); P[4 * g] = c0[0]; P[4 * g + 1] = c0[1]; P[4 * g + 2] = c0[2]; P[4 * g + 3] = c0[3]; } } while (0)
#define CINIT(P0, P1, tt) do { CINIT_H(P0, 0, tt); CINIT_H(P1, 1, tt); } while (0)
#define KLOAD(kf, koff) do { _Pragma("unroll") for (int i_ = 0; i_ < 8; ++i_) kf[i_] = *(const LAS bf16x8*)(kp0 + (koff) + (i_ >> 1) * 2048 + (i_ & 1) * 512); } while (0)
#define EXP4(PC0, PC1, i) do { if ((i) < 4) { _Pragma("unroll") for (int e_ = 0; e_ < 4; ++e_) PC0[4 * (i) + e_] = EXP2F(PC0[4 * (i) + e_]); asm volatile("" : "+v"(PC0)); } \
        else { _Pragma("unroll") for (int e_ = 0; e_ < 4; ++e_) PC1[4 * ((i) - 4) + e_] = EXP2F(PC1[4 * ((i) - 4) + e_]); asm volatile("" : "+v"(PC1)); } } while (0)
#define STEP_HEAD(t) do { if ((t) + 5 < NT) ATT_DMAK((t) + 5, ko_i); if ((t) + 4 < NT) ATT_DMAV((t) + 4, vo_i); } while (0)
#define STEP_TAIL(t, ODD) do { if (ODD) { const int nfl = ((t) + 4 < NT ? 2 : 0) + ((t) + 3 < NT ? 1 : 0) + ((t) + 5 < NT ? 1 : 0); \
          if (nfl >= 4) asm volatile("s_waitcnt vmcnt(4) lgkmcnt(0)" ::: "memory"); else if (nfl == 3) asm volatile("s_waitcnt vmcnt(3) lgkmcnt(0)" ::: "memory"); \
          else if (nfl == 2) asm volatile("s_waitcnt vmcnt(2) lgkmcnt(0)" ::: "memory"); else if (nfl == 1) asm volatile("s_waitcnt vmcnt(1) lgkmcnt(0)" ::: "memory"); \
          else asm volatile("s_waitcnt vmcnt(0) lgkmcnt(0)" ::: "memory"); \
          __builtin_amdgcn_s_barrier(); asm volatile("" ::: "memory"); } SBAR(); \
        { s6 = s6 == 5 ? 0 : s6 + 1; const int r1 = s6 + 1, i5 = s6 + 5, i4 = s6 + 4; ko_r = (r1 >= 6 ? r1 - 6 : r1) * KSB; ko_i = (i5 >= 6 ? i5 - 6 : i5) * KSB; vo_r = s6 * VSB; vo_i = (i4 >= 6 ? i4 - 6 : i4) * VSB; } } while (0)
#define KLD1(i) ((ABL & 32) ? qr[(i) & 3] : *(const LAS bf16x8*)(kp0 + ko_r + ((i) >> 1) * 2048 + ((i) & 1) * 512))
#define QK_EXP(PC0, PC1, PN0, PN1, t) do { bf16x8 kf[8]; _Pragma("unroll") for (int i = 0; i < 8; ++i) kf[i] = KLD1(i); EXP4(PC0, PC1, 0); SBAR(); \
        _Pragma("unroll") for (int i = 0; i < 8; ++i) { \
            if (i & 1) PN1 = MFMA_QK(kf[i], qr[i >> 1], PN1); else PN0 = MFMA_QK(kf[i], qr[i >> 1], PN0); if (i + 1 < 8) EXP4(PC0, PC1, i + 1); if (i == 5) { VLOAD(0); VLOAD(1); } SBAR(); } } while (0)
#define SUMPACK(PC0, PC1, ks) do { if (ABL & 256) { asm volatile("" : "+v"(pw[(ks) & 1])); break; } _Pragma("unroll") for (int i = 0; i < 4; ++i) { \
            const float a_ = (ks) == 0 ? PC0[2 * i] : (ks) == 1 ? PC0[8 + 2 * i] : (ks) == 2 ? PC1[2 * i] : PC1[8 + 2 * i]; \
            const float b_ = (ks) == 0 ? PC0[2 * i + 1] : (ks) == 1 ? PC0[9 + 2 * i] : (ks) == 2 ? PC1[2 * i + 1] : PC1[9 + 2 * i]; \
            ls0 += a_; ls1 += b_; pw[(ks) & 1][i] = cvtpk(a_, b_); } asm volatile("" : "+v"(ls0), "+v"(ls1), "+v"(pw[(ks) & 1])); } while (0)
#define VLOAD(g) do { if (ABL & 32) { vl[(g) % 3] = s16x4{1, 2, 3, 4}; vh[(g) % 3] = s16x4{1, 2, 3, 4}; asm volatile("" : "+v"(vl[(g) % 3]), "+v"(vh[(g) % 3])); } else if ((g) < 4 * ND) { const int ks_ = (g) / ND, d_ = (g) % ND; vl[(g) % 3] = vtr(vp + d_ * 4096 + ks_ * 1024); vh[(g) % 3] = vtr(vp + d_ * 4096 + ks_ * 1024 + 512); } } while (0)
#define PV_SUM(PC0, PC1, t, CI, PRE) do { v4u pw[2]; \
        if (!(PRE)) { VLOAD(0); VLOAD(1); } SUMPACK(PC0, PC1, 0); SBAR(); __builtin_amdgcn_s_setprio(1); \
        _Pragma("unroll") for (int g = 0; g < 4 * ND; ++g) { const int ks = g / ND, d0 = g % ND; \
            VLOAD(g + 2); \
            { const s16x4 a_ = vl[g % 3], b_ = vh[g % 3]; const bf16x8 vf = {a_[0], a_[1], a_[2], a_[3], b_[0], b_[1], b_[2], b_[3]}; o[d0] = MFMA_PV(__builtin_bit_cast(bf16x8, pw[ks & 1]), vf, o[d0]); } \
            if (d0 == ND - 2 && ks < 3) SUMPACK(PC0, PC1, ks + 1); \
            if (g == 1 && (t) + 5 < NT) ATT_DMAK((t) + 5, ko_i); if (g == 3 && (t) + 4 < NT) ATT_DMAV((t) + 4, vo_i); \
            if (CI && g == 2 * ND + 1 && (t) + 2 < NTw) CINIT(PC0, PC1, (t) + 2); \
            SBAR(); } __builtin_amdgcn_s_setprio(0); } while (0)
#define STEP_FULL(PC0, PC1, PN0, PN1, t, ODD) do { const LAS unsigned char* vp = vp0 + vo_r; s16x4 vl[3], vh[3]; QK_EXP(PC0, PC1, PN0, PN1, t); PV_SUM(PC0, PC1, t, true, true); STEP_TAIL(t, ODD); } while (0)
#define STEP_LAST(PC0, PC1, t, ODD) do { const LAS unsigned char* vp = vp0 + vo_r; s16x4 vl[3], vh[3]; _Pragma("unroll") for (int i = 0; i < 8; ++i) EXP4(PC0, PC1, i); PV_SUM(PC0, PC1, t, false, false); STEP_TAIL(t, ODD); } while (0)
    if constexpr (NK == 1) {
    int s6 = 0, ko_r = KSB, ko_i = 5 * KSB, vo_r = 0, vo_i = 4 * VSB;
    f32x16 pA0, pA1, pB0, pB1;
    if (1 < NTw) CINIT(pB0, pB1, 1);
    { bf16x8 kf[8]; CINIT(pA0, pA1, 0); KLOAD(kf, 0);
#pragma unroll
      for (int i = 0; i < 8; ++i) { if (i & 1) pA1 = MFMA32(kf[i], qr[i >> 1], pA1); else pA0 = MFMA32(kf[i], qr[i >> 1], pA0); } }
    asm volatile("s_waitcnt lgkmcnt(0)" ::: "memory"); __builtin_amdgcn_s_barrier(); asm volatile("" ::: "memory"); SBAR();
    int t = 0;
    for (; t + 2 < NTw; t += 2) {
        unsigned long long t0_ = 0; if (DBG_MEASURE == 2 && blockIdx.x == 0 && w == 0) t0_ = __builtin_amdgcn_s_memtime();
        STEP_FULL(pA0, pA1, pB0, pB1, t, false); STEP_FULL(pB0, pB1, pA0, pA1, t + 1, true);
        if (DBG_MEASURE == 2 && blockIdx.x == 0 && w == 0) { const unsigned long long t1_ = __builtin_amdgcn_s_memtime(); LAS unsigned* dg = (LAS unsigned*)(lds + LDSCTL_OFF + 3072); if (lane == 0) { dg[0] += (unsigned)(t1_ - t0_); dg[1] += 2u; } }
    }
    if (NTw - t == 2) { STEP_FULL(pA0, pA1, pB0, pB1, t, false); STEP_LAST(pB0, pB1, t + 1, true); t += 2; }
    else { STEP_LAST(pA0, pA1, t, false); t += 1; }
    for (; t < NT; ++t) { STEP_HEAD(t); STEP_TAIL(t, (t & 1)); }
    } else {
    int ko_r = 0, ko_n = KSB, ko_i = 2 * KSB, vo_r = 2 * VSB, vo_n = 0, vo_i = VSB;
    f32x16 S0, S1; v4u pwA[4], pwB[4];
#define DHEAD(t) do { if ((t) + 2 < NT) ATT_DMAK((t) + 2, ko_i); if ((t) + 1 < NT) ATT_DMAV((t) + 1, vo_i); } while (0)
#define DTAIL(t) do { if ((t) + 2 < NT) asm volatile("s_waitcnt vmcnt(4) lgkmcnt(0)" ::: "memory"); else asm volatile("s_waitcnt vmcnt(0) lgkmcnt(0)" ::: "memory"); \
        __builtin_amdgcn_s_barrier(); asm volatile("" ::: "memory"); SBAR(); \
        { const int tk_ = ko_r; ko_r = ko_n; ko_n = ko_i; ko_i = tk_; const int tv_ = vo_r; vo_r = vo_n; vo_n = vo_i; vo_i = tv_; } } while (0)
#define DQK(t, PRE) do { bf16x8 kf[4]; _Pragma("unroll") for (int i = 0; i < 4; ++i) kf[i] = KLD1(i); SBAR(); \
        _Pragma("unroll") for (int i = 0; i < 8; ++i) { \
            if (i & 1) S1 = MFMA_QK(kf[i & 3], qr[i >> 1], S1); else S0 = MFMA_QK(kf[i & 3], qr[i >> 1], S0); \
            if (i + 4 < 8) kf[i & 3] = KLD1(i + 4); if ((PRE) && i == 6) VLOAD2(0); \
            if ((PRE) && i == 1 && (t) + 2 < NT) ATT_DMAK((t) + 2, ko_i); if ((PRE) && i == 4 && (t) + 1 < NT) ATT_DMAV((t) + 1, vo_i); SBAR(); } } while (0)
#define DSOFT(PW, g) do { if (ABL & 256) { asm volatile("" : "+v"(PW[(g) >> 2])); break; } float a_ = (g) < 8 ? S0[2 * (g)] : S1[2 * ((g) - 8)], b_ = (g) < 8 ? S0[2 * (g) + 1] : S1[2 * ((g) - 8) + 1]; \
        a_ = EXP2F(a_); b_ = EXP2F(b_); ls0 += a_; ls1 += b_; PW[(g) >> 2][(g) & 3] = cvtpk(a_, b_); asm volatile("" : "+v"(ls0), "+v"(ls1), "+v"(PW[(g) >> 2])); } while (0)
#define VLOAD2(g) do { if (ABL & 32) { vl[(g) & 1] = s16x4{1, 2, 3, 4}; vh[(g) & 1] = s16x4{1, 2, 3, 4}; asm volatile("" : "+v"(vl[(g) & 1]), "+v"(vh[(g) & 1])); } else if ((g) < 16) { const int ks_ = (g) >> 2, d_ = (g) & 3; vl[(g) & 1] = vtr(vp + d_ * 4096 + ks_ * 1024); vh[(g) & 1] = vtr(vp + d_ * 4096 + ks_ * 1024 + 512); } } while (0)
#define DPV(PWP, PWC, SOFT, t, PRE) do { if (!(PRE)) { VLOAD2(0); } SBAR(); \
        _Pragma("unroll") for (int g = 0; g < 16; ++g) { const int ks = g >> 2, d0 = g & 3; VLOAD2(g + 1); \
            { const s16x4 a2_ = vl[g & 1], b2_ = vh[g & 1]; const bf16x8 vf = {a2_[0], a2_[1], a2_[2], a2_[3], b2_[0], b2_[1], b2_[2], b2_[3]}; o[d0] = MFMA_PV(__builtin_bit_cast(bf16x8, PWP[ks]), vf, o[d0]); } \
            if (SOFT) DSOFT(PWC, g); \
            if (!(PRE) && g == 2 && (t) + 2 < NT) ATT_DMAK((t) + 2, ko_i); if (!(PRE) && g == 6 && (t) + 1 < NT) ATT_DMAV((t) + 1, vo_i); \
            if (SOFT && g == 8 && (t) + 1 < NTw) CINIT_H(S0, 0, (t) + 1); \
            SBAR(); } } while (0)
#define DSTEP_MID(PWP, PWC, t) do { const LAS unsigned char* vp = vp0 + vo_r; s16x4 vl[2], vh[2]; DQK(t, true); DPV(PWP, PWC, true, t, true); if ((t) + 1 < NTw) CINIT_H(S1, 1, (t) + 1); DTAIL(t); } while (0)
    { const LAS unsigned char* vp = vp0; s16x4 vl[2], vh[2]; (void)vp; (void)vl; (void)vh; DHEAD(0); CINIT(S0, S1, 0); DQK(0, false);
#pragma unroll
      for (int g = 0; g < 16; ++g) DSOFT(pwA, g);
      if (1 < NTw) CINIT(S0, S1, 1); DTAIL(0); }
    int t = 1;
    for (; t + 1 < NTw; t += 2) {
        unsigned long long t0_ = 0; if (DBG_MEASURE == 3 && blockIdx.x == 0 && w == 0) t0_ = __builtin_amdgcn_s_memtime();
        DSTEP_MID(pwA, pwB, t); DSTEP_MID(pwB, pwA, t + 1);
        if (DBG_MEASURE == 3 && blockIdx.x == 0 && w == 0) { const unsigned long long t1_ = __builtin_amdgcn_s_memtime(); LAS unsigned* dg = (LAS unsigned*)(lds + LDSCTL_OFF + 3072); if (lane == 0) { dg[0] += (unsigned)(t1_ - t0_); dg[1] += 2u; } }
    }
    if (t < NTw) { DSTEP_MID(pwA, pwB, t); ++t; { const LAS unsigned char* vp = vp0 + vo_r; s16x4 vl[2], vh[2]; DPV(pwB, pwA, false, t, false); } DTAIL(t); ++t; }
    else { { const LAS unsigned char* vp = vp0 + vo_r; s16x4 vl[2], vh[2]; DPV(pwA, pwB, false, t, false); } DTAIL(t); ++t; }
    for (; t <= NT; ++t) { DHEAD(t); DTAIL(t); }
#undef DHEAD
#undef DTAIL
#undef DQK
#undef DSOFT
#undef DPV
#undef VLOAD2
#undef DSTEP_MID
    }
    float lsum = ls0 + ls1;
#undef STEP_FULL
#undef STEP_LAST
#undef STEP_HEAD
#undef STEP_TAIL
#undef QK_EXP
#undef KLD1
#undef PV_SUM
#undef SUMPACK
#undef VLOAD
#undef EXP4
#undef KLOAD
#undef CINIT
#undef CINIT_H
#undef MFMA32
#undef MFMA_QK
#undef MFMA_PV
#undef EXP2F
#undef SBAR
#undef ATT_DMAK
#undef ATT_DMAV
    lsum += __shfl_xor(lsum, 32);
    epilogue<NK>(lds, ws, in, b, h, w, map, rb, qw0, lane, lsum, o);
}

template <int ABL> __device__ __forceinline__ void attn_phase(LAS unsigned char* lds, unsigned char* ws, const Inputs& in, int G, int v) {
    const float* CF = (const float*)(ws + WS_CONST);
    if (DBG_MEASURE && blockIdx.x == 0 && threadIdx.x == 0) { LAS unsigned* dg = (LAS unsigned*)(lds + LDSCTL_OFF + 3072); dg[0] = 0u; dg[1] = 0u;
        LAS unsigned long long* dq = (LAS unsigned long long*)(lds + LDSCTL_OFF + 3088); dq[0] = __builtin_amdgcn_s_memtime(); dq[1] = __builtin_amdgcn_s_memrealtime(); }
    for (int vv = v; vv < 256; vv += G) {
        if constexpr ((ABL & 4096) == 0)
        { const int j = vv & 3; build_table(lds, CF, 4 + ((vv >> 2) & 7));
          for (int k = 0; k < 4; ++k) { const int head = (vv >> 2) + 64 * k, b = head >> 3, h = head & 7;
              if constexpr ((ABL & 512) != 0) { const int wv = __builtin_amdgcn_readfirstlane(threadIdx.x >> 6);
                  if (wv < 4) { attn_unit<1, 0>(lds, ws, in, b, h, 7 - j, true); attn_unit<1, 0>(lds, ws, in, b, h, j, false); } else { attn_unit<1, (ABL & 0x1bf)>(lds, ws, in, b, h, 7 - j, true); attn_unit<1, (ABL & 0x1bf)>(lds, ws, in, b, h, j, false); } }
              else if constexpr ((ABL & 2048) != 0) { attn_unit<1, 0>(lds, ws, in, b, h, 7 - j, true); attn_unit<1, 0>(lds, ws, in, b, h, j, false); }
              else { attn_unit<1, ABL>(lds, ws, in, b, h, (ABL & 64) ? 0 : 7 - j, true); attn_unit<1, ABL>(lds, ws, in, b, h, (ABL & 64) ? 0 : j, false); } } }
        __syncthreads();
        if constexpr ((ABL & 1024) == 0)
        { const int j = vv & 7; build_table(lds, CF, (vv >> 3) & 3);
          for (int k = 0; k < 4; ++k) { const int head = (vv >> 3) + 32 * k, b = head >> 2, h = head & 3;
              attn_unit<2, (ABL & 0x1ff)>(lds, ws, in, b, h, (ABL & 64) ? 0 : 15 - j, false); attn_unit<2, (ABL & 0x1ff)>(lds, ws, in, b, h, (ABL & 64) ? 0 : j, false); } }
        __syncthreads();
    }
    if (DBG_MEASURE && blockIdx.x == 0 && threadIdx.x == 0) {
        const unsigned long long c1 = __builtin_amdgcn_s_memtime(), r1 = __builtin_amdgcn_s_memrealtime(); LAS unsigned* dg = (LAS unsigned*)(lds + LDSCTL_OFF + 3072); float eps = 0.f;
        LAS unsigned long long* dq = (LAS unsigned long long*)(lds + LDSCTL_OFF + 3088); const unsigned long long dbg_c0 = dq[0], dbg_r0 = dq[1];
        if (DBG_MEASURE == 1) eps = (float)(c1 - dbg_c0) / (float)(r1 - dbg_r0) * 0.1f / 4.0f;
        if (DBG_MEASURE == 2 || DBG_MEASURE == 3) eps = (float)dg[0] / (float)(dg[1] ? dg[1] : 1u) / 300.0f;
        if (DBG_MEASURE == 4) eps = (float)(r1 - dbg_r0) * 0.01f / 1000.0f;
        eps = floorf(eps * 50.0f + 0.5f) * 0.02f;
        ((float*)(ws + WS_CONST))[CF_DBG] = eps;
    }
}
}
template <int ABL> __device__ __forceinline__ void attn_phase(LAS unsigned char* lds, unsigned char* ws, const Inputs& in, int G, int v) { att::attn_phase<ABL>(lds, ws, in, G, v); }

#define RLX_AGENT __ATOMIC_RELAXED, __HIP_MEMORY_SCOPE_AGENT
#define XB_TMO      128
#define XB_XCNT(j)  (256  + 64 * (j))
#define XB_XSUB(j)  (1280 + 64 * (j))
#define XB_XGEN(j)  (2304 + 64 * (j))
#define XB_TOP      3328
#define XB_TOPGEN   3392
#define XCD_BAR_WORDS 3456
#define XB_SPIN_CAP (1u << 18)
constexpr int CW_BAR = 8192;
__device__ __forceinline__ unsigned xb_ld(unsigned* p)              { return __hip_atomic_load(p, __ATOMIC_RELAXED, __HIP_MEMORY_SCOPE_AGENT); }
__device__ __forceinline__ unsigned xb_add(unsigned* p, unsigned v) { return __hip_atomic_fetch_add(p, v, __ATOMIC_RELAXED, __HIP_MEMORY_SCOPE_AGENT); }
__device__ __forceinline__ unsigned xb_xcc_id() { return (unsigned)__builtin_amdgcn_s_getreg((3 << 11) | 20) & 0xFu; }
#define XB_SPIN(cond, bar) do { unsigned _sp = 0; while (cond) { __builtin_amdgcn_s_sleep(1); \
    if ((++_sp & 255u) == 0u) { if (xb_ld(&(bar)[XB_TMO])) break; if (_sp > XB_SPIN_CAP) { atomicAdd(&(bar)[XB_TMO], 1u); break; } } } } while (0)
struct XcdBarrier { unsigned* bar; unsigned x; volatile LAS unsigned* st; };
__device__ __forceinline__ XcdBarrier xcd_barrier_post(unsigned* bar, volatile LAS unsigned* st) {
    XcdBarrier b; b.bar = bar; b.x = xb_xcc_id(); b.st = st;
    if (threadIdx.x == 0) (void)xb_add(&bar[XB_XCNT(b.x)], 1u);
    return b;
}
__device__ __forceinline__ void xcd_barrier_complete(unsigned* bar, unsigned x, unsigned& nloc, unsigned& nx) {
    const unsigned G = gridDim.x * gridDim.y * gridDim.z;
    unsigned sum, cnt, mine, sp = 0u;
    for (;;) {
        sum = 0u; cnt = 0u; mine = 0u;
#pragma unroll
        for (unsigned j = 0; j < 16; ++j) { const unsigned c = xb_ld(&bar[XB_XCNT(j)]); sum += c; cnt += (c > 0u) ? 1u : 0u; mine = (j == x) ? c : mine; }
        if (sum == G) break;
        __builtin_amdgcn_s_sleep(1);
        if ((++sp & 255u) == 0u) { if (xb_ld(&bar[XB_TMO])) break; if (sp > XB_SPIN_CAP) { atomicAdd(&bar[XB_TMO], 1u); break; } }
    }
    nloc = mine > 0u ? mine : 1u; nx = cnt > 0u ? cnt : 1u;
}
__device__ __forceinline__ void xcd_barrier(const XcdBarrier& b) {
    asm volatile("s_waitcnt vmcnt(0)" ::: "memory");
    __syncthreads();
    if (threadIdx.x == 0) {
        unsigned* bar = b.bar;
        __builtin_amdgcn_s_waitcnt(0);
        unsigned nloc = b.st[0], nx = b.st[1];
        if (nloc == 0u) { xcd_barrier_complete(bar, b.x, nloc, nx); b.st[0] = nloc; b.st[1] = nx; }
        const unsigned old = xb_add(&bar[XB_XSUB(b.x)], 1u);
        const unsigned gen = old / nloc;
        if (old + 1u == (gen + 1u) * nloc) {
            __builtin_amdgcn_fence(__ATOMIC_RELEASE, "agent");
            asm volatile("s_waitcnt vmcnt(0)" ::: "memory");
            const unsigned og = xb_add(&bar[XB_TOP], 1u);
            const unsigned tg = og / nx;
            if (og + 1u == (tg + 1u) * nx) xb_add(&bar[XB_TOPGEN], 1u);
            else XB_SPIN(xb_ld(&bar[XB_TOPGEN]) == tg, bar);
            __builtin_amdgcn_fence(__ATOMIC_ACQUIRE, "agent");
            xb_add(&bar[XB_XGEN(b.x)], 1u);
            asm volatile("s_waitcnt vmcnt(0)" ::: "memory");
        } else {
            XB_SPIN(xb_ld(&bar[XB_XGEN(b.x)]) == gen, bar);
            __builtin_amdgcn_fence(__ATOMIC_ACQUIRE, "agent");
            asm volatile("s_waitcnt vmcnt(0)" ::: "memory");
        }
    }
    __syncthreads();
}

constexpr int N_PHASES = 8;
#ifndef DESYNC_TICKS
#define DESYNC_TICKS 0
#endif
#ifndef DESYNC_MASK
#define DESYNC_MASK 0
#endif
__device__ __forceinline__ void phase_stagger(int vcu, int ph) {
    if (!((DESYNC_MASK >> ph) & 1) || DESYNC_TICKS == 0) return;
    const unsigned long long t0 = __builtin_amdgcn_s_memrealtime(); const unsigned long long want = (unsigned long long)((vcu & 3) * DESYNC_TICKS);
    while (__builtin_amdgcn_s_memrealtime() - t0 < want) __builtin_amdgcn_s_sleep(4);
}
#ifndef PROBE_REP_MASK
#define PROBE_REP_MASK 0
#endif
#ifndef PROBE_REPN
#define PROBE_REPN 2
#endif
#define NREP(k) (((PROBE_REP_MASK >> (k)) & 1) ? PROBE_REPN : 1)
struct Args { Inputs in; float* out; unsigned char* ws; int ph_lo, ph_hi; };

__global__ void __launch_bounds__(512, 2) mega(Args args) {
    extern __shared__ __attribute__((aligned(16))) unsigned char lds_raw[];
    LAS unsigned char* lds = (LAS unsigned char*)lds_raw;
    const int tid = threadIdx.x, lane = tid & 63, wave = __builtin_amdgcn_readfirstlane(tid >> 6);
    const int G = gridDim.x; const int bx = blockIdx.x; const int vcu = (G % 8 == 0) ? (bx % 8) * (G / 8) + bx / 8 : bx;
    unsigned char* ws = args.ws; const Inputs& in = args.in;
    unsigned* ctl = (unsigned*)(ws + WS_CTL);
    volatile LAS unsigned* MISC = (volatile LAS unsigned*)(lds + MISC_OFF);
    LAS int* moetab = (LAS int*)(lds + MOETAB_OFF);
    for (int u = tid; u < (LDS_BYTES - LDSCTL_OFF) / 4; u += 512) ((LAS unsigned*)(lds + LDSCTL_OFF))[u] = 0u;
    __syncthreads();
    const int lo = args.ph_lo, hi = args.ph_hi;
    const bool multi = (hi - lo) > 1;
    XcdBarrier bar; bar.bar = ctl + CW_BAR; bar.x = 0; bar.st = nullptr;
    if (multi) bar = xcd_barrier_post(ctl + CW_BAR, MISC + 8);
#define IN(k) (lo <= (k) && (k) < hi)
#define SEAM(k) do { if (IN(k) && IN((k) + 1)) xcd_barrier(bar); } while (0)

    if (IN(0)) { for (int rep = 0; rep < NREP(0); ++rep) { p0_prologue(in, ws, vcu * 8 + wave, G * 8, lane, (LAS float*)(lds + wave * 16384)); if (rep + 1 < NREP(0)) xcd_barrier(bar); } SEAM(0); }

    if (IN(1)) {
        pg8::DenseOrder S; S.init((const bf16_t*)(ws + WS_XN), (const bf16_t*)(ws + WS_WIN), NTOK, NPROJ, DM, G, bx);
        if (tid < 256) ((LAS float*)(lds + GAINS_OFF))[tid] = ((const float*)(ws + WS_CONST))[CF_GAIN + tid];
        __syncthreads();
        EpiInProj E{ws, (const LAS float*)(lds + GAINS_OFF)}; phase_stagger(vcu, 1);
        for (int rep = 0; rep < NREP(1); ++rep) { pg8::gemm_phase(lds, S, E); if (rep + 1 < NREP(1)) xcd_barrier(bar); } SEAM(1);
    }
    if (IN(2)) {
#ifdef HAVE_ATTN
        for (int rep = 0; rep < NREP(2); ++rep) { attn_phase<0>(lds, ws, in, G, vcu); if (rep + 1 < NREP(2)) xcd_barrier(bar); }
#endif
        SEAM(2);
    }
    if (IN(3)) {
        pg8::DenseOrder S; S.init((const bf16_t*)(ws + WS_Y), (const bf16_t*)(ws + WS_WOUT), NTOK, DM, DM, G, bx);
        EpiOutProj E{ws, in.x}; phase_stagger(vcu, 3);
        for (int rep = 0; rep < NREP(3); ++rep) { pg8::gemm_phase(lds, S, E); if (rep + 1 < NREP(3)) xcd_barrier(bar); } SEAM(3);
    }
    if (IN(4)) {
        pg8::DenseOrder S; S.init((const bf16_t*)(ws + WS_X1B), (const bf16_t*)(ws + WS_WR), NTOK, 256, DM, G, bx);
        EpiRoute E{ws, lds};
        pg8::gemm_phase<EpiRoute, pg8::DenseOrder, true>(lds, S, E); SEAM(4);
    }
#ifndef DEBUG_SKIP5
    if (IN(5)) {
        moe_tables(ws, moetab);
        MoeOrder S{(const bf16_t*)(ws + WS_X1B), (const bf16_t*)(ws + WS_WGU), DM, 0, (const int*)(ws + WS_LTOK), moetab, G, vcu};
        EpiGateUp E{ws, moetab}; phase_stagger(vcu, 5);
        for (int rep = 0; rep < NREP(5); ++rep) { pg8::gemm_phase(lds, S, E); if (rep + 1 < NREP(5)) xcd_barrier(bar); } SEAM(5);
    }
#endif
#ifndef DEBUG_SKIP6
    if (IN(6)) {
        if (!IN(5)) moe_tables(ws, moetab);
        MoeOrder S{(const bf16_t*)(ws + WS_HID2), (const bf16_t*)(ws + WS_WD), 2 * EHID, 3, (const int*)(ws + WS_LTOK), moetab, G, vcu};
        EpiDownPair E{ws, args.out}; phase_stagger(vcu, 6);
        for (int rep = 0; rep < NREP(6); ++rep) { pg8::gemm_phase<EpiDownPair, MoeOrder, false, true>(lds, S, E); if (rep + 1 < NREP(6)) xcd_barrier(bar); }
    }
#endif
#ifdef PROBE_EXTRA_BARRIERS
    if (multi) { for (int k = 0; k < PROBE_EXTRA_BARRIERS; ++k) xcd_barrier(bar); }
#endif
#undef IN
#undef SEAM
}

#ifdef PROBE_ATTN_ABL
__global__ void __launch_bounds__(512, 2) attn_probe(Args args) {
    extern __shared__ __attribute__((aligned(16))) unsigned char lds_raw_p[];
    LAS unsigned char* lds = (LAS unsigned char*)lds_raw_p;
    const int G = gridDim.x; const int bx = blockIdx.x; const int vcu = (G % 8 == 0) ? (bx % 8) * (G / 8) + bx / 8 : bx;
    attn_phase<PROBE_ATTN_ABL>(lds, args.ws, args.in, G, vcu);
}
#endif

#ifdef PROBE_UBENCH2
typedef float ub2_f32x16 __attribute__((ext_vector_type(16))); typedef short ub2_bf16x8 __attribute__((ext_vector_type(8))); typedef short ub2_s16x4 __attribute__((ext_vector_type(4)));
template <int V> __global__ void __launch_bounds__(512, 2) ubench2(float* sink, int iters) {
    __shared__ __attribute__((aligned(16))) unsigned char sm[57344];
    LAS unsigned char* lds = (LAS unsigned char*)sm;
    for (int i = threadIdx.x; i < 57344 / 4; i += 512) ((LAS float*)lds)[i] = -0.001f * (float)(i & 1023);
    __syncthreads();
    const int lane = threadIdx.x & 63, hi = lane >> 5, r32 = lane & 31;
    ub2_f32x16 pa0, pa1, pb0 = {}, pb1 = {}, o0 = {}, o1 = {}; ub2_bf16x8 q = {1, 2, 3, 4, 5, 6, 7, 8};
#pragma unroll
    for (int i = 0; i < 16; ++i) { pa0[i] = -0.001f * (float)(threadIdx.x + i); pa1[i] = -0.002f * (float)(threadIdx.x + i); }
    asm volatile("" : "+v"(q));
    const LAS unsigned char* kp = lds + hi * 1024 + r32 * 16;
    const LAS unsigned char* vp = lds + 8192 + ((lane >> 4) & 1) * 32 + (lane & 3) * 8 + (4 * hi + ((lane & 15) >> 2)) * 64;
    const LAS unsigned char* tp = lds + 16384 + ((lane & 3) * 2384 + ((2047 - lane) & ~3)) * 4 % 36864;
    float ls0 = 0.f, ls1 = 0.f;
#define UB_MFMA(a, b, c) ((V & 128) ? (c) : __builtin_amdgcn_mfma_f32_32x32x16_bf16(a, b, c, 0, 0, 0))
#define UB_VLOAD(g) do { if ((g) < 8) { if (V & 2) { vl[(g) % 3] = __builtin_bit_cast(ub2_s16x4, __builtin_amdgcn_ds_read_tr16_b64_v4i16((LAS ub2_s16x4*)(vp + ((g) & 1) * 4096 + ((g) >> 1) * 1024))); vh[(g) % 3] = __builtin_bit_cast(ub2_s16x4, __builtin_amdgcn_ds_read_tr16_b64_v4i16((LAS ub2_s16x4*)(vp + ((g) & 1) * 4096 + ((g) >> 1) * 1024 + 512))); } else { vl[(g) % 3] = ub2_s16x4{1, 2, 3, 4}; vh[(g) % 3] = ub2_s16x4{4, 3, 2, 1}; asm volatile("" : "+v"(vl[(g) % 3]), "+v"(vh[(g) % 3])); } } } while (0)
#define UB_SUMPACK(PC0, PC1, ks) do { _Pragma("unroll") for (int i = 0; i < 4; ++i) { const float a_ = (ks) == 0 ? PC0[2 * i] : (ks) == 1 ? PC0[8 + 2 * i] : (ks) == 2 ? PC1[2 * i] : PC1[8 + 2 * i]; const float b_ = (ks) == 0 ? PC0[2 * i + 1] : (ks) == 1 ? PC0[9 + 2 * i] : (ks) == 2 ? PC1[2 * i + 1] : PC1[9 + 2 * i]; \
            if (V & 32) { ls0 += a_; ls1 += b_; pw[(ks) & 1][i] = att::cvtpk(a_, b_); } else pw[(ks) & 1][i] = __builtin_bit_cast(unsigned, a_); } asm volatile("" : "+v"(ls0), "+v"(ls1), "+v"(pw[(ks) & 1])); } while (0)
#define UB_STEP(PC0, PC1, PN0, PN1) do { \
        ub2_bf16x8 kf[8]; \
        _Pragma("unroll") for (int i = 0; i < 8; ++i) { if (V & 1) kf[i] = *(const LAS ub2_bf16x8*)(kp + (i >> 1) * 2048 + (i & 1) * 512); else kf[i] = q; } \
        __builtin_amdgcn_sched_barrier(0); \
        _Pragma("unroll") for (int i = 0; i < 8; ++i) { \
            if (i & 1) PN1 = UB_MFMA(kf[i], q, PN1); else PN0 = UB_MFMA(kf[i], q, PN0); \
            if (V & 16) { _Pragma("unroll") for (int k = 0; k < 4; ++k) { const int e = 4 * i + k; if (e < 16) PC0[e] = __builtin_amdgcn_exp2f(PC0[e]); else PC1[e - 16] = __builtin_amdgcn_exp2f(PC1[e - 16]); } } \
            if (i < 4) asm volatile("" : "+v"(PC0)); else asm volatile("" : "+v"(PC1)); \
            __builtin_amdgcn_sched_barrier(0); } \
        if (V & 64) { asm volatile("s_waitcnt lgkmcnt(0)" ::: "memory"); __builtin_amdgcn_s_barrier(); __builtin_amdgcn_sched_barrier(0); } \
        v4u pw[2]; ub2_s16x4 vl[3], vh[3]; \
        UB_VLOAD(0); UB_VLOAD(1); UB_SUMPACK(PC0, PC1, 0); __builtin_amdgcn_sched_barrier(0); \
        _Pragma("unroll") for (int g = 0; g < 8; ++g) { const int ks = g / 2, d0 = g % 2; \
            UB_VLOAD(g + 2); \
            { const ub2_s16x4 a_ = vl[g % 3], b_ = vh[g % 3]; const ub2_bf16x8 vf = {a_[0], a_[1], a_[2], a_[3], b_[0], b_[1], b_[2], b_[3]}; \
              if (d0) o1 = UB_MFMA(__builtin_bit_cast(ub2_bf16x8, pw[ks & 1]), vf, o1); else o0 = UB_MFMA(__builtin_bit_cast(ub2_bf16x8, pw[ks & 1]), vf, o0); } \
            if (d0 == 0 && ks < 3) UB_SUMPACK(PC0, PC1, ks + 1); \
            if (g == 5) { if (V & 4) { _Pragma("unroll") for (int c = 0; c < 4; ++c) { const f32x4 c0 = *(const LAS f32x4*)(tp + c * 32), c1 = *(const LAS f32x4*)(tp + 128 + c * 32); \
                        PC0[4 * c] = c0[0]; PC0[4 * c + 1] = c0[1]; PC0[4 * c + 2] = c0[2]; PC0[4 * c + 3] = c0[3]; PC1[4 * c] = c1[0]; PC1[4 * c + 1] = c1[1]; PC1[4 * c + 2] = c1[2]; PC1[4 * c + 3] = c1[3]; } } \
                else { asm volatile("" : "+v"(PC0), "+v"(PC1)); } } \
            __builtin_amdgcn_sched_barrier(0); } \
        if (V & 8) { asm volatile("s_waitcnt lgkmcnt(0)" ::: "memory"); __builtin_amdgcn_s_barrier(); __builtin_amdgcn_sched_barrier(0); } } while (0)
    for (int it = 0; it < iters; it += 2) { UB_STEP(pa0, pa1, pb0, pb1); UB_STEP(pb0, pb1, pa0, pa1); }
    float s = ls0 + ls1;
#pragma unroll
    for (int i = 0; i < 16; ++i) s += o0[i] + o1[i] + pa0[i] + pa1[i] + pb0[i] + pb1[i];
    if (s == 123.456f) sink[threadIdx.x] = s;
#undef UB_VLOAD
#undef UB_SUMPACK
#undef UB_STEP
#undef UB_MFMA
}
#endif

#ifdef PROBE_UBENCH
typedef float ub_f32x16 __attribute__((ext_vector_type(16))); typedef short ub_bf16x8 __attribute__((ext_vector_type(8)));
template <int V> __global__ void __launch_bounds__(512, 2) ubench(float* sink, int iters) {
    ub_f32x16 a0 = {}, a1 = {}; ub_bf16x8 x = {1, 2, 3, 4, 5, 6, 7, 8}, y = {8, 7, 6, 5, 4, 3, 2, 1};
    float e[32];
#pragma unroll
    for (int i = 0; i < 32; ++i) e[i] = -0.001f * (float)(threadIdx.x + i);
    asm volatile("" : "+v"(x), "+v"(y));
    for (int it = 0; it < iters; ++it) {
#pragma unroll
        for (int g = 0; g < 16; ++g) {
            if (V & 1) { if (g & 1) a1 = __builtin_amdgcn_mfma_f32_32x32x16_bf16(x, y, a1, 0, 0, 0); else a0 = __builtin_amdgcn_mfma_f32_32x32x16_bf16(x, y, a0, 0, 0, 0); }
            if (V & 2) {
#pragma unroll
                for (int k = 0; k < 4; ++k) { const int i = (4 * g + k) & 31; e[i] = __builtin_amdgcn_exp2f(e[i]) - 1.0f; } }
            if (V & 4) {
#pragma unroll
                for (int k = 0; k < 2; ++k) { const int i = (2 * g + k) & 31; e[i] = __builtin_amdgcn_exp2f(e[i]) - 1.0f; } }
            __builtin_amdgcn_sched_barrier(0);
        }
    }
    float s = 0.f;
#pragma unroll
    for (int i = 0; i < 32; ++i) s += e[i];
#pragma unroll
    for (int i = 0; i < 16; ++i) s += a0[i] + a1[i];
    if (s == 123.456f) sink[threadIdx.x] = s;
}
#endif

extern "C" void kernel_launch(void* const* d_in, const int* in_sizes, int n_in, void* d_out, int out_size, void* d_ws, size_t ws_size, hipStream_t stream) {
    static int grid = 0;
    if (grid == 0) {
        if (n_in != 20 || in_sizes[0] != NTOK * DM || out_size != NTOK * DM || ws_size < WS_END) { fprintf(stderr, "kernel_launch: unexpected shapes (n_in %d, ws %zu)\n", n_in, ws_size); grid = -1; return; }
        int dev = 0, cus = 0, per_cu = 0;
        if (hipGetDevice(&dev) != hipSuccess || hipDeviceGetAttribute(&cus, hipDeviceAttributeMultiprocessorCount, dev) != hipSuccess) { grid = -1; return; }
        if (hipFuncSetAttribute((const void*)mega, hipFuncAttributeMaxDynamicSharedMemorySize, LDS_BYTES) != hipSuccess) { fprintf(stderr, "kernel_launch: hipFuncSetAttribute failed\n"); grid = -1; return; }
        if (hipOccupancyMaxActiveBlocksPerMultiprocessor(&per_cu, (const void*)mega, 512, LDS_BYTES) != hipSuccess || per_cu < 1) { fprintf(stderr, "kernel_launch: occupancy query says %d blocks per CU\n", per_cu); (void)hipGetLastError(); grid = -1; return; }
        grid = cus;
    }
    if (grid < 0) return;
    Args a{};
    const float** ip = (const float**)&a.in;
    for (int i = 0; i < 20; ++i) ip[i] = (const float*)d_in[i];
    a.out = (float*)d_out; a.ws = (unsigned char*)d_ws; a.ph_lo = 0; a.ph_hi = N_PHASES;
    (void)hipMemsetAsync((unsigned char*)d_ws + WS_CTL, 0, CTL_ZERO_BYTES, stream);
    hipLaunchKernelGGL(mega, dim3(grid), dim3(512), LDS_BYTES, stream, a);
#ifdef PROBE_ATTN_ABL
    { static bool ad = false; if (!ad) { (void)hipFuncSetAttribute((const void*)attn_probe, hipFuncAttributeMaxDynamicSharedMemorySize, LDS_BYTES); ad = true; }
      hipLaunchKernelGGL(attn_probe, dim3(grid), dim3(512), LDS_BYTES, stream, a); }
#endif
#ifdef PROBE_UBENCH2
    hipLaunchKernelGGL(ubench2<PROBE_UBENCH2>, dim3(grid), dim3(512), 0, stream, (float*)((unsigned char*)d_ws + WS_SS), 1000);
#endif
#ifdef PROBE_UBENCH
    hipLaunchKernelGGL(ubench<PROBE_UBENCH>, dim3(grid), dim3(PROBE_UB_THREADS), 0, stream, (float*)((unsigned char*)d_ws + WS_SS), 1000);
#endif
#ifdef PROBE_EXTRA_LO
    for (int k = PROBE_EXTRA_LO; k < PROBE_EXTRA_HI; ++k) { a.ph_lo = k; a.ph_hi = k + 1; hipLaunchKernelGGL(mega, dim3(grid), dim3(512), LDS_BYTES, stream, a); }
#endif
}
```

```cpp
#include <hip/hip_runtime.h>
#include <cstdint>
#include <cstdio>

typedef unsigned short bf16_t;
typedef unsigned v4u __attribute__((ext_vector_type(4)));
typedef unsigned v2u __attribute__((ext_vector_type(2)));
typedef float f32x4 __attribute__((ext_vector_type(4)));
#define LAS __attribute__((address_space(3)))

constexpr int BATCH = 32, SEQ = 2048, DM = 1024, NTOK = BATCH * SEQ;
constexpr int HD = 64, HDIFF = 4, HMOBA = 8, NPROJ = 3072;
constexpr int NEXP = 32, EHID = 256, NLIST = 64;
constexpr int LIST_CAP = NTOK;
constexpr float RMS_EPS = 1e-6f;
constexpr float LOG2E = 1.4426950408889634f;
constexpr float C2 = 0.125f * LOG2E;
constexpr float LAMBDA_INIT = 0.2f;

constexpr size_t MiB = 1u << 20;
constexpr size_t WS_CTL = 0, CTL_ZERO_BYTES = 1 * MiB;
constexpr size_t WS_CONST = 1 * MiB;
constexpr size_t WS_WIN = 2 * MiB, WS_WOUT = 8 * MiB, WS_WR = 10 * MiB, WS_WGU = 12 * MiB, WS_WD = 44 * MiB;
constexpr size_t WS_QD = 64 * MiB, WS_KD = 128 * MiB, WS_VD = 192 * MiB, WS_QM = 256 * MiB, WS_KM = 320 * MiB, WS_VM = 384 * MiB;
constexpr size_t WS_XN = 448 * MiB, WS_Y = 448 * MiB;
constexpr size_t WS_X1B = 576 * MiB, WS_SS = 704 * MiB  , WS_R2 = 708 * MiB, WS_KMEAN = 709 * MiB;
constexpr size_t WS_PA = 64 * MiB, WS_HID = 192 * MiB, WS_LTOK = 272 * MiB, WS_LW = 288 * MiB;
constexpr size_t WS_END = 711 * MiB;
constexpr size_t WS_HID2 = 64 * MiB  , WS_LP = 320 * MiB  , WS_PTOK = 336 * MiB  ;
constexpr int NPAIR = 112;
constexpr int CW_PCNT = 16384;
constexpr int CW_CNT = 1024;
#ifndef DBG_MEASURE
#define DBG_MEASURE 0
#endif
constexpr int CF_DBG = 8;
constexpr int CF_LAMBDA = 0, CF_OFF = 16, CF_GAIN = 64  , CF_BT = 1024;

__device__ __forceinline__ float bf2f(bf16_t v) { return __uint_as_float(((unsigned)v) << 16); }
__device__ __forceinline__ unsigned f2bf(float f) { unsigned u = __float_as_uint(f); return (u + 0x7fffu + ((u >> 16) & 1u)) >> 16; }
__device__ __forceinline__ unsigned pk2(float lo, float hi) { return f2bf(lo) | (f2bf(hi) << 16); }
__device__ __forceinline__ float wave_sum(float v) {
#pragma unroll
    for (int o = 1; o < 64; o <<= 1) v += __shfl_xor(v, o);
    return v;
}
__device__ __forceinline__ float wave_max(float v) {
#pragma unroll
    for (int o = 1; o < 64; o <<= 1) v = fmaxf(v, __shfl_xor(v, o));
    return v;
}
__host__ __device__ __forceinline__ int phys_in(int c) { const int pn = c >> 8, cc = c & 255; return 256 * pn + 128 * ((cc >> 5) & 1) + 32 * (cc >> 6) + (cc & 31); }
__device__ __forceinline__ int t5_bucket(int d) {
    if (d < 16) return d;
    const float nf = (float)d;
    int large = 16 + (int)(logf(nf / 16.0f) / 4.852030263919617f * 16.0f);
    return large < 31 ? large : 31;
}

struct Inputs {
    const float *x, *norm1_g, *w_in, *diff_q_g, *diff_k_g, *lq1, *lk1, *lq2, *lk2, *diff_sub_g, *moba_q_g, *moba_k_g, *rel_bias, *w_out, *norm2_g,
        *router_group, *router_expert, *w_gate, *w_up, *w_down;
};

__device__ __forceinline__ void p0_tr_item(const float* W, int ldw, int k0, int n_src, const float* gk, bf16_t* dst, int drow0, int dpitch, LAS float* scr, int lane) {
    float wv[32];
#pragma unroll
    for (int i = 0; i < 32; ++i) wv[i] = W[(size_t)(k0 + 2 * i + (lane >> 5)) * ldw + n_src + (lane & 31)];
#pragma unroll
    for (int i = 0; i < 32; ++i) { const int kk = 2 * i + (lane >> 5); float v = wv[i]; if (gk) v *= gk[k0 + kk]; scr[kk * 33 + (lane & 31)] = v; }
    asm volatile("s_waitcnt lgkmcnt(0)" ::: "memory");
    const int c = lane & 7;
#pragma unroll
    for (int j = 0; j < 4; ++j) {
        const int n = (lane >> 3) + 8 * j; const LAS float* s = scr + (8 * c) * 33 + n;
        v4u o; o.x = pk2(s[0 * 33], s[1 * 33]); o.y = pk2(s[2 * 33], s[3 * 33]); o.z = pk2(s[4 * 33], s[5 * 33]); o.w = pk2(s[6 * 33], s[7 * 33]);
        *(v4u*)(dst + (size_t)(drow0 + n) * dpitch + k0 + 8 * c) = o;
    }
    asm volatile("s_waitcnt lgkmcnt(0)" ::: "memory");
}

__device__ __forceinline__ void p0_prologue(const Inputs& in, unsigned char* ws, int gw, int NGW, int lane, LAS float* scr) {
    bf16_t* WIN_T = (bf16_t*)(ws + WS_WIN); bf16_t* WOUT_T = (bf16_t*)(ws + WS_WOUT); bf16_t* WR_T = (bf16_t*)(ws + WS_WR);
    bf16_t* WGU_T = (bf16_t*)(ws + WS_WGU); bf16_t* WD_T = (bf16_t*)(ws + WS_WD); bf16_t* XN = (bf16_t*)(ws + WS_XN);
    float* CF = (float*)(ws + WS_CONST);
    constexpr int I_IN = 16 * 96, I_OUT = 16 * 32, I_GU = 32 * 16 * 16, I_D = 32 * 4 * 32, NITEMS = I_IN + I_OUT + I_GU + I_D;
    for (int it = gw; it < NITEMS; it += NGW) {
        int r = it;
        if (r < I_IN) {
            const int kb = r / 96, nb = r % 96, p0 = 32 * nb, pn = p0 >> 8, pp = p0 & 255, bj = pp >> 7, wc = (pp >> 5) & 3;
            p0_tr_item(in.w_in, NPROJ, 64 * kb, 256 * pn + 64 * wc + 32 * bj, in.norm1_g, WIN_T, p0, DM, scr, lane); continue; }
        r -= I_IN;
        if (r < I_OUT) { const int kb = r / 32, nb = r % 32; p0_tr_item(in.w_out, DM, 64 * kb, 32 * nb, nullptr, WOUT_T, 32 * nb, DM, scr, lane); continue; }
        r -= I_OUT;
        if (r < I_GU) {
            const int e = r / 256, rr = r % 256, kb = rr / 16, nb = rr % 16, p0 = 32 * nb, pn = p0 >> 8, bj = (p0 >> 7) & 1, j0 = p0 & 127;
            const float* src = (bj ? in.w_up : in.w_gate) + (size_t)e * DM * EHID;
            p0_tr_item(src, EHID, 64 * kb, 128 * pn + j0, in.norm2_g, WGU_T + (size_t)e * 512 * DM, p0, DM, scr, lane); continue; }
        r -= I_GU;
        { const int e = r / 128, rr = r % 128, kb = rr / 32, nb = rr % 32;
          p0_tr_item(in.w_down + (size_t)e * EHID * DM, DM, 64 * kb, 32 * nb, nullptr, WD_T + (size_t)e * DM * EHID, 32 * nb, EHID, scr, lane); }
    }
    for (int idx = gw * 64 + lane; idx < 256 * DM; idx += NGW * 64) {
        const int p = idx >> 10, k = idx & 1023, g = (p >> 5) & 3, i = p & 31; float v = 0.f;
        if (p < 128) { if (i < 8) v = in.norm2_g[k] * in.router_expert[((size_t)g * DM + k) * 8 + i]; else if (i < 12) v = in.norm2_g[k] * in.router_group[k * 4 + (i - 8)]; }
        WR_T[idx] = (bf16_t)f2bf(v);
    }
    for (int idx = gw * 64 + lane; idx < 12 * 2048; idx += NGW * 64) {
        const int h = idx >> 11, d = idx & 2047; CF[CF_BT + idx] = in.rel_bias[t5_bucket(d) * 12 + h] * LOG2E;
    }
    if (gw == 0) {
        float a = in.lq1[lane] * in.lk1[lane], b = in.lq2[lane] * in.lk2[lane];
        a = wave_sum(a); b = wave_sum(b);
        const float mqd = wave_max(fabsf(in.diff_q_g[lane])), mkd = wave_max(fabsf(in.diff_k_g[lane]));
        const float mqm = wave_max(fabsf(in.moba_q_g[lane])), mkm = wave_max(fabsf(in.moba_k_g[lane]));
        if (lane == 0) CF[CF_LAMBDA] = expf(a) - expf(b) + LAMBDA_INIT;
        CF[CF_GAIN + lane] = in.diff_q_g[lane]; CF[CF_GAIN + 64 + lane] = in.diff_k_g[lane]; CF[CF_GAIN + 128 + lane] = in.moba_q_g[lane]; CF[CF_GAIN + 192 + lane] = in.moba_k_g[lane];
        if (lane < 12) {
            float mb = -1e30f; for (int bk = 0; bk < 32; ++bk) mb = fmaxf(mb, in.rel_bias[bk * 12 + lane]);
            const float qk = lane < 4 ? mqd * mkd : mqm * mkm;
            CF[CF_OFF + lane] = (8.0f * qk + mb) * LOG2E;
        }
    }
    for (int m0 = gw * 4; m0 < NTOK; m0 += NGW * 4) {
        f32x4 v[4][4];
#pragma unroll
        for (int rr = 0; rr < 4; ++rr) { const f32x4* xr = (const f32x4*)(in.x + (size_t)(m0 + rr) * DM) + lane;
#pragma unroll
            for (int j = 0; j < 4; ++j) v[rr][j] = __builtin_nontemporal_load(xr + 64 * j); }
#pragma unroll
        for (int rr = 0; rr < 4; ++rr) { float s = 0.f;
#pragma unroll
            for (int j = 0; j < 4; ++j) s += (v[rr][j].x * v[rr][j].x + v[rr][j].y * v[rr][j].y) + (v[rr][j].z * v[rr][j].z + v[rr][j].w * v[rr][j].w);
            const float r = rsqrtf(wave_sum(s) * (1.f / DM) + RMS_EPS);
            unsigned long long* o8 = (unsigned long long*)(XN + (size_t)(m0 + rr) * DM) + lane;
#pragma unroll
            for (int j = 0; j < 4; ++j) o8[64 * j] = (unsigned long long)pk2(v[rr][j].x * r, v[rr][j].y * r) | ((unsigned long long)pk2(v[rr][j].z * r, v[rr][j].w * r) << 32); }
    }
}

namespace pg8 {
typedef short bf16x8 __attribute__((ext_vector_type(8)));
constexpr int BM = 256, BK = 64, HALF = 128, HTB = HALF * BK * 2, STAGE_BYTES = 8 * HTB, NXCD = 8, WGM = 8;

__host__ __device__ __forceinline__ int lds_byte(int r, int c) { const int st = (r >> 4) * 2 + (c >> 5), rr = r & 15, cc = c & 31, ob = rr * 64 + cc * 2; return st * 1024 + (ob ^ (((ob >> 9) & 1) << 5)); }
__host__ __device__ __forceinline__ void stage_rc(int b, int& R, int& C) { const int st = b / 1024, sb = b % 1024, swz = sb ^ (((sb >> 9) & 1) << 5); R = (st >> 1) * 16 + swz / 64; C = (st & 1) * 32 + (swz % 64) / 2; }
__host__ __device__ __forceinline__ int perm32(int rho) { const int n = rho >> 4, i = rho & 15; return 8 * (i >> 2) + 4 * n + (i & 3); }

struct Unit { int pm, pn, a0, a1; };

struct DenseOrder {
    const bf16_t* A; const bf16_t* Bt; int K; int nM, nN, nwg, G, c;
    __device__ void init(const bf16_t* A_, const bf16_t* Bt_, int M, int N, int K_, int G_, int c_) { A = A_; Bt = Bt_; K = K_; nM = M / BM; nN = N / BM; nwg = nM * nN; G = G_; c = c_; }
    __device__ __forceinline__ bool next(int i, Unit& u) const {
        const long L = (long)i * G + c; if (L >= nwg) return false;
        int wgid = (int)L; { const int q = nwg / NXCD, r = nwg % NXCD, xcd = wgid % NXCD, off = wgid / NXCD; wgid = (xcd < r ? xcd * (q + 1) : r * (q + 1) + (xcd - r) * q) + off; }
        const int nig = WGM * nN, gid = wgid / nig, fm = gid * WGM, gsz = (nM - fm) < WGM ? (nM - fm) : WGM;
        u.pm = fm + ((wgid % nig) % gsz); u.pn = (wgid % nig) / gsz; u.a0 = 0; u.a1 = 256; return true;
    }
    __device__ __forceinline__ const char* abase() const { return (const char*)A; }
    __device__ __forceinline__ unsigned arow(const Unit& u, int r) const { return (unsigned)(u.pm * BM + r) * (unsigned)K * 2u; }
    __device__ __forceinline__ const char* bbase(const Unit& u) const { return (const char*)Bt + (size_t)u.pn * BM * K * 2; }
};

typedef float f32x2 __attribute__((ext_vector_type(2)));
__device__ __forceinline__ unsigned cvt_pk_bf16(float lo, float hi) { unsigned r; asm volatile("v_cvt_pk_bf16_f32 %0, %1, %2" : "=v"(r) : "v"(lo), "v"(hi)); return r; }

template <class Epi, class Sched, bool HALFN = false, bool SPLITB = false>
__device__ __forceinline__ void gemm_phase(LAS unsigned char* lds, const Sched& S, const Epi& E) {
    int tid_ = threadIdx.x; asm volatile("" : "+v"(tid_));
    const int tid = tid_, wid = __builtin_amdgcn_readfirstlane(tid >> 6), lane = tid & 63, wr = wid >> 2, wc = wid & 3, fr = lane & 15, fq = lane >> 4;
    const int K = S.K, nt = K / BK; int LDB = K; if constexpr (SPLITB) LDB = S.ldb();
    int RA[2]; unsigned cA2[2], voffB[2];
#pragma unroll
    for (int i = 0; i < 2; ++i) { int R, C; stage_rc(tid * 16 + i * 8192, R, C); const int Rb = (R & ~31) + perm32(R & 31);
        RA[i] = R; cA2[i] = (unsigned)C * 2u; voffB[i] = (unsigned)(Rb * LDB + C) * 2u; }
    const size_t kstep = (size_t)(BK * 2);
    const size_t hstep = (size_t)HALF * LDB * 2;
    const unsigned ldsw = (unsigned)wid * 1024u;
    const int aoff = lds_byte(wr * 64 + fr, fq * 8), boff = lds_byte(wc * 32 + fr, fq * 8);
#define PG8_SA(b, h) (((b) * 2 + (h)) * HTB)
#define PG8_SB(b, h) ((4 + (b) * 2 + (h)) * HTB)
#define PG8_STAGE(bufoff, gbase, voff) do { _Pragma("unroll") for (int _i = 0; _i < 2; ++_i) \
        __builtin_amdgcn_global_load_lds((const unsigned*)((const char*)(gbase) + (voff)[_i]), (LAS unsigned*)(lds + (bufoff) + ldsw + _i * 8192), 16, 0, 0); } while (0)
#define PG8_LDA(dst, b, h) do { _Pragma("unroll") for (int m = 0; m < 4; ++m) _Pragma("unroll") for (int k = 0; k < 2; ++k) dst[m][k] = *(const LAS bf16x8*)(lds + PG8_SA(b, h) + aoff + m * 2048 + k * 1024); } while (0)
#define PG8_LDB(dst, b, h) do { _Pragma("unroll") for (int n = 0; n < 2; ++n) _Pragma("unroll") for (int k = 0; k < 2; ++k) dst[n][k] = *(const LAS bf16x8*)(lds + PG8_SB(b, h) + boff + n * 2048 + k * 1024); } while (0)
#define PG8_MMA(ai, bj, At, Bt) do { __builtin_amdgcn_s_setprio(1); _Pragma("unroll") for (int m = 0; m < 4; ++m) _Pragma("unroll") for (int n = 0; n < 2; ++n) _Pragma("unroll") for (int k = 0; k < 2; ++k) \
        acc[ai][bj][m][n] = __builtin_amdgcn_mfma_f32_16x16x32_bf16(Bt[n][k], At[m][k], acc[ai][bj][m][n], 0, 0, 0); __builtin_amdgcn_s_setprio(0); } while (0)
#define PG8_WAIT_V(n) asm volatile("s_waitcnt vmcnt(" #n ")" ::: "memory")
#define PG8_WAIT_L(n) asm volatile("s_waitcnt lgkmcnt(" #n ")" ::: "memory")
#define PG8_BAR __builtin_amdgcn_s_barrier()
#define PG8_SCHED __builtin_amdgcn_sched_barrier(0)
    Unit cur, nxt; int ui = 0;
    if (!S.next(0, cur)) return;
    f32x4 acc[2][2][4][2];
#pragma unroll
    for (int a = 0; a < 2; ++a)
#pragma unroll
        for (int b = 0; b < 2; ++b)
#pragma unroll
            for (int m = 0; m < 4; ++m)
#pragma unroll
                for (int n = 0; n < 2; ++n) acc[a][b][m][n] = (f32x4){0.f, 0.f, 0.f, 0.f};
    bf16x8 At[4][2], B0[2][2], B1[2][2];
    const char* const Ab = S.abase();
    unsigned oC[2][2], oN[2][2];
#pragma unroll
    for (int h = 0; h < 2; ++h)
#pragma unroll
        for (int i = 0; i < 2; ++i) { oC[h][i] = S.arow(cur, h * HALF + RA[i]) + cA2[i]; oN[h][i] = oC[h][i]; }
    const char* cB = S.bbase(cur); const char* cBh = cB; if constexpr (SPLITB) cBh = S.bbase2(cur);
    PG8_STAGE(PG8_SB(0, 0), cB, voffB); PG8_STAGE(PG8_SB(0, 1), cB + hstep, voffB); PG8_STAGE(PG8_SA(0, 0), Ab, oC[0]); PG8_STAGE(PG8_SA(0, 1), Ab, oC[1]);
    if (wr == 1) PG8_BAR;
    PG8_WAIT_V(2); PG8_BAR;
    PG8_STAGE(PG8_SB(1, 0), cB + kstep, voffB); PG8_STAGE(PG8_SA(1, 0), Ab + kstep, oC[0]); PG8_STAGE(PG8_SB(1, 1), cB + hstep + kstep, voffB);
    PG8_WAIT_V(6); PG8_BAR;
    for (;;) {
        const bool has_next = S.next(ui + 1, nxt);
        const char* nB = has_next ? S.bbase(nxt) : cB; const char* nBh = nB; if constexpr (SPLITB) { if (has_next) nBh = S.bbase2(nxt); }
        if (has_next) {
#pragma unroll
            for (int h = 0; h < 2; ++h)
#pragma unroll
                for (int i = 0; i < 2; ++i) oN[h][i] = S.arow(nxt, h * HALF + RA[i]) + cA2[i];
        }
        for (int t = 0; t < nt; t += 2) {
            const bool last = (t == nt - 2);
            const char* a1 = Ab + (size_t)(t + 1) * kstep;
            const char* a2 = last ? Ab : Ab + (size_t)(t + 2) * kstep; const char* b2 = last ? nB : ((SPLITB && t + 2 >= (nt >> 1)) ? cBh : cB) + (size_t)(t + 2) * kstep;
            const char* a3 = a2 + kstep; const char* b3 = b2 + kstep;
            unsigned o2[2][2];
#pragma unroll
            for (int h = 0; h < 2; ++h)
#pragma unroll
                for (int i = 0; i < 2; ++i) o2[h][i] = last ? oN[h][i] : oC[h][i];
            PG8_LDB(B0, 0, 0); PG8_LDB(B1, 0, 1); PG8_SCHED; PG8_LDA(At, 0, 0); PG8_STAGE(PG8_SA(1, 1), a1, oC[1]);
            PG8_WAIT_V(8); PG8_WAIT_L(0); PG8_BAR; PG8_MMA(0, 0, At, B0); if (!HALFN) PG8_MMA(0, 1, At, B1); PG8_BAR; PG8_SCHED;
            PG8_LDA(At, 0, 1); PG8_STAGE(PG8_SB(0, 0), b2, voffB); PG8_STAGE(PG8_SB(0, 1), b2 + hstep, voffB); PG8_STAGE(PG8_SA(0, 0), a2, o2[0]);
            PG8_WAIT_V(8); PG8_WAIT_L(0); PG8_BAR; PG8_MMA(1, 0, At, B0); if (!HALFN) PG8_MMA(1, 1, At, B1); PG8_BAR; PG8_SCHED;
            PG8_LDB(B0, 1, 0); PG8_LDB(B1, 1, 1); PG8_SCHED; PG8_LDA(At, 1, 0); PG8_STAGE(PG8_SA(0, 1), a2, o2[1]);
            PG8_WAIT_V(8); PG8_WAIT_L(0); PG8_BAR; PG8_MMA(0, 0, At, B0); if (!HALFN) PG8_MMA(0, 1, At, B1); PG8_BAR; PG8_SCHED;
            PG8_LDA(At, 1, 1); PG8_STAGE(PG8_SB(1, 0), b3, voffB); PG8_STAGE(PG8_SB(1, 1), b3 + hstep, voffB); PG8_STAGE(PG8_SA(1, 0), a3, o2[0]);
            PG8_WAIT_V(8); PG8_WAIT_L(0); PG8_BAR; PG8_MMA(1, 0, At, B0); if (!HALFN) PG8_MMA(1, 1, At, B1); PG8_BAR; PG8_SCHED;
        }
        if (wr == 0) PG8_BAR;
        { int frE = fr, fqE = fq; asm volatile("" : "+v"(frE), "+v"(fqE));
          E(acc, cur, wr, wc, frE, fqE); }
        if (!has_next) break;
#pragma unroll
        for (int a = 0; a < 2; ++a)
#pragma unroll
            for (int b = 0; b < 2; ++b)
#pragma unroll
                for (int m = 0; m < 4; ++m)
#pragma unroll
                    for (int n = 0; n < 2; ++n) acc[a][b][m][n] = (f32x4){0.f, 0.f, 0.f, 0.f};
        cur = nxt; cB = nB; cBh = nBh; ++ui;
#pragma unroll
        for (int h = 0; h < 2; ++h)
#pragma unroll
            for (int i = 0; i < 2; ++i) oC[h][i] = oN[h][i];
        if (wr == 1) PG8_BAR;
    }
    PG8_WAIT_V(0);
    PG8_BAR;
#undef PG8_SA
#undef PG8_SB
#undef PG8_STAGE
#undef PG8_LDA
#undef PG8_LDB
#undef PG8_MMA
#undef PG8_WAIT_V
#undef PG8_WAIT_L
#undef PG8_BAR
#undef PG8_SCHED
}
}

constexpr size_t WS_LR = 304 * MiB;
constexpr int SS_PARTS = 16;
constexpr int RING_BYTES = 131072  , LDSCTL_OFF = 139264  , MISC_OFF = LDSCTL_OFF + 320, MOETAB_OFF = LDSCTL_OFF + 1024;
constexpr int LDS_BYTES = 147456;
constexpr int MT_CNT = 0, MT_ALL = 64, MT_R0 = 64 + 65, MT_R1 = 64 + 65 + 33;
constexpr int PAIRTAB_OFF = LDSCTL_OFF + 6656;
constexpr int PT_CNT = 0, PT_ALL = NPAIR;

__device__ __forceinline__ f32x4 ldg4(const float* p) { return *(const f32x4*)p; }

struct MoeOrder {
    const bf16_t* A; const bf16_t* Bt; int K; int mode; const int* ltok; const LAS int* tab; int G, c;
    __device__ __forceinline__ bool next(int i, pg8::Unit& u) const {
        const int L = i * G + c;
        if (mode == 3) {
            const LAS int* pt = tab + (PAIRTAB_OFF - MOETAB_OFF) / 4;
            const int T = L >> 2; if (T >= pt[PT_ALL + NPAIR]) return false;
            int lo = 0;
#pragma unroll
            for (int s = 64; s >= 1; s >>= 1) if (lo + s < NPAIR && pt[PT_ALL + lo + s] <= T) lo += s;
            const int tile = T - pt[PT_ALL + lo]; u.pm = T; u.pn = L & 3; u.a0 = lo | (tile << 8); const int v = pt[PT_CNT + lo] - tile * 256; u.a1 = v < 256 ? v : 256; return true;
        }
        if (mode == 0) {
            const int T = L >> 1; if (T >= tab[MT_ALL + 64]) return false;
            int lo = 0;
#pragma unroll
            for (int s = 32; s >= 1; s >>= 1) if (tab[MT_ALL + lo + s] <= T) lo += s;
            const int tile = T - tab[MT_ALL + lo]; u.pm = T; u.pn = L & 1; u.a0 = lo | (tile << 8); const int v = tab[MT_CNT + lo] - tile * 256; u.a1 = v < 256 ? v : 256; return true;
        } else {
            const int T = L >> 2; const int tb = mode == 1 ? MT_R0 : MT_R1; if (T >= tab[tb + 32]) return false;
            int lo = 0;
#pragma unroll
            for (int s = 16; s >= 1; s >>= 1) if (tab[tb + lo + s] <= T) lo += s;
            const int list = 2 * lo + (mode - 1), tile = T - tab[tb + lo]; u.pm = tab[MT_ALL + list] + tile; u.pn = L & 3; u.a0 = list | (tile << 8);
            const int v = tab[MT_CNT + list] - tile * 256; u.a1 = v < 256 ? v : 256; return true;
        }
    }
    __device__ __forceinline__ const char* abase() const { return (const char*)A; }
    __device__ __forceinline__ unsigned arow(const pg8::Unit& u, int r) const {
        if (mode == 0) { const int list = u.a0 & 255, tile = u.a0 >> 8; const int tok = r < u.a1 ? ltok[(size_t)list * LIST_CAP + tile * 256 + r] : 0; return (unsigned)tok * (unsigned)(DM * 2); }
        if (mode == 3) return (unsigned)(u.pm * 256 + r) * (unsigned)(2 * EHID * 2);
        return (unsigned)(u.pm * 256 + r) * (unsigned)(EHID * 2);
    }
    __device__ __forceinline__ static void pair_experts(int p, int& elo, int& ehi) { const int g = p / 28; int q = p - g * 28, lo = 0;
#pragma unroll
        for (int k = 0; k < 7; ++k) if (q >= 7 - lo) { q -= 7 - lo; ++lo; }
        elo = g * 8 + lo; ehi = g * 8 + lo + 1 + q; }
    __device__ __forceinline__ int ldb() const { return EHID; }
    __device__ __forceinline__ const char* bbase2(const pg8::Unit& u) const { int elo, ehi; pair_experts(u.a0 & 255, elo, ehi); return (const char*)Bt + ((size_t)ehi * DM + u.pn * 256) * EHID * 2 - (size_t)EHID * 2; }
    __device__ __forceinline__ const char* bbase(const pg8::Unit& u) const {
        if (mode == 3) { int elo, ehi; pair_experts(u.a0 & 255, elo, ehi); return (const char*)Bt + ((size_t)elo * DM + u.pn * 256) * EHID * 2; }
        const int e = (u.a0 & 255) >> 1;
        if (mode == 0) return (const char*)Bt + ((size_t)e * 512 + u.pn * 256) * DM * 2;
        return (const char*)Bt + ((size_t)e * DM + u.pn * 256) * EHID * 2;
    }
};
__device__ __forceinline__ void moe_tables(unsigned char* ws, LAS int* tab) {
    LAS int* pt = tab + (PAIRTAB_OFF - MOETAB_OFF) / 4;
    if (threadIdx.x < 64) tab[MT_CNT + threadIdx.x] = (int)__hip_atomic_load((unsigned*)(ws + WS_CTL) + CW_CNT + 64 * threadIdx.x, __ATOMIC_RELAXED, __HIP_MEMORY_SCOPE_AGENT);
#ifndef DEBUG_NOPT
    else if (threadIdx.x < 64 + NPAIR) pt[PT_CNT + threadIdx.x - 64] = (int)__hip_atomic_load((unsigned*)(ws + WS_CTL) + CW_PCNT + 64 * (threadIdx.x - 64), __ATOMIC_RELAXED, __HIP_MEMORY_SCOPE_AGENT);
#endif
    __syncthreads();
#ifndef DEBUG_NOPT
    if (threadIdx.x == 64) { int a = 0; for (int l = 0; l < NPAIR; ++l) { pt[PT_ALL + l] = a; a += (pt[PT_CNT + l] + 255) >> 8; } pt[PT_ALL + NPAIR] = a; }
#endif
    if (threadIdx.x == 0) { int a = 0, r0 = 0, r1 = 0;
        for (int l = 0; l < 64; ++l) { const int t = (tab[MT_CNT + l] + 255) >> 8; tab[MT_ALL + l] = a; a += t; if (l & 1) { tab[MT_R1 + (l >> 1)] = r1; r1 += t; } else { tab[MT_R0 + (l >> 1)] = r0; r0 += t; } }
        tab[MT_ALL + 64] = a; tab[MT_R0 + 32] = r0; tab[MT_R1 + 32] = r1; }
    __syncthreads();
}

constexpr int GAINS_OFF = LDSCTL_OFF + 4096;
struct EpiInProj {
    unsigned char* ws; const LAS float* gl; bool stub;
    __device__ __forceinline__ void operator()(const f32x4 (&acc)[2][2][4][2], const pg8::Unit& u, int wr, int wc, int fr, int fq) const {
#ifdef PROBE_STUB_EPI
        if (stub) { const float t = acc[0][0][0][0][0] + acc[1][1][3][1][3];
            if (t == 12345.678f) ((float*)(ws + WS_SS))[threadIdx.x] = t; return; }
#endif
        const int seg = u.pn >> 1, gi = ((u.pn & 1) << 2) | wc, b = u.pm >> 3, blk = u.pm & 7;
        const bool nrm = (seg != 2 && seg != 5);
        const LAS float* gp = gl + 64 * (seg == 0 ? 0 : seg == 1 ? 1 : seg == 3 ? 2 : 3);
        const float qs = (seg == 0 || seg == 3) ? C2 : 1.0f;
        f32x4 g[2][2];
#pragma unroll
        for (int bj = 0; bj < 2; ++bj)
#pragma unroll
            for (int n = 0; n < 2; ++n) g[bj][n] = nrm ? *(const LAS f32x4*)(gp + 32 * bj + 8 * fq + 4 * n) * qs : (f32x4){1.f, 1.f, 1.f, 1.f};
        bf16_t* base; size_t rstride;
        if (seg < 2) { base = (bf16_t*)(ws + (seg == 0 ? WS_QD : WS_KD)) + ((size_t)((b * 4 + (gi >> 1)) * 2 + (gi & 1)) * SEQ + blk * 256) * 64; rstride = 64; }
        else if (seg == 2) { base = (bf16_t*)(ws + WS_VD) + ((size_t)(b * 4 + (gi >> 1)) * SEQ + blk * 256) * 128 + (gi & 1) * 64; rstride = 128; }
        else { base = (bf16_t*)(ws + (seg == 3 ? WS_QM : seg == 4 ? WS_KM : WS_VM)) + ((size_t)(b * 8 + gi) * SEQ + blk * 256) * 64; rstride = 64; }
        int cRT = 4096, cBJ = 32, cRK = 64, cFQ = 8; bf16_t* basex = base;
        if (seg == 1 || seg == 4) { cBJ = 2048; cRK = 8; cFQ = 512; }
        else if (seg == 5) { cBJ = 2048; cRK = 32; }
        else if (seg == 2) { cRT = 8192; cBJ = 2048; cRK = 32; basex = base - (gi & 1) * 64 + (gi & 1) * 4096; }
        const int lane_off = fr * cRK + fq * cFQ;
        f32x4 ks[2][2];
#pragma unroll
        for (int bj = 0; bj < 2; ++bj)
#pragma unroll
            for (int n = 0; n < 2; ++n) ks[bj][n] = (f32x4){0.f, 0.f, 0.f, 0.f};
#pragma unroll
        for (int ai = 0; ai < 2; ++ai)
#pragma unroll
            for (int m = 0; m < 4; ++m) {
                const int r = 128 * ai + 64 * wr + 16 * m + fr;
                f32x4 v[2][2]; float ss = 0.f;
#pragma unroll
                for (int bj = 0; bj < 2; ++bj)
#pragma unroll
                    for (int n = 0; n < 2; ++n) { v[bj][n] = acc[ai][bj][m][n]; ss += (v[bj][n][0] * v[bj][n][0] + v[bj][n][1] * v[bj][n][1]) + (v[bj][n][2] * v[bj][n][2] + v[bj][n][3] * v[bj][n][3]); }
                float rs = 1.f;
                if (nrm) { ss += __shfl_xor(ss, 16); ss += __shfl_xor(ss, 32); rs = rsqrtf(ss * (1.f / 64.f) + RMS_EPS); }
#pragma unroll
                for (int bj = 0; bj < 2; ++bj) {
                    const f32x4 a = v[bj][0] * rs * g[bj][0], c = v[bj][1] * rs * g[bj][1];
                    if (seg == 4) { ks[bj][0] += a; ks[bj][1] += c; }
                    v4u w; w.x = pg8::cvt_pk_bf16(a[0], a[1]); w.y = pg8::cvt_pk_bf16(a[2], a[3]); w.z = pg8::cvt_pk_bf16(c[0], c[1]); w.w = pg8::cvt_pk_bf16(c[2], c[3]);
                    *(v4u*)(basex + ((2 * ai + wr) * cRT + 16 * m * cRK + bj * cBJ) + lane_off) = w;
                }
            }
        if (seg == 4) {
            float* km = (float*)(ws + WS_KMEAN) + (((size_t)(b * 8 + blk) * 2 + wr) * 8 + gi) * 64;
#pragma unroll
            for (int bj = 0; bj < 2; ++bj)
#pragma unroll
                for (int n = 0; n < 2; ++n) { f32x4 s = ks[bj][n];
#pragma unroll
                    for (int j = 0; j < 4; ++j) { float t = s[j]; t += __shfl_xor(t, 1); t += __shfl_xor(t, 2); t += __shfl_xor(t, 4); t += __shfl_xor(t, 8); s[j] = t; }
                    if (fr == 0) *(f32x4*)(km + 32 * bj + 8 * fq + 4 * n) = s; }
        }
    }
};

struct EpiOutProj {
    unsigned char* ws; const float* x;
    __device__ __forceinline__ void operator()(const f32x4 (&acc)[2][2][4][2], const pg8::Unit& u, int wr, int wc, int fr, int fq) const {
        bf16_t* X1B = (bf16_t*)(ws + WS_X1B); float* SS = (float*)(ws + WS_SS);
#pragma unroll
        for (int ai = 0; ai < 2; ++ai) {
            f32x4 xv[4][2][2];
#pragma unroll
            for (int m = 0; m < 4; ++m)
#pragma unroll
                for (int bj = 0; bj < 2; ++bj) { const size_t off = ((size_t)u.pm * 256 + 128 * ai + 64 * wr + 16 * m + fr) * DM + u.pn * 256 + 128 * bj + 32 * wc + 8 * fq;
                    xv[m][bj][0] = ldg4(x + off); xv[m][bj][1] = ldg4(x + off + 4); }
#pragma unroll
            for (int m = 0; m < 4; ++m) {
                const size_t row = (size_t)u.pm * 256 + 128 * ai + 64 * wr + 16 * m + fr; float ss = 0.f;
#pragma unroll
                for (int bj = 0; bj < 2; ++bj) {
                    const size_t off = row * DM + u.pn * 256 + 128 * bj + 32 * wc + 8 * fq;
                    const f32x4 a = acc[ai][bj][m][0] + xv[m][bj][0], c = acc[ai][bj][m][1] + xv[m][bj][1];
                    ss += (a[0] * a[0] + a[1] * a[1]) + (a[2] * a[2] + a[3] * a[3]) + (c[0] * c[0] + c[1] * c[1]) + (c[2] * c[2] + c[3] * c[3]);
                    v4u w; w.x = pg8::cvt_pk_bf16(a[0], a[1]); w.y = pg8::cvt_pk_bf16(a[2], a[3]); w.z = pg8::cvt_pk_bf16(c[0], c[1]); w.w = pg8::cvt_pk_bf16(c[2], c[3]);
                    *(v4u*)(X1B + off) = w;
                }
                ss += __shfl_xor(ss, 16); ss += __shfl_xor(ss, 32);
                if (fq == 0) SS[row * SS_PARTS + u.pn * 4 + wc] = ss;
            }
        }
    }
};

constexpr int ROUTE_OFF = LDSCTL_OFF + 2048;
struct EpiRoute {
    unsigned char* ws; LAS unsigned char* lds;
    __device__ __forceinline__ void operator()(const f32x4 (&acc)[2][2][4][2], const pg8::Unit& u, int wr, int wc, int fr, int fq) const {
        const float* SS = (const float*)(ws + WS_SS);
        LAS int* lcount = (LAS int*)(lds + ROUTE_OFF); LAS int* lbase = lcount + 64; LAS int* pcount = lcount + 128; LAS int* pbase = pcount + NPAIR;
        unsigned* CTL = (unsigned*)(ws + WS_CTL); int* LTOK = (int*)(ws + WS_LTOK); float* LW = (float*)(ws + WS_LW); float* LR = (float*)(ws + WS_LR); int* LP = (int*)(ws + WS_LP); int* PTOK = (int*)(ws + WS_PTOK);
        if (threadIdx.x < 64) lcount[threadIdx.x] = 0; else if (threadIdx.x < 64 + NPAIR) pcount[threadIdx.x - 64] = 0;
        asm volatile("s_waitcnt lgkmcnt(0)" ::: "memory"); __builtin_amdgcn_s_barrier(); asm volatile("" ::: "memory");
        int l0v[2][4], p0v[2][4], l1v[2][4], p1v[2][4], prv[2][4], ppv[2][4]; float w0v[2][4], w1v[2][4], r2v[2][4];
#pragma unroll
        for (int ai = 0; ai < 2; ++ai)
#pragma unroll
            for (int m = 0; m < 4; ++m) {
                const int row = u.pm * 256 + 128 * ai + 64 * wr + 16 * m + fr;
                const f32x4 e0 = acc[ai][0][m][0], e1 = acc[ai][0][m][1];
                float gl[4];
#pragma unroll
                for (int j = 0; j < 4; ++j) gl[j] = __shfl_down(e0[j], 16);
                int g = 0; float gv = gl[0];
#pragma unroll
                for (int i = 1; i < 4; ++i) if (gl[i] > gv) { gv = gl[i]; g = i; }
                l0v[ai][m] = -1; p0v[ai][m] = 0; l1v[ai][m] = 0; p1v[ai][m] = 0; prv[ai][m] = 0; ppv[ai][m] = 0; w0v[ai][m] = 0.f; w1v[ai][m] = 0.f; r2v[ai][m] = 0.f;
                if (fq == 0 && g == wc) {
                    const float* sp = SS + (size_t)row * SS_PARTS; const f32x4 s0 = ldg4(sp), s1 = ldg4(sp + 4), s2 = ldg4(sp + 8), s3 = ldg4(sp + 12);
                    const float tot = ((s0[0] + s0[1]) + (s0[2] + s0[3])) + ((s1[0] + s1[1]) + (s1[2] + s1[3])) + ((s2[0] + s2[1]) + (s2[2] + s2[3])) + ((s3[0] + s3[1]) + (s3[2] + s3[3]));
                    const float r2 = rsqrtf(tot * (1.f / DM) + RMS_EPS);
                    const float el[8] = {e0[0], e0[1], e0[2], e0[3], e1[0], e1[1], e1[2], e1[3]};
                    const float mx = fmaxf(fmaxf(gl[0], gl[1]), fmaxf(gl[2], gl[3])) * r2;
                    const float den = (__expf(gl[0] * r2 - mx) + __expf(gl[1] * r2 - mx)) + (__expf(gl[2] * r2 - mx) + __expf(gl[3] * r2 - mx));
                    const float pg = __expf(gv * r2 - mx) / den;
                    float v0 = el[0]; int x0 = 0;
#pragma unroll
                    for (int i = 1; i < 8; ++i) if (el[i] > v0) { v0 = el[i]; x0 = i; }
                    float v1 = -3.0e38f; int x1 = 0;
#pragma unroll
                    for (int i = 0; i < 8; ++i) if (i != x0 && el[i] > v1) { v1 = el[i]; x1 = i; }
                    const float w0 = 1.f / (1.f + __expf((v1 - v0) * r2));
                    const int l0 = (g * 8 + x0) * 2, l1 = (g * 8 + x1) * 2 + 1;
                    l0v[ai][m] = l0; l1v[ai][m] = l1; w0v[ai][m] = pg * w0; w1v[ai][m] = pg * (1.f - w0); r2v[ai][m] = r2;
                    p0v[ai][m] = atomicAdd((int*)(lcount + l0), 1); p1v[ai][m] = atomicAdd((int*)(lcount + l1), 1);
                    { const int lo = x0 < x1 ? x0 : x1, hi = x0 < x1 ? x1 : x0, pr = g * 28 + ((lo * (15 - lo)) >> 1) + (hi - lo - 1);
                      prv[ai][m] = pr | ((x0 > x1 ? 1 : 0) << 7); ppv[ai][m] = atomicAdd((int*)(pcount + pr), 1); }
                }
            }
        asm volatile("s_waitcnt lgkmcnt(0)" ::: "memory"); __builtin_amdgcn_s_barrier(); asm volatile("" ::: "memory");
        if (threadIdx.x < 64) lbase[threadIdx.x] = (int)atomicAdd(CTL + CW_CNT + 64 * threadIdx.x, (unsigned)lcount[threadIdx.x]);
        else if (threadIdx.x < 64 + NPAIR) { const int pq = threadIdx.x - 64; pbase[pq] = (int)atomicAdd(CTL + CW_PCNT + 64 * pq, (unsigned)pcount[pq]); }
        asm volatile("s_waitcnt vmcnt(0) lgkmcnt(0)" ::: "memory"); __builtin_amdgcn_s_barrier(); asm volatile("" ::: "memory");
#pragma unroll
        for (int ai = 0; ai < 2; ++ai)
#pragma unroll
            for (int m = 0; m < 4; ++m) if (l0v[ai][m] >= 0) {
                const int row = u.pm * 256 + 128 * ai + 64 * wr + 16 * m + fr;
                const size_t a0 = (size_t)l0v[ai][m] * LIST_CAP + lbase[l0v[ai][m]] + p0v[ai][m], a1 = (size_t)l1v[ai][m] * LIST_CAP + lbase[l1v[ai][m]] + p1v[ai][m];
                LTOK[a0] = row; LW[a0] = w0v[ai][m]; LR[a0] = r2v[ai][m]; LTOK[a1] = row; LW[a1] = w1v[ai][m]; LR[a1] = r2v[ai][m];
                { const int pr = prv[ai][m] & 127, h0 = (prv[ai][m] >> 7) & 1, ps = pbase[pr] + ppv[ai][m];
                  PTOK[(size_t)pr * LIST_CAP + ps] = row; LP[a0] = pr | (h0 << 7) | (ps << 8); LP[a1] = pr | ((h0 ^ 1) << 7) | (ps << 8); }
            }
    }
};

struct EpiGateUp {
    unsigned char* ws; const LAS int* tab;
    __device__ __forceinline__ void operator()(const f32x4 (&acc)[2][2][4][2], const pg8::Unit& u, int wr, int wc, int fr, int fq) const {
#ifdef DEBUG_NOEPI5
        return;
#endif
        const int list = u.a0 & 255, tile = u.a0 >> 8; const size_t eb = (size_t)list * LIST_CAP + tile * 256;
        const float* LR = (const float*)(ws + WS_LR) + eb; const float* LW = (const float*)(ws + WS_LW) + eb; const int* LP = (const int*)(ws + WS_LP) + eb;
        const LAS int* pt = tab + (PAIRTAB_OFF - MOETAB_OFF) / 4;
        bf16_t* HID = (bf16_t*)(ws + WS_HID2);
        float r2v[2][4], wv[2][4]; int lpv[2][4];
#pragma unroll
        for (int ai = 0; ai < 2; ++ai)
#pragma unroll
            for (int m = 0; m < 4; ++m) { const int r = 128 * ai + 64 * wr + 16 * m + fr, rc = r < u.a1 ? r : u.a1 - 1; r2v[ai][m] = LR[rc]; wv[ai][m] = LW[rc]; lpv[ai][m] = LP[rc]; }
#pragma unroll
        for (int ai = 0; ai < 2; ++ai)
#pragma unroll
            for (int m = 0; m < 4; ++m) {
                const int r = 128 * ai + 64 * wr + 16 * m + fr;
                const float r2 = r2v[ai][m], wt = wv[ai][m]; float h[8];
                const int lp = lpv[ai][m]; const size_t drow = (size_t)pt[PT_ALL + (lp & 127)] * 256 + (size_t)(lp >> 8);
#pragma unroll
                for (int n = 0; n < 2; ++n)
#pragma unroll
                    for (int j = 0; j < 4; ++j) { const float G = acc[ai][0][m][n][j] * r2, U = acc[ai][1][m][n][j] * r2;
                        h[4 * n + j] = G * __builtin_amdgcn_rcpf(1.f + __builtin_amdgcn_exp2f(-G * LOG2E)) * U * wt; }
                v4u w; w.x = pg8::cvt_pk_bf16(h[0], h[1]); w.y = pg8::cvt_pk_bf16(h[2], h[3]); w.z = pg8::cvt_pk_bf16(h[4], h[5]); w.w = pg8::cvt_pk_bf16(h[6], h[7]);
#ifdef DEBUG_NOHIDW
                if (r < u.a1 && drow < 95000) *(v4u*)(HID + drow * (2 * EHID) + ((lp >> 7) & 1) * EHID + u.pn * 128 + 32 * wc + 8 * fq) = w;
#else
                if (r < u.a1) *(v4u*)(HID + drow * (2 * EHID) + ((lp >> 7) & 1) * EHID + u.pn * 128 + 32 * wc + 8 * fq) = w;
#endif
            }
    }
};

struct EpiDownPair {
    unsigned char* ws; float* out;
    __device__ __forceinline__ void operator()(const f32x4 (&acc)[2][2][4][2], const pg8::Unit& u, int wr, int wc, int fr, int fq) const {
        const int pr = u.a0 & 255, tile = u.a0 >> 8; const int* PTOK = (const int*)(ws + WS_PTOK) + (size_t)pr * LIST_CAP + tile * 256;
        const bf16_t* SRC = (const bf16_t*)(ws + WS_X1B);
        int tokv[2][4];
#pragma unroll
        for (int ai = 0; ai < 2; ++ai)
#pragma unroll
            for (int m = 0; m < 4; ++m) { const int r = 128 * ai + 64 * wr + 16 * m + fr, rc = r < u.a1 ? r : u.a1 - 1; tokv[ai][m] = PTOK[rc]; }
#pragma unroll
        for (int ai = 0; ai < 2; ++ai) {
            v4u bs[4][2];
#pragma unroll
            for (int m = 0; m < 4; ++m)
#pragma unroll
                for (int bj = 0; bj < 2; ++bj) bs[m][bj] = *(const v4u*)(SRC + (size_t)tokv[ai][m] * DM + u.pn * 256 + 128 * bj + 32 * wc + 8 * fq);
#pragma unroll
            for (int m = 0; m < 4; ++m) {
                const int r = 128 * ai + 64 * wr + 16 * m + fr; const bool ok = r < u.a1;
#pragma unroll
                for (int bj = 0; bj < 2; ++bj) {
                    const size_t off = (size_t)tokv[ai][m] * DM + u.pn * 256 + 128 * bj + 32 * wc + 8 * fq; const v4u b4 = bs[m][bj];
                    f32x4 a, c;
                    a[0] = __uint_as_float(b4.x << 16); a[1] = __uint_as_float(b4.x & 0xffff0000u); a[2] = __uint_as_float(b4.y << 16); a[3] = __uint_as_float(b4.y & 0xffff0000u);
                    c[0] = __uint_as_float(b4.z << 16); c[1] = __uint_as_float(b4.z & 0xffff0000u); c[2] = __uint_as_float(b4.w << 16); c[3] = __uint_as_float(b4.w & 0xffff0000u);
                    a += acc[ai][bj][m][0]; c += acc[ai][bj][m][1];
                    if (ok) { if (DBG_MEASURE) { const float sc_ = 1.0f + ((const float*)(ws + WS_CONST))[CF_DBG]; a *= sc_; c *= sc_; } *(f32x4*)(out + off) = a; *(f32x4*)(out + off + 4) = c; }
                }
            }
        }
    }
};

template <int RK> struct EpiDown {
    unsigned char* ws; float* out;
    __device__ __forceinline__ void operator()(const f32x4 (&acc)[2][2][4][2], const pg8::Unit& u, int wr, int wc, int fr, int fq) const {
        const int list = u.a0 & 255, tile = u.a0 >> 8; const size_t eb = (size_t)list * LIST_CAP + tile * 256;
        const int* LTOK = (const int*)(ws + WS_LTOK) + eb; const float* LW = (const float*)(ws + WS_LW) + eb;
        const bf16_t* SRC = (const bf16_t*)(ws + (RK == 0 ? WS_X1B : WS_PA)); bf16_t* PA = (bf16_t*)(ws + WS_PA);
        int tokv[2][4]; float wv[2][4];
#pragma unroll
        for (int ai = 0; ai < 2; ++ai)
#pragma unroll
            for (int m = 0; m < 4; ++m) { const int r = 128 * ai + 64 * wr + 16 * m + fr, rc = r < u.a1 ? r : u.a1 - 1; tokv[ai][m] = LTOK[rc]; wv[ai][m] = LW[rc]; }
#pragma unroll
        for (int ai = 0; ai < 2; ++ai) {
            v4u bs[4][2];
#pragma unroll
            for (int m = 0; m < 4; ++m)
#pragma unroll
                for (int bj = 0; bj < 2; ++bj) bs[m][bj] = *(const v4u*)(SRC + (size_t)tokv[ai][m] * DM + u.pn * 256 + 128 * bj + 32 * wc + 8 * fq);
#pragma unroll
            for (int m = 0; m < 4; ++m) {
                const int r = 128 * ai + 64 * wr + 16 * m + fr; const bool ok = r < u.a1; const float wt = wv[ai][m];
#pragma unroll
                for (int bj = 0; bj < 2; ++bj) {
                    const size_t off = (size_t)tokv[ai][m] * DM + u.pn * 256 + 128 * bj + 32 * wc + 8 * fq; const v4u b4 = bs[m][bj];
                    f32x4 a, c;
                    a[0] = __uint_as_float(b4.x << 16); a[1] = __uint_as_float(b4.x & 0xffff0000u); a[2] = __uint_as_float(b4.y << 16); a[3] = __uint_as_float(b4.y & 0xffff0000u);
                    c[0] = __uint_as_float(b4.z << 16); c[1] = __uint_as_float(b4.z & 0xffff0000u); c[2] = __uint_as_float(b4.w << 16); c[3] = __uint_as_float(b4.w & 0xffff0000u);
                    a += acc[ai][bj][m][0] * wt; c += acc[ai][bj][m][1] * wt;
                    if (ok) {
                        if (RK == 0) { v4u w; w.x = pg8::cvt_pk_bf16(a[0], a[1]); w.y = pg8::cvt_pk_bf16(a[2], a[3]); w.z = pg8::cvt_pk_bf16(c[0], c[1]); w.w = pg8::cvt_pk_bf16(c[2], c[3]); *(v4u*)(PA + off) = w; }
                        else { if (DBG_MEASURE) { const float sc_ = 1.0f + ((const float*)(ws + WS_CONST))[CF_DBG]; a *= sc_; c *= sc_; } *(f32x4*)(out + off) = a; *(f32x4*)(out + off + 4) = c; }
                    }
                }
            }
        }
    }
};

#define HAVE_ATTN 1
namespace att {
typedef short bf16x8 __attribute__((ext_vector_type(8)));
typedef short s16x4 __attribute__((ext_vector_type(4)));
typedef short v4i16_t __attribute__((ext_vector_type(4)));
typedef float f32x16 __attribute__((ext_vector_type(16)));
constexpr int TBL_STRIDE = 2384;
constexpr int TBL_BYTES = 38912, SLOT_OFF = TBL_BYTES, NSLOT = 3, STAGE_OFF = SLOT_OFF + 65536  , WSCR_OFF = SLOT_OFF + NSLOT * 32768, ATT_LDS = WSCR_OFF + 2048;
static_assert(4 * TBL_STRIDE * 4 <= TBL_BYTES && ATT_LDS <= LDSCTL_OFF, "attention LDS map");
constexpr float NEGBIG = -1.0e30f;
constexpr int KMEAN_OFF = LDSCTL_OFF + 4608;
__device__ __forceinline__ int crow(int r, int hi) { return (r & 3) + 8 * (r >> 2) + 4 * hi; }
__device__ __forceinline__ s16x4 vtr(const LAS unsigned char* p) { return __builtin_bit_cast(s16x4, __builtin_amdgcn_ds_read_tr16_b64_v4i16((LAS v4i16_t*)p)); }
__device__ __forceinline__ void glds16(const void* gsrc, unsigned lds_dst) { unsigned keep;
    asm volatile("s_mov_b32 %0, m0\n\ts_mov_b32 m0, %2\n\ts_nop 0\n\tglobal_load_lds_dwordx4 %1, off\n\ts_mov_b32 m0, %0" : "=&s"(keep) : "v"(gsrc), "s"(lds_dst) : "memory"); }
__device__ __forceinline__ unsigned cvtpk(float lo, float hi) { typedef float f2 __attribute__((ext_vector_type(2))); typedef __bf16 b2 __attribute__((ext_vector_type(2))); f2 v = {lo, hi}; b2 b = __builtin_convertvector(v, b2); return __builtin_bit_cast(unsigned, b); }

__device__ __forceinline__ void build_table(LAS unsigned char* lds, const float* CF, int h12) {
    LAS float* tb = (LAS float*)lds; const float* BT = CF + CF_BT + h12 * 2048; const float off = CF[CF_OFF + h12];
    for (int idx = threadIdx.x; idx < 4 * TBL_STRIDE; idx += 512) { const int s = idx / TBL_STRIDE, i = idx - s * TBL_STRIDE, j = i + s; tb[idx] = j <= 2047 ? BT[2047 - j] - off : NEGBIG; }
}

template <int NK> __device__ __forceinline__ void epilogue(LAS unsigned char* lds, unsigned char* ws, const Inputs& in, int b, int h, int w, int map, int rb, int qw0, int lane_in, float lsum, att::f32x16 (&o)[NK == 2 ? 4 : 2]) {
    constexpr int ND = NK == 2 ? 4 : 2;
    int lane = lane_in; asm volatile("" : "+v"(lane));
    const int r32 = lane & 31, hi = lane >> 5;
    const float* CF = (const float*)(ws + WS_CONST);
    LAS float* wsf = (LAS float*)(lds + WSCR_OFF) + w * 64;
    if (hi == 0) wsf[r32] = lsum;
    asm volatile("s_waitcnt lgkmcnt(0)" ::: "memory");
    float rli[16];
#pragma unroll
    for (int r = 0; r < 16; ++r) rli[r] = __builtin_amdgcn_rcpf(wsf[crow(r, hi)]);
    bf16_t* Y = (bf16_t*)(ws + WS_Y);
    if (NK == 1) {
        LAS bf16_t* stg = (LAS bf16_t*)(lds + STAGE_OFF) + w * 2048;
#pragma unroll
        for (int r = 0; r < 16; ++r) { const int orow = crow(r, hi);
#pragma unroll
            for (int d0 = 0; d0 < ND; ++d0) stg[orow * 64 + d0 * 32 + r32] = (bf16_t)f2bf(o[d0][r] * rli[r]); }
        asm volatile("s_waitcnt lgkmcnt(0)" ::: "memory");
        bf16_t* Yw = Y + (size_t)(b * SEQ + qw0) * DM + 512 + h * 64;
#pragma unroll
        for (int i = 0; i < 4; ++i) { const int row = i * 8 + (lane >> 3), ch = lane & 7; const v4u v = *(const LAS v4u*)(stg + row * 64 + ch * 8); *(v4u*)(Yw + (size_t)row * DM + ch * 8) = v; }
    } else {
        LAS float* X = (LAS float*)(lds + SLOT_OFF) + (size_t)rb * 32 * 128;
        const float lam = CF[CF_LAMBDA];
        if (map == 1) {
#pragma unroll
            for (int r = 0; r < 16; ++r) { const int orow = crow(r, hi); const float f = rli[r] * lam;
#pragma unroll
                for (int d0 = 0; d0 < ND; ++d0) X[orow * 128 + d0 * 32 + r32] = o[d0][r] * f; }
        }
        asm volatile("s_waitcnt lgkmcnt(0)" ::: "memory"); __syncthreads();
        if (map == 0) {
            float gsub[ND];
#pragma unroll
            for (int d0 = 0; d0 < ND; ++d0) gsub[d0] = in.diff_sub_g[d0 * 32 + r32];
            LAS bf16_t* stg = (LAS bf16_t*)(lds + STAGE_OFF) + rb * 4096;
#pragma unroll
            for (int r = 0; r < 16; ++r) { const int orow = crow(r, hi); float v[ND]; float ss = 0.f;
#pragma unroll
                for (int d0 = 0; d0 < ND; ++d0) { v[d0] = o[d0][r] * rli[r] - X[orow * 128 + d0 * 32 + r32]; ss += v[d0] * v[d0]; }
                ss += __shfl_xor(ss, 1); ss += __shfl_xor(ss, 2); ss += __shfl_xor(ss, 4); ss += __shfl_xor(ss, 8); ss += __shfl_xor(ss, 16);
                const float sc2 = rsqrtf(ss * (1.f / 128.f) + RMS_EPS) * (1.f - LAMBDA_INIT);
#pragma unroll
                for (int d0 = 0; d0 < ND; ++d0) stg[orow * 128 + d0 * 32 + r32] = (bf16_t)f2bf(v[d0] * sc2 * gsub[d0]); }
            asm volatile("s_waitcnt lgkmcnt(0)" ::: "memory");
            bf16_t* Yw = Y + (size_t)(b * SEQ + qw0) * DM + h * 128;
#pragma unroll
            for (int i = 0; i < 8; ++i) { const int row = i * 4 + (lane >> 4), ch = lane & 15; const v4u v = *(const LAS v4u*)(stg + row * 128 + ch * 8); *(v4u*)(Yw + (size_t)row * DM + ch * 8) = v; }
        }
    }
    asm volatile("s_waitcnt lgkmcnt(0)" ::: "memory"); __builtin_amdgcn_s_barrier(); asm volatile("" ::: "memory");
}


template <int NK, int ABL> __device__ __forceinline__ void attn_unit(LAS unsigned char* lds, unsigned char* ws, const Inputs& in, int b, int h, int qb, bool stage_km) {
    constexpr int DV = NK == 2 ? 128 : 64, ND = DV / 32, ROWS = NK == 2 ? 128 : 256, SLOTB = NK == 2 ? 32768 : 16384, VOFF = 8192 * NK;
    const int tid = threadIdx.x; int lane_ = tid & 63; asm volatile("" : "+v"(lane_));
    const int lane = lane_, r32 = lane & 31, hi = lane >> 5; const int w = __builtin_amdgcn_readfirstlane(tid >> 6);
    const int map = NK == 2 ? (w >> 2) : 0, rb = NK == 2 ? (w & 3) : w;
    const int q0 = qb * ROWS, qw0 = q0 + 32 * rb, qabs = qw0 + r32, NT = (q0 + ROWS) / 64;
    const float* CF = (const float*)(ws + WS_CONST);
    const bf16_t *Qh, *Kh0, *Kh1, *Vh;
    if (NK == 2) { const size_t hb = (size_t)(b * 4 + h) * 2; Qh = (const bf16_t*)(ws + WS_QD) + (hb + map) * SEQ * 64; Kh0 = (const bf16_t*)(ws + WS_KD) + hb * SEQ * 64; Kh1 = Kh0 + (size_t)SEQ * 64;
                   Vh = (const bf16_t*)(ws + WS_VD) + (size_t)(b * 4 + h) * SEQ * 128; }
    else { const size_t hb = (size_t)(b * 8 + h); Qh = (const bf16_t*)(ws + WS_QM) + hb * SEQ * 64; Kh0 = (const bf16_t*)(ws + WS_KM) + hb * SEQ * 64; Kh1 = Kh0; Vh = (const bf16_t*)(ws + WS_VM) + hb * SEQ * 64; }
    const bf16_t* ksrc0 = Kh0 + (size_t)w * 512 + lane * 8; const bf16_t* ksrc1 = Kh1 + (size_t)w * 512 + lane * 8;
    const bf16_t* vsrc0 = Vh + (size_t)w * 512 + lane * 8;
    const bf16_t* vsrc1 = vsrc0 + 4096;
    constexpr int KSB = 8192 * NK, VSB = 128 * DV, KRING = SLOT_OFF, VRING = SLOT_OFF + 49152;
    const unsigned kdst = (unsigned)(uintptr_t)(lds + KRING) + (unsigned)w * 1024u, vdst = (unsigned)(uintptr_t)(lds + VRING) + (unsigned)w * 1024u;
#define ATT_DMAK(t, off) do { if (ABL & 16) break; const unsigned d_ = (unsigned)__builtin_amdgcn_readfirstlane(kdst + (unsigned)(off)); const size_t o_ = (size_t)(t) * 64 * 64; glds16(ksrc0 + o_, d_); if (NK == 2) glds16(ksrc1 + o_, d_ + 8192u); } while (0)
#define ATT_DMAV(t, off) do { if (ABL & 16) break; const unsigned d_ = (unsigned)__builtin_amdgcn_readfirstlane(vdst + (unsigned)(off)); const size_t o_ = (size_t)(t) * 64 * DV; glds16(vsrc0 + o_, d_); if (NK == 2) glds16(vsrc1 + o_, d_ + 8192u); } while (0)
    if (NK == 1) { ATT_DMAK(0, 0); ATT_DMAV(0, 0); ATT_DMAK(1, KSB); ATT_DMAV(1, VSB); ATT_DMAK(2, 2 * KSB); ATT_DMAV(2, 2 * VSB); ATT_DMAK(3, 3 * KSB); ATT_DMAV(3, 3 * VSB); if (NT > 4) ATT_DMAK(4, 4 * KSB); }
    else { ATT_DMAK(0, 0); ATT_DMAV(0, 0); ATT_DMAK(1, KSB); }
    bf16x8 qr[4];
#pragma unroll
    for (int d0 = 0; d0 < 4; ++d0) qr[d0] = *(const bf16x8*)(Qh + (size_t)qabs * 64 + d0 * 16 + hi * 8);
    if (NK == 1 && stage_km) { const int n = tid >> 6, d = tid & 63;
        if (n < qb) { const float* k0 = (const float*)(ws + WS_KMEAN) + (((size_t)(b * 8 + n) * 2 + 0) * 8 + h) * 64 + d; const float v = k0[0] + k0[512];
            const unsigned hb = f2bf(v); const float lo = v - bf2f((bf16_t)hb);
            ((LAS bf16_t*)(lds + KMEAN_OFF))[n * 64 + d] = (bf16_t)hb; ((LAS bf16_t*)(lds + KMEAN_OFF + 1024))[n * 64 + d] = (bf16_t)f2bf(lo); } }
#pragma unroll
    for (int d0 = 0; d0 < 4; ++d0) asm volatile("" : "+v"(qr[d0]));
    asm volatile("s_waitcnt vmcnt(0)" ::: "memory"); __syncthreads();
    unsigned selmask = 0xffffffffu;
    if (NK == 1 && qb > 0) {
        float gate[8];
        { f32x16 G = {}; const LAS unsigned char* kmh = lds + KMEAN_OFF + (r32 & 7) * 128 + hi * 16;
#pragma unroll
          for (int d0 = 0; d0 < 4; ++d0) { const bf16x8 ah = *(const LAS bf16x8*)(kmh + d0 * 32), al = *(const LAS bf16x8*)(kmh + 1024 + d0 * 32);
              G = __builtin_amdgcn_mfma_f32_32x32x16_bf16(ah, qr[d0], G, 0, 0, 0); G = __builtin_amdgcn_mfma_f32_32x32x16_bf16(al, qr[d0], G, 0, 0, 0); }
#pragma unroll
          for (int r = 0; r < 4; ++r) { const float mine = G[r], oth = __shfl_xor(mine, 32); gate[r] = hi ? oth : mine; gate[4 + r] = hi ? mine : oth; } }
        selmask = 0u;
#pragma unroll
        for (int n = 0; n < 8; ++n) { int better = 0;
#pragma unroll
            for (int m = 0; m < 8; ++m) if (m != n) better += (m < qb && (gate[m] > gate[n] || (gate[m] == gate[n] && m < n))) ? 1 : 0;
            if (n < qb && better < 3) selmask |= 1u << n; }
        selmask |= 1u << qb;
    }
    const int j0 = 2047 - qabs + 4 * hi, sc = j0 & 3;
    const LAS unsigned char* tb_base = lds + (sc * TBL_STRIDE + (j0 - sc)) * 4;
    const LAS unsigned char* tb_neg = lds + (sc * TBL_STRIDE + 2052) * 4;
    const LAS unsigned char* kp0 = lds + KRING + map * 8192 + hi * 1024 + r32 * 16;
    const LAS unsigned char* vp0 = lds + VRING + ((lane >> 4) & 1) * 32 + (lane & 3) * 8 + (4 * hi + ((lane & 15) >> 2)) * 64;
    f32x16 o[ND];
#pragma unroll
    for (int d = 0; d < ND; ++d) o[d] = f32x16{};
    float ls0 = 0.f, ls1 = 0.f;
    const int NTw = (qw0 + 31) / 64 + 1 < NT ? (qw0 + 31) / 64 + 1 : NT;
#define SBAR() __builtin_amdgcn_sched_barrier(0)
#define MFMA32(a, b, c) __builtin_amdgcn_mfma_f32_32x32x16_bf16(a, b, c, 0, 0, 0)
#define MFMA_QK(a, b, c) ((ABL & 8) ? (c) : MFMA32(a, b, c))
#define MFMA_PV(a, b, c) ((ABL & 4) ? (c) : MFMA32(a, b, c))
#define EXP2F(x) ((ABL & 1) ? (x) : __builtin_amdgcn_exp2f(x))
#define CINIT_H(P, half, tt) do { if (ABL & 2) { asm volatile("" : "+v"(P)); break; } const bool sel_ = NK == 2 || ((selmask >> ((tt) >> 2)) & 1u); const LAS unsigned char* tp_ = (sel_ ? tb_base + (tt) * 256 : tb_neg) + (half) * 128; \
        _Pragma("unroll") for (int g = 0; g < 4; ++g) { const f32x4 c0 = *(const LAS f32x4*)(tp_ + g * 32); P[4 * g] = c0[0]; P[4 * g + 1] = c0[1]; P[4 * g + 2] = c0[2]; P[4 * g + 3] = c0[3]; } } while (0)
#define CINIT(P0, P1, tt) do { CINIT_H(P0, 0, tt); CINIT_H(P1, 1, tt); } while (0)
#define KLOAD(kf, koff) do { _Pragma("unroll") for (int i_ = 0; i_ < 8; ++i_) kf[i_] = *(const LAS bf16x8*)(kp0 + (koff) + (i_ >> 1) * 2048 + (i_ & 1) * 512); } while (0)
#define EXP4(PC0, PC1, i) do { if ((i) < 4) { _Pragma("unroll") for (int e_ = 0; e_ < 4; ++e_) PC0[4 * (i) + e_] = EXP2F(PC0[4 * (i) + e_]); asm volatile("" : "+v"(PC0)); } \
        else { _Pragma("unroll") for (int e_ = 0; e_ < 4; ++e_) PC1[4 * ((i) - 4) + e_] = EXP2F(PC1[4 * ((i) - 4) + e_]); asm volatile("" : "+v"(PC1)); } } while (0)
#define STEP_HEAD(t) do { if ((t) + 5 < NT) ATT_DMAK((t) + 5, ko_i); if ((t) + 4 < NT) ATT_DMAV((t) + 4, vo_i); } while (0)
#define STEP_TAIL(t, ODD) do { if (ODD) { const int nfl = ((t) + 4 < NT ? 2 : 0) + ((t) + 3 < NT ? 1 : 0) + ((t) + 5 < NT ? 1 : 0); \
          if (nfl >= 4) asm volatile("s_waitcnt vmcnt(4) lgkmcnt(0)" ::: "memory"); else if (nfl == 3) asm volatile("s_waitcnt vmcnt(3) lgkmcnt(0)" ::: "memory"); \
          else if (nfl == 2) asm volatile("s_waitcnt vmcnt(2) lgkmcnt(0)" ::: "memory"); else if (nfl == 1) asm volatile("s_waitcnt vmcnt(1) lgkmcnt(0)" ::: "memory"); \
          else asm volatile("s_waitcnt vmcnt(0) lgkmcnt(0)" ::: "memory"); \
          __builtin_amdgcn_s_barrier(); asm volatile("" ::: "memory"); } SBAR(); \
        { s6 = s6 == 5 ? 0 : s6 + 1; const int r1 = s6 + 1, i5 = s6 + 5, i4 = s6 + 4; ko_r = (r1 >= 6 ? r1 - 6 : r1) * KSB; ko_i = (i5 >= 6 ? i5 - 6 : i5) * KSB; vo_r = s6 * VSB; vo_i = (i4 >= 6 ? i4 - 6 : i4) * VSB; } } while (0)
#define KLD1(i) ((ABL & 32) ? qr[(i) & 3] : *(const LAS bf16x8*)(kp0 + ko_r + ((i) >> 1) * 2048 + ((i) & 1) * 512))
#define QK_EXP(PC0, PC1, PN0, PN1, t) do { bf16x8 kf[8]; _Pragma("unroll") for (int i = 0; i < 8; ++i) kf[i] = KLD1(i); EXP4(PC0, PC1, 0); SBAR(); \
        _Pragma("unroll") for (int i = 0; i < 8; ++i) { \
            if (i & 1) PN1 = MFMA_QK(kf[i], qr[i >> 1], PN1); else PN0 = MFMA_QK(kf[i], qr[i >> 1], PN0); if (i + 1 < 8) EXP4(PC0, PC1, i + 1); if (i == 5) { VLOAD(0); VLOAD(1); } SBAR(); } } while (0)
#define SUMPACK(PC0, PC1, ks) do { if (ABL & 256) { asm volatile("" : "+v"(pw[(ks) & 1])); break; } _Pragma("unroll") for (int i = 0; i < 4; ++i) { \
            const float a_ = (ks) == 0 ? PC0[2 * i] : (ks) == 1 ? PC0[8 + 2 * i] : (ks) == 2 ? PC1[2 * i] : PC1[8 + 2 * i]; \
            const float b_ = (ks) == 0 ? PC0[2 * i + 1] : (ks) == 1 ? PC0[9 + 2 * i] : (ks) == 2 ? PC1[2 * i + 1] : PC1[9 + 2 * i]; \
            ls0 += a_; ls1 += b_; pw[(ks) & 1][i] = cvtpk(a_, b_); } asm volatile("" : "+v"(ls0), "+v"(ls1), "+v"(pw[(ks) & 1])); } while (0)
#define VLOAD(g) do { if (ABL & 32) { vl[(g) % 3] = s16x4{1, 2, 3, 4}; vh[(g) % 3] = s16x4{1, 2, 3, 4}; asm volatile("" : "+v"(vl[(g) % 3]), "+v"(vh[(g) % 3])); } else if ((g) < 4 * ND) { const int ks_ = (g) / ND, d_ = (g) % ND; vl[(g) % 3] = vtr(vp + d_ * 4096 + ks_ * 1024); vh[(g) % 3] = vtr(vp + d_ * 4096 + ks_ * 1024 + 512); } } while (0)
#define PV_SUM(PC0, PC1, t, CI, PRE) do { v4u pw[2]; \
        if (!(PRE)) { VLOAD(0); VLOAD(1); } SUMPACK(PC0, PC1, 0); SBAR(); __builtin_amdgcn_s_setprio(1); \
        _Pragma("unroll") for (int g = 0; g < 4 * ND; ++g) { const int ks = g / ND, d0 = g % ND; \
            VLOAD(g + 2); \
            { const s16x4 a_ = vl[g % 3], b_ = vh[g % 3]; const bf16x8 vf = {a_[0], a_[1], a_[2], a_[3], b_[0], b_[1], b_[2], b_[3]}; o[d0] = MFMA_PV(__builtin_bit_cast(bf16x8, pw[ks & 1]), vf, o[d0]); } \
            if (d0 == ND - 2 && ks < 3) SUMPACK(PC0, PC1, ks + 1); \
            if (g == 1 && (t) + 5 < NT) ATT_DMAK((t) + 5, ko_i); if (g == 3 && (t) + 4 < NT) ATT_DMAV((t) + 4, vo_i); \
            if (CI && g == 2 * ND + 1 && (t) + 2 < NTw) CINIT(PC0, PC1, (t) + 2); \
            SBAR(); } __builtin_amdgcn_s_setprio(0); } while (0)
#define STEP_FULL(PC0, PC1, PN0, PN1, t, ODD) do { const LAS unsigned char* vp = vp0 + vo_r; s16x4 vl[3], vh[3]; QK_EXP(PC0, PC1, PN0, PN1, t); PV_SUM(PC0, PC1, t, true, true); STEP_TAIL(t, ODD); } while (0)
#define STEP_LAST(PC0, PC1, t, ODD) do { const LAS unsigned char* vp = vp0 + vo_r; s16x4 vl[3], vh[3]; _Pragma("unroll") for (int i = 0; i < 8; ++i) EXP4(PC0, PC1, i); PV_SUM(PC0, PC1, t, false, false); STEP_TAIL(t, ODD); } while (0)
    if constexpr (NK == 1) {
    int s6 = 0, ko_r = KSB, ko_i = 5 * KSB, vo_r = 0, vo_i = 4 * VSB;
    f32x16 pA0, pA1, pB0, pB1;
    if (1 < NTw) CINIT(pB0, pB1, 1);
    { bf16x8 kf[8]; CINIT(pA0, pA1, 0); KLOAD(kf, 0);
#pragma unroll
      for (int i = 0; i < 8; ++i) { if (i & 1) pA1 = MFMA32(kf[i], qr[i >> 1], pA1); else pA0 = MFMA32(kf[i], qr[i >> 1], pA0); } }
    asm volatile("s_waitcnt lgkmcnt(0)" ::: "memory"); __builtin_amdgcn_s_barrier(); asm volatile("" ::: "memory"); SBAR();
    int t = 0;
    for (; t + 2 < NTw; t += 2) {
        unsigned long long t0_ = 0; if (DBG_MEASURE == 2 && blockIdx.x == 0 && w == 0) t0_ = __builtin_amdgcn_s_memtime();
        STEP_FULL(pA0, pA1, pB0, pB1, t, false); STEP_FULL(pB0, pB1, pA0, pA1, t + 1, true);
        if (DBG_MEASURE == 2 && blockIdx.x == 0 && w == 0) { const unsigned long long t1_ = __builtin_amdgcn_s_memtime(); LAS unsigned* dg = (LAS unsigned*)(lds + LDSCTL_OFF + 3072); if (lane == 0) { dg[0] += (unsigned)(t1_ - t0_); dg[1] += 2u; } }
    }
    if (NTw - t == 2) { STEP_FULL(pA0, pA1, pB0, pB1, t, false); STEP_LAST(pB0, pB1, t + 1, true); t += 2; }
    else { STEP_LAST(pA0, pA1, t, false); t += 1; }
    for (; t < NT; ++t) { STEP_HEAD(t); STEP_TAIL(t, (t & 1)); }
    } else {
    int ko_r = 0, ko_n = KSB, ko_i = 2 * KSB, vo_r = 2 * VSB, vo_n = 0, vo_i = VSB;
    f32x16 S0, S1; v4u pwA[4], pwB[4];
#define DHEAD(t) do { if ((t) + 2 < NT) ATT_DMAK((t) + 2, ko_i); if ((t) + 1 < NT) ATT_DMAV((t) + 1, vo_i); } while (0)
#define DTAIL(t) do { if ((t) + 2 < NT) asm volatile("s_waitcnt vmcnt(4) lgkmcnt(0)" ::: "memory"); else asm volatile("s_waitcnt vmcnt(0) lgkmcnt(0)" ::: "memory"); \
        __builtin_amdgcn_s_barrier(); asm volatile("" ::: "memory"); SBAR(); \
        { const int tk_ = ko_r; ko_r = ko_n; ko_n = ko_i; ko_i = tk_; const int tv_ = vo_r; vo_r = vo_n; vo_n = vo_i; vo_i = tv_; } } while (0)
#define DQK(t, PRE) do { bf16x8 kf[4]; _Pragma("unroll") for (int i = 0; i < 4; ++i) kf[i] = KLD1(i); SBAR(); \
        _Pragma("unroll") for (int i = 0; i < 8; ++i) { \
            if (i & 1) S1 = MFMA_QK(kf[i & 3], qr[i >> 1], S1); else S0 = MFMA_QK(kf[i & 3], qr[i >> 1], S0); \
            if (i + 4 < 8) kf[i & 3] = KLD1(i + 4); if ((PRE) && i == 6) VLOAD2(0); \
            if ((PRE) && i == 1 && (t) + 2 < NT) ATT_DMAK((t) + 2, ko_i); if ((PRE) && i == 4 && (t) + 1 < NT) ATT_DMAV((t) + 1, vo_i); SBAR(); } } while (0)
#define DSOFT(PW, g) do { if (ABL & 256) { asm volatile("" : "+v"(PW[(g) >> 2])); break; } float a_ = (g) < 8 ? S0[2 * (g)] : S1[2 * ((g) - 8)], b_ = (g) < 8 ? S0[2 * (g) + 1] : S1[2 * ((g) - 8) + 1]; \
        a_ = EXP2F(a_); b_ = EXP2F(b_); ls0 += a_; ls1 += b_; PW[(g) >> 2][(g) & 3] = cvtpk(a_, b_); asm volatile("" : "+v"(ls0), "+v"(ls1), "+v"(PW[(g) >> 2])); } while (0)
#define VLOAD2(g) do { if (ABL & 32) { vl[(g) & 1] = s16x4{1, 2, 3, 4}; vh[(g) & 1] = s16x4{1, 2, 3, 4}; asm volatile("" : "+v"(vl[(g) & 1]), "+v"(vh[(g) & 1])); } else if ((g) < 16) { const int ks_ = (g) >> 2, d_ = (g) & 3; vl[(g) & 1] = vtr(vp + d_ * 4096 + ks_ * 1024); vh[(g) & 1] = vtr(vp + d_ * 4096 + ks_ * 1024 + 512); } } while (0)
#define DPV(PWP, PWC, SOFT, t, PRE) do { if (!(PRE)) { VLOAD2(0); } SBAR(); \
        _Pragma("unroll") for (int g = 0; g < 16; ++g) { const int ks = g >> 2, d0 = g & 3; VLOAD2(g + 1); \
            { const s16x4 a2_ = vl[g & 1], b2_ = vh[g & 1]; const bf16x8 vf = {a2_[0], a2_[1], a2_[2], a2_[3], b2_[0], b2_[1], b2_[2], b2_[3]}; o[d0] = MFMA_PV(__builtin_bit_cast(bf16x8, PWP[ks]), vf, o[d0]); } \
            if (SOFT) DSOFT(PWC, g); \
            if (!(PRE) && g == 2 && (t) + 2 < NT) ATT_DMAK((t) + 2, ko_i); if (!(PRE) && g == 6 && (t) + 1 < NT) ATT_DMAV((t) + 1, vo_i); \
            if (SOFT && g == 8 && (t) + 1 < NTw) CINIT_H(S0, 0, (t) + 1); \
            SBAR(); } } while (0)
#define DSTEP_MID(PWP, PWC, t) do { const LAS unsigned char* vp = vp0 + vo_r; s16x4 vl[2], vh[2]; DQK(t, true); DPV(PWP, PWC, true, t, true); if ((t) + 1 < NTw) CINIT_H(S1, 1, (t) + 1); DTAIL(t); } while (0)
    { const LAS unsigned char* vp = vp0; s16x4 vl[2], vh[2]; (void)vp; (void)vl; (void)vh; DHEAD(0); CINIT(S0, S1, 0); DQK(0, false);
#pragma unroll
      for (int g = 0; g < 16; ++g) DSOFT(pwA, g);
      if (1 < NTw) CINIT(S0, S1, 1); DTAIL(0); }
    int t = 1;
    for (; t + 1 < NTw; t += 2) {
        unsigned long long t0_ = 0; if (DBG_MEASURE == 3 && blockIdx.x == 0 && w == 0) t0_ = __builtin_amdgcn_s_memtime();
        DSTEP_MID(pwA, pwB, t); DSTEP_MID(pwB, pwA, t + 1);
        if (DBG_MEASURE == 3 && blockIdx.x == 0 && w == 0) { const unsigned long long t1_ = __builtin_amdgcn_s_memtime(); LAS unsigned* dg = (LAS unsigned*)(lds + LDSCTL_OFF + 3072); if (lane == 0) { dg[0] += (unsigned)(t1_ - t0_); dg[1] += 2u; } }
    }
    if (t < NTw) { DSTEP_MID(pwA, pwB, t); ++t; { const LAS unsigned char* vp = vp0 + vo_r; s16x4 vl[2], vh[2]; DPV(pwB, pwA, false, t, false); } DTAIL(t); ++t; }
    else { { const LAS unsigned char* vp = vp0 + vo_r; s16x4 vl[2], vh[2]; DPV(pwA, pwB, false, t, false); } DTAIL(t); ++t; }
    for (; t <= NT; ++t) { DHEAD(t); DTAIL(t); }
#undef DHEAD
#undef DTAIL
#undef DQK
#undef DSOFT
#undef DPV
#undef VLOAD2
#undef DSTEP_MID
    }
    float lsum = ls0 + ls1;
#undef STEP_FULL
#undef STEP_LAST
#undef STEP_HEAD
#undef STEP_TAIL
#undef QK_EXP
#undef KLD1
#undef PV_SUM
#undef SUMPACK
#undef VLOAD
#undef EXP4
#undef KLOAD
#undef CINIT
#undef CINIT_H
#undef MFMA32
#undef MFMA_QK
#undef MFMA_PV
#undef EXP2F
#undef SBAR
#undef ATT_DMAK
#undef ATT_DMAV
    lsum += __shfl_xor(lsum, 32);
    epilogue<NK>(lds, ws, in, b, h, w, map, rb, qw0, lane, lsum, o);
}

template <int ABL> __device__ __forceinline__ void attn_phase(LAS unsigned char* lds, unsigned char* ws, const Inputs& in, int G, int v) {
    const float* CF = (const float*)(ws + WS_CONST);
    if (DBG_MEASURE && blockIdx.x == 0 && threadIdx.x == 0) { LAS unsigned* dg = (LAS unsigned*)(lds + LDSCTL_OFF + 3072); dg[0] = 0u; dg[1] = 0u;
        LAS unsigned long long* dq = (LAS unsigned long long*)(lds + LDSCTL_OFF + 3088); dq[0] = __builtin_amdgcn_s_memtime(); dq[1] = __builtin_amdgcn_s_memrealtime(); }
    for (int vv = v; vv < 256; vv += G) {
        if constexpr ((ABL & 4096) == 0)
        { const int j = vv & 3; build_table(lds, CF, 4 + ((vv >> 2) & 7));
          for (int k = 0; k < 4; ++k) { const int head = (vv >> 2) + 64 * k, b = head >> 3, h = head & 7;
              if constexpr ((ABL & 512) != 0) { const int wv = __builtin_amdgcn_readfirstlane(threadIdx.x >> 6);
                  if (wv < 4) { attn_unit<1, 0>(lds, ws, in, b, h, 7 - j, true); attn_unit<1, 0>(lds, ws, in, b, h, j, false); } else { attn_unit<1, (ABL & 0x1bf)>(lds, ws, in, b, h, 7 - j, true); attn_unit<1, (ABL & 0x1bf)>(lds, ws, in, b, h, j, false); } }
              else if constexpr ((ABL & 2048) != 0) { attn_unit<1, 0>(lds, ws, in, b, h, 7 - j, true); attn_unit<1, 0>(lds, ws, in, b, h, j, false); }
              else { attn_unit<1, ABL>(lds, ws, in, b, h, (ABL & 64) ? 0 : 7 - j, true); attn_unit<1, ABL>(lds, ws, in, b, h, (ABL & 64) ? 0 : j, false); } } }
        __syncthreads();
        if constexpr ((ABL & 1024) == 0)
        { const int j = vv & 7; build_table(lds, CF, (vv >> 3) & 3);
          for (int k = 0; k < 4; ++k) { const int head = (vv >> 3) + 32 * k, b = head >> 2, h = head & 3;
              attn_unit<2, (ABL & 0x1ff)>(lds, ws, in, b, h, (ABL & 64) ? 0 : 15 - j, false); attn_unit<2, (ABL & 0x1ff)>(lds, ws, in, b, h, (ABL & 64) ? 0 : j, false); } }
        __syncthreads();
    }
    if (DBG_MEASURE && blockIdx.x == 0 && threadIdx.x == 0) {
        const unsigned long long c1 = __builtin_amdgcn_s_memtime(), r1 = __builtin_amdgcn_s_memrealtime(); LAS unsigned* dg = (LAS unsigned*)(lds + LDSCTL_OFF + 3072); float eps = 0.f;
        LAS unsigned long long* dq = (LAS unsigned long long*)(lds + LDSCTL_OFF + 3088); const unsigned long long dbg_c0 = dq[0], dbg_r0 = dq[1];
        if (DBG_MEASURE == 1) eps = (float)(c1 - dbg_c0) / (float)(r1 - dbg_r0) * 0.1f / 4.0f;
        if (DBG_MEASURE == 2 || DBG_MEASURE == 3) eps = (float)dg[0] / (float)(dg[1] ? dg[1] : 1u) / 300.0f;
        if (DBG_MEASURE == 4) eps = (float)(r1 - dbg_r0) * 0.01f / 1000.0f;
        eps = floorf(eps * 50.0f + 0.5f) * 0.02f;
        ((float*)(ws + WS_CONST))[CF_DBG] = eps;
    }
}
}
template <int ABL> __device__ __forceinline__ void attn_phase(LAS unsigned char* lds, unsigned char* ws, const Inputs& in, int G, int v) { att::attn_phase<ABL>(lds, ws, in, G, v); }

#define RLX_AGENT __ATOMIC_RELAXED, __HIP_MEMORY_SCOPE_AGENT
#define XB_TMO      128
#define XB_XCNT(j)  (256  + 64 * (j))
#define XB_XSUB(j)  (1280 + 64 * (j))
#define XB_XGEN(j)  (2304 + 64 * (j))
#define XB_TOP      3328
#define XB_TOPGEN   3392
#define XCD_BAR_WORDS 3456
#define XB_SPIN_CAP (1u << 18)
constexpr int CW_BAR = 8192;
__device__ __forceinline__ unsigned xb_ld(unsigned* p)              { return __hip_atomic_load(p, __ATOMIC_RELAXED, __HIP_MEMORY_SCOPE_AGENT); }
__device__ __forceinline__ unsigned xb_add(unsigned* p, unsigned v) { return __hip_atomic_fetch_add(p, v, __ATOMIC_RELAXED, __HIP_MEMORY_SCOPE_AGENT); }
__device__ __forceinline__ unsigned xb_xcc_id() { return (unsigned)__builtin_amdgcn_s_getreg((3 << 11) | 20) & 0xFu; }
#define XB_SPIN(cond, bar) do { unsigned _sp = 0; while (cond) { __builtin_amdgcn_s_sleep(1); \
    if ((++_sp & 255u) == 0u) { if (xb_ld(&(bar)[XB_TMO])) break; if (_sp > XB_SPIN_CAP) { atomicAdd(&(bar)[XB_TMO], 1u); break; } } } } while (0)
struct XcdBarrier { unsigned* bar; unsigned x; volatile LAS unsigned* st; };
__device__ __forceinline__ XcdBarrier xcd_barrier_post(unsigned* bar, volatile LAS unsigned* st) {
    XcdBarrier b; b.bar = bar; b.x = xb_xcc_id(); b.st = st;
    if (threadIdx.x == 0) (void)xb_add(&bar[XB_XCNT(b.x)], 1u);
    return b;
}
__device__ __forceinline__ void xcd_barrier_complete(unsigned* bar, unsigned x, unsigned& nloc, unsigned& nx) {
    const unsigned G = gridDim.x * gridDim.y * gridDim.z;
    unsigned sum, cnt, mine, sp = 0u;
    for (;;) {
        sum = 0u; cnt = 0u; mine = 0u;
#pragma unroll
        for (unsigned j = 0; j < 16; ++j) { const unsigned c = xb_ld(&bar[XB_XCNT(j)]); sum += c; cnt += (c > 0u) ? 1u : 0u; mine = (j == x) ? c : mine; }
        if (sum == G) break;
        __builtin_amdgcn_s_sleep(1);
        if ((++sp & 255u) == 0u) { if (xb_ld(&bar[XB_TMO])) break; if (sp > XB_SPIN_CAP) { atomicAdd(&bar[XB_TMO], 1u); break; } }
    }
    nloc = mine > 0u ? mine : 1u; nx = cnt > 0u ? cnt : 1u;
}
__device__ __forceinline__ void xcd_barrier(const XcdBarrier& b) {
    asm volatile("s_waitcnt vmcnt(0)" ::: "memory");
    __syncthreads();
    if (threadIdx.x == 0) {
        unsigned* bar = b.bar;
        __builtin_amdgcn_s_waitcnt(0);
        unsigned nloc = b.st[0], nx = b.st[1];
        if (nloc == 0u) { xcd_barrier_complete(bar, b.x, nloc, nx); b.st[0] = nloc; b.st[1] = nx; }
        const unsigned old = xb_add(&bar[XB_XSUB(b.x)], 1u);
        const unsigned gen = old / nloc;
        if (old + 1u == (gen + 1u) * nloc) {
            __builtin_amdgcn_fence(__ATOMIC_RELEASE, "agent");
            asm volatile("s_waitcnt vmcnt(0)" ::: "memory");
            const unsigned og = xb_add(&bar[XB_TOP], 1u);
            const unsigned tg = og / nx;
            if (og + 1u == (tg + 1u) * nx) xb_add(&bar[XB_TOPGEN], 1u);
            else XB_SPIN(xb_ld(&bar[XB_TOPGEN]) == tg, bar);
            __builtin_amdgcn_fence(__ATOMIC_ACQUIRE, "agent");
            xb_add(&bar[XB_XGEN(b.x)], 1u);
            asm volatile("s_waitcnt vmcnt(0)" ::: "memory");
        } else {
            XB_SPIN(xb_ld(&bar[XB_XGEN(b.x)]) == gen, bar);
            __builtin_amdgcn_fence(__ATOMIC_ACQUIRE, "agent");
            asm volatile("s_waitcnt vmcnt(0)" ::: "memory");
        }
    }
    __syncthreads();
}

constexpr int N_PHASES = 8;
#ifndef DESYNC_TICKS
#define DESYNC_TICKS 0
#endif
#ifndef DESYNC_MASK
#define DESYNC_MASK 0
#endif
__device__ __forceinline__ void phase_stagger(int vcu, int ph) {
    if (!((DESYNC_MASK >> ph) & 1) || DESYNC_TICKS == 0) return;
    const unsigned long long t0 = __builtin_amdgcn_s_memrealtime(); const unsigned long long want = (unsigned long long)((vcu & 3) * DESYNC_TICKS);
    while (__builtin_amdgcn_s_memrealtime() - t0 < want) __builtin_amdgcn_s_sleep(4);
}
#ifndef PROBE_REP_MASK
#define PROBE_REP_MASK 0
#endif
#ifndef PROBE_REPN
#define PROBE_REPN 2
#endif
#define NREP(k) (((PROBE_REP_MASK >> (k)) & 1) ? PROBE_REPN : 1)
struct Args { Inputs in; float* out; unsigned char* ws; int ph_lo, ph_hi; };

__global__ void __launch_bounds__(512, 2) mega(Args args) {
    extern __shared__ __attribute__((aligned(16))) unsigned char lds_raw[];
    LAS unsigned char* lds = (LAS unsigned char*)lds_raw;
    const int tid = threadIdx.x, lane = tid & 63, wave = __builtin_amdgcn_readfirstlane(tid >> 6);
    const int G = gridDim.x; const int bx = blockIdx.x; const int vcu = (G % 8 == 0) ? (bx % 8) * (G / 8) + bx / 8 : bx;
    unsigned char* ws = args.ws; const Inputs& in = args.in;
    unsigned* ctl = (unsigned*)(ws + WS_CTL);
    volatile LAS unsigned* MISC = (volatile LAS unsigned*)(lds + MISC_OFF);
    LAS int* moetab = (LAS int*)(lds + MOETAB_OFF);
    for (int u = tid; u < (LDS_BYTES - LDSCTL_OFF) / 4; u += 512) ((LAS unsigned*)(lds + LDSCTL_OFF))[u] = 0u;
    __syncthreads();
    const int lo = args.ph_lo, hi = args.ph_hi;
    const bool multi = (hi - lo) > 1;
    XcdBarrier bar; bar.bar = ctl + CW_BAR; bar.x = 0; bar.st = nullptr;
    if (multi) bar = xcd_barrier_post(ctl + CW_BAR, MISC + 8);
#define IN(k) (lo <= (k) && (k) < hi)
#define SEAM(k) do { if (IN(k) && IN((k) + 1)) xcd_barrier(bar); } while (0)

    if (IN(0)) { for (int rep = 0; rep < NREP(0); ++rep) { p0_prologue(in, ws, vcu * 8 + wave, G * 8, lane, (LAS float*)(lds + wave * 16384)); if (rep + 1 < NREP(0)) xcd_barrier(bar); } SEAM(0); }

    if (IN(1)) {
        pg8::DenseOrder S; S.init((const bf16_t*)(ws + WS_XN), (const bf16_t*)(ws + WS_WIN), NTOK, NPROJ, DM, G, bx);
        if (tid < 256) ((LAS float*)(lds + GAINS_OFF))[tid] = ((const float*)(ws + WS_CONST))[CF_GAIN + tid];
        __syncthreads();
        EpiInProj E{ws, (const LAS float*)(lds + GAINS_OFF), !multi}; phase_stagger(vcu, 1);
        for (int rep = 0; rep < NREP(1); ++rep) { pg8::gemm_phase(lds, S, E); if (rep + 1 < NREP(1)) xcd_barrier(bar); } SEAM(1);
    }
    if (IN(2)) {
#ifdef HAVE_ATTN
        for (int rep = 0; rep < NREP(2); ++rep) { attn_phase<0>(lds, ws, in, G, vcu); if (rep + 1 < NREP(2)) xcd_barrier(bar); }
#endif
        SEAM(2);
    }
    if (IN(3)) {
        pg8::DenseOrder S; S.init((const bf16_t*)(ws + WS_Y), (const bf16_t*)(ws + WS_WOUT), NTOK, DM, DM, G, bx);
        EpiOutProj E{ws, in.x}; phase_stagger(vcu, 3);
        for (int rep = 0; rep < NREP(3); ++rep) { pg8::gemm_phase(lds, S, E); if (rep + 1 < NREP(3)) xcd_barrier(bar); } SEAM(3);
    }
    if (IN(4)) {
        pg8::DenseOrder S; S.init((const bf16_t*)(ws + WS_X1B), (const bf16_t*)(ws + WS_WR), NTOK, 256, DM, G, bx);
        EpiRoute E{ws, lds};
        pg8::gemm_phase<EpiRoute, pg8::DenseOrder, true>(lds, S, E); SEAM(4);
    }
#ifndef DEBUG_SKIP5
    if (IN(5)) {
        moe_tables(ws, moetab);
        MoeOrder S{(const bf16_t*)(ws + WS_X1B), (const bf16_t*)(ws + WS_WGU), DM, 0, (const int*)(ws + WS_LTOK), moetab, G, vcu};
        EpiGateUp E{ws, moetab}; phase_stagger(vcu, 5);
        for (int rep = 0; rep < NREP(5); ++rep) { pg8::gemm_phase(lds, S, E); if (rep + 1 < NREP(5)) xcd_barrier(bar); } SEAM(5);
    }
#endif
#ifndef DEBUG_SKIP6
    if (IN(6)) {
        if (!IN(5)) moe_tables(ws, moetab);
        MoeOrder S{(const bf16_t*)(ws + WS_HID2), (const bf16_t*)(ws + WS_WD), 2 * EHID, 3, (const int*)(ws + WS_LTOK), moetab, G, vcu};
        EpiDownPair E{ws, args.out}; phase_stagger(vcu, 6);
        for (int rep = 0; rep < NREP(6); ++rep) { pg8::gemm_phase<EpiDownPair, MoeOrder, false, true>(lds, S, E); if (rep + 1 < NREP(6)) xcd_barrier(bar); }
    }
#endif
#ifdef PROBE_EXTRA_BARRIERS
    if (multi) { for (int k = 0; k < PROBE_EXTRA_BARRIERS; ++k) xcd_barrier(bar); }
#endif
#undef IN
#undef SEAM
}

#ifdef PROBE_ATTN_ABL
__global__ void __launch_bounds__(512, 2) attn_probe(Args args) {
    extern __shared__ __attribute__((aligned(16))) unsigned char lds_raw_p[];
    LAS unsigned char* lds = (LAS unsigned char*)lds_raw_p;
    const int G = gridDim.x; const int bx = blockIdx.x; const int vcu = (G % 8 == 0) ? (bx % 8) * (G / 8) + bx / 8 : bx;
    attn_phase<PROBE_ATTN_ABL>(lds, args.ws, args.in, G, vcu);
}
#endif

#ifdef PROBE_UBENCH2
typedef float ub2_f32x16 __attribute__((ext_vector_type(16))); typedef short ub2_bf16x8 __attribute__((ext_vector_type(8))); typedef short ub2_s16x4 __attribute__((ext_vector_type(4)));
template <int V> __global__ void __launch_bounds__(512, 2) ubench2(float* sink, int iters) {
    __shared__ __attribute__((aligned(16))) unsigned char sm[57344];
    LAS unsigned char* lds = (LAS unsigned char*)sm;
    for (int i = threadIdx.x; i < 57344 / 4; i += 512) ((LAS float*)lds)[i] = -0.001f * (float)(i & 1023);
    __syncthreads();
    const int lane = threadIdx.x & 63, hi = lane >> 5, r32 = lane & 31;
    ub2_f32x16 pa0, pa1, pb0 = {}, pb1 = {}, o0 = {}, o1 = {}; ub2_bf16x8 q = {1, 2, 3, 4, 5, 6, 7, 8};
#pragma unroll
    for (int i = 0; i < 16; ++i) { pa0[i] = -0.001f * (float)(threadIdx.x + i); pa1[i] = -0.002f * (float)(threadIdx.x + i); }
    asm volatile("" : "+v"(q));
    const LAS unsigned char* kp = lds + hi * 1024 + r32 * 16;
    const LAS unsigned char* vp = lds + 8192 + ((lane >> 4) & 1) * 32 + (lane & 3) * 8 + (4 * hi + ((lane & 15) >> 2)) * 64;
    const LAS unsigned char* tp = lds + 16384 + ((lane & 3) * 2384 + ((2047 - lane) & ~3)) * 4 % 36864;
    float ls0 = 0.f, ls1 = 0.f;
#define UB_MFMA(a, b, c) ((V & 128) ? (c) : __builtin_amdgcn_mfma_f32_32x32x16_bf16(a, b, c, 0, 0, 0))
#define UB_VLOAD(g) do { if ((g) < 8) { if (V & 2) { vl[(g) % 3] = __builtin_bit_cast(ub2_s16x4, __builtin_amdgcn_ds_read_tr16_b64_v4i16((LAS ub2_s16x4*)(vp + ((g) & 1) * 4096 + ((g) >> 1) * 1024))); vh[(g) % 3] = __builtin_bit_cast(ub2_s16x4, __builtin_amdgcn_ds_read_tr16_b64_v4i16((LAS ub2_s16x4*)(vp + ((g) & 1) * 4096 + ((g) >> 1) * 1024 + 512))); } else { vl[(g) % 3] = ub2_s16x4{1, 2, 3, 4}; vh[(g) % 3] = ub2_s16x4{4, 3, 2, 1}; asm volatile("" : "+v"(vl[(g) % 3]), "+v"(vh[(g) % 3])); } } } while (0)
#define UB_SUMPACK(PC0, PC1, ks) do { _Pragma("unroll") for (int i = 0; i < 4; ++i) { const float a_ = (ks) == 0 ? PC0[2 * i] : (ks) == 1 ? PC0[8 + 2 * i] : (ks) == 2 ? PC1[2 * i] : PC1[8 + 2 * i]; const float b_ = (ks) == 0 ? PC0[2 * i + 1] : (ks) == 1 ? PC0[9 + 2 * i] : (ks) == 2 ? PC1[2 * i + 1] : PC1[9 + 2 * i]; \
            if (V & 32) { ls0 += a_; ls1 += b_; pw[(ks) & 1][i] = att::cvtpk(a_, b_); } else pw[(ks) & 1][i] = __builtin_bit_cast(unsigned, a_); } asm volatile("" : "+v"(ls0), "+v"(ls1), "+v"(pw[(ks) & 1])); } while (0)
#define UB_R1(PC0, PC1, PN0, PN1) do { \
        ub2_bf16x8 kf[8]; \
        _Pragma("unroll") for (int i = 0; i < 8; ++i) { if (V & 1) kf[i] = *(const LAS ub2_bf16x8*)(kp + (i >> 1) * 2048 + (i & 1) * 512); else kf[i] = q; } \
        __builtin_amdgcn_sched_barrier(0); \
        _Pragma("unroll") for (int i = 0; i < 8; ++i) { \
            if (i & 1) PN1 = UB_MFMA(kf[i], q, PN1); else PN0 = UB_MFMA(kf[i], q, PN0); \
            if (V & 16) { _Pragma("unroll") for (int k = 0; k < 4; ++k) { const int e = 4 * i + k; if (e < 16) PC0[e] = __builtin_amdgcn_exp2f(PC0[e]); else PC1[e - 16] = __builtin_amdgcn_exp2f(PC1[e - 16]); } } \
            if (i < 4) asm volatile("" : "+v"(PC0)); else asm volatile("" : "+v"(PC1)); \
            __builtin_amdgcn_sched_barrier(0); } \
        if (V & 64) { asm volatile("s_waitcnt lgkmcnt(0)" ::: "memory"); __builtin_amdgcn_s_barrier(); __builtin_amdgcn_sched_barrier(0); } } while (0)
#define UB_R2(PC0, PC1, PN0, PN1) do { \
        v4u pw[2]; ub2_s16x4 vl[3], vh[3]; \
        UB_VLOAD(0); UB_VLOAD(1); UB_SUMPACK(PC0, PC1, 0); __builtin_amdgcn_sched_barrier(0); \
        _Pragma("unroll") for (int g = 0; g < 8; ++g) { const int ks = g / 2, d0 = g % 2; \
            UB_VLOAD(g + 2); \
            { const ub2_s16x4 a_ = vl[g % 3], b_ = vh[g % 3]; const ub2_bf16x8 vf = {a_[0], a_[1], a_[2], a_[3], b_[0], b_[1], b_[2], b_[3]}; \
              if (d0) o1 = UB_MFMA(__builtin_bit_cast(ub2_bf16x8, pw[ks & 1]), vf, o1); else o0 = UB_MFMA(__builtin_bit_cast(ub2_bf16x8, pw[ks & 1]), vf, o0); } \
            if (d0 == 0 && ks < 3) UB_SUMPACK(PC0, PC1, ks + 1); \
            if (g == 5) { if (V & 4) { _Pragma("unroll") for (int c = 0; c < 4; ++c) { const f32x4 c0 = *(const LAS f32x4*)(tp + c * 32), c1 = *(const LAS f32x4*)(tp + 128 + c * 32); \
                        PC0[4 * c] = c0[0]; PC0[4 * c + 1] = c0[1]; PC0[4 * c + 2] = c0[2]; PC0[4 * c + 3] = c0[3]; PC1[4 * c] = c1[0]; PC1[4 * c + 1] = c1[1]; PC1[4 * c + 2] = c1[2]; PC1[4 * c + 3] = c1[3]; } } \
                else { asm volatile("" : "+v"(PC0), "+v"(PC1)); } } \
            __builtin_amdgcn_sched_barrier(0); } \
        if (V & 8) { asm volatile("s_waitcnt lgkmcnt(0)" ::: "memory"); __builtin_amdgcn_s_barrier(); __builtin_amdgcn_sched_barrier(0); } } while (0)
#define UB_STEP(PC0, PC1, PN0, PN1) do { UB_R1(PC0, PC1, PN0, PN1); UB_R2(PC0, PC1, PN0, PN1); } while (0)
    if ((V & 256) && (threadIdx.x >> 6) >= 4) { UB_R1(pb0, pb1, pa0, pa1); }
    for (int it = 0; it < iters; it += 2) { UB_STEP(pa0, pa1, pb0, pb1); UB_STEP(pb0, pb1, pa0, pa1); }
    float s = ls0 + ls1;
#pragma unroll
    for (int i = 0; i < 16; ++i) s += o0[i] + o1[i] + pa0[i] + pa1[i] + pb0[i] + pb1[i];
    if (s == 123.456f) sink[threadIdx.x] = s;
#undef UB_VLOAD
#undef UB_SUMPACK
#undef UB_STEP
#undef UB_R1
#undef UB_R2
#undef UB_MFMA
}
#endif

#ifdef PROBE_UBENCH
typedef float ub_f32x16 __attribute__((ext_vector_type(16))); typedef short ub_bf16x8 __attribute__((ext_vector_type(8)));
template <int V> __global__ void __launch_bounds__(512, 2) ubench(float* sink, int iters) {
    ub_f32x16 a0 = {}, a1 = {}; ub_bf16x8 x = {1, 2, 3, 4, 5, 6, 7, 8}, y = {8, 7, 6, 5, 4, 3, 2, 1};
    float e[32];
#pragma unroll
    for (int i = 0; i < 32; ++i) e[i] = -0.001f * (float)(threadIdx.x + i);
    asm volatile("" : "+v"(x), "+v"(y));
    for (int it = 0; it < iters; ++it) {
#pragma unroll
        for (int g = 0; g < 16; ++g) {
            if (V & 1) { if (g & 1) a1 = __builtin_amdgcn_mfma_f32_32x32x16_bf16(x, y, a1, 0, 0, 0); else a0 = __builtin_amdgcn_mfma_f32_32x32x16_bf16(x, y, a0, 0, 0, 0); }
            if (V & 2) {
#pragma unroll
                for (int k = 0; k < 4; ++k) { const int i = (4 * g + k) & 31; e[i] = __builtin_amdgcn_exp2f(e[i]) - 1.0f; } }
            if (V & 4) {
#pragma unroll
                for (int k = 0; k < 2; ++k) { const int i = (2 * g + k) & 31; e[i] = __builtin_amdgcn_exp2f(e[i]) - 1.0f; } }
            __builtin_amdgcn_sched_barrier(0);
        }
    }
    float s = 0.f;
#pragma unroll
    for (int i = 0; i < 32; ++i) s += e[i];
#pragma unroll
    for (int i = 0; i < 16; ++i) s += a0[i] + a1[i];
    if (s == 123.456f) sink[threadIdx.x] = s;
}
#endif

extern "C" void kernel_launch(void* const* d_in, const int* in_sizes, int n_in, void* d_out, int out_size, void* d_ws, size_t ws_size, hipStream_t stream) {
    static int grid = 0;
    if (grid == 0) {
        if (n_in != 20 || in_sizes[0] != NTOK * DM || out_size != NTOK * DM || ws_size < WS_END) { fprintf(stderr, "kernel_launch: unexpected shapes (n_in %d, ws %zu)\n", n_in, ws_size); grid = -1; return; }
        int dev = 0, cus = 0, per_cu = 0;
        if (hipGetDevice(&dev) != hipSuccess || hipDeviceGetAttribute(&cus, hipDeviceAttributeMultiprocessorCount, dev) != hipSuccess) { grid = -1; return; }
        if (hipFuncSetAttribute((const void*)mega, hipFuncAttributeMaxDynamicSharedMemorySize, LDS_BYTES) != hipSuccess) { fprintf(stderr, "kernel_launch: hipFuncSetAttribute failed\n"); grid = -1; return; }
        if (hipOccupancyMaxActiveBlocksPerMultiprocessor(&per_cu, (const void*)mega, 512, LDS_BYTES) != hipSuccess || per_cu < 1) { fprintf(stderr, "kernel_launch: occupancy query says %d blocks per CU\n", per_cu); (void)hipGetLastError(); grid = -1; return; }
        grid = cus;
    }
    if (grid < 0) return;
    Args a{};
    const float** ip = (const float**)&a.in;
    for (int i = 0; i < 20; ++i) ip[i] = (const float*)d_in[i];
    a.out = (float*)d_out; a.ws = (unsigned char*)d_ws; a.ph_lo = 0; a.ph_hi = N_PHASES;
    (void)hipMemsetAsync((unsigned char*)d_ws + WS_CTL, 0, CTL_ZERO_BYTES, stream);
    hipLaunchKernelGGL(mega, dim3(grid), dim3(512), LDS_BYTES, stream, a);
#ifdef PROBE_ATTN_ABL
    { static bool ad = false; if (!ad) { (void)hipFuncSetAttribute((const void*)attn_probe, hipFuncAttributeMaxDynamicSharedMemorySize, LDS_BYTES); ad = true; }
      hipLaunchKernelGGL(attn_probe, dim3(grid), dim3(512), LDS_BYTES, stream, a); }
#endif
#ifdef PROBE_UBENCH2
    hipLaunchKernelGGL(ubench2<PROBE_UBENCH2>, dim3(grid), dim3(512), 0, stream, (float*)((unsigned char*)d_ws + WS_SS), 1000);
#endif
#ifdef PROBE_UBENCH
    hipLaunchKernelGGL(ubench<PROBE_UBENCH>, dim3(grid), dim3(PROBE_UB_THREADS), 0, stream, (float*)((unsigned char*)d_ws + WS_SS), 1000);
#endif
#ifdef PROBE_EXTRA_LO
    for (int k = PROBE_EXTRA_LO; k < PROBE_EXTRA_HI; ++k) { a.ph_lo = k; a.ph_hi = k + 1; hipLaunchKernelGGL(mega, dim3(grid), dim3(512), LDS_BYTES, stream, a); }
#endif
}
```

```cpp
#include <hip/hip_runtime.h>
#include <cstdint>
#include <cstdio>

typedef unsigned short bf16_t;
typedef unsigned v4u __attribute__((ext_vector_type(4)));
typedef unsigned v2u __attribute__((ext_vector_type(2)));
typedef float f32x4 __attribute__((ext_vector_type(4)));
#define LAS __attribute__((address_space(3)))

constexpr int BATCH = 32, SEQ = 2048, DM = 1024, NTOK = BATCH * SEQ;
constexpr int HD = 64, HDIFF = 4, HMOBA = 8, NPROJ = 3072;
constexpr int NEXP = 32, EHID = 256, NLIST = 64;
constexpr int LIST_CAP = NTOK;
constexpr float RMS_EPS = 1e-6f;
constexpr float LOG2E = 1.4426950408889634f;
constexpr float C2 = 0.125f * LOG2E;
constexpr float LAMBDA_INIT = 0.2f;

constexpr size_t MiB = 1u << 20;
constexpr size_t WS_CTL = 0, CTL_ZERO_BYTES = 1 * MiB;
constexpr size_t WS_CONST = 1 * MiB;
constexpr size_t WS_WIN = 2 * MiB, WS_WOUT = 8 * MiB, WS_WR = 10 * MiB, WS_WGU = 12 * MiB, WS_WD = 44 * MiB;
constexpr size_t WS_QD = 64 * MiB, WS_KD = 128 * MiB, WS_VD = 192 * MiB, WS_QM = 256 * MiB, WS_KM = 320 * MiB, WS_VM = 384 * MiB;
constexpr size_t WS_XN = 448 * MiB, WS_Y = 448 * MiB;
constexpr size_t WS_X1B = 576 * MiB, WS_SS = 704 * MiB  , WS_R2 = 708 * MiB, WS_KMEAN = 709 * MiB;
constexpr size_t WS_PA = 64 * MiB, WS_HID = 192 * MiB, WS_LTOK = 272 * MiB, WS_LW = 288 * MiB;
constexpr size_t WS_END = 711 * MiB;
constexpr size_t WS_HID2 = 64 * MiB  , WS_LP = 320 * MiB  , WS_PTOK = 336 * MiB  ;
constexpr int NPAIR = 112;
constexpr int CW_PCNT = 16384;
constexpr int CW_CNT = 1024;
#ifndef DBG_MEASURE
#define DBG_MEASURE 0
#endif
constexpr int CF_DBG = 8;
constexpr int CF_LAMBDA = 0, CF_OFF = 16, CF_GAIN = 64  , CF_BT = 1024;

__device__ __forceinline__ float bf2f(bf16_t v) { return __uint_as_float(((unsigned)v) << 16); }
__device__ __forceinline__ unsigned f2bf(float f) { unsigned u = __float_as_uint(f); return (u + 0x7fffu + ((u >> 16) & 1u)) >> 16; }
__device__ __forceinline__ unsigned pk2(float lo, float hi) { return f2bf(lo) | (f2bf(hi) << 16); }
__device__ __forceinline__ float wave_sum(float v) {
#pragma unroll
    for (int o = 1; o < 64; o <<= 1) v += __shfl_xor(v, o);
    return v;
}
__device__ __forceinline__ float wave_max(float v) {
#pragma unroll
    for (int o = 1; o < 64; o <<= 1) v = fmaxf(v, __shfl_xor(v, o));
    return v;
}
__host__ __device__ __forceinline__ int phys_in(int c) { const int pn = c >> 8, cc = c & 255; return 256 * pn + 128 * ((cc >> 5) & 1) + 32 * (cc >> 6) + (cc & 31); }
__device__ __forceinline__ int t5_bucket(int d) {
    if (d < 16) return d;
    const float nf = (float)d;
    int large = 16 + (int)(logf(nf / 16.0f) / 4.852030263919617f * 16.0f);
    return large < 31 ? large : 31;
}

struct Inputs {
    const float *x, *norm1_g, *w_in, *diff_q_g, *diff_k_g, *lq1, *lk1, *lq2, *lk2, *diff_sub_g, *moba_q_g, *moba_k_g, *rel_bias, *w_out, *norm2_g,
        *router_group, *router_expert, *w_gate, *w_up, *w_down;
};

__device__ __forceinline__ void p0_tr_item(const float* W, int ldw, int k0, int n_src, const float* gk, bf16_t* dst, int drow0, int dpitch, LAS float* scr, int lane) {
    float wv[32];
#pragma unroll
    for (int i = 0; i < 32; ++i) wv[i] = W[(size_t)(k0 + 2 * i + (lane >> 5)) * ldw + n_src + (lane & 31)];
#pragma unroll
    for (int i = 0; i < 32; ++i) { const int kk = 2 * i + (lane >> 5); float v = wv[i]; if (gk) v *= gk[k0 + kk]; scr[kk * 33 + (lane & 31)] = v; }
    asm volatile("s_waitcnt lgkmcnt(0)" ::: "memory");
    const int c = lane & 7;
#pragma unroll
    for (int j = 0; j < 4; ++j) {
        const int n = (lane >> 3) + 8 * j; const LAS float* s = scr + (8 * c) * 33 + n;
        v4u o; o.x = pk2(s[0 * 33], s[1 * 33]); o.y = pk2(s[2 * 33], s[3 * 33]); o.z = pk2(s[4 * 33], s[5 * 33]); o.w = pk2(s[6 * 33], s[7 * 33]);
        *(v4u*)(dst + (size_t)(drow0 + n) * dpitch + k0 + 8 * c) = o;
    }
    asm volatile("s_waitcnt lgkmcnt(0)" ::: "memory");
}

__device__ __forceinline__ void p0_prologue(const Inputs& in, unsigned char* ws, int gw, int NGW, int lane, LAS float* scr) {
    bf16_t* WIN_T = (bf16_t*)(ws + WS_WIN); bf16_t* WOUT_T = (bf16_t*)(ws + WS_WOUT); bf16_t* WR_T = (bf16_t*)(ws + WS_WR);
    bf16_t* WGU_T = (bf16_t*)(ws + WS_WGU); bf16_t* WD_T = (bf16_t*)(ws + WS_WD); bf16_t* XN = (bf16_t*)(ws + WS_XN);
    float* CF = (float*)(ws + WS_CONST);
    constexpr int I_IN = 16 * 96, I_OUT = 16 * 32, I_GU = 32 * 16 * 16, I_D = 32 * 4 * 32, NITEMS = I_IN + I_OUT + I_GU + I_D;
    for (int it = gw; it < NITEMS; it += NGW) {
        int r = it;
        if (r < I_IN) {
            const int kb = r / 96, nb = r % 96, p0 = 32 * nb, pn = p0 >> 8, pp = p0 & 255, bj = pp >> 7, wc = (pp >> 5) & 3;
            p0_tr_item(in.w_in, NPROJ, 64 * kb, 256 * pn + 64 * wc + 32 * bj, in.norm1_g, WIN_T, p0, DM, scr, lane); continue; }
        r -= I_IN;
        if (r < I_OUT) { const int kb = r / 32, nb = r % 32; p0_tr_item(in.w_out, DM, 64 * kb, 32 * nb, nullptr, WOUT_T, 32 * nb, DM, scr, lane); continue; }
        r -= I_OUT;
        if (r < I_GU) {
            const int e = r / 256, rr = r % 256, kb = rr / 16, nb = rr % 16, p0 = 32 * nb, pn = p0 >> 8, bj = (p0 >> 7) & 1, j0 = p0 & 127;
            const float* src = (bj ? in.w_up : in.w_gate) + (size_t)e * DM * EHID;
            p0_tr_item(src, EHID, 64 * kb, 128 * pn + j0, in.norm2_g, WGU_T + (size_t)e * 512 * DM, p0, DM, scr, lane); continue; }
        r -= I_GU;
        { const int e = r / 128, rr = r % 128, kb = rr / 32, nb = rr % 32;
          p0_tr_item(in.w_down + (size_t)e * EHID * DM, DM, 64 * kb, 32 * nb, nullptr, WD_T + (size_t)e * DM * EHID, 32 * nb, EHID, scr, lane); }
    }
    for (int idx = gw * 64 + lane; idx < 256 * DM; idx += NGW * 64) {
        const int p = idx >> 10, k = idx & 1023, g = (p >> 5) & 3, i = p & 31; float v = 0.f;
        if (p < 128) { if (i < 8) v = in.norm2_g[k] * in.router_expert[((size_t)g * DM + k) * 8 + i]; else if (i < 12) v = in.norm2_g[k] * in.router_group[k * 4 + (i - 8)]; }
        WR_T[idx] = (bf16_t)f2bf(v);
    }
    for (int idx = gw * 64 + lane; idx < 12 * 2048; idx += NGW * 64) {
        const int h = idx >> 11, d = idx & 2047; CF[CF_BT + idx] = in.rel_bias[t5_bucket(d) * 12 + h] * LOG2E;
    }
    if (gw == 0) {
        float a = in.lq1[lane] * in.lk1[lane], b = in.lq2[lane] * in.lk2[lane];
        a = wave_sum(a); b = wave_sum(b);
        const float mqd = wave_max(fabsf(in.diff_q_g[lane])), mkd = wave_max(fabsf(in.diff_k_g[lane]));
        const float mqm = wave_max(fabsf(in.moba_q_g[lane])), mkm = wave_max(fabsf(in.moba_k_g[lane]));
        if (lane == 0) CF[CF_LAMBDA] = expf(a) - expf(b) + LAMBDA_INIT;
        CF[CF_GAIN + lane] = in.diff_q_g[lane]; CF[CF_GAIN + 64 + lane] = in.diff_k_g[lane]; CF[CF_GAIN + 128 + lane] = in.moba_q_g[lane]; CF[CF_GAIN + 192 + lane] = in.moba_k_g[lane];
        if (lane < 12) {
            float mb = -1e30f; for (int bk = 0; bk < 32; ++bk) mb = fmaxf(mb, in.rel_bias[bk * 12 + lane]);
            const float qk = lane < 4 ? mqd * mkd : mqm * mkm;
            CF[CF_OFF + lane] = (8.0f * qk + mb) * LOG2E;
        }
    }
    for (int m0 = gw * 4; m0 < NTOK; m0 += NGW * 4) {
        f32x4 v[4][4];
#pragma unroll
        for (int rr = 0; rr < 4; ++rr) { const f32x4* xr = (const f32x4*)(in.x + (size_t)(m0 + rr) * DM) + lane;
#pragma unroll
            for (int j = 0; j < 4; ++j) v[rr][j] = __builtin_nontemporal_load(xr + 64 * j); }
#pragma unroll
        for (int rr = 0; rr < 4; ++rr) { float s = 0.f;
#pragma unroll
            for (int j = 0; j < 4; ++j) s += (v[rr][j].x * v[rr][j].x + v[rr][j].y * v[rr][j].y) + (v[rr][j].z * v[rr][j].z + v[rr][j].w * v[rr][j].w);
            const float r = rsqrtf(wave_sum(s) * (1.f / DM) + RMS_EPS);
            unsigned long long* o8 = (unsigned long long*)(XN + (size_t)(m0 + rr) * DM) + lane;
#pragma unroll
            for (int j = 0; j < 4; ++j) o8[64 * j] = (unsigned long long)pk2(v[rr][j].x * r, v[rr][j].y * r) | ((unsigned long long)pk2(v[rr][j].z * r, v[rr][j].w * r) << 32); }
    }
}

namespace pg8 {
typedef short bf16x8 __attribute__((ext_vector_type(8)));
constexpr int BM = 256, BK = 64, HALF = 128, HTB = HALF * BK * 2, STAGE_BYTES = 8 * HTB, NXCD = 8, WGM = 8;

__host__ __device__ __forceinline__ int lds_byte(int r, int c) { const int st = (r >> 4) * 2 + (c >> 5), rr = r & 15, cc = c & 31, ob = rr * 64 + cc * 2; return st * 1024 + (ob ^ (((ob >> 9) & 1) << 5)); }
__host__ __device__ __forceinline__ void stage_rc(int b, int& R, int& C) { const int st = b / 1024, sb = b % 1024, swz = sb ^ (((sb >> 9) & 1) << 5); R = (st >> 1) * 16 + swz / 64; C = (st & 1) * 32 + (swz % 64) / 2; }
__host__ __device__ __forceinline__ int perm32(int rho) { const int n = rho >> 4, i = rho & 15; return 8 * (i >> 2) + 4 * n + (i & 3); }

struct Unit { int pm, pn, a0, a1; };

struct DenseOrder {
    const bf16_t* A; const bf16_t* Bt; int K; int nM, nN, nwg, G, c;
    __device__ void init(const bf16_t* A_, const bf16_t* Bt_, int M, int N, int K_, int G_, int c_) { A = A_; Bt = Bt_; K = K_; nM = M / BM; nN = N / BM; nwg = nM * nN; G = G_; c = c_; }
    __device__ __forceinline__ bool next(int i, Unit& u) const {
        const long L = (long)i * G + c; if (L >= nwg) return false;
        int wgid = (int)L; { const int q = nwg / NXCD, r = nwg % NXCD, xcd = wgid % NXCD, off = wgid / NXCD; wgid = (xcd < r ? xcd * (q + 1) : r * (q + 1) + (xcd - r) * q) + off; }
        const int nig = WGM * nN, gid = wgid / nig, fm = gid * WGM, gsz = (nM - fm) < WGM ? (nM - fm) : WGM;
        u.pm = fm + ((wgid % nig) % gsz); u.pn = (wgid % nig) / gsz; u.a0 = 0; u.a1 = 256; return true;
    }
    __device__ __forceinline__ const char* abase() const { return (const char*)A; }
    __device__ __forceinline__ unsigned arow(const Unit& u, int r) const { return (unsigned)(u.pm * BM + r) * (unsigned)K * 2u; }
    __device__ __forceinline__ const char* bbase(const Unit& u) const { return (const char*)Bt + (size_t)u.pn * BM * K * 2; }
};

typedef float f32x2 __attribute__((ext_vector_type(2)));
__device__ __forceinline__ unsigned cvt_pk_bf16(float lo, float hi) { unsigned r; asm volatile("v_cvt_pk_bf16_f32 %0, %1, %2" : "=v"(r) : "v"(lo), "v"(hi)); return r; }

template <class Epi, class Sched, bool HALFN = false, bool SPLITB = false>
__device__ __forceinline__ void gemm_phase(LAS unsigned char* lds, const Sched& S, const Epi& E) {
    int tid_ = threadIdx.x; asm volatile("" : "+v"(tid_));
    const int tid = tid_, wid = __builtin_amdgcn_readfirstlane(tid >> 6), lane = tid & 63, wr = wid >> 2, wc = wid & 3, fr = lane & 15, fq = lane >> 4;
    const int K = S.K, nt = K / BK; int LDB = K; if constexpr (SPLITB) LDB = S.ldb();
    int RA[2]; unsigned cA2[2], voffB[2];
#pragma unroll
    for (int i = 0; i < 2; ++i) { int R, C; stage_rc(tid * 16 + i * 8192, R, C); const int Rb = (R & ~31) + perm32(R & 31);
        RA[i] = R; cA2[i] = (unsigned)C * 2u; voffB[i] = (unsigned)(Rb * LDB + C) * 2u; }
    const size_t kstep = (size_t)(BK * 2);
    const size_t hstep = (size_t)HALF * LDB * 2;
    const unsigned ldsw = (unsigned)wid * 1024u;
    const int aoff = lds_byte(wr * 64 + fr, fq * 8), boff = lds_byte(wc * 32 + fr, fq * 8);
#define PG8_SA(b, h) (((b) * 2 + (h)) * HTB)
#define PG8_SB(b, h) ((4 + (b) * 2 + (h)) * HTB)
#define PG8_STAGE(bufoff, gbase, voff) do { _Pragma("unroll") for (int _i = 0; _i < 2; ++_i) \
        __builtin_amdgcn_global_load_lds((const unsigned*)((const char*)(gbase) + (voff)[_i]), (LAS unsigned*)(lds + (bufoff) + ldsw + _i * 8192), 16, 0, 0); } while (0)
#define PG8_LDA(dst, b, h) do { _Pragma("unroll") for (int m = 0; m < 4; ++m) _Pragma("unroll") for (int k = 0; k < 2; ++k) dst[m][k] = *(const LAS bf16x8*)(lds + PG8_SA(b, h) + aoff + m * 2048 + k * 1024); } while (0)
#define PG8_LDB(dst, b, h) do { _Pragma("unroll") for (int n = 0; n < 2; ++n) _Pragma("unroll") for (int k = 0; k < 2; ++k) dst[n][k] = *(const LAS bf16x8*)(lds + PG8_SB(b, h) + boff + n * 2048 + k * 1024); } while (0)
#define PG8_MMA(ai, bj, At, Bt) do { __builtin_amdgcn_s_setprio(1); _Pragma("unroll") for (int m = 0; m < 4; ++m) _Pragma("unroll") for (int n = 0; n < 2; ++n) _Pragma("unroll") for (int k = 0; k < 2; ++k) \
        acc[ai][bj][m][n] = __builtin_amdgcn_mfma_f32_16x16x32_bf16(Bt[n][k], At[m][k], acc[ai][bj][m][n], 0, 0, 0); __builtin_amdgcn_s_setprio(0); } while (0)
#define PG8_WAIT_V(n) asm volatile("s_waitcnt vmcnt(" #n ")" ::: "memory")
#define PG8_WAIT_L(n) asm volatile("s_waitcnt lgkmcnt(" #n ")" ::: "memory")
#define PG8_BAR __builtin_amdgcn_s_barrier()
#define PG8_SCHED __builtin_amdgcn_sched_barrier(0)
    Unit cur, nxt; int ui = 0;
    if (!S.next(0, cur)) return;
    f32x4 acc[2][2][4][2];
#pragma unroll
    for (int a = 0; a < 2; ++a)
#pragma unroll
        for (int b = 0; b < 2; ++b)
#pragma unroll
            for (int m = 0; m < 4; ++m)
#pragma unroll
                for (int n = 0; n < 2; ++n) acc[a][b][m][n] = (f32x4){0.f, 0.f, 0.f, 0.f};
    bf16x8 At[4][2], B0[2][2], B1[2][2];
    const char* const Ab = S.abase();
    unsigned oC[2][2], oN[2][2];
#pragma unroll
    for (int h = 0; h < 2; ++h)
#pragma unroll
        for (int i = 0; i < 2; ++i) { oC[h][i] = S.arow(cur, h * HALF + RA[i]) + cA2[i]; oN[h][i] = oC[h][i]; }
    const char* cB = S.bbase(cur); const char* cBh = cB; if constexpr (SPLITB) cBh = S.bbase2(cur);
    PG8_STAGE(PG8_SB(0, 0), cB, voffB); PG8_STAGE(PG8_SB(0, 1), cB + hstep, voffB); PG8_STAGE(PG8_SA(0, 0), Ab, oC[0]); PG8_STAGE(PG8_SA(0, 1), Ab, oC[1]);
    if (wr == 1) PG8_BAR;
    PG8_WAIT_V(2); PG8_BAR;
    PG8_STAGE(PG8_SB(1, 0), cB + kstep, voffB); PG8_STAGE(PG8_SA(1, 0), Ab + kstep, oC[0]); PG8_STAGE(PG8_SB(1, 1), cB + hstep + kstep, voffB);
    PG8_WAIT_V(6); PG8_BAR;
    for (;;) {
        const bool has_next = S.next(ui + 1, nxt);
        const char* nB = has_next ? S.bbase(nxt) : cB; const char* nBh = nB; if constexpr (SPLITB) { if (has_next) nBh = S.bbase2(nxt); }
        if (has_next) {
#pragma unroll
            for (int h = 0; h < 2; ++h)
#pragma unroll
                for (int i = 0; i < 2; ++i) oN[h][i] = S.arow(nxt, h * HALF + RA[i]) + cA2[i];
        }
        for (int t = 0; t < nt; t += 2) {
            const bool last = (t == nt - 2);
            const char* a1 = Ab + (size_t)(t + 1) * kstep;
            const char* a2 = last ? Ab : Ab + (size_t)(t + 2) * kstep; const char* b2 = last ? nB : ((SPLITB && t + 2 >= (nt >> 1)) ? cBh : cB) + (size_t)(t + 2) * kstep;
            const char* a3 = a2 + kstep; const char* b3 = b2 + kstep;
            unsigned o2[2][2];
#pragma unroll
            for (int h = 0; h < 2; ++h)
#pragma unroll
                for (int i = 0; i < 2; ++i) o2[h][i] = last ? oN[h][i] : oC[h][i];
            PG8_LDB(B0, 0, 0); PG8_LDB(B1, 0, 1); PG8_SCHED; PG8_LDA(At, 0, 0); PG8_STAGE(PG8_SA(1, 1), a1, oC[1]);
            PG8_WAIT_V(8); PG8_WAIT_L(0); PG8_BAR; PG8_MMA(0, 0, At, B0); if (!HALFN) PG8_MMA(0, 1, At, B1); PG8_BAR; PG8_SCHED;
            PG8_LDA(At, 0, 1); PG8_STAGE(PG8_SB(0, 0), b2, voffB); PG8_STAGE(PG8_SB(0, 1), b2 + hstep, voffB); PG8_STAGE(PG8_SA(0, 0), a2, o2[0]);
            PG8_WAIT_V(8); PG8_WAIT_L(0); PG8_BAR; PG8_MMA(1, 0, At, B0); if (!HALFN) PG8_MMA(1, 1, At, B1); PG8_BAR; PG8_SCHED;
            PG8_LDB(B0, 1, 0); PG8_LDB(B1, 1, 1); PG8_SCHED; PG8_LDA(At, 1, 0); PG8_STAGE(PG8_SA(0, 1), a2, o2[1]);
            PG8_WAIT_V(8); PG8_WAIT_L(0); PG8_BAR; PG8_MMA(0, 0, At, B0); if (!HALFN) PG8_MMA(0, 1, At, B1); PG8_BAR; PG8_SCHED;
            PG8_LDA(At, 1, 1); PG8_STAGE(PG8_SB(1, 0), b3, voffB); PG8_STAGE(PG8_SB(1, 1), b3 + hstep, voffB); PG8_STAGE(PG8_SA(1, 0), a3, o2[0]);
            PG8_WAIT_V(8); PG8_WAIT_L(0); PG8_BAR; PG8_MMA(1, 0, At, B0); if (!HALFN) PG8_MMA(1, 1, At, B1); PG8_BAR; PG8_SCHED;
        }
        if (wr == 0) PG8_BAR;
        { int frE = fr, fqE = fq; asm volatile("" : "+v"(frE), "+v"(fqE));
          E(acc, cur, wr, wc, frE, fqE); }
        if (!has_next) break;
#pragma unroll
        for (int a = 0; a < 2; ++a)
#pragma unroll
            for (int b = 0; b < 2; ++b)
#pragma unroll
                for (int m = 0; m < 4; ++m)
#pragma unroll
                    for (int n = 0; n < 2; ++n) acc[a][b][m][n] = (f32x4){0.f, 0.f, 0.f, 0.f};
        cur = nxt; cB = nB; cBh = nBh; ++ui;
#pragma unroll
        for (int h = 0; h < 2; ++h)
#pragma unroll
            for (int i = 0; i < 2; ++i) oC[h][i] = oN[h][i];
        if (wr == 1) PG8_BAR;
    }
    PG8_WAIT_V(0);
    PG8_BAR;
#undef PG8_SA
#undef PG8_SB
#undef PG8_STAGE
#undef PG8_LDA
#undef PG8_LDB
#undef PG8_MMA
#undef PG8_WAIT_V
#undef PG8_WAIT_L
#undef PG8_BAR
#undef PG8_SCHED
}
}

constexpr size_t WS_LR = 304 * MiB;
constexpr int SS_PARTS = 16;
constexpr int RING_BYTES = 131072  , LDSCTL_OFF = 139264  , MISC_OFF = LDSCTL_OFF + 320, MOETAB_OFF = LDSCTL_OFF + 1024;
constexpr int LDS_BYTES = 147456;
constexpr int MT_CNT = 0, MT_ALL = 64, MT_R0 = 64 + 65, MT_R1 = 64 + 65 + 33;
constexpr int PAIRTAB_OFF = LDSCTL_OFF + 6656;
constexpr int PT_CNT = 0, PT_ALL = NPAIR;

__device__ __forceinline__ f32x4 ldg4(const float* p) { return *(const f32x4*)p; }

struct MoeOrder {
    const bf16_t* A; const bf16_t* Bt; int K; int mode; const int* ltok; const LAS int* tab; int G, c;
    __device__ __forceinline__ bool next(int i, pg8::Unit& u) const {
        const int L = i * G + c;
        if (mode == 3) {
            const LAS int* pt = tab + (PAIRTAB_OFF - MOETAB_OFF) / 4;
            const int T = L >> 2; if (T >= pt[PT_ALL + NPAIR]) return false;
            int lo = 0;
#pragma unroll
            for (int s = 64; s >= 1; s >>= 1) if (lo + s < NPAIR && pt[PT_ALL + lo + s] <= T) lo += s;
            const int tile = T - pt[PT_ALL + lo]; u.pm = T; u.pn = L & 3; u.a0 = lo | (tile << 8); const int v = pt[PT_CNT + lo] - tile * 256; u.a1 = v < 256 ? v : 256; return true;
        }
        if (mode == 0) {
            const int T = L >> 1; if (T >= tab[MT_ALL + 64]) return false;
            int lo = 0;
#pragma unroll
            for (int s = 32; s >= 1; s >>= 1) if (tab[MT_ALL + lo + s] <= T) lo += s;
            const int tile = T - tab[MT_ALL + lo]; u.pm = T; u.pn = L & 1; u.a0 = lo | (tile << 8); const int v = tab[MT_CNT + lo] - tile * 256; u.a1 = v < 256 ? v : 256; return true;
        } else {
            const int T = L >> 2; const int tb = mode == 1 ? MT_R0 : MT_R1; if (T >= tab[tb + 32]) return false;
            int lo = 0;
#pragma unroll
            for (int s = 16; s >= 1; s >>= 1) if (tab[tb + lo + s] <= T) lo += s;
            const int list = 2 * lo + (mode - 1), tile = T - tab[tb + lo]; u.pm = tab[MT_ALL + list] + tile; u.pn = L & 3; u.a0 = list | (tile << 8);
            const int v = tab[MT_CNT + list] - tile * 256; u.a1 = v < 256 ? v : 256; return true;
        }
    }
    __device__ __forceinline__ const char* abase() const { return (const char*)A; }
    __device__ __forceinline__ unsigned arow(const pg8::Unit& u, int r) const {
        if (mode == 0) { const int list = u.a0 & 255, tile = u.a0 >> 8; const int tok = r < u.a1 ? ltok[(size_t)list * LIST_CAP + tile * 256 + r] : 0; return (unsigned)tok * (unsigned)(DM * 2); }
        if (mode == 3) return (unsigned)(u.pm * 256 + r) * (unsigned)(2 * EHID * 2);
        return (unsigned)(u.pm * 256 + r) * (unsigned)(EHID * 2);
    }
    __device__ __forceinline__ static void pair_experts(int p, int& elo, int& ehi) { const int g = p / 28; int q = p - g * 28, lo = 0;
#pragma unroll
        for (int k = 0; k < 7; ++k) if (q >= 7 - lo) { q -= 7 - lo; ++lo; }
        elo = g * 8 + lo; ehi = g * 8 + lo + 1 + q; }
    __device__ __forceinline__ int ldb() const { return EHID; }
    __device__ __forceinline__ const char* bbase2(const pg8::Unit& u) const { int elo, ehi; pair_experts(u.a0 & 255, elo, ehi); return (const char*)Bt + ((size_t)ehi * DM + u.pn * 256) * EHID * 2 - (size_t)EHID * 2; }
    __device__ __forceinline__ const char* bbase(const pg8::Unit& u) const {
        if (mode == 3) { int elo, ehi; pair_experts(u.a0 & 255, elo, ehi); return (const char*)Bt + ((size_t)elo * DM + u.pn * 256) * EHID * 2; }
        const int e = (u.a0 & 255) >> 1;
        if (mode == 0) return (const char*)Bt + ((size_t)e * 512 + u.pn * 256) * DM * 2;
        return (const char*)Bt + ((size_t)e * DM + u.pn * 256) * EHID * 2;
    }
};
__device__ __forceinline__ void moe_tables(unsigned char* ws, LAS int* tab) {
    LAS int* pt = tab + (PAIRTAB_OFF - MOETAB_OFF) / 4;
    if (threadIdx.x < 64) tab[MT_CNT + threadIdx.x] = (int)__hip_atomic_load((unsigned*)(ws + WS_CTL) + CW_CNT + 64 * threadIdx.x, __ATOMIC_RELAXED, __HIP_MEMORY_SCOPE_AGENT);
#ifndef DEBUG_NOPT
    else if (threadIdx.x < 64 + NPAIR) pt[PT_CNT + threadIdx.x - 64] = (int)__hip_atomic_load((unsigned*)(ws + WS_CTL) + CW_PCNT + 64 * (threadIdx.x - 64), __ATOMIC_RELAXED, __HIP_MEMORY_SCOPE_AGENT);
#endif
    __syncthreads();
#ifndef DEBUG_NOPT
    if (threadIdx.x == 64) { int a = 0; for (int l = 0; l < NPAIR; ++l) { pt[PT_ALL + l] = a; a += (pt[PT_CNT + l] + 255) >> 8; } pt[PT_ALL + NPAIR] = a; }
#endif
    if (threadIdx.x == 0) { int a = 0, r0 = 0, r1 = 0;
        for (int l = 0; l < 64; ++l) { const int t = (tab[MT_CNT + l] + 255) >> 8; tab[MT_ALL + l] = a; a += t; if (l & 1) { tab[MT_R1 + (l >> 1)] = r1; r1 += t; } else { tab[MT_R0 + (l >> 1)] = r0; r0 += t; } }
        tab[MT_ALL + 64] = a; tab[MT_R0 + 32] = r0; tab[MT_R1 + 32] = r1; }
    __syncthreads();
}

constexpr int GAINS_OFF = LDSCTL_OFF + 4096;
struct EpiInProj {
    unsigned char* ws; const LAS float* gl; bool stub;
    __device__ __forceinline__ void operator()(const f32x4 (&acc)[2][2][4][2], const pg8::Unit& u, int wr, int wc, int fr, int fq) const {
#ifdef PROBE_STUB_EPI
        if (stub) { const float t = acc[0][0][0][0][0] + acc[1][1][3][1][3];
            if (t == 12345.678f) ((float*)(ws + WS_SS))[threadIdx.x] = t; return; }
#endif
        const int seg = u.pn >> 1, gi = ((u.pn & 1) << 2) | wc, b = u.pm >> 3, blk = u.pm & 7;
        const bool nrm = (seg != 2 && seg != 5);
        const LAS float* gp = gl + 64 * (seg == 0 ? 0 : seg == 1 ? 1 : seg == 3 ? 2 : 3);
        const float qs = (seg == 0 || seg == 3) ? C2 : 1.0f;
        f32x4 g[2][2];
#pragma unroll
        for (int bj = 0; bj < 2; ++bj)
#pragma unroll
            for (int n = 0; n < 2; ++n) g[bj][n] = nrm ? *(const LAS f32x4*)(gp + 32 * bj + 8 * fq + 4 * n) * qs : (f32x4){1.f, 1.f, 1.f, 1.f};
        bf16_t* base; size_t rstride;
        if (seg < 2) { base = (bf16_t*)(ws + (seg == 0 ? WS_QD : WS_KD)) + ((size_t)((b * 4 + (gi >> 1)) * 2 + (gi & 1)) * SEQ + blk * 256) * 64; rstride = 64; }
        else if (seg == 2) { base = (bf16_t*)(ws + WS_VD) + ((size_t)(b * 4 + (gi >> 1)) * SEQ + blk * 256) * 128 + (gi & 1) * 64; rstride = 128; }
        else { base = (bf16_t*)(ws + (seg == 3 ? WS_QM : seg == 4 ? WS_KM : WS_VM)) + ((size_t)(b * 8 + gi) * SEQ + blk * 256) * 64; rstride = 64; }
        int cRT = 4096, cBJ = 32, cRK = 64, cFQ = 8; bf16_t* basex = base;
        if (seg == 1 || seg == 4) { cBJ = 2048; cRK = 8; cFQ = 512; }
        else if (seg == 5) { cBJ = 2048; cRK = 32; }
        else if (seg == 2) { cRT = 8192; cBJ = 2048; cRK = 32; basex = base - (gi & 1) * 64 + (gi & 1) * 4096; }
        const int lane_off = fr * cRK + fq * cFQ;
        f32x4 ks[2][2];
#pragma unroll
        for (int bj = 0; bj < 2; ++bj)
#pragma unroll
            for (int n = 0; n < 2; ++n) ks[bj][n] = (f32x4){0.f, 0.f, 0.f, 0.f};
#pragma unroll
        for (int ai = 0; ai < 2; ++ai)
#pragma unroll
            for (int m = 0; m < 4; ++m) {
                const int r = 128 * ai + 64 * wr + 16 * m + fr;
                f32x4 v[2][2]; float ss = 0.f;
#pragma unroll
                for (int bj = 0; bj < 2; ++bj)
#pragma unroll
                    for (int n = 0; n < 2; ++n) { v[bj][n] = acc[ai][bj][m][n]; ss += (v[bj][n][0] * v[bj][n][0] + v[bj][n][1] * v[bj][n][1]) + (v[bj][n][2] * v[bj][n][2] + v[bj][n][3] * v[bj][n][3]); }
                float rs = 1.f;
                if (nrm) { ss += __shfl_xor(ss, 16); ss += __shfl_xor(ss, 32); rs = rsqrtf(ss * (1.f / 64.f) + RMS_EPS); }
#pragma unroll
                for (int bj = 0; bj < 2; ++bj) {
                    const f32x4 a = v[bj][0] * rs * g[bj][0], c = v[bj][1] * rs * g[bj][1];
                    if (seg == 4) { ks[bj][0] += a; ks[bj][1] += c; }
                    v4u w; w.x = pg8::cvt_pk_bf16(a[0], a[1]); w.y = pg8::cvt_pk_bf16(a[2], a[3]); w.z = pg8::cvt_pk_bf16(c[0], c[1]); w.w = pg8::cvt_pk_bf16(c[2], c[3]);
                    *(v4u*)(basex + ((2 * ai + wr) * cRT + 16 * m * cRK + bj * cBJ) + lane_off) = w;
                }
            }
        if (seg == 4) {
            float* km = (float*)(ws + WS_KMEAN) + (((size_t)(b * 8 + blk) * 2 + wr) * 8 + gi) * 64;
#pragma unroll
            for (int bj = 0; bj < 2; ++bj)
#pragma unroll
                for (int n = 0; n < 2; ++n) { f32x4 s = ks[bj][n];
#pragma unroll
                    for (int j = 0; j < 4; ++j) { float t = s[j]; t += __shfl_xor(t, 1); t += __shfl_xor(t, 2); t += __shfl_xor(t, 4); t += __shfl_xor(t, 8); s[j] = t; }
                    if (fr == 0) *(f32x4*)(km + 32 * bj + 8 * fq + 4 * n) = s; }
        }
    }
};

struct EpiOutProj {
    unsigned char* ws; const float* x;
    __device__ __forceinline__ void operator()(const f32x4 (&acc)[2][2][4][2], const pg8::Unit& u, int wr, int wc, int fr, int fq) const {
        bf16_t* X1B = (bf16_t*)(ws + WS_X1B); float* SS = (float*)(ws + WS_SS);
#pragma unroll
        for (int ai = 0; ai < 2; ++ai) {
            f32x4 xv[4][2][2];
#pragma unroll
            for (int m = 0; m < 4; ++m)
#pragma unroll
                for (int bj = 0; bj < 2; ++bj) { const size_t off = ((size_t)u.pm * 256 + 128 * ai + 64 * wr + 16 * m + fr) * DM + u.pn * 256 + 128 * bj + 32 * wc + 8 * fq;
                    xv[m][bj][0] = ldg4(x + off); xv[m][bj][1] = ldg4(x + off + 4); }
#pragma unroll
            for (int m = 0; m < 4; ++m) {
                const size_t row = (size_t)u.pm * 256 + 128 * ai + 64 * wr + 16 * m + fr; float ss = 0.f;
#pragma unroll
                for (int bj = 0; bj < 2; ++bj) {
                    const size_t off = row * DM + u.pn * 256 + 128 * bj + 32 * wc + 8 * fq;
                    const f32x4 a = acc[ai][bj][m][0] + xv[m][bj][0], c = acc[ai][bj][m][1] + xv[m][bj][1];
                    ss += (a[0] * a[0] + a[1] * a[1]) + (a[2] * a[2] + a[3] * a[3]) + (c[0] * c[0] + c[1] * c[1]) + (c[2] * c[2] + c[3] * c[3]);
                    v4u w; w.x = pg8::cvt_pk_bf16(a[0], a[1]); w.y = pg8::cvt_pk_bf16(a[2], a[3]); w.z = pg8::cvt_pk_bf16(c[0], c[1]); w.w = pg8::cvt_pk_bf16(c[2], c[3]);
                    *(v4u*)(X1B + off) = w;
                }
                ss += __shfl_xor(ss, 16); ss += __shfl_xor(ss, 32);
                if (fq == 0) SS[row * SS_PARTS + u.pn * 4 + wc] = ss;
            }
        }
    }
};

constexpr int ROUTE_OFF = LDSCTL_OFF + 2048;
struct EpiRoute {
    unsigned char* ws; LAS unsigned char* lds;
    __device__ __forceinline__ void operator()(const f32x4 (&acc)[2][2][4][2], const pg8::Unit& u, int wr, int wc, int fr, int fq) const {
        const float* SS = (const float*)(ws + WS_SS);
        LAS int* lcount = (LAS int*)(lds + ROUTE_OFF); LAS int* lbase = lcount + 64; LAS int* pcount = lcount + 128; LAS int* pbase = pcount + NPAIR;
        unsigned* CTL = (unsigned*)(ws + WS_CTL); int* LTOK = (int*)(ws + WS_LTOK); float* LW = (float*)(ws + WS_LW); float* LR = (float*)(ws + WS_LR); int* LP = (int*)(ws + WS_LP); int* PTOK = (int*)(ws + WS_PTOK);
        if (threadIdx.x < 64) lcount[threadIdx.x] = 0; else if (threadIdx.x < 64 + NPAIR) pcount[threadIdx.x - 64] = 0;
        asm volatile("s_waitcnt lgkmcnt(0)" ::: "memory"); __builtin_amdgcn_s_barrier(); asm volatile("" ::: "memory");
        int l0v[2][4], p0v[2][4], l1v[2][4], p1v[2][4], prv[2][4], ppv[2][4]; float w0v[2][4], w1v[2][4], r2v[2][4];
#pragma unroll
        for (int ai = 0; ai < 2; ++ai)
#pragma unroll
            for (int m = 0; m < 4; ++m) {
                const int row = u.pm * 256 + 128 * ai + 64 * wr + 16 * m + fr;
                const f32x4 e0 = acc[ai][0][m][0], e1 = acc[ai][0][m][1];
                float gl[4];
#pragma unroll
                for (int j = 0; j < 4; ++j) gl[j] = __shfl_down(e0[j], 16);
                int g = 0; float gv = gl[0];
#pragma unroll
                for (int i = 1; i < 4; ++i) if (gl[i] > gv) { gv = gl[i]; g = i; }
                l0v[ai][m] = -1; p0v[ai][m] = 0; l1v[ai][m] = 0; p1v[ai][m] = 0; prv[ai][m] = 0; ppv[ai][m] = 0; w0v[ai][m] = 0.f; w1v[ai][m] = 0.f; r2v[ai][m] = 0.f;
                if (fq == 0 && g == wc) {
                    const float* sp = SS + (size_t)row * SS_PARTS; const f32x4 s0 = ldg4(sp), s1 = ldg4(sp + 4), s2 = ldg4(sp + 8), s3 = ldg4(sp + 12);
                    const float tot = ((s0[0] + s0[1]) + (s0[2] + s0[3])) + ((s1[0] + s1[1]) + (s1[2] + s1[3])) + ((s2[0] + s2[1]) + (s2[2] + s2[3])) + ((s3[0] + s3[1]) + (s3[2] + s3[3]));
                    const float r2 = rsqrtf(tot * (1.f / DM) + RMS_EPS);
                    const float el[8] = {e0[0], e0[1], e0[2], e0[3], e1[0], e1[1], e1[2], e1[3]};
                    const float mx = fmaxf(fmaxf(gl[0], gl[1]), fmaxf(gl[2], gl[3])) * r2;
                    const float den = (__expf(gl[0] * r2 - mx) + __expf(gl[1] * r2 - mx)) + (__expf(gl[2] * r2 - mx) + __expf(gl[3] * r2 - mx));
                    const float pg = __expf(gv * r2 - mx) / den;
                    float v0 = el[0]; int x0 = 0;
#pragma unroll
                    for (int i = 1; i < 8; ++i) if (el[i] > v0) { v0 = el[i]; x0 = i; }
                    float v1 = -3.0e38f; int x1 = 0;
#pragma unroll
                    for (int i = 0; i < 8; ++i) if (i != x0 && el[i] > v1) { v1 = el[i]; x1 = i; }
                    const float w0 = 1.f / (1.f + __expf((v1 - v0) * r2));
                    const int l0 = (g * 8 + x0) * 2, l1 = (g * 8 + x1) * 2 + 1;
                    l0v[ai][m] = l0; l1v[ai][m] = l1; w0v[ai][m] = pg * w0; w1v[ai][m] = pg * (1.f - w0); r2v[ai][m] = r2;
                    p0v[ai][m] = atomicAdd((int*)(lcount + l0), 1); p1v[ai][m] = atomicAdd((int*)(lcount + l1), 1);
                    { const int lo = x0 < x1 ? x0 : x1, hi = x0 < x1 ? x1 : x0, pr = g * 28 + ((lo * (15 - lo)) >> 1) + (hi - lo - 1);
                      prv[ai][m] = pr | ((x0 > x1 ? 1 : 0) << 7); ppv[ai][m] = atomicAdd((int*)(pcount + pr), 1); }
                }
            }
        asm volatile("s_waitcnt lgkmcnt(0)" ::: "memory"); __builtin_amdgcn_s_barrier(); asm volatile("" ::: "memory");
        if (threadIdx.x < 64) lbase[threadIdx.x] = (int)atomicAdd(CTL + CW_CNT + 64 * threadIdx.x, (unsigned)lcount[threadIdx.x]);
        else if (threadIdx.x < 64 + NPAIR) { const int pq = threadIdx.x - 64; pbase[pq] = (int)atomicAdd(CTL + CW_PCNT + 64 * pq, (unsigned)pcount[pq]); }
        asm volatile("s_waitcnt vmcnt(0) lgkmcnt(0)" ::: "memory"); __builtin_amdgcn_s_barrier(); asm volatile("" ::: "memory");
#pragma unroll
        for (int ai = 0; ai < 2; ++ai)
#pragma unroll
            for (int m = 0; m < 4; ++m) if (l0v[ai][m] >= 0) {
                const int row = u.pm * 256 + 128 * ai + 64 * wr + 16 * m + fr;
                const size_t a0 = (size_t)l0v[ai][m] * LIST_CAP + lbase[l0v[ai][m]] + p0v[ai][m], a1 = (size_t)l1v[ai][m] * LIST_CAP + lbase[l1v[ai][m]] + p1v[ai][m];
                LTOK[a0] = row; LW[a0] = w0v[ai][m]; LR[a0] = r2v[ai][m]; LTOK[a1] = row; LW[a1] = w1v[ai][m]; LR[a1] = r2v[ai][m];
                { const int pr = prv[ai][m] & 127, h0 = (prv[ai][m] >> 7) & 1, ps = pbase[pr] + ppv[ai][m];
                  PTOK[(size_t)pr * LIST_CAP + ps] = row; LP[a0] = pr | (h0 << 7) | (ps << 8); LP[a1] = pr | ((h0 ^ 1) << 7) | (ps << 8); }
            }
    }
};

struct EpiGateUp {
    unsigned char* ws; const LAS int* tab;
    __device__ __forceinline__ void operator()(const f32x4 (&acc)[2][2][4][2], const pg8::Unit& u, int wr, int wc, int fr, int fq) const {
#ifdef DEBUG_NOEPI5
        return;
#endif
        const int list = u.a0 & 255, tile = u.a0 >> 8; const size_t eb = (size_t)list * LIST_CAP + tile * 256;
        const float* LR = (const float*)(ws + WS_LR) + eb; const float* LW = (const float*)(ws + WS_LW) + eb; const int* LP = (const int*)(ws + WS_LP) + eb;
        const LAS int* pt = tab + (PAIRTAB_OFF - MOETAB_OFF) / 4;
        bf16_t* HID = (bf16_t*)(ws + WS_HID2);
        float r2v[2][4], wv[2][4]; int lpv[2][4];
#pragma unroll
        for (int ai = 0; ai < 2; ++ai)
#pragma unroll
            for (int m = 0; m < 4; ++m) { const int r = 128 * ai + 64 * wr + 16 * m + fr, rc = r < u.a1 ? r : u.a1 - 1; r2v[ai][m] = LR[rc]; wv[ai][m] = LW[rc]; lpv[ai][m] = LP[rc]; }
#pragma unroll
        for (int ai = 0; ai < 2; ++ai)
#pragma unroll
            for (int m = 0; m < 4; ++m) {
                const int r = 128 * ai + 64 * wr + 16 * m + fr;
                const float r2 = r2v[ai][m], wt = wv[ai][m]; float h[8];
                const int lp = lpv[ai][m]; const size_t drow = (size_t)pt[PT_ALL + (lp & 127)] * 256 + (size_t)(lp >> 8);
#pragma unroll
                for (int n = 0; n < 2; ++n)
#pragma unroll
                    for (int j = 0; j < 4; ++j) { const float G = acc[ai][0][m][n][j] * r2, U = acc[ai][1][m][n][j] * r2;
                        h[4 * n + j] = G * __builtin_amdgcn_rcpf(1.f + __builtin_amdgcn_exp2f(-G * LOG2E)) * U * wt; }
                v4u w; w.x = pg8::cvt_pk_bf16(h[0], h[1]); w.y = pg8::cvt_pk_bf16(h[2], h[3]); w.z = pg8::cvt_pk_bf16(h[4], h[5]); w.w = pg8::cvt_pk_bf16(h[6], h[7]);
#ifdef DEBUG_NOHIDW
                if (r < u.a1 && drow < 95000) *(v4u*)(HID + drow * (2 * EHID) + ((lp >> 7) & 1) * EHID + u.pn * 128 + 32 * wc + 8 * fq) = w;
#else
                if (r < u.a1) *(v4u*)(HID + drow * (2 * EHID) + ((lp >> 7) & 1) * EHID + u.pn * 128 + 32 * wc + 8 * fq) = w;
#endif
            }
    }
};

struct EpiDownPair {
    unsigned char* ws; float* out;
    __device__ __forceinline__ void operator()(const f32x4 (&acc)[2][2][4][2], const pg8::Unit& u, int wr, int wc, int fr, int fq) const {
        const int pr = u.a0 & 255, tile = u.a0 >> 8; const int* PTOK = (const int*)(ws + WS_PTOK) + (size_t)pr * LIST_CAP + tile * 256;
        const bf16_t* SRC = (const bf16_t*)(ws + WS_X1B);
        int tokv[2][4];
#pragma unroll
        for (int ai = 0; ai < 2; ++ai)
#pragma unroll
            for (int m = 0; m < 4; ++m) { const int r = 128 * ai + 64 * wr + 16 * m + fr, rc = r < u.a1 ? r : u.a1 - 1; tokv[ai][m] = PTOK[rc]; }
#pragma unroll
        for (int ai = 0; ai < 2; ++ai) {
            v4u bs[4][2];
#pragma unroll
            for (int m = 0; m < 4; ++m)
#pragma unroll
                for (int bj = 0; bj < 2; ++bj) bs[m][bj] = *(const v4u*)(SRC + (size_t)tokv[ai][m] * DM + u.pn * 256 + 128 * bj + 32 * wc + 8 * fq);
#pragma unroll
            for (int m = 0; m < 4; ++m) {
                const int r = 128 * ai + 64 * wr + 16 * m + fr; const bool ok = r < u.a1;
#pragma unroll
                for (int bj = 0; bj < 2; ++bj) {
                    const size_t off = (size_t)tokv[ai][m] * DM + u.pn * 256 + 128 * bj + 32 * wc + 8 * fq; const v4u b4 = bs[m][bj];
                    f32x4 a, c;
                    a[0] = __uint_as_float(b4.x << 16); a[1] = __uint_as_float(b4.x & 0xffff0000u); a[2] = __uint_as_float(b4.y << 16); a[3] = __uint_as_float(b4.y & 0xffff0000u);
                    c[0] = __uint_as_float(b4.z << 16); c[1] = __uint_as_float(b4.z & 0xffff0000u); c[2] = __uint_as_float(b4.w << 16); c[3] = __uint_as_float(b4.w & 0xffff0000u);
                    a += acc[ai][bj][m][0]; c += acc[ai][bj][m][1];
                    if (ok) { if (DBG_MEASURE) { const float sc_ = 1.0f + ((const float*)(ws + WS_CONST))[CF_DBG]; a *= sc_; c *= sc_; } *(f32x4*)(out + off) = a; *(f32x4*)(out + off + 4) = c; }
                }
            }
        }
    }
};

template <int RK> struct EpiDown {
    unsigned char* ws; float* out;
    __device__ __forceinline__ void operator()(const f32x4 (&acc)[2][2][4][2], const pg8::Unit& u, int wr, int wc, int fr, int fq) const {
        const int list = u.a0 & 255, tile = u.a0 >> 8; const size_t eb = (size_t)list * LIST_CAP + tile * 256;
        const int* LTOK = (const int*)(ws + WS_LTOK) + eb; const float* LW = (const float*)(ws + WS_LW) + eb;
        const bf16_t* SRC = (const bf16_t*)(ws + (RK == 0 ? WS_X1B : WS_PA)); bf16_t* PA = (bf16_t*)(ws + WS_PA);
        int tokv[2][4]; float wv[2][4];
#pragma unroll
        for (int ai = 0; ai < 2; ++ai)
#pragma unroll
            for (int m = 0; m < 4; ++m) { const int r = 128 * ai + 64 * wr + 16 * m + fr, rc = r < u.a1 ? r : u.a1 - 1; tokv[ai][m] = LTOK[rc]; wv[ai][m] = LW[rc]; }
#pragma unroll
        for (int ai = 0; ai < 2; ++ai) {
            v4u bs[4][2];
#pragma unroll
            for (int m = 0; m < 4; ++m)
#pragma unroll
                for (int bj = 0; bj < 2; ++bj) bs[m][bj] = *(const v4u*)(SRC + (size_t)tokv[ai][m] * DM + u.pn * 256 + 128 * bj + 32 * wc + 8 * fq);
#pragma unroll
            for (int m = 0; m < 4; ++m) {
                const int r = 128 * ai + 64 * wr + 16 * m + fr; const bool ok = r < u.a1; const float wt = wv[ai][m];
#pragma unroll
                for (int bj = 0; bj < 2; ++bj) {
                    const size_t off = (size_t)tokv[ai][m] * DM + u.pn * 256 + 128 * bj + 32 * wc + 8 * fq; const v4u b4 = bs[m][bj];
                    f32x4 a, c;
                    a[0] = __uint_as_float(b4.x << 16); a[1] = __uint_as_float(b4.x & 0xffff0000u); a[2] = __uint_as_float(b4.y << 16); a[3] = __uint_as_float(b4.y & 0xffff0000u);
                    c[0] = __uint_as_float(b4.z << 16); c[1] = __uint_as_float(b4.z & 0xffff0000u); c[2] = __uint_as_float(b4.w << 16); c[3] = __uint_as_float(b4.w & 0xffff0000u);
                    a += acc[ai][bj][m][0] * wt; c += acc[ai][bj][m][1] * wt;
                    if (ok) {
                        if (RK == 0) { v4u w; w.x = pg8::cvt_pk_bf16(a[0], a[1]); w.y = pg8::cvt_pk_bf16(a[2], a[3]); w.z = pg8::cvt_pk_bf16(c[0], c[1]); w.w = pg8::cvt_pk_bf16(c[2], c[3]); *(v4u*)(PA + off) = w; }
                        else { if (DBG_MEASURE) { const float sc_ = 1.0f + ((const float*)(ws + WS_CONST))[CF_DBG]; a *= sc_; c *= sc_; } *(f32x4*)(out + off) = a; *(f32x4*)(out + off + 4) = c; }
                    }
                }
            }
        }
    }
};

#define HAVE_ATTN 1
namespace att {
typedef short bf16x8 __attribute__((ext_vector_type(8)));
typedef short s16x4 __attribute__((ext_vector_type(4)));
typedef short v4i16_t __attribute__((ext_vector_type(4)));
typedef float f32x16 __attribute__((ext_vector_type(16)));
constexpr int TBL_STRIDE = 2384;
constexpr int TBL_BYTES = 38912, SLOT_OFF = TBL_BYTES, NSLOT = 3, STAGE_OFF = SLOT_OFF + 65536  , WSCR_OFF = SLOT_OFF + NSLOT * 32768, ATT_LDS = WSCR_OFF + 2048;
static_assert(4 * TBL_STRIDE * 4 <= TBL_BYTES && ATT_LDS <= LDSCTL_OFF, "attention LDS map");
constexpr float NEGBIG = -1.0e30f;
constexpr int KMEAN_OFF = LDSCTL_OFF + 4608;
__device__ __forceinline__ int crow(int r, int hi) { return (r & 3) + 8 * (r >> 2) + 4 * hi; }
__device__ __forceinline__ s16x4 vtr(const LAS unsigned char* p) { return __builtin_bit_cast(s16x4, __builtin_amdgcn_ds_read_tr16_b64_v4i16((LAS v4i16_t*)p)); }
__device__ __forceinline__ void glds16(const void* gsrc, unsigned lds_dst) { unsigned keep;
    asm volatile("s_mov_b32 %0, m0\n\ts_mov_b32 m0, %2\n\ts_nop 0\n\tglobal_load_lds_dwordx4 %1, off\n\ts_mov_b32 m0, %0" : "=&s"(keep) : "v"(gsrc), "s"(lds_dst) : "memory"); }
__device__ __forceinline__ void bdma16(__amdgpu_buffer_rsrc_t srd, unsigned voff, unsigned soff, unsigned lds_dst) {
    asm volatile("s_mov_b32 m0, %0\n\ts_nop 0\n\tbuffer_load_dwordx4 %1, %2, %3 offen lds" :: "s"(lds_dst), "v"(voff), "s"(srd), "s"(soff) : "m0", "memory"); }
__device__ __forceinline__ unsigned cvtpk(float lo, float hi) { typedef float f2 __attribute__((ext_vector_type(2))); typedef __bf16 b2 __attribute__((ext_vector_type(2))); f2 v = {lo, hi}; b2 b = __builtin_convertvector(v, b2); return __builtin_bit_cast(unsigned, b); }

__device__ __forceinline__ void build_table(LAS unsigned char* lds, const float* CF, int h12) {
    LAS float* tb = (LAS float*)lds; const float* BT = CF + CF_BT + h12 * 2048; const float off = CF[CF_OFF + h12];
    for (int idx = threadIdx.x; idx < 4 * TBL_STRIDE; idx += 512) { const int s = idx / TBL_STRIDE, i = idx - s * TBL_STRIDE, j = i + s; tb[idx] = j <= 2047 ? BT[2047 - j] - off : NEGBIG; }
}

template <int NK> __device__ __forceinline__ void epilogue(LAS unsigned char* lds, unsigned char* ws, const Inputs& in, int b, int h, int w, int map, int rb, int qw0, int lane_in, float lsum, att::f32x16 (&o)[NK == 2 ? 4 : 2]) {
    constexpr int ND = NK == 2 ? 4 : 2;
    int lane = lane_in; asm volatile("" : "+v"(lane));
    const int r32 = lane & 31, hi = lane >> 5;
    const float* CF = (const float*)(ws + WS_CONST);
    LAS float* wsf = (LAS float*)(lds + WSCR_OFF) + w * 64;
    if (hi == 0) wsf[r32] = lsum;
    asm volatile("s_waitcnt lgkmcnt(0)" ::: "memory");
    float rli[16];
#pragma unroll
    for (int r = 0; r < 16; ++r) rli[r] = __builtin_amdgcn_rcpf(wsf[crow(r, hi)]);
    bf16_t* Y = (bf16_t*)(ws + WS_Y);
    if (NK == 1) {
        LAS bf16_t* stg = (LAS bf16_t*)(lds + STAGE_OFF) + w * 2048;
#pragma unroll
        for (int r = 0; r < 16; ++r) { const int orow = crow(r, hi);
#pragma unroll
            for (int d0 = 0; d0 < ND; ++d0) stg[orow * 64 + d0 * 32 + r32] = (bf16_t)f2bf(o[d0][r] * rli[r]); }
        asm volatile("s_waitcnt lgkmcnt(0)" ::: "memory");
        bf16_t* Yw = Y + (size_t)(b * SEQ + qw0) * DM + 512 + h * 64;
#pragma unroll
        for (int i = 0; i < 4; ++i) { const int row = i * 8 + (lane >> 3), ch = lane & 7; const v4u v = *(const LAS v4u*)(stg + row * 64 + ch * 8); *(v4u*)(Yw + (size_t)row * DM + ch * 8) = v; }
    } else {
        LAS float* X = (LAS float*)(lds + SLOT_OFF) + (size_t)rb * 32 * 128;
        const float lam = CF[CF_LAMBDA];
        if (map == 1) {
#pragma unroll
            for (int r = 0; r < 16; ++r) { const int orow = crow(r, hi); const float f = rli[r] * lam;
#pragma unroll
                for (int d0 = 0; d0 < ND; ++d0) X[orow * 128 + d0 * 32 + r32] = o[d0][r] * f; }
        }
        asm volatile("s_waitcnt lgkmcnt(0)" ::: "memory"); __syncthreads();
        if (map == 0) {
            float gsub[ND];
#pragma unroll
            for (int d0 = 0; d0 < ND; ++d0) gsub[d0] = in.diff_sub_g[d0 * 32 + r32];
            LAS bf16_t* stg = (LAS bf16_t*)(lds + STAGE_OFF) + rb * 4096;
#pragma unroll
            for (int r = 0; r < 16; ++r) { const int orow = crow(r, hi); float v[ND]; float ss = 0.f;
#pragma unroll
                for (int d0 = 0; d0 < ND; ++d0) { v[d0] = o[d0][r] * rli[r] - X[orow * 128 + d0 * 32 + r32]; ss += v[d0] * v[d0]; }
                ss += __shfl_xor(ss, 1); ss += __shfl_xor(ss, 2); ss += __shfl_xor(ss, 4); ss += __shfl_xor(ss, 8); ss += __shfl_xor(ss, 16);
                const float sc2 = rsqrtf(ss * (1.f / 128.f) + RMS_EPS) * (1.f - LAMBDA_INIT);
#pragma unroll
                for (int d0 = 0; d0 < ND; ++d0) stg[orow * 128 + d0 * 32 + r32] = (bf16_t)f2bf(v[d0] * sc2 * gsub[d0]); }
            asm volatile("s_waitcnt lgkmcnt(0)" ::: "memory");
            bf16_t* Yw = Y + (size_t)(b * SEQ + qw0) * DM + h * 128;
#pragma unroll
            for (int i = 0; i < 8; ++i) { const int row = i * 4 + (lane >> 4), ch = lane & 15; const v4u v = *(const LAS v4u*)(stg + row * 128 + ch * 8); *(v4u*)(Yw + (size_t)row * DM + ch * 8) = v; }
        }
    }
    asm volatile("s_waitcnt lgkmcnt(0)" ::: "memory"); __builtin_amdgcn_s_barrier(); asm volatile("" ::: "memory");
}


template <int NK, int ABL> __device__ __forceinline__ void attn_unit(LAS unsigned char* lds, unsigned char* ws, const Inputs& in, int b, int h, int qb, bool stage_km) {
    constexpr int DV = NK == 2 ? 128 : 64, ND = DV / 32, ROWS = NK == 2 ? 128 : 256, SLOTB = NK == 2 ? 32768 : 16384, VOFF = 8192 * NK;
    const int tid = threadIdx.x; int lane_ = tid & 63; asm volatile("" : "+v"(lane_));
    const int lane = lane_, r32 = lane & 31, hi = lane >> 5; const int w = __builtin_amdgcn_readfirstlane(tid >> 6);
    const int map = NK == 2 ? (w >> 2) : 0, rb = NK == 2 ? (w & 3) : w;
    const int q0 = qb * ROWS, qw0 = q0 + 32 * rb, qabs = qw0 + r32, NT = (q0 + ROWS) / 64;
    const float* CF = (const float*)(ws + WS_CONST);
    const bf16_t *Qh, *Kh0, *Kh1, *Vh;
    if (NK == 2) { const size_t hb = (size_t)(b * 4 + h) * 2; Qh = (const bf16_t*)(ws + WS_QD) + (hb + map) * SEQ * 64; Kh0 = (const bf16_t*)(ws + WS_KD) + hb * SEQ * 64; Kh1 = Kh0 + (size_t)SEQ * 64;
                   Vh = (const bf16_t*)(ws + WS_VD) + (size_t)(b * 4 + h) * SEQ * 128; }
    else { const size_t hb = (size_t)(b * 8 + h); Qh = (const bf16_t*)(ws + WS_QM) + hb * SEQ * 64; Kh0 = (const bf16_t*)(ws + WS_KM) + hb * SEQ * 64; Kh1 = Kh0; Vh = (const bf16_t*)(ws + WS_VM) + hb * SEQ * 64; }
    const __amdgpu_buffer_rsrc_t srdK = __builtin_amdgcn_make_buffer_rsrc((void*)Kh0, (short)0, NK * SEQ * 64 * 2, 0x00020000);
    const __amdgpu_buffer_rsrc_t srdV = __builtin_amdgcn_make_buffer_rsrc((void*)Vh, (short)0, SEQ * DV * 2, 0x00020000);
    const unsigned voff = (unsigned)w * 1024u + (unsigned)lane * 16u;
    constexpr int KSB = 8192 * NK, VSB = 128 * DV, KRING = SLOT_OFF, VRING = SLOT_OFF + 49152;
    const unsigned kdst = (unsigned)(uintptr_t)(lds + KRING) + (unsigned)w * 1024u, vdst = (unsigned)(uintptr_t)(lds + VRING) + (unsigned)w * 1024u;
#define ATT_DMAK(t, off) do { if (ABL & 16) break; const unsigned d_ = (unsigned)__builtin_amdgcn_readfirstlane(kdst + (unsigned)(off)); const unsigned o_ = (unsigned)(t) * 8192u; bdma16(srdK, voff, o_, d_); if (NK == 2) bdma16(srdK, voff, o_ + (unsigned)(SEQ * 64 * 2), d_ + 8192u); } while (0)
#define ATT_DMAV(t, off) do { if (ABL & 16) break; const unsigned d_ = (unsigned)__builtin_amdgcn_readfirstlane(vdst + (unsigned)(off)); const unsigned o_ = (unsigned)(t) * (unsigned)(128 * DV); bdma16(srdV, voff, o_, d_); if (NK == 2) bdma16(srdV, voff, o_ + 8192u, d_ + 8192u); } while (0)
    if (NK == 1) { ATT_DMAK(0, 0); ATT_DMAV(0, 0); ATT_DMAK(1, KSB); ATT_DMAV(1, VSB); ATT_DMAK(2, 2 * KSB); ATT_DMAV(2, 2 * VSB); ATT_DMAK(3, 3 * KSB); ATT_DMAV(3, 3 * VSB); if (NT > 4) ATT_DMAK(4, 4 * KSB); }
    else { ATT_DMAK(0, 0); ATT_DMAV(0, 0); ATT_DMAK(1, KSB); }
    bf16x8 qr[4];
#pragma unroll
    for (int d0 = 0; d0 < 4; ++d0) qr[d0] = *(const bf16x8*)(Qh + (size_t)qabs * 64 + d0 * 16 + hi * 8);
    if (NK == 1 && stage_km) { const int n = tid >> 6, d = tid & 63;
        if (n < qb) { const float* k0 = (const float*)(ws + WS_KMEAN) + (((size_t)(b * 8 + n) * 2 + 0) * 8 + h) * 64 + d; const float v = k0[0] + k0[512];
            const unsigned hb = f2bf(v); const float lo = v - bf2f((bf16_t)hb);
            ((LAS bf16_t*)(lds + KMEAN_OFF))[n * 64 + d] = (bf16_t)hb; ((LAS bf16_t*)(lds + KMEAN_OFF + 1024))[n * 64 + d] = (bf16_t)f2bf(lo); } }
#pragma unroll
    for (int d0 = 0; d0 < 4; ++d0) asm volatile("" : "+v"(qr[d0]));
    asm volatile("s_waitcnt vmcnt(0)" ::: "memory"); __syncthreads();
    unsigned selmask = 0xffffffffu;
    if (NK == 1 && qb > 0) {
        float gate[8];
        { f32x16 G = {}; const LAS unsigned char* kmh = lds + KMEAN_OFF + (r32 & 7) * 128 + hi * 16;
#pragma unroll
          for (int d0 = 0; d0 < 4; ++d0) { const bf16x8 ah = *(const LAS bf16x8*)(kmh + d0 * 32), al = *(const LAS bf16x8*)(kmh + 1024 + d0 * 32);
              G = __builtin_amdgcn_mfma_f32_32x32x16_bf16(ah, qr[d0], G, 0, 0, 0); G = __builtin_amdgcn_mfma_f32_32x32x16_bf16(al, qr[d0], G, 0, 0, 0); }
#pragma unroll
          for (int r = 0; r < 4; ++r) { const float mine = G[r], oth = __shfl_xor(mine, 32); gate[r] = hi ? oth : mine; gate[4 + r] = hi ? mine : oth; } }
        selmask = 0u;
#pragma unroll
        for (int n = 0; n < 8; ++n) { int better = 0;
#pragma unroll
            for (int m = 0; m < 8; ++m) if (m != n) better += (m < qb && (gate[m] > gate[n] || (gate[m] == gate[n] && m < n))) ? 1 : 0;
            if (n < qb && better < 3) selmask |= 1u << n; }
        selmask |= 1u << qb;
    }
    const int j0 = 2047 - qabs + 4 * hi, sc = j0 & 3;
    const LAS unsigned char* tb_base = lds + (sc * TBL_STRIDE + (j0 - sc)) * 4;
    const LAS unsigned char* tb_neg = lds + (sc * TBL_STRIDE + 2052) * 4;
    const LAS unsigned char* kp0 = lds + KRING + map * 8192 + hi * 1024 + r32 * 16;
    const LAS unsigned char* vp0 = lds + VRING + ((lane >> 4) & 1) * 32 + (lane & 3) * 8 + (4 * hi + ((lane & 15) >> 2)) * 64;
    f32x16 o[ND];
#pragma unroll
    for (int d = 0; d < ND; ++d) o[d] = f32x16{};
    float ls0 = 0.f, ls1 = 0.f;
    const int NTw = (qw0 + 31) / 64 + 1 < NT ? (qw0 + 31) / 64 + 1 : NT;
#define SBAR() __builtin_amdgcn_sched_barrier(0)
#define MFMA32(a, b, c) __builtin_amdgcn_mfma_f32_32x32x16_bf16(a, b, c, 0, 0, 0)
#define MFMA_QK(a, b, c) ((ABL & 8) ? (c) : MFMA32(a, b, c))
#define MFMA_PV(a, b, c) ((ABL & 4) ? (c) : MFMA32(a, b, c))
#define EXP2F(x) ((ABL & 1) ? (x) : __builtin_amdgcn_exp2f(x))
#define CINIT_H(P, half, tt) do { if (ABL & 2) { asm volatile("" : "+v"(P)); break; } const bool sel_ = NK == 2 || ((selmask >> ((tt) >> 2)) & 1u); const LAS unsigned char* tp_ = (sel_ ? tb_base + (tt) * 256 : tb_neg) + (half) * 128; \
        _Pragma("unroll") for (int g = 0; g < 4; ++g) { const f32x4 c0 = *(const LAS f32x4*)(tp_ + g * 32); P[4 * g] = c0[0]; P[4 * g + 1] = c0[1]; P[4 * g + 2] = c0[2]; P[4 * g + 3] = c0[3]; } } while (0)
#define CINIT(P0, P1, tt) do { CINIT_H(P0, 0, tt); CINIT_H(P1, 1, tt); } while (0)
#define KLOAD(kf, koff) do { _Pragma("unroll") for (int i_ = 0; i_ < 8; ++i_) kf[i_] = *(const LAS bf16x8*)(kp0 + (koff) + (i_ >> 1) * 2048 + (i_ & 1) * 512); } while (0)
#define EXP4(PC0, PC1, i) do { if ((i) < 4) { _Pragma("unroll") for (int e_ = 0; e_ < 4; ++e_) PC0[4 * (i) + e_] = EXP2F(PC0[4 * (i) + e_]); asm volatile("" : "+v"(PC0)); } \
        else { _Pragma("unroll") for (int e_ = 0; e_ < 4; ++e_) PC1[4 * ((i) - 4) + e_] = EXP2F(PC1[4 * ((i) - 4) + e_]); asm volatile("" : "+v"(PC1)); } } while (0)
#define STEP_HEAD(t) do { if ((t) + 5 < NT) ATT_DMAK((t) + 5, ko_i); if ((t) + 4 < NT) ATT_DMAV((t) + 4, vo_i); } while (0)
#define STEP_TAIL(t, ODD) do { if (ODD) { const int nfl = ((t) + 4 < NT ? 2 : 0) + ((t) + 3 < NT ? 1 : 0) + ((t) + 5 < NT ? 1 : 0); \
          if (nfl >= 4) asm volatile("s_waitcnt vmcnt(4) lgkmcnt(0)" ::: "memory"); else if (nfl == 3) asm volatile("s_waitcnt vmcnt(3) lgkmcnt(0)" ::: "memory"); \
          else if (nfl == 2) asm volatile("s_waitcnt vmcnt(2) lgkmcnt(0)" ::: "memory"); else if (nfl == 1) asm volatile("s_waitcnt vmcnt(1) lgkmcnt(0)" ::: "memory"); \
          else asm volatile("s_waitcnt vmcnt(0) lgkmcnt(0)" ::: "memory"); \
          __builtin_amdgcn_s_barrier(); asm volatile("" ::: "memory"); } SBAR(); \
        { s6 = s6 == 5 ? 0 : s6 + 1; const int r1 = s6 + 1, i5 = s6 + 5, i4 = s6 + 4; ko_r = (r1 >= 6 ? r1 - 6 : r1) * KSB; ko_i = (i5 >= 6 ? i5 - 6 : i5) * KSB; vo_r = s6 * VSB; vo_i = (i4 >= 6 ? i4 - 6 : i4) * VSB; } } while (0)
#define KLD1(i) ((ABL & 32) ? qr[(i) & 3] : *(const LAS bf16x8*)(kp0 + ko_r + ((i) >> 1) * 2048 + ((i) & 1) * 512))
#define QK_EXP(PC0, PC1, PN0, PN1, t) do { bf16x8 kf[8]; _Pragma("unroll") for (int i = 0; i < 8; ++i) kf[i] = KLD1(i); EXP4(PC0, PC1, 0); SBAR(); \
        _Pragma("unroll") for (int i = 0; i < 8; ++i) { \
            if (i & 1) PN1 = MFMA_QK(kf[i], qr[i >> 1], PN1); else PN0 = MFMA_QK(kf[i], qr[i >> 1], PN0); if (i + 1 < 8) EXP4(PC0, PC1, i + 1); if (i == 5) { VLOAD(0); VLOAD(1); } SBAR(); } } while (0)
#define SUMPACK(PC0, PC1, ks) do { if (ABL & 256) { asm volatile("" : "+v"(pw[(ks) & 1])); break; } _Pragma("unroll") for (int i = 0; i < 4; ++i) { \
            const float a_ = (ks) == 0 ? PC0[2 * i] : (ks) == 1 ? PC0[8 + 2 * i] : (ks) == 2 ? PC1[2 * i] : PC1[8 + 2 * i]; \
            const float b_ = (ks) == 0 ? PC0[2 * i + 1] : (ks) == 1 ? PC0[9 + 2 * i] : (ks) == 2 ? PC1[2 * i + 1] : PC1[9 + 2 * i]; \
            ls0 += a_; ls1 += b_; pw[(ks) & 1][i] = cvtpk(a_, b_); } asm volatile("" : "+v"(ls0), "+v"(ls1), "+v"(pw[(ks) & 1])); } while (0)
#define VLOAD(g) do { if (ABL & 32) { vl[(g) % 3] = s16x4{1, 2, 3, 4}; vh[(g) % 3] = s16x4{1, 2, 3, 4}; asm volatile("" : "+v"(vl[(g) % 3]), "+v"(vh[(g) % 3])); } else if ((g) < 4 * ND) { const int ks_ = (g) / ND, d_ = (g) % ND; vl[(g) % 3] = vtr(vp + d_ * 4096 + ks_ * 1024); vh[(g) % 3] = vtr(vp + d_ * 4096 + ks_ * 1024 + 512); } } while (0)
#define PV_SUM(PC0, PC1, t, CI, PRE) do { v4u pw[2]; \
        if (!(PRE)) { VLOAD(0); VLOAD(1); } SUMPACK(PC0, PC1, 0); SBAR(); __builtin_amdgcn_s_setprio(1); \
        _Pragma("unroll") for (int g = 0; g < 4 * ND; ++g) { const int ks = g / ND, d0 = g % ND; \
            VLOAD(g + 2); \
            { const s16x4 a_ = vl[g % 3], b_ = vh[g % 3]; const bf16x8 vf = {a_[0], a_[1], a_[2], a_[3], b_[0], b_[1], b_[2], b_[3]}; o[d0] = MFMA_PV(__builtin_bit_cast(bf16x8, pw[ks & 1]), vf, o[d0]); } \
            if (d0 == ND - 2 && ks < 3) SUMPACK(PC0, PC1, ks + 1); \
            if (g == 1 && (t) + 5 < NT) ATT_DMAK((t) + 5, ko_i); if (g == 3 && (t) + 4 < NT) ATT_DMAV((t) + 4, vo_i); \
            if (CI && g == 2 * ND + 1 && (t) + 2 < NTw) CINIT(PC0, PC1, (t) + 2); \
            SBAR(); } __builtin_amdgcn_s_setprio(0); } while (0)
#define STEP_FULL(PC0, PC1, PN0, PN1, t, ODD) do { const LAS unsigned char* vp = vp0 + vo_r; s16x4 vl[3], vh[3]; QK_EXP(PC0, PC1, PN0, PN1, t); PV_SUM(PC0, PC1, t, true, true); STEP_TAIL(t, ODD); } while (0)
#define STEP_LAST(PC0, PC1, t, ODD) do { const LAS unsigned char* vp = vp0 + vo_r; s16x4 vl[3], vh[3]; _Pragma("unroll") for (int i = 0; i < 8; ++i) EXP4(PC0, PC1, i); PV_SUM(PC0, PC1, t, false, false); STEP_TAIL(t, ODD); } while (0)
    if constexpr (NK == 1) {
    int s6 = 0, ko_r = KSB, ko_i = 5 * KSB, vo_r = 0, vo_i = 4 * VSB;
    f32x16 pA0, pA1, pB0, pB1;
    if (1 < NTw) CINIT(pB0, pB1, 1);
    { bf16x8 kf[8]; CINIT(pA0, pA1, 0); KLOAD(kf, 0);
#pragma unroll
      for (int i = 0; i < 8; ++i) { if (i & 1) pA1 = MFMA32(kf[i], qr[i >> 1], pA1); else pA0 = MFMA32(kf[i], qr[i >> 1], pA0); } }
    asm volatile("s_waitcnt lgkmcnt(0)" ::: "memory"); __builtin_amdgcn_s_barrier(); asm volatile("" ::: "memory"); SBAR();
    int t = 0;
    for (; t + 2 < NTw; t += 2) {
        unsigned long long t0_ = 0; if (DBG_MEASURE == 2 && blockIdx.x == 0 && w == 0) t0_ = __builtin_amdgcn_s_memtime();
        STEP_FULL(pA0, pA1, pB0, pB1, t, false); STEP_FULL(pB0, pB1, pA0, pA1, t + 1, true);
        if (DBG_MEASURE == 2 && blockIdx.x == 0 && w == 0) { const unsigned long long t1_ = __builtin_amdgcn_s_memtime(); LAS unsigned* dg = (LAS unsigned*)(lds + LDSCTL_OFF + 3072); if (lane == 0) { dg[0] += (unsigned)(t1_ - t0_); dg[1] += 2u; } }
    }
    if (NTw - t == 2) { STEP_FULL(pA0, pA1, pB0, pB1, t, false); STEP_LAST(pB0, pB1, t + 1, true); t += 2; }
    else { STEP_LAST(pA0, pA1, t, false); t += 1; }
    for (; t < NT; ++t) { STEP_HEAD(t); STEP_TAIL(t, (t & 1)); }
    } else {
    int ko_r = 0, ko_n = KSB, ko_i = 2 * KSB, vo_r = 2 * VSB, vo_n = 0, vo_i = VSB;
    f32x16 S0, S1; v4u pwA[4], pwB[4];
#define DHEAD(t) do { if ((t) + 2 < NT) ATT_DMAK((t) + 2, ko_i); if ((t) + 1 < NT) ATT_DMAV((t) + 1, vo_i); } while (0)
#define DTAIL(t) do { if ((t) + 2 < NT) asm volatile("s_waitcnt vmcnt(4) lgkmcnt(0)" ::: "memory"); else asm volatile("s_waitcnt vmcnt(0) lgkmcnt(0)" ::: "memory"); \
        __builtin_amdgcn_s_barrier(); asm volatile("" ::: "memory"); SBAR(); \
        { const int tk_ = ko_r; ko_r = ko_n; ko_n = ko_i; ko_i = tk_; const int tv_ = vo_r; vo_r = vo_n; vo_n = vo_i; vo_i = tv_; } } while (0)
#define DQK(t, PRE) do { bf16x8 kf[4]; _Pragma("unroll") for (int i = 0; i < 4; ++i) kf[i] = KLD1(i); SBAR(); \
        _Pragma("unroll") for (int i = 0; i < 8; ++i) { \
            if (i & 1) S1 = MFMA_QK(kf[i & 3], qr[i >> 1], S1); else S0 = MFMA_QK(kf[i & 3], qr[i >> 1], S0); \
            if (i + 4 < 8) kf[i & 3] = KLD1(i + 4); if ((PRE) && i == 6) VLOAD2(0); \
            if ((PRE) && i == 1 && (t) + 2 < NT) ATT_DMAK((t) + 2, ko_i); if ((PRE) && i == 4 && (t) + 1 < NT) ATT_DMAV((t) + 1, vo_i); SBAR(); } } while (0)
#define DSOFT(PW, g) do { if (ABL & 256) { asm volatile("" : "+v"(PW[(g) >> 2])); break; } float a_ = (g) < 8 ? S0[2 * (g)] : S1[2 * ((g) - 8)], b_ = (g) < 8 ? S0[2 * (g) + 1] : S1[2 * ((g) - 8) + 1]; \
        a_ = EXP2F(a_); b_ = EXP2F(b_); ls0 += a_; ls1 += b_; PW[(g) >> 2][(g) & 3] = cvtpk(a_, b_); asm volatile("" : "+v"(ls0), "+v"(ls1), "+v"(PW[(g) >> 2])); } while (0)
#define VLOAD2(g) do { if (ABL & 32) { vl[(g) & 1] = s16x4{1, 2, 3, 4}; vh[(g) & 1] = s16x4{1, 2, 3, 4}; asm volatile("" : "+v"(vl[(g) & 1]), "+v"(vh[(g) & 1])); } else if ((g) < 16) { const int ks_ = (g) >> 2, d_ = (g) & 3; vl[(g) & 1] = vtr(vp + d_ * 4096 + ks_ * 1024); vh[(g) & 1] = vtr(vp + d_ * 4096 + ks_ * 1024 + 512); } } while (0)
#define DPV(PWP, PWC, SOFT, t, PRE) do { if (!(PRE)) { VLOAD2(0); } SBAR(); \
        _Pragma("unroll") for (int g = 0; g < 16; ++g) { const int ks = g >> 2, d0 = g & 3; VLOAD2(g + 1); \
            { const s16x4 a2_ = vl[g & 1], b2_ = vh[g & 1]; const bf16x8 vf = {a2_[0], a2_[1], a2_[2], a2_[3], b2_[0], b2_[1], b2_[2], b2_[3]}; o[d0] = MFMA_PV(__builtin_bit_cast(bf16x8, PWP[ks]), vf, o[d0]); } \
            if (SOFT) DSOFT(PWC, g); \
            if (!(PRE) && g == 2 && (t) + 2 < NT) ATT_DMAK((t) + 2, ko_i); if (!(PRE) && g == 6 && (t) + 1 < NT) ATT_DMAV((t) + 1, vo_i); \
            if (SOFT && g == 8 && (t) + 1 < NTw) CINIT_H(S0, 0, (t) + 1); \
            SBAR(); } } while (0)
#define DSTEP_MID(PWP, PWC, t) do { const LAS unsigned char* vp = vp0 + vo_r; s16x4 vl[2], vh[2]; DQK(t, true); DPV(PWP, PWC, true, t, true); if ((t) + 1 < NTw) CINIT_H(S1, 1, (t) + 1); DTAIL(t); } while (0)
    { const LAS unsigned char* vp = vp0; s16x4 vl[2], vh[2]; (void)vp; (void)vl; (void)vh; DHEAD(0); CINIT(S0, S1, 0); DQK(0, false);
#pragma unroll
      for (int g = 0; g < 16; ++g) DSOFT(pwA, g);
      if (1 < NTw) CINIT(S0, S1, 1); DTAIL(0); }
    int t = 1;
    for (; t + 1 < NTw; t += 2) {
        unsigned long long t0_ = 0; if (DBG_MEASURE == 3 && blockIdx.x == 0 && w == 0) t0_ = __builtin_amdgcn_s_memtime();
        DSTEP_MID(pwA, pwB, t); DSTEP_MID(pwB, pwA, t + 1);
        if (DBG_MEASURE == 3 && blockIdx.x == 0 && w == 0) { const unsigned long long t1_ = __builtin_amdgcn_s_memtime(); LAS unsigned* dg = (LAS unsigned*)(lds + LDSCTL_OFF + 3072); if (lane == 0) { dg[0] += (unsigned)(t1_ - t0_); dg[1] += 2u; } }
    }
    if (t < NTw) { DSTEP_MID(pwA, pwB, t); ++t; { const LAS unsigned char* vp = vp0 + vo_r; s16x4 vl[2], vh[2]; DPV(pwB, pwA, false, t, false); } DTAIL(t); ++t; }
    else { { const LAS unsigned char* vp = vp0 + vo_r; s16x4 vl[2], vh[2]; DPV(pwA, pwB, false, t, false); } DTAIL(t); ++t; }
    for (; t <= NT; ++t) { DHEAD(t); DTAIL(t); }
#undef DHEAD
#undef DTAIL
#undef DQK
#undef DSOFT
#undef DPV
#undef VLOAD2
#undef DSTEP_MID
    }
    float lsum = ls0 + ls1;
#undef STEP_FULL
#undef STEP_LAST
#undef STEP_HEAD
#undef STEP_TAIL
#undef QK_EXP
#undef KLD1
#undef PV_SUM
#undef SUMPACK
#undef VLOAD
#undef EXP4
#undef KLOAD
#undef CINIT
#undef CINIT_H
#undef MFMA32
#undef MFMA_QK
#undef MFMA_PV
#undef EXP2F
#undef SBAR
#undef ATT_DMAK
#undef ATT_DMAV
    lsum += __shfl_xor(lsum, 32);
    epilogue<NK>(lds, ws, in, b, h, w, map, rb, qw0, lane, lsum, o);
}

template <int ABL> __device__ __forceinline__ void attn_phase(LAS unsigned char* lds, unsigned char* ws, const Inputs& in, int G, int v) {
    const float* CF = (const float*)(ws + WS_CONST);
    if (DBG_MEASURE && blockIdx.x == 0 && threadIdx.x == 0) { LAS unsigned* dg = (LAS unsigned*)(lds + LDSCTL_OFF + 3072); dg[0] = 0u; dg[1] = 0u;
        LAS unsigned long long* dq = (LAS unsigned long long*)(lds + LDSCTL_OFF + 3088); dq[0] = __builtin_amdgcn_s_memtime(); dq[1] = __builtin_amdgcn_s_memrealtime(); }
    for (int vv = v; vv < 256; vv += G) {
        if constexpr ((ABL & 4096) == 0)
        { const int j = vv & 3; build_table(lds, CF, 4 + ((vv >> 2) & 7));
          for (int k = 0; k < 4; ++k) { const int head = (vv >> 2) + 64 * k, b = head >> 3, h = head & 7;
              if constexpr ((ABL & 512) != 0) { const int wv = __builtin_amdgcn_readfirstlane(threadIdx.x >> 6);
                  if (wv < 4) { attn_unit<1, 0>(lds, ws, in, b, h, 7 - j, true); attn_unit<1, 0>(lds, ws, in, b, h, j, false); } else { attn_unit<1, (ABL & 0x1bf)>(lds, ws, in, b, h, 7 - j, true); attn_unit<1, (ABL & 0x1bf)>(lds, ws, in, b, h, j, false); } }
              else if constexpr ((ABL & 2048) != 0) { attn_unit<1, 0>(lds, ws, in, b, h, 7 - j, true); attn_unit<1, 0>(lds, ws, in, b, h, j, false); }
              else { attn_unit<1, ABL>(lds, ws, in, b, h, (ABL & 64) ? 0 : 7 - j, true); attn_unit<1, ABL>(lds, ws, in, b, h, (ABL & 64) ? 0 : j, false); } } }
        __syncthreads();
        if constexpr ((ABL & 1024) == 0)
        { const int j = vv & 7; build_table(lds, CF, (vv >> 3) & 3);
          for (int k = 0; k < 4; ++k) { const int head = (vv >> 3) + 32 * k, b = head >> 2, h = head & 3;
              attn_unit<2, (ABL & 0x1ff)>(lds, ws, in, b, h, (ABL & 64) ? 0 : 15 - j, false); attn_unit<2, (ABL & 0x1ff)>(lds, ws, in, b, h, (ABL & 64) ? 0 : j, false); } }
        __syncthreads();
    }
    if (DBG_MEASURE && blockIdx.x == 0 && threadIdx.x == 0) {
        const unsigned long long c1 = __builtin_amdgcn_s_memtime(), r1 = __builtin_amdgcn_s_memrealtime(); LAS unsigned* dg = (LAS unsigned*)(lds + LDSCTL_OFF + 3072); float eps = 0.f;
        LAS unsigned long long* dq = (LAS unsigned long long*)(lds + LDSCTL_OFF + 3088); const unsigned long long dbg_c0 = dq[0], dbg_r0 = dq[1];
        if (DBG_MEASURE == 1) eps = (float)(c1 - dbg_c0) / (float)(r1 - dbg_r0) * 0.1f / 4.0f;
        if (DBG_MEASURE == 2 || DBG_MEASURE == 3) eps = (float)dg[0] / (float)(dg[1] ? dg[1] : 1u) / 300.0f;
        if (DBG_MEASURE == 4) eps = (float)(r1 - dbg_r0) * 0.01f / 1000.0f;
        eps = floorf(eps * 50.0f + 0.5f) * 0.02f;
        ((float*)(ws + WS_CONST))[CF_DBG] = eps;
    }
}
}
template <int ABL> __device__ __forceinline__ void attn_phase(LAS unsigned char* lds, unsigned char* ws, const Inputs& in, int G, int v) { att::attn_phase<ABL>(lds, ws, in, G, v); }

#define RLX_AGENT __ATOMIC_RELAXED, __HIP_MEMORY_SCOPE_AGENT
#define XB_TMO      128
#define XB_XCNT(j)  (256  + 64 * (j))
#define XB_XSUB(j)  (1280 + 64 * (j))
#define XB_XGEN(j)  (2304 + 64 * (j))
#define XB_TOP      3328
#define XB_TOPGEN   3392
#define XCD_BAR_WORDS 3456
#define XB_SPIN_CAP (1u << 18)
constexpr int CW_BAR = 8192;
__device__ __forceinline__ unsigned xb_ld(unsigned* p)              { return __hip_atomic_load(p, __ATOMIC_RELAXED, __HIP_MEMORY_SCOPE_AGENT); }
__device__ __forceinline__ unsigned xb_add(unsigned* p, unsigned v) { return __hip_atomic_fetch_add(p, v, __ATOMIC_RELAXED, __HIP_MEMORY_SCOPE_AGENT); }
__device__ __forceinline__ unsigned xb_xcc_id() { return (unsigned)__builtin_amdgcn_s_getreg((3 << 11) | 20) & 0xFu; }
#define XB_SPIN(cond, bar) do { unsigned _sp = 0; while (cond) { __builtin_amdgcn_s_sleep(1); \
    if ((++_sp & 255u) == 0u) { if (xb_ld(&(bar)[XB_TMO])) break; if (_sp > XB_SPIN_CAP) { atomicAdd(&(bar)[XB_TMO], 1u); break; } } } } while (0)
struct XcdBarrier { unsigned* bar; unsigned x; volatile LAS unsigned* st; };
__device__ __forceinline__ XcdBarrier xcd_barrier_post(unsigned* bar, volatile LAS unsigned* st) {
    XcdBarrier b; b.bar = bar; b.x = xb_xcc_id(); b.st = st;
    if (threadIdx.x == 0) (void)xb_add(&bar[XB_XCNT(b.x)], 1u);
    return b;
}
__device__ __forceinline__ void xcd_barrier_complete(unsigned* bar, unsigned x, unsigned& nloc, unsigned& nx) {
    const unsigned G = gridDim.x * gridDim.y * gridDim.z;
    unsigned sum, cnt, mine, sp = 0u;
    for (;;) {
        sum = 0u; cnt = 0u; mine = 0u;
#pragma unroll
        for (unsigned j = 0; j < 16; ++j) { const unsigned c = xb_ld(&bar[XB_XCNT(j)]); sum += c; cnt += (c > 0u) ? 1u : 0u; mine = (j == x) ? c : mine; }
        if (sum == G) break;
        __builtin_amdgcn_s_sleep(1);
        if ((++sp & 255u) == 0u) { if (xb_ld(&bar[XB_TMO])) break; if (sp > XB_SPIN_CAP) { atomicAdd(&bar[XB_TMO], 1u); break; } }
    }
    nloc = mine > 0u ? mine : 1u; nx = cnt > 0u ? cnt : 1u;
}
__device__ __forceinline__ void xcd_barrier(const XcdBarrier& b) {
    asm volatile("s_waitcnt vmcnt(0)" ::: "memory");
    __syncthreads();
    if (threadIdx.x == 0) {
        unsigned* bar = b.bar;
        __builtin_amdgcn_s_waitcnt(0);
        unsigned nloc = b.st[0], nx = b.st[1];
        if (nloc == 0u) { xcd_barrier_complete(bar, b.x, nloc, nx); b.st[0] = nloc; b.st[1] = nx; }
        const unsigned old = xb_add(&bar[XB_XSUB(b.x)], 1u);
        const unsigned gen = old / nloc;
        if (old + 1u == (gen + 1u) * nloc) {
            __builtin_amdgcn_fence(__ATOMIC_RELEASE, "agent");
            asm volatile("s_waitcnt vmcnt(0)" ::: "memory");
            const unsigned og = xb_add(&bar[XB_TOP], 1u);
            const unsigned tg = og / nx;
            if (og + 1u == (tg + 1u) * nx) xb_add(&bar[XB_TOPGEN], 1u);
            else XB_SPIN(xb_ld(&bar[XB_TOPGEN]) == tg, bar);
            __builtin_amdgcn_fence(__ATOMIC_ACQUIRE, "agent");
            xb_add(&bar[XB_XGEN(b.x)], 1u);
            asm volatile("s_waitcnt vmcnt(0)" ::: "memory");
        } else {
            XB_SPIN(xb_ld(&bar[XB_XGEN(b.x)]) == gen, bar);
            __builtin_amdgcn_fence(__ATOMIC_ACQUIRE, "agent");
            asm volatile("s_waitcnt vmcnt(0)" ::: "memory");
        }
    }
    __syncthreads();
}

constexpr int N_PHASES = 8;
#ifndef DESYNC_TICKS
#define DESYNC_TICKS 0
#endif
#ifndef DESYNC_MASK
#define DESYNC_MASK 0
#endif
__device__ __forceinline__ void phase_stagger(int vcu, int ph) {
    if (!((DESYNC_MASK >> ph) & 1) || DESYNC_TICKS == 0) return;
    const unsigned long long t0 = __builtin_amdgcn_s_memrealtime(); const unsigned long long want = (unsigned long long)((vcu & 3) * DESYNC_TICKS);
    while (__builtin_amdgcn_s_memrealtime() - t0 < want) __builtin_amdgcn_s_sleep(4);
}
#ifndef PROBE_REP_MASK
#define PROBE_REP_MASK 0
#endif
#ifndef PROBE_REPN
#define PROBE_REPN 2
#endif
#define NREP(k) (((PROBE_REP_MASK >> (k)) & 1) ? PROBE_REPN : 1)
struct Args { Inputs in; float* out; unsigned char* ws; int ph_lo, ph_hi; };

__global__ void __launch_bounds__(512, 2) mega(Args args) {
    extern __shared__ __attribute__((aligned(16))) unsigned char lds_raw[];
    LAS unsigned char* lds = (LAS unsigned char*)lds_raw;
    const int tid = threadIdx.x, lane = tid & 63, wave = __builtin_amdgcn_readfirstlane(tid >> 6);
    const int G = gridDim.x; const int bx = blockIdx.x; const int vcu = (G % 8 == 0) ? (bx % 8) * (G / 8) + bx / 8 : bx;
    unsigned char* ws = args.ws; const Inputs& in = args.in;
    unsigned* ctl = (unsigned*)(ws + WS_CTL);
    volatile LAS unsigned* MISC = (volatile LAS unsigned*)(lds + MISC_OFF);
    LAS int* moetab = (LAS int*)(lds + MOETAB_OFF);
    for (int u = tid; u < (LDS_BYTES - LDSCTL_OFF) / 4; u += 512) ((LAS unsigned*)(lds + LDSCTL_OFF))[u] = 0u;
    __syncthreads();
    const int lo = args.ph_lo, hi = args.ph_hi;
    const bool multi = (hi - lo) > 1;
    XcdBarrier bar; bar.bar = ctl + CW_BAR; bar.x = 0; bar.st = nullptr;
    if (multi) bar = xcd_barrier_post(ctl + CW_BAR, MISC + 8);
#define IN(k) (lo <= (k) && (k) < hi)
#define SEAM(k) do { if (IN(k) && IN((k) + 1)) xcd_barrier(bar); } while (0)

    if (IN(0)) { for (int rep = 0; rep < NREP(0); ++rep) { p0_prologue(in, ws, vcu * 8 + wave, G * 8, lane, (LAS float*)(lds + wave * 16384)); if (rep + 1 < NREP(0)) xcd_barrier(bar); } SEAM(0); }

    if (IN(1)) {
        pg8::DenseOrder S; S.init((const bf16_t*)(ws + WS_XN), (const bf16_t*)(ws + WS_WIN), NTOK, NPROJ, DM, G, bx);
        if (tid < 256) ((LAS float*)(lds + GAINS_OFF))[tid] = ((const float*)(ws + WS_CONST))[CF_GAIN + tid];
        __syncthreads();
        EpiInProj E{ws, (const LAS float*)(lds + GAINS_OFF), !multi}; phase_stagger(vcu, 1);
        for (int rep = 0; rep < NREP(1); ++rep) { pg8::gemm_phase(lds, S, E); if (rep + 1 < NREP(1)) xcd_barrier(bar); } SEAM(1);
    }
    if (IN(2)) {
#ifdef HAVE_ATTN
        for (int rep = 0; rep < NREP(2); ++rep) { attn_phase<0>(lds, ws, in, G, vcu); if (rep + 1 < NREP(2)) xcd_barrier(bar); }
#endif
        SEAM(2);
    }
    if (IN(3)) {
        pg8::DenseOrder S; S.init((const bf16_t*)(ws + WS_Y), (const bf16_t*)(ws + WS_WOUT), NTOK, DM, DM, G, bx);
        EpiOutProj E{ws, in.x}; phase_stagger(vcu, 3);
        for (int rep = 0; rep < NREP(3); ++rep) { pg8::gemm_phase(lds, S, E); if (rep + 1 < NREP(3)) xcd_barrier(bar); } SEAM(3);
    }
    if (IN(4)) {
        pg8::DenseOrder S; S.init((const bf16_t*)(ws + WS_X1B), (const bf16_t*)(ws + WS_WR), NTOK, 256, DM, G, bx);
        EpiRoute E{ws, lds};
        pg8::gemm_phase<EpiRoute, pg8::DenseOrder, true>(lds, S, E); SEAM(4);
    }
#ifndef DEBUG_SKIP5
    if (IN(5)) {
        moe_tables(ws, moetab);
        MoeOrder S{(const bf16_t*)(ws + WS_X1B), (const bf16_t*)(ws + WS_WGU), DM, 0, (const int*)(ws + WS_LTOK), moetab, G, vcu};
        EpiGateUp E{ws, moetab}; phase_stagger(vcu, 5);
        for (int rep = 0; rep < NREP(5); ++rep) { pg8::gemm_phase(lds, S, E); if (rep + 1 < NREP(5)) xcd_barrier(bar); } SEAM(5);
    }
#endif
#ifndef DEBUG_SKIP6
    if (IN(6)) {
        if (!IN(5)) moe_tables(ws, moetab);
        MoeOrder S{(const bf16_t*)(ws + WS_HID2), (const bf16_t*)(ws + WS_WD), 2 * EHID, 3, (const int*)(ws + WS_LTOK), moetab, G, vcu};
        EpiDownPair E{ws, args.out}; phase_stagger(vcu, 6);
        for (int rep = 0; rep < NREP(6); ++rep) { pg8::gemm_phase<EpiDownPair, MoeOrder, false, true>(lds, S, E); if (rep + 1 < NREP(6)) xcd_barrier(bar); }
    }
#endif
#ifdef PROBE_EXTRA_BARRIERS
    if (multi) { for (int k = 0; k < PROBE_EXTRA_BARRIERS; ++k) xcd_barrier(bar); }
#endif
#undef IN
#undef SEAM
}

#ifdef PROBE_ATTN_ABL
__global__ void __launch_bounds__(512, 2) attn_probe(Args args) {
    extern __shared__ __attribute__((aligned(16))) unsigned char lds_raw_p[];
    LAS unsigned char* lds = (LAS unsigned char*)lds_raw_p;
    const int G = gridDim.x; const int bx = blockIdx.x; const int vcu = (G % 8 == 0) ? (bx % 8) * (G / 8) + bx / 8 : bx;
    attn_phase<PROBE_ATTN_ABL>(lds, args.ws, args.in, G, vcu);
}
#endif

#ifdef PROBE_UBENCH3
typedef float ub3_f2 __attribute__((ext_vector_type(2)));
template <int V> __global__ void __launch_bounds__(512, 2) ubench3(float* sink, int iters) {
    ub3_f2 r[32]; const ub3_f2 k = {1.0000001f, 0.9999999f};
#pragma unroll
    for (int i = 0; i < 32; ++i) r[i] = ub3_f2{1.0f + 0.001f * (float)(threadIdx.x + i), 1.0f - 0.001f * (float)i};
    for (int it = 0; it < iters; ++it) {
#pragma unroll
        for (int i = 0; i < 32; ++i) {
            if (V == 0) { asm volatile("v_mul_f32 %0, %0, %2\n\tv_mul_f32 %1, %1, %3" : "+v"(r[i].x), "+v"(r[i].y) : "v"(k.x), "v"(k.y)); }
            else if (V == 1) { asm volatile("v_pk_mul_f32 %0, %0, %1" : "+v"(r[i]) : "v"(k)); }
            else if (V == 2) { asm volatile("v_add_f32 %0, %0, %2\n\tv_add_f32 %1, %1, %3" : "+v"(r[i].x), "+v"(r[i].y) : "v"(k.x), "v"(k.y)); }
            else { asm volatile("v_pk_add_f32 %0, %0, %1" : "+v"(r[i]) : "v"(k)); }
        }
    }
    float s = 0.f;
#pragma unroll
    for (int i = 0; i < 32; ++i) s += r[i].x + r[i].y;
    if (s == 123.456f) sink[threadIdx.x] = s;
}
#endif
#ifdef PROBE_UBENCH2
typedef float ub2_f32x16 __attribute__((ext_vector_type(16))); typedef short ub2_bf16x8 __attribute__((ext_vector_type(8))); typedef short ub2_s16x4 __attribute__((ext_vector_type(4)));
template <int V> __global__ void __launch_bounds__(512, 2) ubench2(float* sink, int iters) {
    __shared__ __attribute__((aligned(16))) unsigned char sm[57344];
    LAS unsigned char* lds = (LAS unsigned char*)sm;
    for (int i = threadIdx.x; i < 57344 / 4; i += 512) ((LAS float*)lds)[i] = -0.001f * (float)(i & 1023);
    __syncthreads();
    const int lane = threadIdx.x & 63, hi = lane >> 5, r32 = lane & 31;
    ub2_f32x16 pa0, pa1, pb0 = {}, pb1 = {}, o0 = {}, o1 = {}; ub2_bf16x8 q = {1, 2, 3, 4, 5, 6, 7, 8};
#pragma unroll
    for (int i = 0; i < 16; ++i) { pa0[i] = -0.001f * (float)(threadIdx.x + i); pa1[i] = -0.002f * (float)(threadIdx.x + i); }
    asm volatile("" : "+v"(q));
    const LAS unsigned char* kp = lds + hi * 1024 + r32 * 16;
    const LAS unsigned char* vp = lds + 8192 + ((lane >> 4) & 1) * 32 + (lane & 3) * 8 + (4 * hi + ((lane & 15) >> 2)) * 64;
    const LAS unsigned char* tp = lds + 16384 + ((lane & 3) * 2384 + ((2047 - lane) & ~3)) * 4 % 36864;
    float ls0 = 0.f, ls1 = 0.f;
#define UB_MFMA(a, b, c) ((V & 128) ? (c) : __builtin_amdgcn_mfma_f32_32x32x16_bf16(a, b, c, 0, 0, 0))
#define UB_VLOAD(g) do { if ((g) < 8) { if (V & 2) { vl[(g) % 3] = __builtin_bit_cast(ub2_s16x4, __builtin_amdgcn_ds_read_tr16_b64_v4i16((LAS ub2_s16x4*)(vp + ((g) & 1) * 4096 + ((g) >> 1) * 1024))); vh[(g) % 3] = __builtin_bit_cast(ub2_s16x4, __builtin_amdgcn_ds_read_tr16_b64_v4i16((LAS ub2_s16x4*)(vp + ((g) & 1) * 4096 + ((g) >> 1) * 1024 + 512))); } else { vl[(g) % 3] = ub2_s16x4{1, 2, 3, 4}; vh[(g) % 3] = ub2_s16x4{4, 3, 2, 1}; asm volatile("" : "+v"(vl[(g) % 3]), "+v"(vh[(g) % 3])); } } } while (0)
#define UB_SUMPACK(PC0, PC1, ks) do { _Pragma("unroll") for (int i = 0; i < 4; ++i) { const float a_ = (ks) == 0 ? PC0[2 * i] : (ks) == 1 ? PC0[8 + 2 * i] : (ks) == 2 ? PC1[2 * i] : PC1[8 + 2 * i]; const float b_ = (ks) == 0 ? PC0[2 * i + 1] : (ks) == 1 ? PC0[9 + 2 * i] : (ks) == 2 ? PC1[2 * i + 1] : PC1[9 + 2 * i]; \
            if (V & 32) { ls0 += a_; ls1 += b_; pw[(ks) & 1][i] = att::cvtpk(a_, b_); } else pw[(ks) & 1][i] = __builtin_bit_cast(unsigned, a_); } asm volatile("" : "+v"(ls0), "+v"(ls1), "+v"(pw[(ks) & 1])); } while (0)
#define UB_R1(PC0, PC1, PN0, PN1) do { \
        ub2_bf16x8 kf[8]; \
        _Pragma("unroll") for (int i = 0; i < 8; ++i) { if (V & 1) kf[i] = *(const LAS ub2_bf16x8*)(kp + (i >> 1) * 2048 + (i & 1) * 512); else kf[i] = q; } \
        __builtin_amdgcn_sched_barrier(0); \
        _Pragma("unroll") for (int i = 0; i < 8; ++i) { \
            if (i & 1) PN1 = UB_MFMA(kf[i], q, PN1); else PN0 = UB_MFMA(kf[i], q, PN0); \
            if (V & 16) { _Pragma("unroll") for (int k = 0; k < 4; ++k) { const int e = 4 * i + k; if (e < 16) PC0[e] = __builtin_amdgcn_exp2f(PC0[e]); else PC1[e - 16] = __builtin_amdgcn_exp2f(PC1[e - 16]); } } \
            if (i < 4) asm volatile("" : "+v"(PC0)); else asm volatile("" : "+v"(PC1)); \
            __builtin_amdgcn_sched_barrier(0); } \
        if (V & 64) { asm volatile("s_waitcnt lgkmcnt(0)" ::: "memory"); __builtin_amdgcn_s_barrier(); __builtin_amdgcn_sched_barrier(0); } } while (0)
#define UB_R2(PC0, PC1, PN0, PN1) do { \
        v4u pw[2]; ub2_s16x4 vl[3], vh[3]; \
        UB_VLOAD(0); UB_VLOAD(1); UB_SUMPACK(PC0, PC1, 0); __builtin_amdgcn_sched_barrier(0); \
        _Pragma("unroll") for (int g = 0; g < 8; ++g) { const int ks = g / 2, d0 = g % 2; \
            UB_VLOAD(g + 2); \
            { const ub2_s16x4 a_ = vl[g % 3], b_ = vh[g % 3]; const ub2_bf16x8 vf = {a_[0], a_[1], a_[2], a_[3], b_[0], b_[1], b_[2], b_[3]}; \
              if (d0) o1 = UB_MFMA(__builtin_bit_cast(ub2_bf16x8, pw[ks & 1]), vf, o1); else o0 = UB_MFMA(__builtin_bit_cast(ub2_bf16x8, pw[ks & 1]), vf, o0); } \
            if (d0 == 0 && ks < 3) UB_SUMPACK(PC0, PC1, ks + 1); \
            if (g == 5) { if (V & 4) { _Pragma("unroll") for (int c = 0; c < 4; ++c) { const f32x4 c0 = *(const LAS f32x4*)(tp + c * 32), c1 = *(const LAS f32x4*)(tp + 128 + c * 32); \
                        PC0[4 * c] = c0[0]; PC0[4 * c + 1] = c0[1]; PC0[4 * c + 2] = c0[2]; PC0[4 * c + 3] = c0[3]; PC1[4 * c] = c1[0]; PC1[4 * c + 1] = c1[1]; PC1[4 * c + 2] = c1[2]; PC1[4 * c + 3] = c1[3]; } } \
                else { asm volatile("" : "+v"(PC0), "+v"(PC1)); } } \
            __builtin_amdgcn_sched_barrier(0); } \
        if (V & 8) { asm volatile("s_waitcnt lgkmcnt(0)" ::: "memory"); __builtin_amdgcn_s_barrier(); __builtin_amdgcn_sched_barrier(0); } } while (0)
#define UB_STEP(PC0, PC1, PN0, PN1) do { UB_R1(PC0, PC1, PN0, PN1); UB_R2(PC0, PC1, PN0, PN1); } while (0)
    if ((V & 256) && (threadIdx.x >> 6) >= 4) { UB_R1(pb0, pb1, pa0, pa1); }
    for (int it = 0; it < iters; it += 2) { UB_STEP(pa0, pa1, pb0, pb1); UB_STEP(pb0, pb1, pa0, pa1); }
    float s = ls0 + ls1;
#pragma unroll
    for (int i = 0; i < 16; ++i) s += o0[i] + o1[i] + pa0[i] + pa1[i] + pb0[i] + pb1[i];
    if (s == 123.456f) sink[threadIdx.x] = s;
#undef UB_VLOAD
#undef UB_SUMPACK
#undef UB_STEP
#undef UB_R1
#undef UB_R2
#undef UB_MFMA
}
#endif

#ifdef PROBE_UBENCH
typedef float ub_f32x16 __attribute__((ext_vector_type(16))); typedef short ub_bf16x8 __attribute__((ext_vector_type(8)));
template <int V> __global__ void __launch_bounds__(512, 2) ubench(float* sink, int iters) {
    ub_f32x16 a0 = {}, a1 = {}; ub_bf16x8 x = {1, 2, 3, 4, 5, 6, 7, 8}, y = {8, 7, 6, 5, 4, 3, 2, 1};
    float e[32];
#pragma unroll
    for (int i = 0; i < 32; ++i) e[i] = -0.001f * (float)(threadIdx.x + i);
    asm volatile("" : "+v"(x), "+v"(y));
    for (int it = 0; it < iters; ++it) {
#pragma unroll
        for (int g = 0; g < 16; ++g) {
            if (V & 1) { if (g & 1) a1 = __builtin_amdgcn_mfma_f32_32x32x16_bf16(x, y, a1, 0, 0, 0); else a0 = __builtin_amdgcn_mfma_f32_32x32x16_bf16(x, y, a0, 0, 0, 0); }
            if (V & 2) {
#pragma unroll
                for (int k = 0; k < 4; ++k) { const int i = (4 * g + k) & 31; e[i] = __builtin_amdgcn_exp2f(e[i]) - 1.0f; } }
            if (V & 4) {
#pragma unroll
                for (int k = 0; k < 2; ++k) { const int i = (2 * g + k) & 31; e[i] = __builtin_amdgcn_exp2f(e[i]) - 1.0f; } }
            __builtin_amdgcn_sched_barrier(0);
        }
    }
    float s = 0.f;
#pragma unroll
    for (int i = 0; i < 32; ++i) s += e[i];
#pragma unroll
    for (int i = 0; i < 16; ++i) s += a0[i] + a1[i];
    if (s == 123.456f) sink[threadIdx.x] = s;
}
#endif

extern "C" void kernel_launch(void* const* d_in, const int* in_sizes, int n_in, void* d_out, int out_size, void* d_ws, size_t ws_size, hipStream_t stream) {
    static int grid = 0;
    if (grid == 0) {
        if (n_in != 20 || in_sizes[0] != NTOK * DM || out_size != NTOK * DM || ws_size < WS_END) { fprintf(stderr, "kernel_launch: unexpected shapes (n_in %d, ws %zu)\n", n_in, ws_size); grid = -1; return; }
        int dev = 0, cus = 0, per_cu = 0;
        if (hipGetDevice(&dev) != hipSuccess || hipDeviceGetAttribute(&cus, hipDeviceAttributeMultiprocessorCount, dev) != hipSuccess) { grid = -1; return; }
        if (hipFuncSetAttribute((const void*)mega, hipFuncAttributeMaxDynamicSharedMemorySize, LDS_BYTES) != hipSuccess) { fprintf(stderr, "kernel_launch: hipFuncSetAttribute failed\n"); grid = -1; return; }
        if (hipOccupancyMaxActiveBlocksPerMultiprocessor(&per_cu, (const void*)mega, 512, LDS_BYTES) != hipSuccess || per_cu < 1) { fprintf(stderr, "kernel_launch: occupancy query says %d blocks per CU\n", per_cu); (void)hipGetLastError(); grid = -1; return; }
        grid = cus;
    }
    if (grid < 0) return;
    Args a{};
    const float** ip = (const float**)&a.in;
    for (int i = 0; i < 20; ++i) ip[i] = (const float*)d_in[i];
    a.out = (float*)d_out; a.ws = (unsigned char*)d_ws; a.ph_lo = 0; a.ph_hi = N_PHASES;
    (void)hipMemsetAsync((unsigned char*)d_ws + WS_CTL, 0, CTL_ZERO_BYTES, stream);
    hipLaunchKernelGGL(mega, dim3(grid), dim3(512), LDS_BYTES, stream, a);
#ifdef PROBE_ATTN_ABL
    { static bool ad = false; if (!ad) { (void)hipFuncSetAttribute((const void*)attn_probe, hipFuncAttributeMaxDynamicSharedMemorySize, LDS_BYTES); ad = true; }
      hipLaunchKernelGGL(attn_probe, dim3(grid), dim3(512), LDS_BYTES, stream, a); }
#endif
#ifdef PROBE_UBENCH3
    hipLaunchKernelGGL(ubench3<PROBE_UBENCH3>, dim3(grid), dim3(512), 0, stream, (float*)((unsigned char*)d_ws + WS_SS), 20000);
#endif
#ifdef PROBE_UBENCH2
    hipLaunchKernelGGL(ubench2<PROBE_UBENCH2>, dim3(grid), dim3(512), 0, stream, (float*)((unsigned char*)d_ws + WS_SS), 1000);
#endif
#ifdef PROBE_UBENCH
    hipLaunchKernelGGL(ubench<PROBE_UBENCH>, dim3(grid), dim3(PROBE_UB_THREADS), 0, stream, (float*)((unsigned char*)d_ws + WS_SS), 1000);
#endif
#ifdef PROBE_EXTRA_LO
    for (int k = PROBE_EXTRA_LO; k < PROBE_EXTRA_HI; ++k) { a.ph_lo = k; a.ph_hi = k + 1; hipLaunchKernelGGL(mega, dim3(grid), dim3(512), LDS_BYTES, stream, a); }
#endif
}
```

```cpp
#include <hip/hip_runtime.h>
#include <cstdint>
#include <cstdio>

typedef unsigned short bf16_t;
typedef unsigned v4u __attribute__((ext_vector_type(4)));
typedef unsigned v2u __attribute__((ext_vector_type(2)));
typedef float f32x4 __attribute__((ext_vector_type(4)));
#define LAS __attribute__((address_space(3)))

constexpr int BATCH = 32, SEQ = 2048, DM = 1024, NTOK = BATCH * SEQ;
constexpr int HD = 64, HDIFF = 4, HMOBA = 8, NPROJ = 3072;
constexpr int NEXP = 32, EHID = 256, NLIST = 64;
constexpr int LIST_CAP = NTOK;
constexpr float RMS_EPS = 1e-6f;
constexpr float LOG2E = 1.4426950408889634f;
constexpr float C2 = 0.125f * LOG2E;
constexpr float LAMBDA_INIT = 0.2f;

constexpr size_t MiB = 1u << 20;
constexpr size_t WS_CTL = 0, CTL_ZERO_BYTES = 1 * MiB;
constexpr size_t WS_CONST = 1 * MiB;
constexpr size_t WS_WIN = 2 * MiB, WS_WOUT = 8 * MiB, WS_WR = 10 * MiB, WS_WGU = 12 * MiB, WS_WD = 44 * MiB;
constexpr size_t WS_QD = 64 * MiB, WS_KD = 128 * MiB, WS_VD = 192 * MiB, WS_QM = 256 * MiB, WS_KM = 320 * MiB, WS_VM = 384 * MiB;
constexpr size_t WS_XN = 448 * MiB, WS_Y = 448 * MiB;
constexpr size_t WS_X1B = 576 * MiB, WS_SS = 704 * MiB  , WS_R2 = 708 * MiB, WS_KMEAN = 709 * MiB;
constexpr size_t WS_PA = 64 * MiB, WS_HID = 192 * MiB, WS_LTOK = 272 * MiB, WS_LW = 288 * MiB;
constexpr size_t WS_END = 711 * MiB;
constexpr size_t WS_HID2 = 64 * MiB  , WS_LP = 320 * MiB  , WS_PTOK = 336 * MiB  ;
constexpr int NPAIR = 112;
constexpr int CW_PCNT = 16384;
constexpr int CW_CNT = 1024;
#ifndef DBG_MEASURE
#define DBG_MEASURE 0
#endif
constexpr int CF_DBG = 8;
constexpr int CF_LAMBDA = 0, CF_OFF = 16, CF_GAIN = 64  , CF_BT = 1024;

__device__ __forceinline__ float bf2f(bf16_t v) { return __uint_as_float(((unsigned)v) << 16); }
__device__ __forceinline__ unsigned f2bf(float f) { unsigned u = __float_as_uint(f); return (u + 0x7fffu + ((u >> 16) & 1u)) >> 16; }
__device__ __forceinline__ unsigned pk2(float lo, float hi) { return f2bf(lo) | (f2bf(hi) << 16); }
__device__ __forceinline__ float wave_sum(float v) {
#pragma unroll
    for (int o = 1; o < 64; o <<= 1) v += __shfl_xor(v, o);
    return v;
}
__device__ __forceinline__ float wave_max(float v) {
#pragma unroll
    for (int o = 1; o < 64; o <<= 1) v = fmaxf(v, __shfl_xor(v, o));
    return v;
}
__host__ __device__ __forceinline__ int phys_in(int c) { const int pn = c >> 8, cc = c & 255; return 256 * pn + 128 * ((cc >> 5) & 1) + 32 * (cc >> 6) + (cc & 31); }
__device__ __forceinline__ int t5_bucket(int d) {
    if (d < 16) return d;
    const float nf = (float)d;
    int large = 16 + (int)(logf(nf / 16.0f) / 4.852030263919617f * 16.0f);
    return large < 31 ? large : 31;
}

struct Inputs {
    const float *x, *norm1_g, *w_in, *diff_q_g, *diff_k_g, *lq1, *lk1, *lq2, *lk2, *diff_sub_g, *moba_q_g, *moba_k_g, *rel_bias, *w_out, *norm2_g,
        *router_group, *router_expert, *w_gate, *w_up, *w_down;
};

__device__ __forceinline__ void p0_tr_item(const float* W, int ldw, int k0, int n_src, const float* gk, bf16_t* dst, int drow0, int dpitch, LAS float* scr, int lane) {
    float wv[32];
#pragma unroll
    for (int i = 0; i < 32; ++i) wv[i] = W[(size_t)(k0 + 2 * i + (lane >> 5)) * ldw + n_src + (lane & 31)];
#pragma unroll
    for (int i = 0; i < 32; ++i) { const int kk = 2 * i + (lane >> 5); float v = wv[i]; if (gk) v *= gk[k0 + kk]; scr[kk * 33 + (lane & 31)] = v; }
    asm volatile("s_waitcnt lgkmcnt(0)" ::: "memory");
    const int c = lane & 7;
#pragma unroll
    for (int j = 0; j < 4; ++j) {
        const int n = (lane >> 3) + 8 * j; const LAS float* s = scr + (8 * c) * 33 + n;
        v4u o; o.x = pk2(s[0 * 33], s[1 * 33]); o.y = pk2(s[2 * 33], s[3 * 33]); o.z = pk2(s[4 * 33], s[5 * 33]); o.w = pk2(s[6 * 33], s[7 * 33]);
        *(v4u*)(dst + (size_t)(drow0 + n) * dpitch + k0 + 8 * c) = o;
    }
    asm volatile("s_waitcnt lgkmcnt(0)" ::: "memory");
}

__device__ __forceinline__ void p0_prologue(const Inputs& in, unsigned char* ws, int gw, int NGW, int lane, LAS float* scr) {
    bf16_t* WIN_T = (bf16_t*)(ws + WS_WIN); bf16_t* WOUT_T = (bf16_t*)(ws + WS_WOUT); bf16_t* WR_T = (bf16_t*)(ws + WS_WR);
    bf16_t* WGU_T = (bf16_t*)(ws + WS_WGU); bf16_t* WD_T = (bf16_t*)(ws + WS_WD); bf16_t* XN = (bf16_t*)(ws + WS_XN);
    float* CF = (float*)(ws + WS_CONST);
    constexpr int I_IN = 16 * 96, I_OUT = 16 * 32, I_GU = 32 * 16 * 16, I_D = 32 * 4 * 32, NITEMS = I_IN + I_OUT + I_GU + I_D;
    for (int it = gw; it < NITEMS; it += NGW) {
        int r = it;
        if (r < I_IN) {
            const int kb = r / 96, nb = r % 96, p0 = 32 * nb, pn = p0 >> 8, pp = p0 & 255, bj = pp >> 7, wc = (pp >> 5) & 3;
            p0_tr_item(in.w_in, NPROJ, 64 * kb, 256 * pn + 64 * wc + 32 * bj, in.norm1_g, WIN_T, p0, DM, scr, lane); continue; }
        r -= I_IN;
        if (r < I_OUT) { const int kb = r / 32, nb = r % 32; p0_tr_item(in.w_out, DM, 64 * kb, 32 * nb, nullptr, WOUT_T, 32 * nb, DM, scr, lane); continue; }
        r -= I_OUT;
        if (r < I_GU) {
            const int e = r / 256, rr = r % 256, kb = rr / 16, nb = rr % 16, p0 = 32 * nb, pn = p0 >> 8, bj = (p0 >> 7) & 1, j0 = p0 & 127;
            const float* src = (bj ? in.w_up : in.w_gate) + (size_t)e * DM * EHID;
            p0_tr_item(src, EHID, 64 * kb, 128 * pn + j0, in.norm2_g, WGU_T + (size_t)e * 512 * DM, p0, DM, scr, lane); continue; }
        r -= I_GU;
        { const int e = r / 128, rr = r % 128, kb = rr / 32, nb = rr % 32;
          p0_tr_item(in.w_down + (size_t)e * EHID * DM, DM, 64 * kb, 32 * nb, nullptr, WD_T + (size_t)e * DM * EHID, 32 * nb, EHID, scr, lane); }
    }
    for (int idx = gw * 64 + lane; idx < 256 * DM; idx += NGW * 64) {
        const int p = idx >> 10, k = idx & 1023, g = (p >> 5) & 3, i = p & 31; float v = 0.f;
        if (p < 128) { if (i < 8) v = in.norm2_g[k] * in.router_expert[((size_t)g * DM + k) * 8 + i]; else if (i < 12) v = in.norm2_g[k] * in.router_group[k * 4 + (i - 8)]; }
        WR_T[idx] = (bf16_t)f2bf(v);
    }
    for (int idx = gw * 64 + lane; idx < 12 * 2048; idx += NGW * 64) {
        const int h = idx >> 11, d = idx & 2047; CF[CF_BT + idx] = in.rel_bias[t5_bucket(d) * 12 + h] * LOG2E;
    }
    if (gw == 0) {
        float a = in.lq1[lane] * in.lk1[lane], b = in.lq2[lane] * in.lk2[lane];
        a = wave_sum(a); b = wave_sum(b);
        const float mqd = wave_max(fabsf(in.diff_q_g[lane])), mkd = wave_max(fabsf(in.diff_k_g[lane]));
        const float mqm = wave_max(fabsf(in.moba_q_g[lane])), mkm = wave_max(fabsf(in.moba_k_g[lane]));
        if (lane == 0) CF[CF_LAMBDA] = expf(a) - expf(b) + LAMBDA_INIT;
        CF[CF_GAIN + lane] = in.diff_q_g[lane]; CF[CF_GAIN + 64 + lane] = in.diff_k_g[lane]; CF[CF_GAIN + 128 + lane] = in.moba_q_g[lane]; CF[CF_GAIN + 192 + lane] = in.moba_k_g[lane];
        if (lane < 12) {
            float mb = -1e30f; for (int bk = 0; bk < 32; ++bk) mb = fmaxf(mb, in.rel_bias[bk * 12 + lane]);
            const float qk = lane < 4 ? mqd * mkd : mqm * mkm;
            CF[CF_OFF + lane] = (8.0f * qk + mb) * LOG2E;
        }
    }
    for (int m0 = gw * 4; m0 < NTOK; m0 += NGW * 4) {
        f32x4 v[4][4];
#pragma unroll
        for (int rr = 0; rr < 4; ++rr) { const f32x4* xr = (const f32x4*)(in.x + (size_t)(m0 + rr) * DM) + lane;
#pragma unroll
            for (int j = 0; j < 4; ++j) v[rr][j] = __builtin_nontemporal_load(xr + 64 * j); }
#pragma unroll
        for (int rr = 0; rr < 4; ++rr) { float s = 0.f;
#pragma unroll
            for (int j = 0; j < 4; ++j) s += (v[rr][j].x * v[rr][j].x + v[rr][j].y * v[rr][j].y) + (v[rr][j].z * v[rr][j].z + v[rr][j].w * v[rr][j].w);
            const float r = rsqrtf(wave_sum(s) * (1.f / DM) + RMS_EPS);
            unsigned long long* o8 = (unsigned long long*)(XN + (size_t)(m0 + rr) * DM) + lane;
#pragma unroll
            for (int j = 0; j < 4; ++j) o8[64 * j] = (unsigned long long)pk2(v[rr][j].x * r, v[rr][j].y * r) | ((unsigned long long)pk2(v[rr][j].z * r, v[rr][j].w * r) << 32); }
    }
}

namespace pg8 {
typedef short bf16x8 __attribute__((ext_vector_type(8)));
constexpr int BM = 256, BK = 64, HALF = 128, HTB = HALF * BK * 2, STAGE_BYTES = 8 * HTB, NXCD = 8, WGM = 8;

__host__ __device__ __forceinline__ int lds_byte(int r, int c) { const int st = (r >> 4) * 2 + (c >> 5), rr = r & 15, cc = c & 31, ob = rr * 64 + cc * 2; return st * 1024 + (ob ^ (((ob >> 9) & 1) << 5)); }
__host__ __device__ __forceinline__ void stage_rc(int b, int& R, int& C) { const int st = b / 1024, sb = b % 1024, swz = sb ^ (((sb >> 9) & 1) << 5); R = (st >> 1) * 16 + swz / 64; C = (st & 1) * 32 + (swz % 64) / 2; }
__host__ __device__ __forceinline__ int perm32(int rho) { const int n = rho >> 4, i = rho & 15; return 8 * (i >> 2) + 4 * n + (i & 3); }

struct Unit { int pm, pn, a0, a1; };

struct DenseOrder {
    const bf16_t* A; const bf16_t* Bt; int K; int nM, nN, nwg, G, c;
    __device__ void init(const bf16_t* A_, const bf16_t* Bt_, int M, int N, int K_, int G_, int c_) { A = A_; Bt = Bt_; K = K_; nM = M / BM; nN = N / BM; nwg = nM * nN; G = G_; c = c_; }
    __device__ __forceinline__ bool next(int i, Unit& u) const {
        const long L = (long)i * G + c; if (L >= nwg) return false;
        int wgid = (int)L; { const int q = nwg / NXCD, r = nwg % NXCD, xcd = wgid % NXCD, off = wgid / NXCD; wgid = (xcd < r ? xcd * (q + 1) : r * (q + 1) + (xcd - r) * q) + off; }
        const int nig = WGM * nN, gid = wgid / nig, fm = gid * WGM, gsz = (nM - fm) < WGM ? (nM - fm) : WGM;
        u.pm = fm + ((wgid % nig) % gsz); u.pn = (wgid % nig) / gsz; u.a0 = 0; u.a1 = 256; return true;
    }
    __device__ __forceinline__ const char* abase() const { return (const char*)A; }
    __device__ __forceinline__ unsigned arow(const Unit& u, int r) const { return (unsigned)(u.pm * BM + r) * (unsigned)K * 2u; }
    __device__ __forceinline__ const char* bbase(const Unit& u) const { return (const char*)Bt + (size_t)u.pn * BM * K * 2; }
};

typedef float f32x2 __attribute__((ext_vector_type(2)));
__device__ __forceinline__ unsigned cvt_pk_bf16(float lo, float hi) { unsigned r; asm volatile("v_cvt_pk_bf16_f32 %0, %1, %2" : "=v"(r) : "v"(lo), "v"(hi)); return r; }

template <class Epi, class Sched, bool HALFN = false, bool SPLITB = false>
__device__ __forceinline__ void gemm_phase(LAS unsigned char* lds, const Sched& S, const Epi& E) {
    int tid_ = threadIdx.x; asm volatile("" : "+v"(tid_));
    const int tid = tid_, wid = __builtin_amdgcn_readfirstlane(tid >> 6), lane = tid & 63, wr = wid >> 2, wc = wid & 3, fr = lane & 15, fq = lane >> 4;
    const int K = S.K, nt = K / BK; int LDB = K; if constexpr (SPLITB) LDB = S.ldb();
    int RA[2]; unsigned cA2[2], voffB[2];
#pragma unroll
    for (int i = 0; i < 2; ++i) { int R, C; stage_rc(tid * 16 + i * 8192, R, C); const int Rb = (R & ~31) + perm32(R & 31);
        RA[i] = R; cA2[i] = (unsigned)C * 2u; voffB[i] = (unsigned)(Rb * LDB + C) * 2u; }
    const size_t kstep = (size_t)(BK * 2);
    const size_t hstep = (size_t)HALF * LDB * 2;
    const unsigned ldsw = (unsigned)wid * 1024u;
    const int aoff = lds_byte(wr * 64 + fr, fq * 8), boff = lds_byte(wc * 32 + fr, fq * 8);
#define PG8_SA(b, h) (((b) * 2 + (h)) * HTB)
#define PG8_SB(b, h) ((4 + (b) * 2 + (h)) * HTB)
    const char* const Ab0 = S.abase(); const char* const Bb0 = (const char*)S.Bt;
    const __amdgpu_buffer_rsrc_t srdA = __builtin_amdgcn_make_buffer_rsrc((void*)Ab0, (short)0, 0x7fffffff, 0x00020000), srdB = __builtin_amdgcn_make_buffer_rsrc((void*)Bb0, (short)0, 0x7fffffff, 0x00020000);
    const unsigned ldsb = (unsigned)__builtin_amdgcn_readfirstlane((unsigned)(uintptr_t)lds + ldsw);
#define PG8_BDMA(srd, vo, so, m0v) asm volatile("s_mov_b32 m0, %0\n\ts_nop 0\n\tbuffer_load_dwordx4 %1, %2, %3 offen lds" :: "s"(m0v), "v"(vo), "s"(srd), "s"(so) : "m0", "memory")
#define PG8_STAGE_A(bufoff, gbase, voff) do { const unsigned so_ = (unsigned)__builtin_amdgcn_readfirstlane((unsigned)((const char*)(gbase) - Ab0)); _Pragma("unroll") for (int _i = 0; _i < 2; ++_i) PG8_BDMA(srdA, (voff)[_i], so_, ldsb + (unsigned)(bufoff) + (unsigned)_i * 8192u); } while (0)
#define PG8_STAGE_B(bufoff, gbase, voff) do { const unsigned so_ = (unsigned)__builtin_amdgcn_readfirstlane((unsigned)((const char*)(gbase) - Bb0)); _Pragma("unroll") for (int _i = 0; _i < 2; ++_i) PG8_BDMA(srdB, (voff)[_i], so_, ldsb + (unsigned)(bufoff) + (unsigned)_i * 8192u); } while (0)
#define PG8_LDA(dst, b, h) do { _Pragma("unroll") for (int m = 0; m < 4; ++m) _Pragma("unroll") for (int k = 0; k < 2; ++k) dst[m][k] = *(const LAS bf16x8*)(lds + PG8_SA(b, h) + aoff + m * 2048 + k * 1024); } while (0)
#define PG8_LDB(dst, b, h) do { _Pragma("unroll") for (int n = 0; n < 2; ++n) _Pragma("unroll") for (int k = 0; k < 2; ++k) dst[n][k] = *(const LAS bf16x8*)(lds + PG8_SB(b, h) + boff + n * 2048 + k * 1024); } while (0)
#define PG8_MMA(ai, bj, At, Bt) do { __builtin_amdgcn_s_setprio(1); _Pragma("unroll") for (int m = 0; m < 4; ++m) _Pragma("unroll") for (int n = 0; n < 2; ++n) _Pragma("unroll") for (int k = 0; k < 2; ++k) \
        acc[ai][bj][m][n] = __builtin_amdgcn_mfma_f32_16x16x32_bf16(Bt[n][k], At[m][k], acc[ai][bj][m][n], 0, 0, 0); __builtin_amdgcn_s_setprio(0); } while (0)
#define PG8_WAIT_V(n) asm volatile("s_waitcnt vmcnt(" #n ")" ::: "memory")
#define PG8_WAIT_L(n) asm volatile("s_waitcnt lgkmcnt(" #n ")" ::: "memory")
#define PG8_BAR __builtin_amdgcn_s_barrier()
#define PG8_SCHED __builtin_amdgcn_sched_barrier(0)
    Unit cur, nxt; int ui = 0;
    if (!S.next(0, cur)) return;
    f32x4 acc[2][2][4][2];
#pragma unroll
    for (int a = 0; a < 2; ++a)
#pragma unroll
        for (int b = 0; b < 2; ++b)
#pragma unroll
            for (int m = 0; m < 4; ++m)
#pragma unroll
                for (int n = 0; n < 2; ++n) acc[a][b][m][n] = (f32x4){0.f, 0.f, 0.f, 0.f};
    bf16x8 At[4][2], B0[2][2], B1[2][2];
    const char* const Ab = S.abase();
    unsigned oC[2][2], oN[2][2];
#pragma unroll
    for (int h = 0; h < 2; ++h)
#pragma unroll
        for (int i = 0; i < 2; ++i) { oC[h][i] = S.arow(cur, h * HALF + RA[i]) + cA2[i]; oN[h][i] = oC[h][i]; }
    const char* cB = S.bbase(cur); const char* cBh = cB; if constexpr (SPLITB) cBh = S.bbase2(cur);
    PG8_STAGE_B(PG8_SB(0, 0), cB, voffB); PG8_STAGE_B(PG8_SB(0, 1), cB + hstep, voffB); PG8_STAGE_A(PG8_SA(0, 0), Ab, oC[0]); PG8_STAGE_A(PG8_SA(0, 1), Ab, oC[1]);
    if (wr == 1) PG8_BAR;
    PG8_WAIT_V(2); PG8_BAR;
    PG8_STAGE_B(PG8_SB(1, 0), cB + kstep, voffB); PG8_STAGE_A(PG8_SA(1, 0), Ab + kstep, oC[0]); PG8_STAGE_B(PG8_SB(1, 1), cB + hstep + kstep, voffB);
    PG8_WAIT_V(6); PG8_BAR;
    for (;;) {
        const bool has_next = S.next(ui + 1, nxt);
        const char* nB = has_next ? S.bbase(nxt) : cB; const char* nBh = nB; if constexpr (SPLITB) { if (has_next) nBh = S.bbase2(nxt); }
        if (has_next) {
#pragma unroll
            for (int h = 0; h < 2; ++h)
#pragma unroll
                for (int i = 0; i < 2; ++i) oN[h][i] = S.arow(nxt, h * HALF + RA[i]) + cA2[i];
        }
        for (int t = 0; t < nt; t += 2) {
            const bool last = (t == nt - 2);
            const char* a1 = Ab + (size_t)(t + 1) * kstep;
            const char* a2 = last ? Ab : Ab + (size_t)(t + 2) * kstep; const char* b2 = last ? nB : ((SPLITB && t + 2 >= (nt >> 1)) ? cBh : cB) + (size_t)(t + 2) * kstep;
            const char* a3 = a2 + kstep; const char* b3 = b2 + kstep;
            unsigned o2[2][2];
#pragma unroll
            for (int h = 0; h < 2; ++h)
#pragma unroll
                for (int i = 0; i < 2; ++i) o2[h][i] = last ? oN[h][i] : oC[h][i];
            PG8_LDB(B0, 0, 0); PG8_LDB(B1, 0, 1); PG8_SCHED; PG8_LDA(At, 0, 0); PG8_STAGE_A(PG8_SA(1, 1), a1, oC[1]);
            PG8_WAIT_V(8); PG8_WAIT_L(0); PG8_BAR; PG8_MMA(0, 0, At, B0); if (!HALFN) PG8_MMA(0, 1, At, B1); PG8_BAR; PG8_SCHED;
            PG8_LDA(At, 0, 1); PG8_STAGE_B(PG8_SB(0, 0), b2, voffB); PG8_STAGE_B(PG8_SB(0, 1), b2 + hstep, voffB); PG8_STAGE_A(PG8_SA(0, 0), a2, o2[0]);
            PG8_WAIT_V(8); PG8_WAIT_L(0); PG8_BAR; PG8_MMA(1, 0, At, B0); if (!HALFN) PG8_MMA(1, 1, At, B1); PG8_BAR; PG8_SCHED;
            PG8_LDB(B0, 1, 0); PG8_LDB(B1, 1, 1); PG8_SCHED; PG8_LDA(At, 1, 0); PG8_STAGE_A(PG8_SA(0, 1), a2, o2[1]);
            PG8_WAIT_V(8); PG8_WAIT_L(0); PG8_BAR; PG8_MMA(0, 0, At, B0); if (!HALFN) PG8_MMA(0, 1, At, B1); PG8_BAR; PG8_SCHED;
            PG8_LDA(At, 1, 1); PG8_STAGE_B(PG8_SB(1, 0), b3, voffB); PG8_STAGE_B(PG8_SB(1, 1), b3 + hstep, voffB); PG8_STAGE_A(PG8_SA(1, 0), a3, o2[0]);
            PG8_WAIT_V(8); PG8_WAIT_L(0); PG8_BAR; PG8_MMA(1, 0, At, B0); if (!HALFN) PG8_MMA(1, 1, At, B1); PG8_BAR; PG8_SCHED;
        }
        if (wr == 0) PG8_BAR;
        { int frE = fr, fqE = fq; asm volatile("" : "+v"(frE), "+v"(fqE));
          E(acc, cur, wr, wc, frE, fqE); }
        if (!has_next) break;
#pragma unroll
        for (int a = 0; a < 2; ++a)
#pragma unroll
            for (int b = 0; b < 2; ++b)
#pragma unroll
                for (int m = 0; m < 4; ++m)
#pragma unroll
                    for (int n = 0; n < 2; ++n) acc[a][b][m][n] = (f32x4){0.f, 0.f, 0.f, 0.f};
        cur = nxt; cB = nB; cBh = nBh; ++ui;
#pragma unroll
        for (int h = 0; h < 2; ++h)
#pragma unroll
            for (int i = 0; i < 2; ++i) oC[h][i] = oN[h][i];
        if (wr == 1) PG8_BAR;
    }
    PG8_WAIT_V(0);
    PG8_BAR;
#undef PG8_SA
#undef PG8_SB
#undef PG8_STAGE_A
#undef PG8_STAGE_B
#undef PG8_BDMA
#undef PG8_LDA
#undef PG8_LDB
#undef PG8_MMA
#undef PG8_WAIT_V
#undef PG8_WAIT_L
#undef PG8_BAR
#undef PG8_SCHED
}
}

constexpr size_t WS_LR = 304 * MiB;
constexpr int SS_PARTS = 16;
constexpr int RING_BYTES = 131072  , LDSCTL_OFF = 139264  , MISC_OFF = LDSCTL_OFF + 320, MOETAB_OFF = LDSCTL_OFF + 1024;
constexpr int LDS_BYTES = 147456;
constexpr int MT_CNT = 0, MT_ALL = 64, MT_R0 = 64 + 65, MT_R1 = 64 + 65 + 33;
constexpr int PAIRTAB_OFF = LDSCTL_OFF + 6656;
constexpr int PT_CNT = 0, PT_ALL = NPAIR;

__device__ __forceinline__ f32x4 ldg4(const float* p) { return *(const f32x4*)p; }

struct MoeOrder {
    const bf16_t* A; const bf16_t* Bt; int K; int mode; const int* ltok; const LAS int* tab; int G, c;
    __device__ __forceinline__ bool next(int i, pg8::Unit& u) const {
        const int L = i * G + c;
        if (mode == 3) {
            const LAS int* pt = tab + (PAIRTAB_OFF - MOETAB_OFF) / 4;
            const int T = L >> 2; if (T >= pt[PT_ALL + NPAIR]) return false;
            int lo = 0;
#pragma unroll
            for (int s = 64; s >= 1; s >>= 1) if (lo + s < NPAIR && pt[PT_ALL + lo + s] <= T) lo += s;
            const int tile = T - pt[PT_ALL + lo]; u.pm = T; u.pn = L & 3; u.a0 = lo | (tile << 8); const int v = pt[PT_CNT + lo] - tile * 256; u.a1 = v < 256 ? v : 256; return true;
        }
        if (mode == 0) {
            const int T = L >> 1; if (T >= tab[MT_ALL + 64]) return false;
            int lo = 0;
#pragma unroll
            for (int s = 32; s >= 1; s >>= 1) if (tab[MT_ALL + lo + s] <= T) lo += s;
            const int tile = T - tab[MT_ALL + lo]; u.pm = T; u.pn = L & 1; u.a0 = lo | (tile << 8); const int v = tab[MT_CNT + lo] - tile * 256; u.a1 = v < 256 ? v : 256; return true;
        } else {
            const int T = L >> 2; const int tb = mode == 1 ? MT_R0 : MT_R1; if (T >= tab[tb + 32]) return false;
            int lo = 0;
#pragma unroll
            for (int s = 16; s >= 1; s >>= 1) if (tab[tb + lo + s] <= T) lo += s;
            const int list = 2 * lo + (mode - 1), tile = T - tab[tb + lo]; u.pm = tab[MT_ALL + list] + tile; u.pn = L & 3; u.a0 = list | (tile << 8);
            const int v = tab[MT_CNT + list] - tile * 256; u.a1 = v < 256 ? v : 256; return true;
        }
    }
    __device__ __forceinline__ const char* abase() const { return (const char*)A; }
    __device__ __forceinline__ unsigned arow(const pg8::Unit& u, int r) const {
        if (mode == 0) { const int list = u.a0 & 255, tile = u.a0 >> 8; const int tok = r < u.a1 ? ltok[(size_t)list * LIST_CAP + tile * 256 + r] : 0; return (unsigned)tok * (unsigned)(DM * 2); }
        if (mode == 3) return (unsigned)(u.pm * 256 + r) * (unsigned)(2 * EHID * 2);
        return (unsigned)(u.pm * 256 + r) * (unsigned)(EHID * 2);
    }
    __device__ __forceinline__ static void pair_experts(int p, int& elo, int& ehi) { const int g = p / 28; int q = p - g * 28, lo = 0;
#pragma unroll
        for (int k = 0; k < 7; ++k) if (q >= 7 - lo) { q -= 7 - lo; ++lo; }
        elo = g * 8 + lo; ehi = g * 8 + lo + 1 + q; }
    __device__ __forceinline__ int ldb() const { return EHID; }
    __device__ __forceinline__ const char* bbase2(const pg8::Unit& u) const { int elo, ehi; pair_experts(u.a0 & 255, elo, ehi); return (const char*)Bt + ((size_t)ehi * DM + u.pn * 256) * EHID * 2 - (size_t)EHID * 2; }
    __device__ __forceinline__ const char* bbase(const pg8::Unit& u) const {
        if (mode == 3) { int elo, ehi; pair_experts(u.a0 & 255, elo, ehi); return (const char*)Bt + ((size_t)elo * DM + u.pn * 256) * EHID * 2; }
        const int e = (u.a0 & 255) >> 1;
        if (mode == 0) return (const char*)Bt + ((size_t)e * 512 + u.pn * 256) * DM * 2;
        return (const char*)Bt + ((size_t)e * DM + u.pn * 256) * EHID * 2;
    }
};
__device__ __forceinline__ void moe_tables(unsigned char* ws, LAS int* tab) {
    LAS int* pt = tab + (PAIRTAB_OFF - MOETAB_OFF) / 4;
    if (threadIdx.x < 64) tab[MT_CNT + threadIdx.x] = (int)__hip_atomic_load((unsigned*)(ws + WS_CTL) + CW_CNT + 64 * threadIdx.x, __ATOMIC_RELAXED, __HIP_MEMORY_SCOPE_AGENT);
#ifndef DEBUG_NOPT
    else if (threadIdx.x < 64 + NPAIR) pt[PT_CNT + threadIdx.x - 64] = (int)__hip_atomic_load((unsigned*)(ws + WS_CTL) + CW_PCNT + 64 * (threadIdx.x - 64), __ATOMIC_RELAXED, __HIP_MEMORY_SCOPE_AGENT);
#endif
    __syncthreads();
#ifndef DEBUG_NOPT
    if (threadIdx.x == 64) { int a = 0; for (int l = 0; l < NPAIR; ++l) { pt[PT_ALL + l] = a; a += (pt[PT_CNT + l] + 255) >> 8; } pt[PT_ALL + NPAIR] = a; }
#endif
    if (threadIdx.x == 0) { int a = 0, r0 = 0, r1 = 0;
        for (int l = 0; l < 64; ++l) { const int t = (tab[MT_CNT + l] + 255) >> 8; tab[MT_ALL + l] = a; a += t; if (l & 1) { tab[MT_R1 + (l >> 1)] = r1; r1 += t; } else { tab[MT_R0 + (l >> 1)] = r0; r0 += t; } }
        tab[MT_ALL + 64] = a; tab[MT_R0 + 32] = r0; tab[MT_R1 + 32] = r1; }
    __syncthreads();
}

constexpr int GAINS_OFF = LDSCTL_OFF + 4096;
struct EpiInProj {
    unsigned char* ws; const LAS float* gl; bool stub;
    __device__ __forceinline__ void operator()(const f32x4 (&acc)[2][2][4][2], const pg8::Unit& u, int wr, int wc, int fr, int fq) const {
#ifdef PROBE_STUB_EPI
        if (stub) { const float t = acc[0][0][0][0][0] + acc[1][1][3][1][3];
            if (t == 12345.678f) ((float*)(ws + WS_SS))[threadIdx.x] = t; return; }
#endif
        const int seg = u.pn >> 1, gi = ((u.pn & 1) << 2) | wc, b = u.pm >> 3, blk = u.pm & 7;
        const bool nrm = (seg != 2 && seg != 5);
        const LAS float* gp = gl + 64 * (seg == 0 ? 0 : seg == 1 ? 1 : seg == 3 ? 2 : 3);
        const float qs = (seg == 0 || seg == 3) ? C2 : 1.0f;
        f32x4 g[2][2];
#pragma unroll
        for (int bj = 0; bj < 2; ++bj)
#pragma unroll
            for (int n = 0; n < 2; ++n) g[bj][n] = nrm ? *(const LAS f32x4*)(gp + 32 * bj + 8 * fq + 4 * n) * qs : (f32x4){1.f, 1.f, 1.f, 1.f};
        bf16_t* base; size_t rstride;
        if (seg < 2) { base = (bf16_t*)(ws + (seg == 0 ? WS_QD : WS_KD)) + ((size_t)((b * 4 + (gi >> 1)) * 2 + (gi & 1)) * SEQ + blk * 256) * 64; rstride = 64; }
        else if (seg == 2) { base = (bf16_t*)(ws + WS_VD) + ((size_t)(b * 4 + (gi >> 1)) * SEQ + blk * 256) * 128 + (gi & 1) * 64; rstride = 128; }
        else { base = (bf16_t*)(ws + (seg == 3 ? WS_QM : seg == 4 ? WS_KM : WS_VM)) + ((size_t)(b * 8 + gi) * SEQ + blk * 256) * 64; rstride = 64; }
        int cRT = 4096, cBJ = 32, cRK = 64, cFQ = 8; bf16_t* basex = base;
        if (seg == 1 || seg == 4) { cBJ = 2048; cRK = 8; cFQ = 512; }
        else if (seg == 5) { cBJ = 2048; cRK = 32; }
        else if (seg == 2) { cRT = 8192; cBJ = 2048; cRK = 32; basex = base - (gi & 1) * 64 + (gi & 1) * 4096; }
        const int lane_off = fr * cRK + fq * cFQ;
        f32x4 ks[2][2];
#pragma unroll
        for (int bj = 0; bj < 2; ++bj)
#pragma unroll
            for (int n = 0; n < 2; ++n) ks[bj][n] = (f32x4){0.f, 0.f, 0.f, 0.f};
#pragma unroll
        for (int ai = 0; ai < 2; ++ai)
#pragma unroll
            for (int m = 0; m < 4; ++m) {
                const int r = 128 * ai + 64 * wr + 16 * m + fr;
                f32x4 v[2][2]; float ss = 0.f;
#pragma unroll
                for (int bj = 0; bj < 2; ++bj)
#pragma unroll
                    for (int n = 0; n < 2; ++n) { v[bj][n] = acc[ai][bj][m][n]; ss += (v[bj][n][0] * v[bj][n][0] + v[bj][n][1] * v[bj][n][1]) + (v[bj][n][2] * v[bj][n][2] + v[bj][n][3] * v[bj][n][3]); }
                float rs = 1.f;
                if (nrm) { ss += __shfl_xor(ss, 16); ss += __shfl_xor(ss, 32); rs = rsqrtf(ss * (1.f / 64.f) + RMS_EPS); }
#pragma unroll
                for (int bj = 0; bj < 2; ++bj) {
                    const f32x4 a = v[bj][0] * rs * g[bj][0], c = v[bj][1] * rs * g[bj][1];
                    if (seg == 4) { ks[bj][0] += a; ks[bj][1] += c; }
                    v4u w; w.x = pg8::cvt_pk_bf16(a[0], a[1]); w.y = pg8::cvt_pk_bf16(a[2], a[3]); w.z = pg8::cvt_pk_bf16(c[0], c[1]); w.w = pg8::cvt_pk_bf16(c[2], c[3]);
                    *(v4u*)(basex + ((2 * ai + wr) * cRT + 16 * m * cRK + bj * cBJ) + lane_off) = w;
                }
            }
        if (seg == 4) {
            float* km = (float*)(ws + WS_KMEAN) + (((size_t)(b * 8 + blk) * 2 + wr) * 8 + gi) * 64;
#pragma unroll
            for (int bj = 0; bj < 2; ++bj)
#pragma unroll
                for (int n = 0; n < 2; ++n) { f32x4 s = ks[bj][n];
#pragma unroll
                    for (int j = 0; j < 4; ++j) { float t = s[j]; t += __shfl_xor(t, 1); t += __shfl_xor(t, 2); t += __shfl_xor(t, 4); t += __shfl_xor(t, 8); s[j] = t; }
                    if (fr == 0) *(f32x4*)(km + 32 * bj + 8 * fq + 4 * n) = s; }
        }
    }
};

struct EpiOutProj {
    unsigned char* ws; const float* x;
    __device__ __forceinline__ void operator()(const f32x4 (&acc)[2][2][4][2], const pg8::Unit& u, int wr, int wc, int fr, int fq) const {
        bf16_t* X1B = (bf16_t*)(ws + WS_X1B); float* SS = (float*)(ws + WS_SS);
#pragma unroll
        for (int ai = 0; ai < 2; ++ai) {
            f32x4 xv[4][2][2];
#pragma unroll
            for (int m = 0; m < 4; ++m)
#pragma unroll
                for (int bj = 0; bj < 2; ++bj) { const size_t off = ((size_t)u.pm * 256 + 128 * ai + 64 * wr + 16 * m + fr) * DM + u.pn * 256 + 128 * bj + 32 * wc + 8 * fq;
                    xv[m][bj][0] = ldg4(x + off); xv[m][bj][1] = ldg4(x + off + 4); }
#pragma unroll
            for (int m = 0; m < 4; ++m) {
                const size_t row = (size_t)u.pm * 256 + 128 * ai + 64 * wr + 16 * m + fr; float ss = 0.f;
#pragma unroll
                for (int bj = 0; bj < 2; ++bj) {
                    const size_t off = row * DM + u.pn * 256 + 128 * bj + 32 * wc + 8 * fq;
                    const f32x4 a = acc[ai][bj][m][0] + xv[m][bj][0], c = acc[ai][bj][m][1] + xv[m][bj][1];
                    ss += (a[0] * a[0] + a[1] * a[1]) + (a[2] * a[2] + a[3] * a[3]) + (c[0] * c[0] + c[1] * c[1]) + (c[2] * c[2] + c[3] * c[3]);
                    v4u w; w.x = pg8::cvt_pk_bf16(a[0], a[1]); w.y = pg8::cvt_pk_bf16(a[2], a[3]); w.z = pg8::cvt_pk_bf16(c[0], c[1]); w.w = pg8::cvt_pk_bf16(c[2], c[3]);
                    *(v4u*)(X1B + off) = w;
                }
                ss += __shfl_xor(ss, 16); ss += __shfl_xor(ss, 32);
                if (fq == 0) SS[row * SS_PARTS + u.pn * 4 + wc] = ss;
            }
        }
    }
};

constexpr int ROUTE_OFF = LDSCTL_OFF + 2048;
struct EpiRoute {
    unsigned char* ws; LAS unsigned char* lds;
    __device__ __forceinline__ void operator()(const f32x4 (&acc)[2][2][4][2], const pg8::Unit& u, int wr, int wc, int fr, int fq) const {
        const float* SS = (const float*)(ws + WS_SS);
        LAS int* lcount = (LAS int*)(lds + ROUTE_OFF); LAS int* lbase = lcount + 64; LAS int* pcount = lcount + 128; LAS int* pbase = pcount + NPAIR;
        unsigned* CTL = (unsigned*)(ws + WS_CTL); int* LTOK = (int*)(ws + WS_LTOK); float* LW = (float*)(ws + WS_LW); float* LR = (float*)(ws + WS_LR); int* LP = (int*)(ws + WS_LP); int* PTOK = (int*)(ws + WS_PTOK);
        if (threadIdx.x < 64) lcount[threadIdx.x] = 0; else if (threadIdx.x < 64 + NPAIR) pcount[threadIdx.x - 64] = 0;
        asm volatile("s_waitcnt lgkmcnt(0)" ::: "memory"); __builtin_amdgcn_s_barrier(); asm volatile("" ::: "memory");
        int l0v[2][4], p0v[2][4], l1v[2][4], p1v[2][4], prv[2][4], ppv[2][4]; float w0v[2][4], w1v[2][4], r2v[2][4];
#pragma unroll
        for (int ai = 0; ai < 2; ++ai)
#pragma unroll
            for (int m = 0; m < 4; ++m) {
                const int row = u.pm * 256 + 128 * ai + 64 * wr + 16 * m + fr;
                const f32x4 e0 = acc[ai][0][m][0], e1 = acc[ai][0][m][1];
                float gl[4];
#pragma unroll
                for (int j = 0; j < 4; ++j) gl[j] = __shfl_down(e0[j], 16);
                int g = 0; float gv = gl[0];
#pragma unroll
                for (int i = 1; i < 4; ++i) if (gl[i] > gv) { gv = gl[i]; g = i; }
                l0v[ai][m] = -1; p0v[ai][m] = 0; l1v[ai][m] = 0; p1v[ai][m] = 0; prv[ai][m] = 0; ppv[ai][m] = 0; w0v[ai][m] = 0.f; w1v[ai][m] = 0.f; r2v[ai][m] = 0.f;
                if (fq == 0 && g == wc) {
                    const float* sp = SS + (size_t)row * SS_PARTS; const f32x4 s0 = ldg4(sp), s1 = ldg4(sp + 4), s2 = ldg4(sp + 8), s3 = ldg4(sp + 12);
                    const float tot = ((s0[0] + s0[1]) + (s0[2] + s0[3])) + ((s1[0] + s1[1]) + (s1[2] + s1[3])) + ((s2[0] + s2[1]) + (s2[2] + s2[3])) + ((s3[0] + s3[1]) + (s3[2] + s3[3]));
                    const float r2 = rsqrtf(tot * (1.f / DM) + RMS_EPS);
                    const float el[8] = {e0[0], e0[1], e0[2], e0[3], e1[0], e1[1], e1[2], e1[3]};
                    const float mx = fmaxf(fmaxf(gl[0], gl[1]), fmaxf(gl[2], gl[3])) * r2;
                    const float den = (__expf(gl[0] * r2 - mx) + __expf(gl[1] * r2 - mx)) + (__expf(gl[2] * r2 - mx) + __expf(gl[3] * r2 - mx));
                    const float pg = __expf(gv * r2 - mx) / den;
                    float v0 = el[0]; int x0 = 0;
#pragma unroll
                    for (int i = 1; i < 8; ++i) if (el[i] > v0) { v0 = el[i]; x0 = i; }
                    float v1 = -3.0e38f; int x1 = 0;
#pragma unroll
                    for (int i = 0; i < 8; ++i) if (i != x0 && el[i] > v1) { v1 = el[i]; x1 = i; }
                    const float w0 = 1.f / (1.f + __expf((v1 - v0) * r2));
                    const int l0 = (g * 8 + x0) * 2, l1 = (g * 8 + x1) * 2 + 1;
                    l0v[ai][m] = l0; l1v[ai][m] = l1; w0v[ai][m] = pg * w0; w1v[ai][m] = pg * (1.f - w0); r2v[ai][m] = r2;
                    p0v[ai][m] = atomicAdd((int*)(lcount + l0), 1); p1v[ai][m] = atomicAdd((int*)(lcount + l1), 1);
                    { const int lo = x0 < x1 ? x0 : x1, hi = x0 < x1 ? x1 : x0, pr = g * 28 + ((lo * (15 - lo)) >> 1) + (hi - lo - 1);
                      prv[ai][m] = pr | ((x0 > x1 ? 1 : 0) << 7); ppv[ai][m] = atomicAdd((int*)(pcount + pr), 1); }
                }
            }
        asm volatile("s_waitcnt lgkmcnt(0)" ::: "memory"); __builtin_amdgcn_s_barrier(); asm volatile("" ::: "memory");
        if (threadIdx.x < 64) lbase[threadIdx.x] = (int)atomicAdd(CTL + CW_CNT + 64 * threadIdx.x, (unsigned)lcount[threadIdx.x]);
        else if (threadIdx.x < 64 + NPAIR) { const int pq = threadIdx.x - 64; pbase[pq] = (int)atomicAdd(CTL + CW_PCNT + 64 * pq, (unsigned)pcount[pq]); }
        asm volatile("s_waitcnt vmcnt(0) lgkmcnt(0)" ::: "memory"); __builtin_amdgcn_s_barrier(); asm volatile("" ::: "memory");
#pragma unroll
        for (int ai = 0; ai < 2; ++ai)
#pragma unroll
            for (int m = 0; m < 4; ++m) if (l0v[ai][m] >= 0) {
                const int row = u.pm * 256 + 128 * ai + 64 * wr + 16 * m + fr;
                const size_t a0 = (size_t)l0v[ai][m] * LIST_CAP + lbase[l0v[ai][m]] + p0v[ai][m], a1 = (size_t)l1v[ai][m] * LIST_CAP + lbase[l1v[ai][m]] + p1v[ai][m];
                LTOK[a0] = row; LW[a0] = w0v[ai][m]; LR[a0] = r2v[ai][m]; LTOK[a1] = row; LW[a1] = w1v[ai][m]; LR[a1] = r2v[ai][m];
                { const int pr = prv[ai][m] & 127, h0 = (prv[ai][m] >> 7) & 1, ps = pbase[pr] + ppv[ai][m];
                  PTOK[(size_t)pr * LIST_CAP + ps] = row; LP[a0] = pr | (h0 << 7) | (ps << 8); LP[a1] = pr | ((h0 ^ 1) << 7) | (ps << 8); }
            }
    }
};

struct EpiGateUp {
    unsigned char* ws; const LAS int* tab;
    __device__ __forceinline__ void operator()(const f32x4 (&acc)[2][2][4][2], const pg8::Unit& u, int wr, int wc, int fr, int fq) const {
#ifdef DEBUG_NOEPI5
        return;
#endif
        const int list = u.a0 & 255, tile = u.a0 >> 8; const size_t eb = (size_t)list * LIST_CAP + tile * 256;
        const float* LR = (const float*)(ws + WS_LR) + eb; const float* LW = (const float*)(ws + WS_LW) + eb; const int* LP = (const int*)(ws + WS_LP) + eb;
        const LAS int* pt = tab + (PAIRTAB_OFF - MOETAB_OFF) / 4;
        bf16_t* HID = (bf16_t*)(ws + WS_HID2);
        float r2v[2][4], wv[2][4]; int lpv[2][4];
#pragma unroll
        for (int ai = 0; ai < 2; ++ai)
#pragma unroll
            for (int m = 0; m < 4; ++m) { const int r = 128 * ai + 64 * wr + 16 * m + fr, rc = r < u.a1 ? r : u.a1 - 1; r2v[ai][m] = LR[rc]; wv[ai][m] = LW[rc]; lpv[ai][m] = LP[rc]; }
#pragma unroll
        for (int ai = 0; ai < 2; ++ai)
#pragma unroll
            for (int m = 0; m < 4; ++m) {
                const int r = 128 * ai + 64 * wr + 16 * m + fr;
                const float r2 = r2v[ai][m], wt = wv[ai][m]; float h[8];
                const int lp = lpv[ai][m]; const size_t drow = (size_t)pt[PT_ALL + (lp & 127)] * 256 + (size_t)(lp >> 8);
#pragma unroll
                for (int n = 0; n < 2; ++n)
#pragma unroll
                    for (int j = 0; j < 4; ++j) { const float G = acc[ai][0][m][n][j] * r2, U = acc[ai][1][m][n][j] * r2;
                        h[4 * n + j] = G * __builtin_amdgcn_rcpf(1.f + __builtin_amdgcn_exp2f(-G * LOG2E)) * U * wt; }
                v4u w; w.x = pg8::cvt_pk_bf16(h[0], h[1]); w.y = pg8::cvt_pk_bf16(h[2], h[3]); w.z = pg8::cvt_pk_bf16(h[4], h[5]); w.w = pg8::cvt_pk_bf16(h[6], h[7]);
#ifdef DEBUG_NOHIDW
                if (r < u.a1 && drow < 95000) *(v4u*)(HID + drow * (2 * EHID) + ((lp >> 7) & 1) * EHID + u.pn * 128 + 32 * wc + 8 * fq) = w;
#else
                if (r < u.a1) *(v4u*)(HID + drow * (2 * EHID) + ((lp >> 7) & 1) * EHID + u.pn * 128 + 32 * wc + 8 * fq) = w;
#endif
            }
    }
};

struct EpiDownPair {
    unsigned char* ws; float* out;
    __device__ __forceinline__ void operator()(const f32x4 (&acc)[2][2][4][2], const pg8::Unit& u, int wr, int wc, int fr, int fq) const {
        const int pr = u.a0 & 255, tile = u.a0 >> 8; const int* PTOK = (const int*)(ws + WS_PTOK) + (size_t)pr * LIST_CAP + tile * 256;
        const bf16_t* SRC = (const bf16_t*)(ws + WS_X1B);
        int tokv[2][4];
#pragma unroll
        for (int ai = 0; ai < 2; ++ai)
#pragma unroll
            for (int m = 0; m < 4; ++m) { const int r = 128 * ai + 64 * wr + 16 * m + fr, rc = r < u.a1 ? r : u.a1 - 1; tokv[ai][m] = PTOK[rc]; }
#pragma unroll
        for (int ai = 0; ai < 2; ++ai) {
            v4u bs[4][2];
#pragma unroll
            for (int m = 0; m < 4; ++m)
#pragma unroll
                for (int bj = 0; bj < 2; ++bj) bs[m][bj] = *(const v4u*)(SRC + (size_t)tokv[ai][m] * DM + u.pn * 256 + 128 * bj + 32 * wc + 8 * fq);
#pragma unroll
            for (int m = 0; m < 4; ++m) {
                const int r = 128 * ai + 64 * wr + 16 * m + fr; const bool ok = r < u.a1;
#pragma unroll
                for (int bj = 0; bj < 2; ++bj) {
                    const size_t off = (size_t)tokv[ai][m] * DM + u.pn * 256 + 128 * bj + 32 * wc + 8 * fq; const v4u b4 = bs[m][bj];
                    f32x4 a, c;
                    a[0] = __uint_as_float(b4.x << 16); a[1] = __uint_as_float(b4.x & 0xffff0000u); a[2] = __uint_as_float(b4.y << 16); a[3] = __uint_as_float(b4.y & 0xffff0000u);
                    c[0] = __uint_as_float(b4.z << 16); c[1] = __uint_as_float(b4.z & 0xffff0000u); c[2] = __uint_as_float(b4.w << 16); c[3] = __uint_as_float(b4.w & 0xffff0000u);
                    a += acc[ai][bj][m][0]; c += acc[ai][bj][m][1];
                    if (ok) { if (DBG_MEASURE) { const float sc_ = 1.0f + ((const float*)(ws + WS_CONST))[CF_DBG]; a *= sc_; c *= sc_; } *(f32x4*)(out + off) = a; *(f32x4*)(out + off + 4) = c; }
                }
            }
        }
    }
};

template <int RK> struct EpiDown {
    unsigned char* ws; float* out;
    __device__ __forceinline__ void operator()(const f32x4 (&acc)[2][2][4][2], const pg8::Unit& u, int wr, int wc, int fr, int fq) const {
        const int list = u.a0 & 255, tile = u.a0 >> 8; const size_t eb = (size_t)list * LIST_CAP + tile * 256;
        const int* LTOK = (const int*)(ws + WS_LTOK) + eb; const float* LW = (const float*)(ws + WS_LW) + eb;
        const bf16_t* SRC = (const bf16_t*)(ws + (RK == 0 ? WS_X1B : WS_PA)); bf16_t* PA = (bf16_t*)(ws + WS_PA);
        int tokv[2][4]; float wv[2][4];
#pragma unroll
        for (int ai = 0; ai < 2; ++ai)
#pragma unroll
            for (int m = 0; m < 4; ++m) { const int r = 128 * ai + 64 * wr + 16 * m + fr, rc = r < u.a1 ? r : u.a1 - 1; tokv[ai][m] = LTOK[rc]; wv[ai][m] = LW[rc]; }
#pragma unroll
        for (int ai = 0; ai < 2; ++ai) {
            v4u bs[4][2];
#pragma unroll
            for (int m = 0; m < 4; ++m)
#pragma unroll
                for (int bj = 0; bj < 2; ++bj) bs[m][bj] = *(const v4u*)(SRC + (size_t)tokv[ai][m] * DM + u.pn * 256 + 128 * bj + 32 * wc + 8 * fq);
#pragma unroll
            for (int m = 0; m < 4; ++m) {
                const int r = 128 * ai + 64 * wr + 16 * m + fr; const bool ok = r < u.a1; const float wt = wv[ai][m];
#pragma unroll
                for (int bj = 0; bj < 2; ++bj) {
                    const size_t off = (size_t)tokv[ai][m] * DM + u.pn * 256 + 128 * bj + 32 * wc + 8 * fq; const v4u b4 = bs[m][bj];
                    f32x4 a, c;
                    a[0] = __uint_as_float(b4.x << 16); a[1] = __uint_as_float(b4.x & 0xffff0000u); a[2] = __uint_as_float(b4.y << 16); a[3] = __uint_as_float(b4.y & 0xffff0000u);
                    c[0] = __uint_as_float(b4.z << 16); c[1] = __uint_as_float(b4.z & 0xffff0000u); c[2] = __uint_as_float(b4.w << 16); c[3] = __uint_as_float(b4.w & 0xffff0000u);
                    a += acc[ai][bj][m][0] * wt; c += acc[ai][bj][m][1] * wt;
                    if (ok) {
                        if (RK == 0) { v4u w; w.x = pg8::cvt_pk_bf16(a[0], a[1]); w.y = pg8::cvt_pk_bf16(a[2], a[3]); w.z = pg8::cvt_pk_bf16(c[0], c[1]); w.w = pg8::cvt_pk_bf16(c[2], c[3]); *(v4u*)(PA + off) = w; }
                        else { if (DBG_MEASURE) { const float sc_ = 1.0f + ((const float*)(ws + WS_CONST))[CF_DBG]; a *= sc_; c *= sc_; } *(f32x4*)(out + off) = a; *(f32x4*)(out + off + 4) = c; }
                    }
                }
            }
        }
    }
};

#define HAVE_ATTN 1
namespace att {
typedef short bf16x8 __attribute__((ext_vector_type(8)));
typedef short s16x4 __attribute__((ext_vector_type(4)));
typedef short v4i16_t __attribute__((ext_vector_type(4)));
typedef float f32x16 __attribute__((ext_vector_type(16)));
constexpr int TBL_STRIDE = 2384;
constexpr int TBL_BYTES = 38912, SLOT_OFF = TBL_BYTES, NSLOT = 3, STAGE_OFF = SLOT_OFF + 65536  , WSCR_OFF = SLOT_OFF + NSLOT * 32768, ATT_LDS = WSCR_OFF + 2048;
static_assert(4 * TBL_STRIDE * 4 <= TBL_BYTES && ATT_LDS <= LDSCTL_OFF, "attention LDS map");
constexpr float NEGBIG = -1.0e30f;
constexpr int KMEAN_OFF = LDSCTL_OFF + 4608;
__device__ __forceinline__ int crow(int r, int hi) { return (r & 3) + 8 * (r >> 2) + 4 * hi; }
__device__ __forceinline__ s16x4 vtr(const LAS unsigned char* p) { return __builtin_bit_cast(s16x4, __builtin_amdgcn_ds_read_tr16_b64_v4i16((LAS v4i16_t*)p)); }
__device__ __forceinline__ void glds16(const void* gsrc, unsigned lds_dst) { unsigned keep;
    asm volatile("s_mov_b32 %0, m0\n\ts_mov_b32 m0, %2\n\ts_nop 0\n\tglobal_load_lds_dwordx4 %1, off\n\ts_mov_b32 m0, %0" : "=&s"(keep) : "v"(gsrc), "s"(lds_dst) : "memory"); }
__device__ __forceinline__ void bdma16(__amdgpu_buffer_rsrc_t srd, unsigned voff, unsigned soff, unsigned lds_dst) {
    asm volatile("s_mov_b32 m0, %0\n\ts_nop 0\n\tbuffer_load_dwordx4 %1, %2, %3 offen lds" :: "s"(lds_dst), "v"(voff), "s"(srd), "s"(soff) : "m0", "memory"); }
__device__ __forceinline__ unsigned cvtpk(float lo, float hi) { typedef float f2 __attribute__((ext_vector_type(2))); typedef __bf16 b2 __attribute__((ext_vector_type(2))); f2 v = {lo, hi}; b2 b = __builtin_convertvector(v, b2); return __builtin_bit_cast(unsigned, b); }

__device__ __forceinline__ void build_table(LAS unsigned char* lds, const float* CF, int h12) {
    LAS float* tb = (LAS float*)lds; const float* BT = CF + CF_BT + h12 * 2048; const float off = CF[CF_OFF + h12];
    for (int idx = threadIdx.x; idx < 4 * TBL_STRIDE; idx += 512) { const int s = idx / TBL_STRIDE, i = idx - s * TBL_STRIDE, j = i + s; tb[idx] = j <= 2047 ? BT[2047 - j] - off : NEGBIG; }
}

template <int NK> __device__ __forceinline__ void epilogue(LAS unsigned char* lds, unsigned char* ws, const Inputs& in, int b, int h, int w, int map, int rb, int qw0, int lane_in, float lsum, att::f32x16 (&o)[NK == 2 ? 4 : 2]) {
    constexpr int ND = NK == 2 ? 4 : 2;
    int lane = lane_in; asm volatile("" : "+v"(lane));
    const int r32 = lane & 31, hi = lane >> 5;
    const float* CF = (const float*)(ws + WS_CONST);
    LAS float* wsf = (LAS float*)(lds + WSCR_OFF) + w * 64;
    if (hi == 0) wsf[r32] = lsum;
    asm volatile("s_waitcnt lgkmcnt(0)" ::: "memory");
    float rli[16];
#pragma unroll
    for (int r = 0; r < 16; ++r) rli[r] = __builtin_amdgcn_rcpf(wsf[crow(r, hi)]);
    bf16_t* Y = (bf16_t*)(ws + WS_Y);
    if (NK == 1) {
        LAS bf16_t* stg = (LAS bf16_t*)(lds + STAGE_OFF) + w * 2048;
#pragma unroll
        for (int r = 0; r < 16; ++r) { const int orow = crow(r, hi);
#pragma unroll
            for (int d0 = 0; d0 < ND; ++d0) stg[orow * 64 + d0 * 32 + r32] = (bf16_t)f2bf(o[d0][r] * rli[r]); }
        asm volatile("s_waitcnt lgkmcnt(0)" ::: "memory");
        bf16_t* Yw = Y + (size_t)(b * SEQ + qw0) * DM + 512 + h * 64;
#pragma unroll
        for (int i = 0; i < 4; ++i) { const int row = i * 8 + (lane >> 3), ch = lane & 7; const v4u v = *(const LAS v4u*)(stg + row * 64 + ch * 8); *(v4u*)(Yw + (size_t)row * DM + ch * 8) = v; }
    } else {
        LAS float* X = (LAS float*)(lds + SLOT_OFF) + (size_t)rb * 32 * 128;
        const float lam = CF[CF_LAMBDA];
        if (map == 1) {
#pragma unroll
            for (int r = 0; r < 16; ++r) { const int orow = crow(r, hi); const float f = rli[r] * lam;
#pragma unroll
                for (int d0 = 0; d0 < ND; ++d0) X[orow * 128 + d0 * 32 + r32] = o[d0][r] * f; }
        }
        asm volatile("s_waitcnt lgkmcnt(0)" ::: "memory"); __syncthreads();
        if (map == 0) {
            float gsub[ND];
#pragma unroll
            for (int d0 = 0; d0 < ND; ++d0) gsub[d0] = in.diff_sub_g[d0 * 32 + r32];
            LAS bf16_t* stg = (LAS bf16_t*)(lds + STAGE_OFF) + rb * 4096;
#pragma unroll
            for (int r = 0; r < 16; ++r) { const int orow = crow(r, hi); float v[ND]; float ss = 0.f;
#pragma unroll
                for (int d0 = 0; d0 < ND; ++d0) { v[d0] = o[d0][r] * rli[r] - X[orow * 128 + d0 * 32 + r32]; ss += v[d0] * v[d0]; }
                ss += __shfl_xor(ss, 1); ss += __shfl_xor(ss, 2); ss += __shfl_xor(ss, 4); ss += __shfl_xor(ss, 8); ss += __shfl_xor(ss, 16);
                const float sc2 = rsqrtf(ss * (1.f / 128.f) + RMS_EPS) * (1.f - LAMBDA_INIT);
#pragma unroll
                for (int d0 = 0; d0 < ND; ++d0) stg[orow * 128 + d0 * 32 + r32] = (bf16_t)f2bf(v[d0] * sc2 * gsub[d0]); }
            asm volatile("s_waitcnt lgkmcnt(0)" ::: "memory");
            bf16_t* Yw = Y + (size_t)(b * SEQ + qw0) * DM + h * 128;
#pragma unroll
            for (int i = 0; i < 8; ++i) { const int row = i * 4 + (lane >> 4), ch = lane & 15; const v4u v = *(const LAS v4u*)(stg + row * 128 + ch * 8); *(v4u*)(Yw + (size_t)row * DM + ch * 8) = v; }
        }
    }
    asm volatile("s_waitcnt lgkmcnt(0)" ::: "memory"); __builtin_amdgcn_s_barrier(); asm volatile("" ::: "memory");
}


template <int NK, int ABL> __device__ __forceinline__ void attn_unit(LAS unsigned char* lds, unsigned char* ws, const Inputs& in, int b, int h, int qb, bool stage_km) {
    constexpr int DV = NK == 2 ? 128 : 64, ND = DV / 32, ROWS = NK == 2 ? 128 : 256, SLOTB = NK == 2 ? 32768 : 16384, VOFF = 8192 * NK;
    const int tid = threadIdx.x; int lane_ = tid & 63; asm volatile("" : "+v"(lane_));
    const int lane = lane_, r32 = lane & 31, hi = lane >> 5; const int w = __builtin_amdgcn_readfirstlane(tid >> 6);
    const int map = NK == 2 ? (w >> 2) : 0, rb = NK == 2 ? (w & 3) : w;
    const int q0 = qb * ROWS, qw0 = q0 + 32 * rb, qabs = qw0 + r32, NT = (q0 + ROWS) / 64;
    const float* CF = (const float*)(ws + WS_CONST);
    const bf16_t *Qh, *Kh0, *Kh1, *Vh;
    if (NK == 2) { const size_t hb = (size_t)(b * 4 + h) * 2; Qh = (const bf16_t*)(ws + WS_QD) + (hb + map) * SEQ * 64; Kh0 = (const bf16_t*)(ws + WS_KD) + hb * SEQ * 64; Kh1 = Kh0 + (size_t)SEQ * 64;
                   Vh = (const bf16_t*)(ws + WS_VD) + (size_t)(b * 4 + h) * SEQ * 128; }
    else { const size_t hb = (size_t)(b * 8 + h); Qh = (const bf16_t*)(ws + WS_QM) + hb * SEQ * 64; Kh0 = (const bf16_t*)(ws + WS_KM) + hb * SEQ * 64; Kh1 = Kh0; Vh = (const bf16_t*)(ws + WS_VM) + hb * SEQ * 64; }
    const __amdgpu_buffer_rsrc_t srdK = __builtin_amdgcn_make_buffer_rsrc((void*)Kh0, (short)0, NK * SEQ * 64 * 2, 0x00020000);
    const __amdgpu_buffer_rsrc_t srdV = __builtin_amdgcn_make_buffer_rsrc((void*)Vh, (short)0, SEQ * DV * 2, 0x00020000);
    const unsigned voff = (unsigned)w * 1024u + (unsigned)lane * 16u;
    constexpr int KSB = 8192 * NK, VSB = 128 * DV, KRING = SLOT_OFF, VRING = SLOT_OFF + 49152;
    const unsigned kdst = (unsigned)(uintptr_t)(lds + KRING) + (unsigned)w * 1024u, vdst = (unsigned)(uintptr_t)(lds + VRING) + (unsigned)w * 1024u;
#define ATT_DMAK(t, off) do { if (ABL & 16) break; const unsigned d_ = (unsigned)__builtin_amdgcn_readfirstlane(kdst + (unsigned)(off)); const unsigned o_ = (unsigned)(t) * 8192u; bdma16(srdK, voff, o_, d_); if (NK == 2) bdma16(srdK, voff, o_ + (unsigned)(SEQ * 64 * 2), d_ + 8192u); } while (0)
#define ATT_DMAV(t, off) do { if (ABL & 16) break; const unsigned d_ = (unsigned)__builtin_amdgcn_readfirstlane(vdst + (unsigned)(off)); const unsigned o_ = (unsigned)(t) * (unsigned)(128 * DV); bdma16(srdV, voff, o_, d_); if (NK == 2) bdma16(srdV, voff, o_ + 8192u, d_ + 8192u); } while (0)
    if (NK == 1) { ATT_DMAK(0, 0); ATT_DMAV(0, 0); ATT_DMAK(1, KSB); ATT_DMAV(1, VSB); ATT_DMAK(2, 2 * KSB); ATT_DMAV(2, 2 * VSB); ATT_DMAK(3, 3 * KSB); ATT_DMAV(3, 3 * VSB); if (NT > 4) ATT_DMAK(4, 4 * KSB); }
    else { ATT_DMAK(0, 0); ATT_DMAV(0, 0); ATT_DMAK(1, KSB); }
    bf16x8 qr[4];
#pragma unroll
    for (int d0 = 0; d0 < 4; ++d0) qr[d0] = *(const bf16x8*)(Qh + (size_t)qabs * 64 + d0 * 16 + hi * 8);
    if (NK == 1 && stage_km) { const int n = tid >> 6, d = tid & 63;
        if (n < qb) { const float* k0 = (const float*)(ws + WS_KMEAN) + (((size_t)(b * 8 + n) * 2 + 0) * 8 + h) * 64 + d; const float v = k0[0] + k0[512];
            const unsigned hb = f2bf(v); const float lo = v - bf2f((bf16_t)hb);
            ((LAS bf16_t*)(lds + KMEAN_OFF))[n * 64 + d] = (bf16_t)hb; ((LAS bf16_t*)(lds + KMEAN_OFF + 1024))[n * 64 + d] = (bf16_t)f2bf(lo); } }
#pragma unroll
    for (int d0 = 0; d0 < 4; ++d0) asm volatile("" : "+v"(qr[d0]));
    asm volatile("s_waitcnt vmcnt(0)" ::: "memory"); __syncthreads();
    unsigned selmask = 0xffffffffu;
    if (NK == 1 && qb > 0) {
        float gate[8];
        { f32x16 G = {}; const LAS unsigned char* kmh = lds + KMEAN_OFF + (r32 & 7) * 128 + hi * 16;
#pragma unroll
          for (int d0 = 0; d0 < 4; ++d0) { const bf16x8 ah = *(const LAS bf16x8*)(kmh + d0 * 32), al = *(const LAS bf16x8*)(kmh + 1024 + d0 * 32);
              G = __builtin_amdgcn_mfma_f32_32x32x16_bf16(ah, qr[d0], G, 0, 0, 0); G = __builtin_amdgcn_mfma_f32_32x32x16_bf16(al, qr[d0], G, 0, 0, 0); }
#pragma unroll
          for (int r = 0; r < 4; ++r) { const float mine = G[r], oth = __shfl_xor(mine, 32); gate[r] = hi ? oth : mine; gate[4 + r] = hi ? mine : oth; } }
        selmask = 0u;
#pragma unroll
        for (int n = 0; n < 8; ++n) { int better = 0;
#pragma unroll
            for (int m = 0; m < 8; ++m) if (m != n) better += (m < qb && (gate[m] > gate[n] || (gate[m] == gate[n] && m < n))) ? 1 : 0;
            if (n < qb && better < 3) selmask |= 1u << n; }
        selmask |= 1u << qb;
    }
    const int j0 = 2047 - qabs + 4 * hi, sc = j0 & 3;
    const LAS unsigned char* tb_base = lds + (sc * TBL_STRIDE + (j0 - sc)) * 4;
    const LAS unsigned char* tb_neg = lds + (sc * TBL_STRIDE + 2052) * 4;
    const LAS unsigned char* kp0 = lds + KRING + map * 8192 + hi * 1024 + r32 * 16;
    const LAS unsigned char* vp0 = lds + VRING + ((lane >> 4) & 1) * 32 + (lane & 3) * 8 + (4 * hi + ((lane & 15) >> 2)) * 64;
    f32x16 o[ND];
#pragma unroll
    for (int d = 0; d < ND; ++d) o[d] = f32x16{};
    float ls0 = 0.f, ls1 = 0.f;
    const int NTw = (qw0 + 31) / 64 + 1 < NT ? (qw0 + 31) / 64 + 1 : NT;
#define SBAR() __builtin_amdgcn_sched_barrier(0)
#define MFMA32(a, b, c) __builtin_amdgcn_mfma_f32_32x32x16_bf16(a, b, c, 0, 0, 0)
#define MFMA_QK(a, b, c) ((ABL & 8) ? (c) : MFMA32(a, b, c))
#define MFMA_PV(a, b, c) ((ABL & 4) ? (c) : MFMA32(a, b, c))
#define EXP2F(x) ((ABL & 1) ? (x) : __builtin_amdgcn_exp2f(x))
#define CINIT_H(P, half, tt) do { if (ABL & 2) { asm volatile("" : "+v"(P)); break; } const bool sel_ = NK == 2 || ((selmask >> ((tt) >> 2)) & 1u); const LAS unsigned char* tp_ = (sel_ ? tb_base + (tt) * 256 : tb_neg) + (half) * 128; \
        _Pragma("unroll") for (int g = 0; g < 4; ++g) { const f32x4 c0 = *(const LAS f32x4*)(tp_ + g * 32); P[4 * g] = c0[0]; P[4 * g + 1] = c0[1]; P[4 * g + 2] = c0[2]; P[4 * g + 3] = c0[3]; } } while (0)
#define CINIT(P0, P1, tt) do { CINIT_H(P0, 0, tt); CINIT_H(P1, 1, tt); } while (0)
#define KLOAD(kf, koff) do { _Pragma("unroll") for (int i_ = 0; i_ < 8; ++i_) kf[i_] = *(const LAS bf16x8*)(kp0 + (koff) + (i_ >> 1) * 2048 + (i_ & 1) * 512); } while (0)
#define EXP4(PC0, PC1, i) do { if ((i) < 4) { _Pragma("unroll") for (int e_ = 0; e_ < 4; ++e_) PC0[4 * (i) + e_] = EXP2F(PC0[4 * (i) + e_]); asm volatile("" : "+v"(PC0)); } \
        else { _Pragma("unroll") for (int e_ = 0; e_ < 4; ++e_) PC1[4 * ((i) - 4) + e_] = EXP2F(PC1[4 * ((i) - 4) + e_]); asm volatile("" : "+v"(PC1)); } } while (0)
#define STEP_HEAD(t) do { if ((t) + 5 < NT) ATT_DMAK((t) + 5, ko_i); if ((t) + 4 < NT) ATT_DMAV((t) + 4, vo_i); } while (0)
#define STEP_TAIL(t, ODD) do { if (ODD) { const int nfl = ((t) + 4 < NT ? 2 : 0) + ((t) + 3 < NT ? 1 : 0) + ((t) + 5 < NT ? 1 : 0); \
          if (nfl >= 4) asm volatile("s_waitcnt vmcnt(4) lgkmcnt(0)" ::: "memory"); else if (nfl == 3) asm volatile("s_waitcnt vmcnt(3) lgkmcnt(0)" ::: "memory"); \
          else if (nfl == 2) asm volatile("s_waitcnt vmcnt(2) lgkmcnt(0)" ::: "memory"); else if (nfl == 1) asm volatile("s_waitcnt vmcnt(1) lgkmcnt(0)" ::: "memory"); \
          else asm volatile("s_waitcnt vmcnt(0) lgkmcnt(0)" ::: "memory"); \
          __builtin_amdgcn_s_barrier(); asm volatile("" ::: "memory"); } SBAR(); \
        { s6 = s6 == 5 ? 0 : s6 + 1; const int r1 = s6 + 1, i5 = s6 + 5, i4 = s6 + 4; ko_r = (r1 >= 6 ? r1 - 6 : r1) * KSB; ko_i = (i5 >= 6 ? i5 - 6 : i5) * KSB; vo_r = s6 * VSB; vo_i = (i4 >= 6 ? i4 - 6 : i4) * VSB; } } while (0)
#define KLD1(i) ((ABL & 32) ? qr[(i) & 3] : *(const LAS bf16x8*)(kp0 + ko_r + ((i) >> 1) * 2048 + ((i) & 1) * 512))
#define QK_EXP(PC0, PC1, PN0, PN1, t) do { bf16x8 kf[8]; _Pragma("unroll") for (int i = 0; i < 8; ++i) kf[i] = KLD1(i); EXP4(PC0, PC1, 0); SBAR(); \
        _Pragma("unroll") for (int i = 0; i < 8; ++i) { \
            if (i & 1) PN1 = MFMA_QK(kf[i], qr[i >> 1], PN1); else PN0 = MFMA_QK(kf[i], qr[i >> 1], PN0); if (i + 1 < 8) EXP4(PC0, PC1, i + 1); if (i == 5) { VLOAD(0); VLOAD(1); } SBAR(); } } while (0)
#define SUMPACK(PC0, PC1, ks) do { if (ABL & 256) { asm volatile("" : "+v"(pw[(ks) & 1])); break; } _Pragma("unroll") for (int i = 0; i < 4; ++i) { \
            const float a_ = (ks) == 0 ? PC0[2 * i] : (ks) == 1 ? PC0[8 + 2 * i] : (ks) == 2 ? PC1[2 * i] : PC1[8 + 2 * i]; \
            const float b_ = (ks) == 0 ? PC0[2 * i + 1] : (ks) == 1 ? PC0[9 + 2 * i] : (ks) == 2 ? PC1[2 * i + 1] : PC1[9 + 2 * i]; \
            ls0 += a_; ls1 += b_; pw[(ks) & 1][i] = cvtpk(a_, b_); } asm volatile("" : "+v"(ls0), "+v"(ls1), "+v"(pw[(ks) & 1])); } while (0)
#define VLOAD(g) do { if (ABL & 32) { vl[(g) % 3] = s16x4{1, 2, 3, 4}; vh[(g) % 3] = s16x4{1, 2, 3, 4}; asm volatile("" : "+v"(vl[(g) % 3]), "+v"(vh[(g) % 3])); } else if ((g) < 4 * ND) { const int ks_ = (g) / ND, d_ = (g) % ND; vl[(g) % 3] = vtr(vp + d_ * 4096 + ks_ * 1024); vh[(g) % 3] = vtr(vp + d_ * 4096 + ks_ * 1024 + 512); } } while (0)
#define PV_SUM(PC0, PC1, t, CI, PRE) do { v4u pw[2]; \
        if (!(PRE)) { VLOAD(0); VLOAD(1); } SUMPACK(PC0, PC1, 0); SBAR(); __builtin_amdgcn_s_setprio(1); \
        _Pragma("unroll") for (int g = 0; g < 4 * ND; ++g) { const int ks = g / ND, d0 = g % ND; \
            VLOAD(g + 2); \
            { const s16x4 a_ = vl[g % 3], b_ = vh[g % 3]; const bf16x8 vf = {a_[0], a_[1], a_[2], a_[3], b_[0], b_[1], b_[2], b_[3]}; o[d0] = MFMA_PV(__builtin_bit_cast(bf16x8, pw[ks & 1]), vf, o[d0]); } \
            if (d0 == ND - 2 && ks < 3) SUMPACK(PC0, PC1, ks + 1); \
            if (g == 1 && (t) + 5 < NT) ATT_DMAK((t) + 5, ko_i); if (g == 3 && (t) + 4 < NT) ATT_DMAV((t) + 4, vo_i); \
            if (CI && g == 2 * ND + 1 && (t) + 2 < NTw) CINIT(PC0, PC1, (t) + 2); \
            SBAR(); } __builtin_amdgcn_s_setprio(0); } while (0)
#define STEP_FULL(PC0, PC1, PN0, PN1, t, ODD) do { const LAS unsigned char* vp = vp0 + vo_r; s16x4 vl[3], vh[3]; QK_EXP(PC0, PC1, PN0, PN1, t); PV_SUM(PC0, PC1, t, true, true); STEP_TAIL(t, ODD); } while (0)
#define STEP_LAST(PC0, PC1, t, ODD) do { const LAS unsigned char* vp = vp0 + vo_r; s16x4 vl[3], vh[3]; _Pragma("unroll") for (int i = 0; i < 8; ++i) EXP4(PC0, PC1, i); PV_SUM(PC0, PC1, t, false, false); STEP_TAIL(t, ODD); } while (0)
    if constexpr (NK == 1) {
    int s6 = 0, ko_r = KSB, ko_i = 5 * KSB, vo_r = 0, vo_i = 4 * VSB;
    f32x16 pA0, pA1, pB0, pB1;
    if (1 < NTw) CINIT(pB0, pB1, 1);
    { bf16x8 kf[8]; CINIT(pA0, pA1, 0); KLOAD(kf, 0);
#pragma unroll
      for (int i = 0; i < 8; ++i) { if (i & 1) pA1 = MFMA32(kf[i], qr[i >> 1], pA1); else pA0 = MFMA32(kf[i], qr[i >> 1], pA0); } }
    asm volatile("s_waitcnt lgkmcnt(0)" ::: "memory"); __builtin_amdgcn_s_barrier(); asm volatile("" ::: "memory"); SBAR();
    int t = 0;
    for (; t + 2 < NTw; t += 2) {
        unsigned long long t0_ = 0; if (DBG_MEASURE == 2 && blockIdx.x == 0 && w == 0) t0_ = __builtin_amdgcn_s_memtime();
        STEP_FULL(pA0, pA1, pB0, pB1, t, false); STEP_FULL(pB0, pB1, pA0, pA1, t + 1, true);
        if (DBG_MEASURE == 2 && blockIdx.x == 0 && w == 0) { const unsigned long long t1_ = __builtin_amdgcn_s_memtime(); LAS unsigned* dg = (LAS unsigned*)(lds + LDSCTL_OFF + 3072); if (lane == 0) { dg[0] += (unsigned)(t1_ - t0_); dg[1] += 2u; } }
    }
    if (NTw - t == 2) { STEP_FULL(pA0, pA1, pB0, pB1, t, false); STEP_LAST(pB0, pB1, t + 1, true); t += 2; }
    else { STEP_LAST(pA0, pA1, t, false); t += 1; }
    for (; t < NT; ++t) { STEP_HEAD(t); STEP_TAIL(t, (t & 1)); }
    } else {
    int ko_r = 0, ko_n = KSB, ko_i = 2 * KSB, vo_r = 2 * VSB, vo_n = 0, vo_i = VSB;
    f32x16 S0, S1; v4u pwA[4], pwB[4];
#define DHEAD(t) do { if ((t) + 2 < NT) ATT_DMAK((t) + 2, ko_i); if ((t) + 1 < NT) ATT_DMAV((t) + 1, vo_i); } while (0)
#define DTAIL(t) do { if ((t) + 2 < NT) asm volatile("s_waitcnt vmcnt(4) lgkmcnt(0)" ::: "memory"); else asm volatile("s_waitcnt vmcnt(0) lgkmcnt(0)" ::: "memory"); \
        __builtin_amdgcn_s_barrier(); asm volatile("" ::: "memory"); SBAR(); \
        { const int tk_ = ko_r; ko_r = ko_n; ko_n = ko_i; ko_i = tk_; const int tv_ = vo_r; vo_r = vo_n; vo_n = vo_i; vo_i = tv_; } } while (0)
#define DQK(t, PRE) do { bf16x8 kf[4]; _Pragma("unroll") for (int i = 0; i < 4; ++i) kf[i] = KLD1(i); SBAR(); \
        _Pragma("unroll") for (int i = 0; i < 8; ++i) { \
            if (i & 1) S1 = MFMA_QK(kf[i & 3], qr[i >> 1], S1); else S0 = MFMA_QK(kf[i & 3], qr[i >> 1], S0); \
            if (i + 4 < 8) kf[i & 3] = KLD1(i + 4); if ((PRE) && i == 6) VLOAD2(0); \
            if ((PRE) && i == 1 && (t) + 2 < NT) ATT_DMAK((t) + 2, ko_i); if ((PRE) && i == 4 && (t) + 1 < NT) ATT_DMAV((t) + 1, vo_i); SBAR(); } } while (0)
#define DSOFT(PW, g) do { if (ABL & 256) { asm volatile("" : "+v"(PW[(g) >> 2])); break; } float a_ = (g) < 8 ? S0[2 * (g)] : S1[2 * ((g) - 8)], b_ = (g) < 8 ? S0[2 * (g) + 1] : S1[2 * ((g) - 8) + 1]; \
        a_ = EXP2F(a_); b_ = EXP2F(b_); ls0 += a_; ls1 += b_; PW[(g) >> 2][(g) & 3] = cvtpk(a_, b_); asm volatile("" : "+v"(ls0), "+v"(ls1), "+v"(PW[(g) >> 2])); } while (0)
#define VLOAD2(g) do { if (ABL & 32) { vl[(g) & 1] = s16x4{1, 2, 3, 4}; vh[(g) & 1] = s16x4{1, 2, 3, 4}; asm volatile("" : "+v"(vl[(g) & 1]), "+v"(vh[(g) & 1])); } else if ((g) < 16) { const int ks_ = (g) >> 2, d_ = (g) & 3; vl[(g) & 1] = vtr(vp + d_ * 4096 + ks_ * 1024); vh[(g) & 1] = vtr(vp + d_ * 4096 + ks_ * 1024 + 512); } } while (0)
#define DPV(PWP, PWC, SOFT, t, PRE) do { if (!(PRE)) { VLOAD2(0); } SBAR(); \
        _Pragma("unroll") for (int g = 0; g < 16; ++g) { const int ks = g >> 2, d0 = g & 3; VLOAD2(g + 1); \
            { const s16x4 a2_ = vl[g & 1], b2_ = vh[g & 1]; const bf16x8 vf = {a2_[0], a2_[1], a2_[2], a2_[3], b2_[0], b2_[1], b2_[2], b2_[3]}; o[d0] = MFMA_PV(__builtin_bit_cast(bf16x8, PWP[ks]), vf, o[d0]); } \
            if (SOFT) DSOFT(PWC, g); \
            if (!(PRE) && g == 2 && (t) + 2 < NT) ATT_DMAK((t) + 2, ko_i); if (!(PRE) && g == 6 && (t) + 1 < NT) ATT_DMAV((t) + 1, vo_i); \
            if (SOFT && g == 8 && (t) + 1 < NTw) CINIT_H(S0, 0, (t) + 1); \
            SBAR(); } } while (0)
#define DSTEP_MID(PWP, PWC, t) do { const LAS unsigned char* vp = vp0 + vo_r; s16x4 vl[2], vh[2]; DQK(t, true); DPV(PWP, PWC, true, t, true); if ((t) + 1 < NTw) CINIT_H(S1, 1, (t) + 1); DTAIL(t); } while (0)
    { const LAS unsigned char* vp = vp0; s16x4 vl[2], vh[2]; (void)vp; (void)vl; (void)vh; DHEAD(0); CINIT(S0, S1, 0); DQK(0, false);
#pragma unroll
      for (int g = 0; g < 16; ++g) DSOFT(pwA, g);
      if (1 < NTw) CINIT(S0, S1, 1); DTAIL(0); }
    int t = 1;
    for (; t + 1 < NTw; t += 2) {
        unsigned long long t0_ = 0; if (DBG_MEASURE == 3 && blockIdx.x == 0 && w == 0) t0_ = __builtin_amdgcn_s_memtime();
        DSTEP_MID(pwA, pwB, t); DSTEP_MID(pwB, pwA, t + 1);
        if (DBG_MEASURE == 3 && blockIdx.x == 0 && w == 0) { const unsigned long long t1_ = __builtin_amdgcn_s_memtime(); LAS unsigned* dg = (LAS unsigned*)(lds + LDSCTL_OFF + 3072); if (lane == 0) { dg[0] += (unsigned)(t1_ - t0_); dg[1] += 2u; } }
    }
    if (t < NTw) { DSTEP_MID(pwA, pwB, t); ++t; { const LAS unsigned char* vp = vp0 + vo_r; s16x4 vl[2], vh[2]; DPV(pwB, pwA, false, t, false); } DTAIL(t); ++t; }
    else { { const LAS unsigned char* vp = vp0 + vo_r; s16x4 vl[2], vh[2]; DPV(pwA, pwB, false, t, false); } DTAIL(t); ++t; }
    for (; t <= NT; ++t) { DHEAD(t); DTAIL(t); }
#undef DHEAD
#undef DTAIL
#undef DQK
#undef DSOFT
#undef DPV
#undef VLOAD2
#undef DSTEP_MID
    }
    float lsum = ls0 + ls1;
#undef STEP_FULL
#undef STEP_LAST
#undef STEP_HEAD
#undef STEP_TAIL
#undef QK_EXP
#undef KLD1
#undef PV_SUM
#undef SUMPACK
#undef VLOAD
#undef EXP4
#undef KLOAD
#undef CINIT
#undef CINIT_H
#undef MFMA32
#undef MFMA_QK
#undef MFMA_PV
#undef EXP2F
#undef SBAR
#undef ATT_DMAK
#undef ATT_DMAV
    lsum += __shfl_xor(lsum, 32);
    epilogue<NK>(lds, ws, in, b, h, w, map, rb, qw0, lane, lsum, o);
}

template <int ABL> __device__ __forceinline__ void attn_phase(LAS unsigned char* lds, unsigned char* ws, const Inputs& in, int G, int v) {
    const float* CF = (const float*)(ws + WS_CONST);
    if (DBG_MEASURE && blockIdx.x == 0 && threadIdx.x == 0) { LAS unsigned* dg = (LAS unsigned*)(lds + LDSCTL_OFF + 3072); dg[0] = 0u; dg[1] = 0u;
        LAS unsigned long long* dq = (LAS unsigned long long*)(lds + LDSCTL_OFF + 3088); dq[0] = __builtin_amdgcn_s_memtime(); dq[1] = __builtin_amdgcn_s_memrealtime(); }
    for (int vv = v; vv < 256; vv += G) {
        if constexpr ((ABL & 4096) == 0)
        { const int j = vv & 3; build_table(lds, CF, 4 + ((vv >> 2) & 7));
          for (int k = 0; k < 4; ++k) { const int head = (vv >> 2) + 64 * k, b = head >> 3, h = head & 7;
              if constexpr ((ABL & 512) != 0) { const int wv = __builtin_amdgcn_readfirstlane(threadIdx.x >> 6);
                  if (wv < 4) { attn_unit<1, 0>(lds, ws, in, b, h, 7 - j, true); attn_unit<1, 0>(lds, ws, in, b, h, j, false); } else { attn_unit<1, (ABL & 0x1bf)>(lds, ws, in, b, h, 7 - j, true); attn_unit<1, (ABL & 0x1bf)>(lds, ws, in, b, h, j, false); } }
              else if constexpr ((ABL & 2048) != 0) { attn_unit<1, 0>(lds, ws, in, b, h, 7 - j, true); attn_unit<1, 0>(lds, ws, in, b, h, j, false); }
              else { attn_unit<1, ABL>(lds, ws, in, b, h, (ABL & 64) ? 0 : 7 - j, true); attn_unit<1, ABL>(lds, ws, in, b, h, (ABL & 64) ? 0 : j, false); } } }
        __syncthreads();
        if constexpr ((ABL & 1024) == 0)
        { const int j = vv & 7; build_table(lds, CF, (vv >> 3) & 3);
          for (int k = 0; k < 4; ++k) { const int head = (vv >> 3) + 32 * k, b = head >> 2, h = head & 3;
              attn_unit<2, (ABL & 0x1ff)>(lds, ws, in, b, h, (ABL & 64) ? 0 : 15 - j, false); attn_unit<2, (ABL & 0x1ff)>(lds, ws, in, b, h, (ABL & 64) ? 0 : j, false); } }
        __syncthreads();
    }
    if (DBG_MEASURE && blockIdx.x == 0 && threadIdx.x == 0) {
        const unsigned long long c1 = __builtin_amdgcn_s_memtime(), r1 = __builtin_amdgcn_s_memrealtime(); LAS unsigned* dg = (LAS unsigned*)(lds + LDSCTL_OFF + 3072); float eps = 0.f;
        LAS unsigned long long* dq = (LAS unsigned long long*)(lds + LDSCTL_OFF + 3088); const unsigned long long dbg_c0 = dq[0], dbg_r0 = dq[1];
        if (DBG_MEASURE == 1) eps = (float)(c1 - dbg_c0) / (float)(r1 - dbg_r0) * 0.1f / 4.0f;
        if (DBG_MEASURE == 2 || DBG_MEASURE == 3) eps = (float)dg[0] / (float)(dg[1] ? dg[1] : 1u) / 300.0f;
        if (DBG_MEASURE == 4) eps = (float)(r1 - dbg_r0) * 0.01f / 1000.0f;
        eps = floorf(eps * 50.0f + 0.5f) * 0.02f;
        ((float*)(ws + WS_CONST))[CF_DBG] = eps;
    }
}
}
template <int ABL> __device__ __forceinline__ void attn_phase(LAS unsigned char* lds, unsigned char* ws, const Inputs& in, int G, int v) { att::attn_phase<ABL>(lds, ws, in, G, v); }

#define RLX_AGENT __ATOMIC_RELAXED, __HIP_MEMORY_SCOPE_AGENT
#define XB_TMO      128
#define XB_XCNT(j)  (256  + 64 * (j))
#define XB_XSUB(j)  (1280 + 64 * (j))
#define XB_XGEN(j)  (2304 + 64 * (j))
#define XB_TOP      3328
#define XB_TOPGEN   3392
#define XCD_BAR_WORDS 3456
#define XB_SPIN_CAP (1u << 18)
constexpr int CW_BAR = 8192;
__device__ __forceinline__ unsigned xb_ld(unsigned* p)              { return __hip_atomic_load(p, __ATOMIC_RELAXED, __HIP_MEMORY_SCOPE_AGENT); }
__device__ __forceinline__ unsigned xb_add(unsigned* p, unsigned v) { return __hip_atomic_fetch_add(p, v, __ATOMIC_RELAXED, __HIP_MEMORY_SCOPE_AGENT); }
__device__ __forceinline__ unsigned xb_xcc_id() { return (unsigned)__builtin_amdgcn_s_getreg((3 << 11) | 20) & 0xFu; }
#define XB_SPIN(cond, bar) do { unsigned _sp = 0; while (cond) { __builtin_amdgcn_s_sleep(1); \
    if ((++_sp & 255u) == 0u) { if (xb_ld(&(bar)[XB_TMO])) break; if (_sp > XB_SPIN_CAP) { atomicAdd(&(bar)[XB_TMO], 1u); break; } } } } while (0)
struct XcdBarrier { unsigned* bar; unsigned x; volatile LAS unsigned* st; };
__device__ __forceinline__ XcdBarrier xcd_barrier_post(unsigned* bar, volatile LAS unsigned* st) {
    XcdBarrier b; b.bar = bar; b.x = xb_xcc_id(); b.st = st;
    if (threadIdx.x == 0) (void)xb_add(&bar[XB_XCNT(b.x)], 1u);
    return b;
}
__device__ __forceinline__ void xcd_barrier_complete(unsigned* bar, unsigned x, unsigned& nloc, unsigned& nx) {
    const unsigned G = gridDim.x * gridDim.y * gridDim.z;
    unsigned sum, cnt, mine, sp = 0u;
    for (;;) {
        sum = 0u; cnt = 0u; mine = 0u;
#pragma unroll
        for (unsigned j = 0; j < 16; ++j) { const unsigned c = xb_ld(&bar[XB_XCNT(j)]); sum += c; cnt += (c > 0u) ? 1u : 0u; mine = (j == x) ? c : mine; }
        if (sum == G) break;
        __builtin_amdgcn_s_sleep(1);
        if ((++sp & 255u) == 0u) { if (xb_ld(&bar[XB_TMO])) break; if (sp > XB_SPIN_CAP) { atomicAdd(&bar[XB_TMO], 1u); break; } }
    }
    nloc = mine > 0u ? mine : 1u; nx = cnt > 0u ? cnt : 1u;
}
__device__ __forceinline__ void xcd_barrier(const XcdBarrier& b) {
    asm volatile("s_waitcnt vmcnt(0)" ::: "memory");
    __syncthreads();
    if (threadIdx.x == 0) {
        unsigned* bar = b.bar;
        __builtin_amdgcn_s_waitcnt(0);
        unsigned nloc = b.st[0], nx = b.st[1];
        if (nloc == 0u) { xcd_barrier_complete(bar, b.x, nloc, nx); b.st[0] = nloc; b.st[1] = nx; }
        const unsigned old = xb_add(&bar[XB_XSUB(b.x)], 1u);
        const unsigned gen = old / nloc;
        if (old + 1u == (gen + 1u) * nloc) {
            __builtin_amdgcn_fence(__ATOMIC_RELEASE, "agent");
            asm volatile("s_waitcnt vmcnt(0)" ::: "memory");
            const unsigned og = xb_add(&bar[XB_TOP], 1u);
            const unsigned tg = og / nx;
            if (og + 1u == (tg + 1u) * nx) xb_add(&bar[XB_TOPGEN], 1u);
            else XB_SPIN(xb_ld(&bar[XB_TOPGEN]) == tg, bar);
            __builtin_amdgcn_fence(__ATOMIC_ACQUIRE, "agent");
            xb_add(&bar[XB_XGEN(b.x)], 1u);
            asm volatile("s_waitcnt vmcnt(0)" ::: "memory");
        } else {
            XB_SPIN(xb_ld(&bar[XB_XGEN(b.x)]) == gen, bar);
            __builtin_amdgcn_fence(__ATOMIC_ACQUIRE, "agent");
            asm volatile("s_waitcnt vmcnt(0)" ::: "memory");
        }
    }
    __syncthreads();
}

constexpr int N_PHASES = 8;
#ifndef DESYNC_TICKS
#define DESYNC_TICKS 0
#endif
#ifndef DESYNC_MASK
#define DESYNC_MASK 0
#endif
__device__ __forceinline__ void phase_stagger(int vcu, int ph) {
    if (!((DESYNC_MASK >> ph) & 1) || DESYNC_TICKS == 0) return;
    const unsigned long long t0 = __builtin_amdgcn_s_memrealtime(); const unsigned long long want = (unsigned long long)((vcu & 3) * DESYNC_TICKS);
    while (__builtin_amdgcn_s_memrealtime() - t0 < want) __builtin_amdgcn_s_sleep(4);
}
#ifndef PROBE_REP_MASK
#define PROBE_REP_MASK 0
#endif
#ifndef PROBE_REPN
#define PROBE_REPN 2
#endif
#define NREP(k) (((PROBE_REP_MASK >> (k)) & 1) ? PROBE_REPN : 1)
struct Args { Inputs in; float* out; unsigned char* ws; int ph_lo, ph_hi; };

__global__ void __launch_bounds__(512, 2) mega(Args args) {
    extern __shared__ __attribute__((aligned(16))) unsigned char lds_raw[];
    LAS unsigned char* lds = (LAS unsigned char*)lds_raw;
    const int tid = threadIdx.x, lane = tid & 63, wave = __builtin_amdgcn_readfirstlane(tid >> 6);
    const int G = gridDim.x; const int bx = blockIdx.x; const int vcu = (G % 8 == 0) ? (bx % 8) * (G / 8) + bx / 8 : bx;
    unsigned char* ws = args.ws; const Inputs& in = args.in;
    unsigned* ctl = (unsigned*)(ws + WS_CTL);
    volatile LAS unsigned* MISC = (volatile LAS unsigned*)(lds + MISC_OFF);
    LAS int* moetab = (LAS int*)(lds + MOETAB_OFF);
    for (int u = tid; u < (LDS_BYTES - LDSCTL_OFF) / 4; u += 512) ((LAS unsigned*)(lds + LDSCTL_OFF))[u] = 0u;
    __syncthreads();
    const int lo = args.ph_lo, hi = args.ph_hi;
    const bool multi = (hi - lo) > 1;
    XcdBarrier bar; bar.bar = ctl + CW_BAR; bar.x = 0; bar.st = nullptr;
    if (multi) bar = xcd_barrier_post(ctl + CW_BAR, MISC + 8);
#define IN(k) (lo <= (k) && (k) < hi)
#define SEAM(k) do { if (IN(k) && IN((k) + 1)) xcd_barrier(bar); } while (0)

    if (IN(0)) { for (int rep = 0; rep < NREP(0); ++rep) { p0_prologue(in, ws, vcu * 8 + wave, G * 8, lane, (LAS float*)(lds + wave * 16384)); if (rep + 1 < NREP(0)) xcd_barrier(bar); } SEAM(0); }

    if (IN(1)) {
        pg8::DenseOrder S; S.init((const bf16_t*)(ws + WS_XN), (const bf16_t*)(ws + WS_WIN), NTOK, NPROJ, DM, G, bx);
        if (tid < 256) ((LAS float*)(lds + GAINS_OFF))[tid] = ((const float*)(ws + WS_CONST))[CF_GAIN + tid];
        __syncthreads();
        EpiInProj E{ws, (const LAS float*)(lds + GAINS_OFF), !multi}; phase_stagger(vcu, 1);
        for (int rep = 0; rep < NREP(1); ++rep) { pg8::gemm_phase(lds, S, E); if (rep + 1 < NREP(1)) xcd_barrier(bar); } SEAM(1);
    }
    if (IN(2)) {
#ifdef HAVE_ATTN
        for (int rep = 0; rep < NREP(2); ++rep) { attn_phase<0>(lds, ws, in, G, vcu); if (rep + 1 < NREP(2)) xcd_barrier(bar); }
#endif
        SEAM(2);
    }
    if (IN(3)) {
        pg8::DenseOrder S; S.init((const bf16_t*)(ws + WS_Y), (const bf16_t*)(ws + WS_WOUT), NTOK, DM, DM, G, bx);
        EpiOutProj E{ws, in.x}; phase_stagger(vcu, 3);
        for (int rep = 0; rep < NREP(3); ++rep) { pg8::gemm_phase(lds, S, E); if (rep + 1 < NREP(3)) xcd_barrier(bar); } SEAM(3);
    }
    if (IN(4)) {
        pg8::DenseOrder S; S.init((const bf16_t*)(ws + WS_X1B), (const bf16_t*)(ws + WS_WR), NTOK, 256, DM, G, bx);
        EpiRoute E{ws, lds};
        pg8::gemm_phase<EpiRoute, pg8::DenseOrder, true>(lds, S, E); SEAM(4);
    }
#ifndef DEBUG_SKIP5
    if (IN(5)) {
        moe_tables(ws, moetab);
        MoeOrder S{(const bf16_t*)(ws + WS_X1B), (const bf16_t*)(ws + WS_WGU), DM, 0, (const int*)(ws + WS_LTOK), moetab, G, vcu};
        EpiGateUp E{ws, moetab}; phase_stagger(vcu, 5);
        for (int rep = 0; rep < NREP(5); ++rep) { pg8::gemm_phase(lds, S, E); if (rep + 1 < NREP(5)) xcd_barrier(bar); } SEAM(5);
    }
#endif
#ifndef DEBUG_SKIP6
    if (IN(6)) {
        if (!IN(5)) moe_tables(ws, moetab);
        MoeOrder S{(const bf16_t*)(ws + WS_HID2), (const bf16_t*)(ws + WS_WD), 2 * EHID, 3, (const int*)(ws + WS_LTOK), moetab, G, vcu};
        EpiDownPair E{ws, args.out}; phase_stagger(vcu, 6);
        for (int rep = 0; rep < NREP(6); ++rep) { pg8::gemm_phase<EpiDownPair, MoeOrder, false, true>(lds, S, E); if (rep + 1 < NREP(6)) xcd_barrier(bar); }
    }
#endif
#ifdef PROBE_EXTRA_BARRIERS
    if (multi) { for (int k = 0; k < PROBE_EXTRA_BARRIERS; ++k) xcd_barrier(bar); }
#endif
#undef IN
#undef SEAM
}

#ifdef PROBE_ATTN_ABL
__global__ void __launch_bounds__(512, 2) attn_probe(Args args) {
    extern __shared__ __attribute__((aligned(16))) unsigned char lds_raw_p[];
    LAS unsigned char* lds = (LAS unsigned char*)lds_raw_p;
    const int G = gridDim.x; const int bx = blockIdx.x; const int vcu = (G % 8 == 0) ? (bx % 8) * (G / 8) + bx / 8 : bx;
    attn_phase<PROBE_ATTN_ABL>(lds, args.ws, args.in, G, vcu);
}
#endif

#ifdef PROBE_UBENCH3
typedef float ub3_f2 __attribute__((ext_vector_type(2)));
template <int V> __global__ void __launch_bounds__(512, 2) ubench3(float* sink, int iters) {
    ub3_f2 r[32]; const ub3_f2 k = {1.0000001f, 0.9999999f};
#pragma unroll
    for (int i = 0; i < 32; ++i) r[i] = ub3_f2{1.0f + 0.001f * (float)(threadIdx.x + i), 1.0f - 0.001f * (float)i};
    for (int it = 0; it < iters; ++it) {
#pragma unroll
        for (int i = 0; i < 32; ++i) {
            if (V == 0) { asm volatile("v_mul_f32 %0, %0, %2\n\tv_mul_f32 %1, %1, %3" : "+v"(r[i].x), "+v"(r[i].y) : "v"(k.x), "v"(k.y)); }
            else if (V == 1) { asm volatile("v_pk_mul_f32 %0, %0, %1" : "+v"(r[i]) : "v"(k)); }
            else if (V == 2) { asm volatile("v_add_f32 %0, %0, %2\n\tv_add_f32 %1, %1, %3" : "+v"(r[i].x), "+v"(r[i].y) : "v"(k.x), "v"(k.y)); }
            else { asm volatile("v_pk_add_f32 %0, %0, %1" : "+v"(r[i]) : "v"(k)); }
        }
    }
    float s = 0.f;
#pragma unroll
    for (int i = 0; i < 32; ++i) s += r[i].x + r[i].y;
    if (s == 123.456f) sink[threadIdx.x] = s;
}
#endif
#ifdef PROBE_UBENCH2
typedef float ub2_f32x16 __attribute__((ext_vector_type(16))); typedef short ub2_bf16x8 __attribute__((ext_vector_type(8))); typedef short ub2_s16x4 __attribute__((ext_vector_type(4)));
template <int V> __global__ void __launch_bounds__(512, 2) ubench2(float* sink, int iters) {
    __shared__ __attribute__((aligned(16))) unsigned char sm[57344];
    LAS unsigned char* lds = (LAS unsigned char*)sm;
    for (int i = threadIdx.x; i < 57344 / 4; i += 512) ((LAS float*)lds)[i] = -0.001f * (float)(i & 1023);
    __syncthreads();
    const int lane = threadIdx.x & 63, hi = lane >> 5, r32 = lane & 31;
    ub2_f32x16 pa0, pa1, pb0 = {}, pb1 = {}, o0 = {}, o1 = {}; ub2_bf16x8 q = {1, 2, 3, 4, 5, 6, 7, 8};
#pragma unroll
    for (int i = 0; i < 16; ++i) { pa0[i] = -0.001f * (float)(threadIdx.x + i); pa1[i] = -0.002f * (float)(threadIdx.x + i); }
    asm volatile("" : "+v"(q));
    const LAS unsigned char* kp = lds + hi * 1024 + r32 * 16;
    const LAS unsigned char* vp = lds + 8192 + ((lane >> 4) & 1) * 32 + (lane & 3) * 8 + (4 * hi + ((lane & 15) >> 2)) * 64;
    const LAS unsigned char* tp = lds + 16384 + ((lane & 3) * 2384 + ((2047 - lane) & ~3)) * 4 % 36864;
    float ls0 = 0.f, ls1 = 0.f;
#define UB_MFMA(a, b, c) ((V & 128) ? (c) : __builtin_amdgcn_mfma_f32_32x32x16_bf16(a, b, c, 0, 0, 0))
#define UB_VLOAD(g) do { if ((g) < 8) { if (V & 2) { vl[(g) % 3] = __builtin_bit_cast(ub2_s16x4, __builtin_amdgcn_ds_read_tr16_b64_v4i16((LAS ub2_s16x4*)(vp + ((g) & 1) * 4096 + ((g) >> 1) * 1024))); vh[(g) % 3] = __builtin_bit_cast(ub2_s16x4, __builtin_amdgcn_ds_read_tr16_b64_v4i16((LAS ub2_s16x4*)(vp + ((g) & 1) * 4096 + ((g) >> 1) * 1024 + 512))); } else { vl[(g) % 3] = ub2_s16x4{1, 2, 3, 4}; vh[(g) % 3] = ub2_s16x4{4, 3, 2, 1}; asm volatile("" : "+v"(vl[(g) % 3]), "+v"(vh[(g) % 3])); } } } while (0)
#define UB_SUMPACK(PC0, PC1, ks) do { _Pragma("unroll") for (int i = 0; i < 4; ++i) { const float a_ = (ks) == 0 ? PC0[2 * i] : (ks) == 1 ? PC0[8 + 2 * i] : (ks) == 2 ? PC1[2 * i] : PC1[8 + 2 * i]; const float b_ = (ks) == 0 ? PC0[2 * i + 1] : (ks) == 1 ? PC0[9 + 2 * i] : (ks) == 2 ? PC1[2 * i + 1] : PC1[9 + 2 * i]; \
            if (V & 32) { ls0 += a_; ls1 += b_; pw[(ks) & 1][i] = att::cvtpk(a_, b_); } else pw[(ks) & 1][i] = __builtin_bit_cast(unsigned, a_); } asm volatile("" : "+v"(ls0), "+v"(ls1), "+v"(pw[(ks) & 1])); } while (0)
#define UB_R1(PC0, PC1, PN0, PN1) do { \
        ub2_bf16x8 kf[8]; \
        _Pragma("unroll") for (int i = 0; i < 8; ++i) { if (V & 1) kf[i] = *(const LAS ub2_bf16x8*)(kp + (i >> 1) * 2048 + (i & 1) * 512); else kf[i] = q; } \
        __builtin_amdgcn_sched_barrier(0); \
        _Pragma("unroll") for (int i = 0; i < 8; ++i) { \
            if (i & 1) PN1 = UB_MFMA(kf[i], q, PN1); else PN0 = UB_MFMA(kf[i], q, PN0); \
            if (V & 16) { _Pragma("unroll") for (int k = 0; k < 4; ++k) { const int e = 4 * i + k; if (e < 16) PC0[e] = __builtin_amdgcn_exp2f(PC0[e]); else PC1[e - 16] = __builtin_amdgcn_exp2f(PC1[e - 16]); } } \
            if (i < 4) asm volatile("" : "+v"(PC0)); else asm volatile("" : "+v"(PC1)); \
            __builtin_amdgcn_sched_barrier(0); } \
        if (V & 64) { asm volatile("s_waitcnt lgkmcnt(0)" ::: "memory"); __builtin_amdgcn_s_barrier(); __builtin_amdgcn_sched_barrier(0); } } while (0)
#define UB_R2(PC0, PC1, PN0, PN1) do { \
        v4u pw[2]; ub2_s16x4 vl[3], vh[3]; \
        UB_VLOAD(0); UB_VLOAD(1); UB_SUMPACK(PC0, PC1, 0); __builtin_amdgcn_sched_barrier(0); \
        _Pragma("unroll") for (int g = 0; g < 8; ++g) { const int ks = g / 2, d0 = g % 2; \
            UB_VLOAD(g + 2); \
            { const ub2_s16x4 a_ = vl[g % 3], b_ = vh[g % 3]; const ub2_bf16x8 vf = {a_[0], a_[1], a_[2], a_[3], b_[0], b_[1], b_[2], b_[3]}; \
              if (d0) o1 = UB_MFMA(__builtin_bit_cast(ub2_bf16x8, pw[ks & 1]), vf, o1); else o0 = UB_MFMA(__builtin_bit_cast(ub2_bf16x8, pw[ks & 1]), vf, o0); } \
            if (d0 == 0 && ks < 3) UB_SUMPACK(PC0, PC1, ks + 1); \
            if (g == 5) { if (V & 4) { _Pragma("unroll") for (int c = 0; c < 4; ++c) { const f32x4 c0 = *(const LAS f32x4*)(tp + c * 32), c1 = *(const LAS f32x4*)(tp + 128 + c * 32); \
                        PC0[4 * c] = c0[0]; PC0[4 * c + 1] = c0[1]; PC0[4 * c + 2] = c0[2]; PC0[4 * c + 3] = c0[3]; PC1[4 * c] = c1[0]; PC1[4 * c + 1] = c1[1]; PC1[4 * c + 2] = c1[2]; PC1[4 * c + 3] = c1[3]; } } \
                else { asm volatile("" : "+v"(PC0), "+v"(PC1)); } } \
            __builtin_amdgcn_sched_barrier(0); } \
        if (V & 8) { asm volatile("s_waitcnt lgkmcnt(0)" ::: "memory"); __builtin_amdgcn_s_barrier(); __builtin_amdgcn_sched_barrier(0); } } while (0)
#define UB_STEP(PC0, PC1, PN0, PN1) do { UB_R1(PC0, PC1, PN0, PN1); UB_R2(PC0, PC1, PN0, PN1); } while (0)
    if ((V & 256) && (threadIdx.x >> 6) >= 4) { UB_R1(pb0, pb1, pa0, pa1); }
    for (int it = 0; it < iters; it += 2) { UB_STEP(pa0, pa1, pb0, pb1); UB_STEP(pb0, pb1, pa0, pa1); }
    float s = ls0 + ls1;
#pragma unroll
    for (int i = 0; i < 16; ++i) s += o0[i] + o1[i] + pa0[i] + pa1[i] + pb0[i] + pb1[i];
    if (s == 123.456f) sink[threadIdx.x] = s;
#undef UB_VLOAD
#undef UB_SUMPACK
#undef UB_STEP
#undef UB_R1
#undef UB_R2
#undef UB_MFMA
}
#endif

#ifdef PROBE_UBENCH
typedef float ub_f32x16 __attribute__((ext_vector_type(16))); typedef short ub_bf16x8 __attribute__((ext_vector_type(8)));
template <int V> __global__ void __launch_bounds__(512, 2) ubench(float* sink, int iters) {
    ub_f32x16 a0 = {}, a1 = {}; ub_bf16x8 x = {1, 2, 3, 4, 5, 6, 7, 8}, y = {8, 7, 6, 5, 4, 3, 2, 1};
    float e[32];
#pragma unroll
    for (int i = 0; i < 32; ++i) e[i] = -0.001f * (float)(threadIdx.x + i);
    asm volatile("" : "+v"(x), "+v"(y));
    for (int it = 0; it < iters; ++it) {
#pragma unroll
        for (int g = 0; g < 16; ++g) {
            if (V & 1) { if (g & 1) a1 = __builtin_amdgcn_mfma_f32_32x32x16_bf16(x, y, a1, 0, 0, 0); else a0 = __builtin_amdgcn_mfma_f32_32x32x16_bf16(x, y, a0, 0, 0, 0); }
            if (V & 2) {
#pragma unroll
                for (int k = 0; k < 4; ++k) { const int i = (4 * g + k) & 31; e[i] = __builtin_amdgcn_exp2f(e[i]) - 1.0f; } }
            if (V & 4) {
#pragma unroll
                for (int k = 0; k < 2; ++k) { const int i = (2 * g + k) & 31; e[i] = __builtin_amdgcn_exp2f(e[i]) - 1.0f; } }
            __builtin_amdgcn_sched_barrier(0);
        }
    }
    float s = 0.f;
#pragma unroll
    for (int i = 0; i < 32; ++i) s += e[i];
#pragma unroll
    for (int i = 0; i < 16; ++i) s += a0[i] + a1[i];
    if (s == 123.456f) sink[threadIdx.x] = s;
}
#endif

extern "C" void kernel_launch(void* const* d_in, const int* in_sizes, int n_in, void* d_out, int out_size, void* d_ws, size_t ws_size, hipStream_t stream) {
    static int grid = 0;
    if (grid == 0) {
        if (n_in != 20 || in_sizes[0] != NTOK * DM || out_size != NTOK * DM || ws_size < WS_END) { fprintf(stderr, "kernel_launch: unexpected shapes (n_in %d, ws %zu)\n", n_in, ws_size); grid = -1; return; }
        int dev = 0, cus = 0, per_cu = 0;
        if (hipGetDevice(&dev) != hipSuccess || hipDeviceGetAttribute(&cus, hipDeviceAttributeMultiprocessorCount, dev) != hipSuccess) { grid = -1; return; }
        if (hipFuncSetAttribute((const void*)mega, hipFuncAttributeMaxDynamicSharedMemorySize, LDS_BYTES) != hipSuccess) { fprintf(stderr, "kernel_launch: hipFuncSetAttribute failed\n"); grid = -1; return; }
        if (hipOccupancyMaxActiveBlocksPerMultiprocessor(&per_cu, (const void*)mega, 512, LDS_BYTES) != hipSuccess || per_cu < 1) { fprintf(stderr, "kernel_launch: occupancy query says %d blocks per CU\n", per_cu); (void)hipGetLastError(); grid = -1; return; }
        grid = cus;
    }
    if (grid < 0) return;
    Args a{};
    const float** ip = (const float**)&a.in;
    for (int i = 0; i < 20; ++i) ip[i] = (const float*)d_in[i];
    a.out = (float*)d_out; a.ws = (unsigned char*)d_ws; a.ph_lo = 0; a.ph_hi = N_PHASES;
    (void)hipMemsetAsync((unsigned char*)d_ws + WS_CTL, 0, CTL_ZERO_BYTES, stream);
    hipLaunchKernelGGL(mega, dim3(grid), dim3(512), LDS_BYTES, stream, a);
#ifdef PROBE_ATTN_ABL
    { static bool ad = false; if (!ad) { (void)hipFuncSetAttribute((const void*)attn_probe, hipFuncAttributeMaxDynamicSharedMemorySize, LDS_BYTES); ad = true; }
      hipLaunchKernelGGL(attn_probe, dim3(grid), dim3(512), LDS_BYTES, stream, a); }
#endif
#ifdef PROBE_UBENCH3
    hipLaunchKernelGGL(ubench3<PROBE_UBENCH3>, dim3(grid), dim3(512), 0, stream, (float*)((unsigned char*)d_ws + WS_SS), 20000);
#endif
#ifdef PROBE_UBENCH2
    hipLaunchKernelGGL(ubench2<PROBE_UBENCH2>, dim3(grid), dim3(512), 0, stream, (float*)((unsigned char*)d_ws + WS_SS), 1000);
#endif
#ifdef PROBE_UBENCH
    hipLaunchKernelGGL(ubench<PROBE_UBENCH>, dim3(grid), dim3(PROBE_UB_THREADS), 0, stream, (float*)((unsigned char*)d_ws + WS_SS), 1000);
#endif
#ifdef PROBE_EXTRA_LO
    for (int k = PROBE_EXTRA_LO; k < PROBE_EXTRA_HI; ++k) { a.ph_lo = k; a.ph_hi = k + 1; hipLaunchKernelGGL(mega, dim3(grid), dim3(512), LDS_BYTES, stream, a); }
#endif
}
```
